# Optimizing an MI355X kernel written in HIP

```python
import math
import jax, jax.numpy as jnp
from jax import lax
import numpy as np

D_MODEL = 1024
BATCH = 4
SEQ = 4096
DEPTH = 2

D_FF = 2816
HEAD_DIM = 64
DA_HEADS = 4
DA_QK = 32
MLA_HEADS = 6
MLA_Q_RANK = 256
MLA_KV_RANK = 128
MLA_NOPE = 64
MLA_ROPE = 32
ROPE_THETA = 10000.0
NSA_HEADS = 6
NSA_KV_HEADS = 2
NSA_GROUP = NSA_HEADS // NSA_KV_HEADS
NSA_CMP_LEN = 32
NSA_CMP_STRIDE = 16
NSA_CMP_HIDDEN = 128
NSA_SLC_LEN = 64
NSA_TOPN = 16
NSA_WINDOW = 512
FORCE_BONUS = 100.0
Q_BLOCK = 128
SLC_Q_BLOCK = 64
NEG_INF = -1e30
RMS_EPS = 1e-6

MIX_WIDTH = (DA_HEADS + MLA_HEADS + NSA_HEADS) * HEAD_DIM
IN_SPLITS = (
    DA_HEADS * 2 * DA_QK,
    DA_HEADS * 2 * DA_QK,
    DA_HEADS * HEAD_DIM,
    MLA_Q_RANK,
    MLA_KV_RANK,
    MLA_ROPE,
    NSA_HEADS * HEAD_DIM,
    NSA_KV_HEADS * HEAD_DIM,
    NSA_KV_HEADS * HEAD_DIM,
    NSA_KV_HEADS * HEAD_DIM,
    NSA_KV_HEADS * HEAD_DIM,
    NSA_KV_HEADS * HEAD_DIM,
    NSA_KV_HEADS * HEAD_DIM,
    3 * NSA_HEADS,
)
D_IN = sum(IN_SPLITS)

kernel_name = "hybrid_diffattn_mla_nsa_macaron_adaln"


def rmsnorm(x, g):
    xf = x.astype(jnp.float32)
    y = xf * lax.rsqrt(jnp.mean(xf * xf, axis=-1, keepdims=True) + RMS_EPS)
    return y.astype(x.dtype) * g


def modulate(x, g, shift, scale):
    return rmsnorm(x, g) * (1.0 + scale) + shift


def swiglu(h, w_in, w_out):
    gate, up = jnp.split(h @ w_in, 2, axis=-1)
    return (jax.nn.silu(gate) * up) @ w_out


def alibi_slopes(n):
    def pow2(m):
        start = 2.0 ** (-8.0 / m)
        return [start ** (i + 1) for i in range(m)]
    if math.log2(n).is_integer():
        s = pow2(n)
    else:
        closest = 2 ** int(math.floor(math.log2(n)))
        s = pow2(closest) + pow2(2 * closest)[0::2][: n - closest]
    return np.asarray(s, dtype=np.float32)


def rope_tables(T):
    inv = ROPE_THETA ** (-jnp.arange(0, MLA_ROPE, 2, dtype=jnp.float32) / MLA_ROPE)
    ang = jnp.arange(T, dtype=jnp.float32)[:, None] * inv[None, :]
    ang = jnp.concatenate([ang, ang], axis=-1)
    return jnp.cos(ang), jnp.sin(ang)


def apply_rope(x, cos, sin):
    half = x.shape[-1] // 2
    rot = jnp.concatenate([-x[..., half:], x[..., :half]], axis=-1)
    return x * cos.astype(x.dtype) + rot * sin.astype(x.dtype)


def masked_softmax(s, mask):
    p = jax.nn.softmax(jnp.where(mask, s, NEG_INF), axis=-1)
    return jnp.where(mask, p, 0.0)


def blocked_map(fn, n_blocks):
    ys = lax.map(fn, jnp.arange(n_blocks))
    nb, B, H, Qb, d = ys.shape
    return jnp.moveaxis(ys, 0, 2).reshape(B, H, nb * Qb, d)


def causal_block_probs(q_blk, k, s0, scale, slopes):
    Qb, T = q_blk.shape[2], k.shape[2]
    dist = (s0 + jnp.arange(Qb))[:, None] - jnp.arange(T)[None, :]
    s = jnp.einsum('bhqd,bhkd->bhqk', q_blk, k).astype(jnp.float32) * scale
    if slopes is not None:
        s = s - slopes[:, None, None] * dist.astype(jnp.float32)
    return masked_softmax(s, dist >= 0)


def to_heads(t, n):
    B, T, _ = t.shape
    return t.reshape(B, T, n, -1).transpose(0, 2, 1, 3)


def merge_heads(o):
    B, H, T, d = o.shape
    return o.transpose(0, 2, 1, 3).reshape(B, T, H * d)


def diff_attention(q, k, v, lam_params, lam_init, subln_g, slopes):
    q1, q2 = q[..., :DA_QK], q[..., DA_QK:]
    k1, k2 = k[..., :DA_QK], k[..., DA_QK:]
    lp = lam_params.astype(jnp.float32)
    lam = jnp.exp(jnp.sum(lp[0] * lp[1])) - jnp.exp(jnp.sum(lp[2] * lp[3])) + lam_init
    scale = DA_QK ** -0.5

    def block(i):
        s0 = i * Q_BLOCK
        p1 = causal_block_probs(lax.dynamic_slice_in_dim(q1, s0, Q_BLOCK, axis=2), k1, s0, scale, slopes)
        p2 = causal_block_probs(lax.dynamic_slice_in_dim(q2, s0, Q_BLOCK, axis=2), k2, s0, scale, slopes)
        return jnp.einsum('bhqk,bhkd->bhqd', (p1 - lam * p2).astype(v.dtype), v)

    o = blocked_map(block, q.shape[2] // Q_BLOCK)
    return rmsnorm(o, subln_g) * (1.0 - lam_init)


def mla_attention(c_q, c_kv, k_rope, q_norm_g, kv_norm_g, w_uq, w_ukv, cos, sin):
    B, T, _ = c_q.shape
    q = (rmsnorm(c_q, q_norm_g) @ w_uq).reshape(B, T, MLA_HEADS, MLA_NOPE + MLA_ROPE).transpose(0, 2, 1, 3)
    kv = (rmsnorm(c_kv, kv_norm_g) @ w_ukv).reshape(B, T, MLA_HEADS, MLA_NOPE + HEAD_DIM).transpose(0, 2, 1, 3)
    k_nope, v = kv[..., :MLA_NOPE], kv[..., MLA_NOPE:]
    q = jnp.concatenate([q[..., :MLA_NOPE], apply_rope(q[..., MLA_NOPE:], cos, sin)], axis=-1)
    k_pe = apply_rope(k_rope, cos, sin)[:, None]
    k = jnp.concatenate([k_nope, jnp.broadcast_to(k_pe, (B, MLA_HEADS, T, MLA_ROPE))], axis=-1)
    scale = (MLA_NOPE + MLA_ROPE) ** -0.5

    def block(i):
        s0 = i * Q_BLOCK
        p = causal_block_probs(lax.dynamic_slice_in_dim(q, s0, Q_BLOCK, axis=2), k, s0, scale, None)
        return jnp.einsum('bhqk,bhkd->bhqd', p.astype(v.dtype), v)

    return blocked_map(block, T // Q_BLOCK)


def compress_blocks(blocks, pos, w1, w2):
    B, G, N, L, dh = blocks.shape
    z = (blocks + pos).reshape(B, G, N, L * dh)
    return jax.nn.gelu(z @ w1) @ w2


def nsa_attention(q, kc, vc, ks, vs, kw, vw, gate_logits, cmp_pos, cmp_w1, cmp_w2, slopes):
    B, T, _ = q.shape
    G, R, dh = NSA_KV_HEADS, NSA_GROUP, HEAD_DIM
    scale = dh ** -0.5
    q = q.reshape(B, T, G, R, dh).transpose(0, 2, 3, 1, 4)
    kc, vc, ks, vs, kw, vw = [t.reshape(B, T, G, dh).transpose(0, 2, 1, 3) for t in (kc, vc, ks, vs, kw, vw)]
    sl = slopes.reshape(G, R)
    qpos = jnp.arange(T)

    n_cmp = (T - NSA_CMP_LEN) // NSA_CMP_STRIDE + 1
    c_start = jnp.arange(n_cmp) * NSA_CMP_STRIDE
    tok = c_start[:, None] + jnp.arange(NSA_CMP_LEN)[None, :]
    k_cmp = compress_blocks(kc[:, :, tok], cmp_pos[0], cmp_w1[0], cmp_w2[0])
    v_cmp = compress_blocks(vc[:, :, tok], cmp_pos[1], cmp_w1[1], cmp_w2[1])
    dist_c = qpos[:, None] - (c_start + NSA_CMP_LEN - 1)[None, :]
    s_c = (jnp.einsum('bgrtd,bgnd->bgrtn', q, k_cmp).astype(jnp.float32) * scale
           - sl[None, :, :, None, None] * dist_c.astype(jnp.float32))
    p_c = masked_softmax(s_c, dist_c >= 0)
    o_cmp = jnp.einsum('bgrtn,bgnd->bgrtd', p_c.astype(v_cmp.dtype), v_cmp)

    n_sel = T // NSA_SLC_LEN
    n_top = min(NSA_TOPN, n_sel)
    s_start = jnp.arange(n_sel) * NSA_SLC_LEN
    cover = ((c_start[:, None] < s_start[None, :] + NSA_SLC_LEN)
             & (c_start[:, None] + NSA_CMP_LEN > s_start[None, :])).astype(jnp.float32)
    importance = jnp.einsum('bgrtn,nj->bgtj', p_c, cover)
    cur = qpos // NSA_SLC_LEN
    blk = jnp.arange(n_sel)
    valid = blk[None, :] <= cur[:, None]
    forced = (blk[None, :] == 0) | (blk[None, :] >= cur[:, None] - 1)
    score = jnp.where(valid, importance + FORCE_BONUS * forced, -1.0)
    top_score, top_idx = lax.top_k(score, n_top)
    top_valid = top_score >= 0.0

    ks_blk = ks.reshape(B, G, n_sel, NSA_SLC_LEN, dh)
    vs_blk = vs.reshape(B, G, n_sel, NSA_SLC_LEN, dh)
    gather = jax.vmap(jax.vmap(lambda blocks, ix: blocks[ix]))
    M = n_top * NSA_SLC_LEN

    def slc_block(i):
        s0 = i * SLC_Q_BLOCK
        q_b = lax.dynamic_slice_in_dim(q, s0, SLC_Q_BLOCK, axis=3)
        idx_b = lax.dynamic_slice_in_dim(top_idx, s0, SLC_Q_BLOCK, axis=2)
        ok_b = lax.dynamic_slice_in_dim(top_valid, s0, SLC_Q_BLOCK, axis=2)
        k_g = gather(ks_blk, idx_b).reshape(B, G, SLC_Q_BLOCK, M, dh)
        v_g = gather(vs_blk, idx_b).reshape(B, G, SLC_Q_BLOCK, M, dh)
        tok_pos = (idx_b[..., None] * NSA_SLC_LEN + jnp.arange(NSA_SLC_LEN)).reshape(B, G, SLC_Q_BLOCK, M)
        dist = (s0 + jnp.arange(SLC_Q_BLOCK))[None, None, :, None] - tok_pos
        ok = jnp.repeat(ok_b, NSA_SLC_LEN, axis=-1) & (dist >= 0)
        s = (jnp.einsum('bgrqd,bgqmd->bgrqm', q_b, k_g).astype(jnp.float32) * scale
             - sl[None, :, :, None, None] * dist[:, :, None].astype(jnp.float32))
        p = masked_softmax(s, ok[:, :, None])
        o = jnp.einsum('bgrqm,bgqmd->bgrqd', p.astype(v_g.dtype), v_g)
        return o.reshape(B, G * R, SLC_Q_BLOCK, dh)

    o_slc = blocked_map(slc_block, T // SLC_Q_BLOCK).reshape(B, G, R, T, dh)

    kw_pad = jnp.pad(kw, ((0, 0), (0, 0), (NSA_WINDOW, 0), (0, 0)))
    vw_pad = jnp.pad(vw, ((0, 0), (0, 0), (NSA_WINDOW, 0), (0, 0)))
    KW = NSA_WINDOW + Q_BLOCK

    def win_block(i):
        s0 = i * Q_BLOCK
        q_b = lax.dynamic_slice_in_dim(q, s0, Q_BLOCK, axis=3)
        k_b = lax.dynamic_slice_in_dim(kw_pad, s0, KW, axis=2)
        v_b = lax.dynamic_slice_in_dim(vw_pad, s0, KW, axis=2)
        kpos = s0 - NSA_WINDOW + jnp.arange(KW)
        dist = (s0 + jnp.arange(Q_BLOCK))[:, None] - kpos[None, :]
        ok = (dist >= 0) & (dist < NSA_WINDOW) & (kpos[None, :] >= 0)
        s = (jnp.einsum('bgrqd,bgkd->bgrqk', q_b, k_b).astype(jnp.float32) * scale
             - sl[None, :, :, None, None] * dist.astype(jnp.float32))
        p = masked_softmax(s, ok)
        o = jnp.einsum('bgrqk,bgkd->bgrqd', p.astype(v_b.dtype), v_b)
        return o.reshape(B, G * R, Q_BLOCK, dh)

    o_win = blocked_map(win_block, T // Q_BLOCK).reshape(B, G, R, T, dh)

    gates = jax.nn.sigmoid(gate_logits.reshape(B, T, 3, G, R).transpose(2, 0, 3, 4, 1))[..., None]
    o = gates[0] * o_cmp + gates[1] * o_slc + gates[2] * o_win
    return o.transpose(0, 3, 1, 2, 4).reshape(B, T, G * R * dh)


def setup_inputs(seed: int = 0) -> dict:
    key = jax.random.key(seed)
    k = jax.random.split(key, 24)

    def nrm(kk, shape, scale):
        return jax.random.normal(kk, shape, jnp.float32) * scale

    D, F, L = D_MODEL, D_FF, DEPTH
    return {
        "x": nrm(k[0], (BATCH, SEQ, D), 1.0),
        "c": nrm(k[1], (BATCH, D), 1.0),
        "ada_w": nrm(k[2], (L, D, 9 * D), 0.5 * D ** -0.5),
        "ada_b": nrm(k[3], (L, 9 * D), 0.02),
        "norm_ffn1": 1.0 + nrm(k[4], (L, D), 0.01),
        "norm_mix": 1.0 + nrm(k[5], (L, D), 0.01),
        "norm_ffn2": 1.0 + nrm(k[6], (L, D), 0.01),
        "ffn1_w_in": nrm(k[7], (L, D, 2 * F), D ** -0.5),
        "ffn1_w_out": nrm(k[8], (L, F, D), F ** -0.5),
        "ffn2_w_in": nrm(k[9], (L, D, 2 * F), D ** -0.5),
        "ffn2_w_out": nrm(k[10], (L, F, D), F ** -0.5),
        "w_in": nrm(k[11], (L, D, D_IN), D ** -0.5),
        "w_out": nrm(k[12], (L, MIX_WIDTH, D), MIX_WIDTH ** -0.5),
        "da_lambda": nrm(k[13], (L, 4, DA_QK), 0.1),
        "da_subln": 1.0 + nrm(k[14], (L, 2 * DA_QK), 0.01),
        "mla_q_norm": 1.0 + nrm(k[15], (L, MLA_Q_RANK), 0.01),
        "mla_kv_norm": 1.0 + nrm(k[16], (L, MLA_KV_RANK), 0.01),
        "mla_w_uq": nrm(k[17], (L, MLA_Q_RANK, MLA_HEADS * (MLA_NOPE + MLA_ROPE)), MLA_Q_RANK ** -0.5),
        "mla_w_ukv": nrm(k[18], (L, MLA_KV_RANK, MLA_HEADS * (MLA_NOPE + HEAD_DIM)), MLA_KV_RANK ** -0.5),
        "nsa_cmp_pos": nrm(k[19], (L, 2, NSA_CMP_LEN, HEAD_DIM), 0.1),
        "nsa_cmp_w1": nrm(k[20], (L, 2, NSA_CMP_LEN * HEAD_DIM, NSA_CMP_HIDDEN), (NSA_CMP_LEN * HEAD_DIM) ** -0.5),
        "nsa_cmp_w2": nrm(k[21], (L, 2, NSA_CMP_HIDDEN, HEAD_DIM), NSA_CMP_HIDDEN ** -0.5),
        "final_norm": 1.0 + nrm(k[22], (D,), 0.01),
    }


def reference(x, c, ada_w, ada_b, norm_ffn1, norm_mix, norm_ffn2, ffn1_w_in, ffn1_w_out,
              ffn2_w_in, ffn2_w_out, w_in, w_out, da_lambda, da_subln, mla_q_norm, mla_kv_norm,
              mla_w_uq, mla_w_ukv, nsa_cmp_pos, nsa_cmp_w1, nsa_cmp_w2, final_norm):
    B, T, D = x.shape
    split_at = np.cumsum(IN_SPLITS)[:-1].tolist()
    da_slopes = jnp.asarray(alibi_slopes(DA_HEADS))
    nsa_slopes = jnp.asarray(alibi_slopes(NSA_HEADS))
    cos, sin = rope_tables(T)
    cond = jax.nn.silu(c)
    for l in range(DEPTH):
        mods = (cond @ ada_w[l] + ada_b[l]).reshape(B, 9, 1, D)
        sh1, sc1, g1, sh2, sc2, g2, sh3, sc3, g3 = [mods[:, i] for i in range(9)]

        x = x + 0.5 * g1 * swiglu(modulate(x, norm_ffn1[l], sh1, sc1), ffn1_w_in[l], ffn1_w_out[l])

        h = modulate(x, norm_mix[l], sh2, sc2)
        (a_q, a_k, a_v, b_cq, b_ckv, b_kr, c_q, c_kc, c_vc, c_ks, c_vs, c_kw, c_vw,
         c_g) = jnp.split(h @ w_in[l], split_at, axis=-1)
        lam_init = 0.8 - 0.6 * math.exp(-0.3 * l)
        o_a = merge_heads(diff_attention(to_heads(a_q, DA_HEADS), to_heads(a_k, DA_HEADS),
                                         to_heads(a_v, DA_HEADS), da_lambda[l], lam_init,
                                         da_subln[l], da_slopes))
        o_b = merge_heads(mla_attention(b_cq, b_ckv, b_kr, mla_q_norm[l], mla_kv_norm[l],
                                        mla_w_uq[l], mla_w_ukv[l], cos, sin))
        o_c = nsa_attention(c_q, c_kc, c_vc, c_ks, c_vs, c_kw, c_vw, c_g,
                            nsa_cmp_pos[l], nsa_cmp_w1[l], nsa_cmp_w2[l], nsa_slopes)
        mix = jnp.concatenate([o_a, o_b, o_c], axis=-1) @ w_out[l]
        x = x + g2 * mix

        x = x + 0.5 * g3 * swiglu(modulate(x, norm_ffn2[l], sh3, sc3), ffn2_w_in[l], ffn2_w_out[l])
    return rmsnorm(x, final_norm)
```

```cpp
#include <hip/hip_runtime.h>
#include <hip/hip_cooperative_groups.h>
#include <cstdio>
#include <cstdint>
namespace cg = cooperative_groups;
__device__ __forceinline__ int pg8_opq_tid() { int v = (int)threadIdx.x; asm volatile("" : "+v"(v)); return v; }
namespace pg8 {
#define PG8_LAS __attribute__((address_space(3)))
typedef unsigned short bf16_t;
typedef short bf16x8 __attribute__((ext_vector_type(8)));
typedef float f32x4 __attribute__((ext_vector_type(4)));
typedef unsigned u32x4 __attribute__((ext_vector_type(4)));
constexpr int BM = 256, BK = 64, HALF = 128, HTB = HALF * BK * 2  , STAGE_BYTES = 8 * HTB, NXCD = 8, WGM = 8;

__host__ __device__ __forceinline__ int lds_byte(int r, int c) { const int st = (r >> 4) * 2 + (c >> 5), rr = r & 15, cc = c & 31, ob = rr * 64 + cc * 2; return st * 1024 + (ob ^ (((ob >> 9) & 1) << 5)); }
__host__ __device__ __forceinline__ void stage_rc(int b, int& R, int& C) { const int st = b / 1024, sb = b % 1024, swz = sb ^ (((sb >> 9) & 1) << 5); R = (st >> 1) * 16 + swz / 64; C = (st & 1) * 32 + (swz % 64) / 2; }
__host__ __device__ __forceinline__ int perm32(int rho) { const int n = rho >> 4, i = rho & 15; return 8 * (i >> 2) + 4 * n + (i & 3); }

struct Unit { int pm, pn; };
struct Gemm { const bf16_t* A; const bf16_t* Bt; int M, N, K; };

struct StaticOrder {
    int nM, nN, nwg, G, c;
    __host__ __device__ void init(int M, int N, int G_, int c_) { nM = M / BM; nN = N / BM; nwg = nM * nN; G = G_; c = c_; }
    __host__ __device__ bool next(int i, Unit& u) const {
        const long L = (long)i * G + c; if (L >= nwg) return false;
        int wgid = (int)L; { const int q = nwg / NXCD, r = nwg % NXCD, xcd = wgid % NXCD, off = wgid / NXCD; wgid = (xcd < r ? xcd * (q + 1) : r * (q + 1) + (xcd - r) * q) + off; }
        const int nig = WGM * nN, gid = wgid / nig, fm = gid * WGM, gsz = (nM - fm) < WGM ? (nM - fm) : WGM;
        u.pm = fm + ((wgid % nig) % gsz); u.pn = (wgid % nig) / gsz; return true;
    }
    __device__ __forceinline__ void a_ready(const Unit&) const {}
    __device__ __forceinline__ void done(const Unit&) const {}
};

__device__ __forceinline__ unsigned cvt_pk_bf16(float lo, float hi) { unsigned r; asm volatile("v_cvt_pk_bf16_f32 %0, %1, %2" : "=v"(r) : "v"(lo), "v"(hi)); return r; }
typedef float f32x2 __attribute__((ext_vector_type(2)));
__device__ __forceinline__ f32x2 gelu_pk(f32x2 v) {
    const f32x2 av = __builtin_elementwise_abs(v), d = av * 0.2316418882f + 1.0f;
    f32x2 t; t.x = __builtin_amdgcn_rcpf(d.x); t.y = __builtin_amdgcn_rcpf(d.y);
    f32x2 q = t * 0.5307027145f + (-0.7265760135f); q = q * t + 0.7107068705f; q = q * t + (-0.142248368f); q = q * t + 0.127414796f; q = q * t;
    const f32x2 s = (v * v) * (-0.72134752044f);
    f32x2 e; e.x = __builtin_amdgcn_exp2f(s.x); e.y = __builtin_amdgcn_exp2f(s.y);
    const f32x2 m = v * (q * e), r = v - m;
    f32x2 o; o.x = v.x < 0.f ? m.x : r.x; o.y = v.y < 0.f ? m.y : r.y; return o;
}

template <int ACT  > struct EpiBf16 {
    static constexpr bool PERM = true, AFTER_DRAIN = false; static_assert(ACT == 0 || ACT == 1, "EpiBf16: ACT is 0 (none) or 1 (gelu_pk)");
    bf16_t* O; int ldc; const float* bias; int split_cols; size_t split_stride; float scale0;
    __device__ __forceinline__ void operator()(const f32x4 (&acc)[2][2][4][2], const Unit& u, int wr, int wc, int fr, int fq) const {
        const int row0 = u.pm * BM + wr * 64 + fr; int colt = u.pn * BM; bf16_t* base = O;
        float sc = 1.f; if (split_cols) { const int t = colt / split_cols; base += (size_t)t * split_stride; colt -= t * split_cols; if (t == 0) sc = scale0; }
        const int col0 = colt + wc * 32 + 8 * fq, bcol0 = u.pn * BM + wc * 32 + 8 * fq;
        f32x4 bv[2][2];
#pragma unroll
        for (int bj = 0; bj < 2; ++bj)
#pragma unroll
            for (int n = 0; n < 2; ++n) bv[bj][n] = bias ? *(const f32x4*)(bias + bcol0 + bj * HALF + 4 * n) : (f32x4){0.f, 0.f, 0.f, 0.f};
#pragma unroll
        for (int ai = 0; ai < 2; ++ai)
#pragma unroll
            for (int m = 0; m < 4; ++m) { bf16_t* rowp = base + (size_t)(row0 + ai * HALF + m * 16) * ldc + col0;
#pragma unroll
                for (int bj = 0; bj < 2; ++bj) { f32x4 v0 = acc[ai][bj][m][0] + bv[bj][0], v1 = acc[ai][bj][m][1] + bv[bj][1];
                    if (ACT == 1) { f32x2 a = gelu_pk((f32x2){v0[0], v0[1]}), b = gelu_pk((f32x2){v0[2], v0[3]}), c = gelu_pk((f32x2){v1[0], v1[1]}), d = gelu_pk((f32x2){v1[2], v1[3]});
                        v0 = (f32x4){a.x, a.y, b.x, b.y}; v1 = (f32x4){c.x, c.y, d.x, d.y}; }
                    v0 = v0 * sc; v1 = v1 * sc; u32x4 w; w.x = cvt_pk_bf16(v0[0], v0[1]); w.y = cvt_pk_bf16(v0[2], v0[3]); w.z = cvt_pk_bf16(v1[0], v1[1]); w.w = cvt_pk_bf16(v1[2], v1[3]);
                    *(u32x4*)(rowp + bj * HALF) = w; } }
    }
};
template <class Epi, class Sched, bool ALIGN_EPI = false, bool SP2 = false>
__device__ __forceinline__ void gemm_phase(PG8_LAS unsigned char* lds, const Gemm g, const Sched& S, const Epi& E) {
    const int tid = pg8_opq_tid(), wid = __builtin_amdgcn_readfirstlane(tid >> 6), lane = tid & 63, wr = wid >> 2, wc = wid & 3, fr = lane & 15, fq = lane >> 4;
    const int K = g.K, nt = K / BK;
    unsigned voffA[2], voffB[2];
#pragma unroll
    for (int i = 0; i < 2; ++i) { int R, C; stage_rc(tid * 16 + i * 8192, R, C); const int Rb = Epi::PERM ? ((R & ~31) + perm32(R & 31)) : R;
        voffA[i] = (unsigned)(R * K + C) * 2u; voffB[i] = (unsigned)(Rb * K + C) * 2u; }
    const size_t kstep = (size_t)(BK * 2);
    const size_t hstep = (size_t)HALF * K * 2;
    const size_t tstep = 2 * hstep;
    const unsigned ldsw = (unsigned)wid * 1024u;
    const int aoff = lds_byte(wr * 64 + fr, fq * 8), boff = lds_byte(wc * 32 + fr, fq * 8);
#define PG8_SA(b, h) (((b) * 2 + (h)) * HTB)
#define PG8_SB(b, h) ((4 + (b) * 2 + (h)) * HTB)
#define PG8_STAGE(bufoff, gbase, voff) do { _Pragma("unroll") for (int _i = 0; _i < 2; ++_i) \
        __builtin_amdgcn_global_load_lds((const unsigned*)((const char*)(gbase) + (voff)[_i]), (PG8_LAS unsigned*)(lds + (bufoff) + ldsw + _i * 8192), 16, 0, 0); } while (0)
#define PG8_LDA(dst, b, h) do { _Pragma("unroll") for (int m = 0; m < 4; ++m) _Pragma("unroll") for (int k = 0; k < 2; ++k) dst[m][k] = *(const PG8_LAS bf16x8*)(lds + PG8_SA(b, h) + aoff + m * 2048 + k * 1024); } while (0)
#define PG8_LDB(dst, b, h) do { _Pragma("unroll") for (int n = 0; n < 2; ++n) _Pragma("unroll") for (int k = 0; k < 2; ++k) dst[n][k] = *(const PG8_LAS bf16x8*)(lds + PG8_SB(b, h) + boff + n * 2048 + k * 1024); } while (0)
#define PG8_MMA(ai, bj, At, Bt) do { __builtin_amdgcn_s_setprio(1); _Pragma("unroll") for (int m = 0; m < 4; ++m) _Pragma("unroll") for (int n = 0; n < 2; ++n) _Pragma("unroll") for (int k = 0; k < 2; ++k) \
        acc[ai][bj][m][n] = __builtin_amdgcn_mfma_f32_16x16x32_bf16(Bt[n][k], At[m][k], acc[ai][bj][m][n], 0, 0, 0); __builtin_amdgcn_s_setprio(0); } while (0)
#define PG8_WAIT_V(n) asm volatile("s_waitcnt vmcnt(" #n ")" ::: "memory")
#define PG8_WAIT_L(n) asm volatile("s_waitcnt lgkmcnt(" #n ")" ::: "memory")
#define PG8_BAR __builtin_amdgcn_s_barrier()
#define PG8_SCHED __builtin_amdgcn_sched_barrier(0)
    Unit cur, nxt; int ui = 0;
    if (!S.next(0, cur)) return;
    f32x4 acc[2][2][4][2];
#pragma unroll
    for (int a = 0; a < 2; ++a)
#pragma unroll
        for (int b = 0; b < 2; ++b)
#pragma unroll
            for (int m = 0; m < 4; ++m)
#pragma unroll
                for (int n = 0; n < 2; ++n) acc[a][b][m][n] = (f32x4){0.f, 0.f, 0.f, 0.f};
    bf16x8 At[4][2], B0[2][2], B1[2][2];
    const char* cA = (const char*)g.A + (size_t)cur.pm * tstep; const char* cB = (const char*)g.Bt + (size_t)cur.pn * tstep;
    S.a_ready(cur);
    if constexpr (SP2) {
        PG8_STAGE(PG8_SB(0, 0), cB, voffB); PG8_STAGE(PG8_SB(0, 1), cB + hstep, voffB); PG8_STAGE(PG8_SA(0, 0), cA, voffA); PG8_STAGE(PG8_SA(0, 1), cA + hstep, voffA);
        if (wr == 1) PG8_BAR;
        PG8_WAIT_V(2); PG8_BAR;
        PG8_STAGE(PG8_SB(1, 0), cB + kstep, voffB); PG8_STAGE(PG8_SA(1, 0), cA + kstep, voffA); PG8_STAGE(PG8_SB(1, 1), cB + hstep + kstep, voffB);
        PG8_WAIT_V(6); PG8_BAR;
    } else {
        PG8_STAGE(PG8_SB(0, 0), cB, voffB); PG8_STAGE(PG8_SA(0, 0), cA, voffA); PG8_STAGE(PG8_SB(0, 1), cB + hstep, voffB); PG8_STAGE(PG8_SA(0, 1), cA + hstep, voffA);
        if (wr == 1) PG8_BAR;
        PG8_WAIT_V(4); PG8_BAR;
        PG8_STAGE(PG8_SB(1, 0), cB + kstep, voffB); PG8_STAGE(PG8_SA(1, 0), cA + kstep, voffA); PG8_STAGE(PG8_SB(1, 1), cB + hstep + kstep, voffB);
        PG8_WAIT_V(6); PG8_BAR;
    }
    for (;;) {
        const bool has_next = S.next(ui + 1, nxt);
        const char* nA = has_next ? (const char*)g.A + (size_t)nxt.pm * tstep : cA; const char* nB = has_next ? (const char*)g.Bt + (size_t)nxt.pn * tstep : cB;
        for (int t = 0; t < nt; t += 2) {
            const bool last = (t == nt - 2);
            const char* a1 = cA + (size_t)(t + 1) * kstep;
            const char* a2 = last ? nA : cA + (size_t)(t + 2) * kstep; const char* b2 = last ? nB : cB + (size_t)(t + 2) * kstep;
            const char* a3 = a2 + kstep; const char* b3 = b2 + kstep;
            if (last && has_next) S.a_ready(nxt);
            if constexpr (SP2) {
            PG8_LDB(B0, 0, 0); PG8_LDB(B1, 0, 1); PG8_SCHED; PG8_LDA(At, 0, 0); PG8_STAGE(PG8_SA(1, 1), a1 + hstep, voffA);
            PG8_WAIT_V(8); PG8_WAIT_L(0); PG8_BAR; PG8_MMA(0, 0, At, B0); PG8_MMA(0, 1, At, B1); PG8_BAR; PG8_SCHED;
            PG8_LDA(At, 0, 1); PG8_STAGE(PG8_SB(0, 0), b2, voffB); PG8_STAGE(PG8_SB(0, 1), b2 + hstep, voffB); PG8_STAGE(PG8_SA(0, 0), a2, voffA);
            PG8_WAIT_V(8); PG8_WAIT_L(0); PG8_BAR; PG8_MMA(1, 0, At, B0); PG8_MMA(1, 1, At, B1); PG8_BAR; PG8_SCHED;
            PG8_LDB(B0, 1, 0); PG8_LDB(B1, 1, 1); PG8_SCHED; PG8_LDA(At, 1, 0); PG8_STAGE(PG8_SA(0, 1), a2 + hstep, voffA);
            PG8_WAIT_V(8); PG8_WAIT_L(0); PG8_BAR; PG8_MMA(0, 0, At, B0); PG8_MMA(0, 1, At, B1); PG8_BAR; PG8_SCHED;
            PG8_LDA(At, 1, 1); PG8_STAGE(PG8_SB(1, 0), b3, voffB); PG8_STAGE(PG8_SB(1, 1), b3 + hstep, voffB); PG8_STAGE(PG8_SA(1, 0), a3, voffA);
            PG8_WAIT_V(8); PG8_WAIT_L(0); PG8_BAR; PG8_MMA(1, 0, At, B0); PG8_MMA(1, 1, At, B1); PG8_BAR; PG8_SCHED;
            } else {
            PG8_LDB(B0, 0, 0); PG8_SCHED; PG8_LDA(At, 0, 0); PG8_STAGE(PG8_SA(1, 1), a1 + hstep, voffA);
            PG8_WAIT_L(8); PG8_BAR; PG8_WAIT_L(0); PG8_MMA(0, 0, At, B0); PG8_BAR; PG8_SCHED;
            PG8_LDB(B1, 0, 1); PG8_STAGE(PG8_SB(0, 0), b2, voffB);
            PG8_BAR; PG8_WAIT_L(0); PG8_MMA(0, 1, At, B1); PG8_BAR;
            PG8_LDA(At, 0, 1); PG8_STAGE(PG8_SA(0, 0), a2, voffA);
            PG8_BAR; PG8_WAIT_L(0); PG8_MMA(1, 0, At, B0); PG8_BAR; PG8_SCHED;
            PG8_STAGE(PG8_SB(0, 1), b2 + hstep, voffB);
            PG8_WAIT_V(6); PG8_BAR; PG8_MMA(1, 1, At, B1); PG8_BAR;
            PG8_LDB(B0, 1, 0); PG8_SCHED; PG8_LDA(At, 1, 0); PG8_STAGE(PG8_SA(0, 1), a2 + hstep, voffA);
            PG8_WAIT_L(8); PG8_BAR; PG8_WAIT_L(0); PG8_MMA(0, 0, At, B0); PG8_BAR; PG8_SCHED;
            PG8_LDB(B1, 1, 1); PG8_STAGE(PG8_SB(1, 0), b3, voffB);
            PG8_BAR; PG8_WAIT_L(0); PG8_MMA(0, 1, At, B1); PG8_BAR;
            PG8_LDA(At, 1, 1); PG8_STAGE(PG8_SA(1, 0), a3, voffA);
            PG8_BAR; PG8_WAIT_L(0); PG8_MMA(1, 0, At, B0); PG8_BAR; PG8_SCHED;
            PG8_STAGE(PG8_SB(1, 1), b3 + hstep, voffB);
            PG8_WAIT_V(6); PG8_BAR; PG8_MMA(1, 1, At, B1); PG8_BAR;
            }
        }
        if constexpr (ALIGN_EPI) { if (wr == 0) PG8_BAR; }
        if constexpr (!Epi::AFTER_DRAIN) { E(acc, cur, wr, wc, fr, fq); S.done(cur); }
        if (!has_next) break;
#pragma unroll
        for (int a = 0; a < 2; ++a)
#pragma unroll
            for (int b = 0; b < 2; ++b)
#pragma unroll
                for (int m = 0; m < 4; ++m)
#pragma unroll
                    for (int n = 0; n < 2; ++n) acc[a][b][m][n] = (f32x4){0.f, 0.f, 0.f, 0.f};
        cur = nxt; cA = nA; cB = nB; ++ui;
        if constexpr (ALIGN_EPI) { if (wr == 1) PG8_BAR; }
    }
    PG8_WAIT_V(0);
    if constexpr (!ALIGN_EPI) { if (wr == 0) PG8_BAR; }
    PG8_BAR;
    if constexpr (Epi::AFTER_DRAIN) { E.fused(acc, cur, wr, wc, fr, fq, lds, wid, lane); S.done(cur); }
#undef PG8_SA
#undef PG8_SB
#undef PG8_STAGE
#undef PG8_LDA
#undef PG8_LDB
#undef PG8_MMA
#undef PG8_WAIT_V
#undef PG8_WAIT_L
#undef PG8_BAR
#undef PG8_SCHED
}
}

#define LAS __attribute__((address_space(3)))
typedef unsigned short bf16_t;
typedef short bf16x8 __attribute__((ext_vector_type(8)));
typedef short s16x4 __attribute__((ext_vector_type(4)));
typedef float f32x4 __attribute__((ext_vector_type(4)));
typedef float f32x2 __attribute__((ext_vector_type(2)));
typedef float f32x16 __attribute__((ext_vector_type(16)));
typedef unsigned u32x4 __attribute__((ext_vector_type(4)));
typedef unsigned u32x2 __attribute__((ext_vector_type(2)));
typedef __bf16 bf16x2_t __attribute__((ext_vector_type(2)));

#ifndef EN_MIX
#define EN_MIX 1
#endif
#ifndef EN_DA
#define EN_DA 1
#endif
#ifndef EN_MLA
#define EN_MLA 1
#endif
#ifndef EN_WIN
#define EN_WIN 1
#endif
#ifndef EN_CMP
#define EN_CMP 1
#endif
#ifndef EN_SLC
#define EN_SLC 1
#endif

constexpr int NB = 4, T = 4096, D = 1024, M = NB * T, F = 2816, F2 = 5632, DIN = 2354, DINP = 2560;
constexpr int NTHR = 512, NWAVE = 8, LDS_BYTES = 147456, FETCH_OFF = LDS_BYTES - 64;
constexpr int C_AQ = 0, C_AK = 256, C_AV = 512, C_BKR = 1152, C_CQ = 1184, C_KC = 1568, C_VC = 1696, C_KS = 1824, C_VS = 1952, C_KW = 2080, C_VW = 2208, C_G = 2336;
constexpr float LOG2E = 1.4426950408889634f, RMS_EPS = 1e-6f, NEGBIG = -1e30f;

constexpr size_t MiB = 1u << 20, KiB = 1u << 10;
constexpr size_t WS_CTL = 0;
constexpr size_t WS_MODS = 64 * KiB;
constexpr size_t WS_ROPE = 512 * KiB;
constexpr size_t WS_POSB = 1 * MiB;
constexpr size_t WS_SSQ = 1 * MiB + 64 * KiB;
constexpr size_t WS_KCMP = 2 * MiB;
constexpr size_t WS_SEL = 3 * MiB;
constexpr size_t WS_W = 4 * MiB;
constexpr size_t W_1A = 0, W_1B = W_1A + (size_t)F2 * D * 2, W_2A = W_1B + (size_t)D * F * 2, W_2B = W_2A + (size_t)F2 * D * 2,
                 W_IN = W_2B + (size_t)D * F * 2, W_OUT = W_IN + (size_t)DINP * D * 2, W_UQ = W_OUT + (size_t)D * D * 2, W_UKV = W_UQ + 768 * 256 * 2,
                 W_C1 = W_UKV + 768 * 128 * 2, W_C2 = W_C1 + 2 * 128 * 2048 * 2, W_END = W_C2 + 2 * 64 * 128 * 2;
static_assert(WS_W + W_END <= 48 * MiB, "weights");
constexpr size_t WS_XN = 48 * MiB;
constexpr size_t WS_U = 80 * MiB;
constexpr size_t WS_CQ = 168 * MiB;
constexpr size_t WS_CKV = 176 * MiB;
constexpr size_t WS_MQ = 180 * MiB;
constexpr size_t WS_MKV = 204 * MiB;
constexpr size_t WS_END = 228 * MiB;

__device__ __forceinline__ unsigned cvtpk(float lo, float hi) { f32x2 v = {lo, hi}; bf16x2_t b = __builtin_convertvector(v, bf16x2_t); return __builtin_bit_cast(unsigned, b); }
__device__ __forceinline__ float bf2f(short b) { return __uint_as_float(((unsigned)(unsigned short)b) << 16); }
__device__ __forceinline__ float wave_sum(float v) {
#pragma unroll
    for (int o = 1; o < 64; o <<= 1) v += __shfl_xor(v, o);
    return v;
}
__device__ __forceinline__ float fast_exp2(float x) { return __builtin_amdgcn_exp2f(x); }
__device__ __forceinline__ float fast_rcp(float x) { return __builtin_amdgcn_rcpf(x); }
__device__ __forceinline__ float sigmoid_f(float x) { return fast_rcp(1.0f + fast_exp2(-x * LOG2E)); }
__device__ __forceinline__ int crow(int i, int h) { return (i & 3) + 8 * (i >> 2) + 4 * h; }
__device__ __forceinline__ int opq(int v) { asm volatile("" : "+v"(v)); return v; }
#define MFMA32(a, b, c) __builtin_amdgcn_mfma_f32_32x32x16_bf16((a), (b), (c), 0, 0, 0)
#define MFMA16(a, b, c) __builtin_amdgcn_mfma_f32_16x16x32_bf16((a), (b), (c), 0, 0, 0)

struct Args { const float* in[23]; float* out; unsigned char* ws; };
__device__ __forceinline__ unsigned char* ws_opq(unsigned char* p) {
    const unsigned long long v = (unsigned long long)p;
    unsigned lo = (unsigned)__builtin_amdgcn_readfirstlane((int)(unsigned)v), hi = (unsigned)__builtin_amdgcn_readfirstlane((int)(unsigned)(v >> 32));
    asm volatile("" : "+s"(lo), "+s"(hi));
    return (unsigned char*)(((unsigned long long)hi << 32) | (unsigned long long)lo);
}
#define WSB(A_) ws_opq((A_).ws)

struct EpiSwiGLU {
    static constexpr bool PERM = true, AFTER_DRAIN = false;
    bf16_t* O;
    __device__ __forceinline__ void operator()(const f32x4 (&acc)[2][2][4][2], const pg8::Unit& u, int wr_, int wc_, int fr_, int fq_) const {
        const int t_ = opq(threadIdx.x), w_ = __builtin_amdgcn_readfirstlane(t_ >> 6), wr = w_ >> 2, wc = w_ & 3, fr = t_ & 15, fq = (t_ >> 4) & 3;
        const int row0 = u.pm * 256 + wr * 64 + fr, col0 = u.pn * 128 + wc * 32 + 8 * fq;
#pragma unroll
        for (int ai = 0; ai < 2; ++ai)
#pragma unroll
            for (int m = 0; m < 4; ++m) {
                bf16_t* rowp = O + (size_t)(row0 + ai * 128 + m * 16) * F + col0;
                float r[8];
#pragma unroll
                for (int n = 0; n < 2; ++n)
#pragma unroll
                    for (int j = 0; j < 4; ++j) { const float g = acc[ai][0][m][n][j], up = acc[ai][1][m][n][j]; r[n * 4 + j] = g * sigmoid_f(g) * up; }
                u32x4 w; w.x = cvtpk(r[0], r[1]); w.y = cvtpk(r[2], r[3]); w.z = cvtpk(r[4], r[5]); w.w = cvtpk(r[6], r[7]);
                *(u32x4*)rowp = w;
            }
    }
};
struct EpiResid {
    static constexpr bool PERM = false, AFTER_DRAIN = false;
    const float* resid; float* out; const float* gate; float coef;
    __device__ __forceinline__ void operator()(const f32x4 (&acc)[2][2][4][2], const pg8::Unit& u, int wr_, int wc_, int fr_, int fq_) const {
        const int t_ = opq(threadIdx.x), w_ = __builtin_amdgcn_readfirstlane(t_ >> 6), wr = w_ >> 2, wc = w_ & 3, fr = t_ & 15, fq = (t_ >> 4) & 3;
        const int row0 = u.pm * 256 + wr * 64 + fr, b = (u.pm * 256) >> 12, col0 = u.pn * 256 + wc * 32 + 4 * fq;
#pragma unroll
        for (int bj = 0; bj < 2; ++bj)
#pragma unroll
            for (int n = 0; n < 2; ++n) {
                const int c = col0 + bj * 128 + n * 16;
                const f32x4 gv = *(const f32x4*)(gate + (size_t)b * 9216 + c) * coef;
#pragma unroll
                for (int ai = 0; ai < 2; ++ai)
#pragma unroll
                    for (int m = 0; m < 4; ++m) {
                        const size_t off = (size_t)(row0 + ai * 128 + m * 16) * D + c;
                        const f32x4 o = *(const f32x4*)(resid + off) + gv * acc[ai][bj][m][n];
                        *(f32x4*)(out + off) = o;
                        if (m & 1) asm volatile("" ::: "memory");
                    }
            }
    }
};
struct EpiProj {
    static constexpr bool PERM = true, AFTER_DRAIN = false;
    bf16_t* PROJ; bf16_t* CQ; bf16_t* CKV; float* ssq_q; float* ssq_kv;
    __device__ __forceinline__ void operator()(const f32x4 (&acc)[2][2][4][2], const pg8::Unit& u, int wr_, int wc_, int fr_, int fq_) const {
        const int t_ = opq(threadIdx.x), w_ = __builtin_amdgcn_readfirstlane(t_ >> 6), wr = w_ >> 2, wc = w_ & 3, fr = t_ & 15, fq = (t_ >> 4) & 3;
        const int row0 = u.pm * 256 + wr * 64 + fr;
#pragma unroll
        for (int bj = 0; bj < 2; ++bj) {
            bf16_t* base; int ld, cb; float* ssq;
            if (u.pn == 3) { base = CQ; ld = 256; cb = bj * 128; ssq = ssq_q; }
            else if (u.pn == 4 && bj == 0) { base = CKV; ld = 128; cb = 0; ssq = ssq_kv; }
            else { base = PROJ; ld = DINP; cb = u.pn * 256 + bj * 128; ssq = nullptr; }
            const int col0 = cb + wc * 32 + 8 * fq;
#pragma unroll
            for (int ai = 0; ai < 2; ++ai)
#pragma unroll
                for (int m = 0; m < 4; ++m) {
                    const int row = row0 + ai * 128 + m * 16;
                    const f32x4 v0 = acc[ai][bj][m][0], v1 = acc[ai][bj][m][1];
                    u32x4 w; w.x = cvtpk(v0[0], v0[1]); w.y = cvtpk(v0[2], v0[3]); w.z = cvtpk(v1[0], v1[1]); w.w = cvtpk(v1[2], v1[3]);
                    *(u32x4*)(base + (size_t)row * ld + col0) = w;
                    if (ssq) {
                        float s = (v0[0] * v0[0] + v0[1] * v0[1]) + (v0[2] * v0[2] + v0[3] * v0[3]) + (v1[0] * v1[0] + v1[1] * v1[1]) + (v1[2] * v1[2] + v1[3] * v1[3]);
                        s += __shfl_xor(s, 16); s += __shfl_xor(s, 32);
                        if (fq == 0) atomicAdd(ssq + row, s);
                    }
                    asm volatile("" ::: "memory");
                }
        }
    }
};
struct EpiRowScale {
    static constexpr bool PERM = true, AFTER_DRAIN = false;
    bf16_t* O; int ldc; const float* ssq; float inv_n;
    __device__ __forceinline__ void operator()(const f32x4 (&acc)[2][2][4][2], const pg8::Unit& u, int wr_, int wc_, int fr_, int fq_) const {
        const int t_ = opq(threadIdx.x), w_ = __builtin_amdgcn_readfirstlane(t_ >> 6), wr = w_ >> 2, wc = w_ & 3, fr = t_ & 15, fq = (t_ >> 4) & 3;
        const int row0 = u.pm * 256 + wr * 64 + fr, col0 = u.pn * 256 + wc * 32 + 8 * fq;
#pragma unroll
        for (int ai = 0; ai < 2; ++ai)
#pragma unroll
            for (int m = 0; m < 4; ++m) {
                const int row = row0 + ai * 128 + m * 16;
                const float rs = rsqrtf(ssq[row] * inv_n + RMS_EPS);
#pragma unroll
                for (int bj = 0; bj < 2; ++bj) {
                    const f32x4 v0 = acc[ai][bj][m][0] * rs, v1 = acc[ai][bj][m][1] * rs;
                    u32x4 w; w.x = cvtpk(v0[0], v0[1]); w.y = cvtpk(v0[2], v0[3]); w.z = cvtpk(v1[0], v1[1]); w.w = cvtpk(v1[2], v1[3]);
                    *(u32x4*)(O + (size_t)row * ldc + col0 + bj * 128) = w;
                }
                asm volatile("" ::: "memory");
            }
    }
};

template <int MODE> __device__ __forceinline__ int wrow(int n) {
    if (MODE == 1) return n < F ? ((n >> 7) * 256 + (n & 127)) : (((n - F) >> 7) * 256 + 128 + ((n - F) & 127));
    return n;
}
template <int MODE>
__device__ __forceinline__ void cvt_item(const float* W, int K, int N, int NP, bf16_t* WT, const float* kscale, LAS float* scr, int item, int lane) {
    const int nblk = NP / 32, kb = item / nblk, nb = item % nblk, k0 = 64 * kb, n0 = 32 * nb;
    const int n_rd = n0 + (lane & 31);
#pragma unroll 8
    for (int i = 0; i < 32; ++i) {
        const int kk = 2 * i + (lane >> 5);
        float v = (n_rd < N) ? W[(size_t)(k0 + kk) * N + n_rd] : 0.f;
        if (kscale) v *= kscale[k0 + kk];
        scr[kk * 33 + (lane & 31)] = v;
    }
    asm volatile("s_waitcnt lgkmcnt(0)" ::: "memory");
    const int c = lane & 7;
#pragma unroll
    for (int j = 0; j < 4; ++j) {
        const int n = (lane >> 3) + 8 * j; const LAS float* s = scr + (8 * c) * 33 + n;
        u32x4 o; o.x = cvtpk(s[0 * 33], s[1 * 33]); o.y = cvtpk(s[2 * 33], s[3 * 33]); o.z = cvtpk(s[4 * 33], s[5 * 33]); o.w = cvtpk(s[6 * 33], s[7 * 33]);
        *(u32x4*)(WT + (size_t)wrow<MODE>(n0 + n) * K + k0 + 8 * c) = o;
    }
    asm volatile("s_waitcnt lgkmcnt(0)" ::: "memory");
}
__device__ __forceinline__ void convert_layer(const Args& A, int l, LAS unsigned char* lds) {
    const int tid = opq(threadIdx.x), lane = tid & 63, wid = __builtin_amdgcn_readfirstlane(tid >> 6), gw = blockIdx.x * NWAVE + wid, ngw = gridDim.x * NWAVE;
    LAS float* scr = (LAS float*)(lds + wid * 8704);
    unsigned char* wb = WSB(A) + WS_W;
    constexpr int I_A = 16 * 176, I_B = 44 * 32, I_IN = 16 * 80, I_OUT = 16 * 32, I_UQ = 4 * 24, I_UKV = 2 * 24, I_C1 = 32 * 4, I_C2 = 2 * 2;
    constexpr int NITEMS = 2 * I_A + 2 * I_B + I_IN + I_OUT + I_UQ + I_UKV + 2 * I_C1 + 2 * I_C2;
    for (int it = gw; it < NITEMS; it += ngw) {
        int r = it;
        if (r < I_A) { cvt_item<1>(A.in[7] + (size_t)l * D * F2, D, F2, F2, (bf16_t*)(wb + W_1A), nullptr, scr, r, lane); continue; } r -= I_A;
        if (r < I_A) { cvt_item<1>(A.in[9] + (size_t)l * D * F2, D, F2, F2, (bf16_t*)(wb + W_2A), nullptr, scr, r, lane); continue; } r -= I_A;
        if (r < I_B) { cvt_item<0>(A.in[8] + (size_t)l * F * D, F, D, D, (bf16_t*)(wb + W_1B), nullptr, scr, r, lane); continue; } r -= I_B;
        if (r < I_B) { cvt_item<0>(A.in[10] + (size_t)l * F * D, F, D, D, (bf16_t*)(wb + W_2B), nullptr, scr, r, lane); continue; } r -= I_B;
        if (r < I_IN) { cvt_item<0>(A.in[11] + (size_t)l * D * DIN, D, DIN, DINP, (bf16_t*)(wb + W_IN), nullptr, scr, r, lane); continue; } r -= I_IN;
        if (r < I_OUT) { cvt_item<0>(A.in[12] + (size_t)l * D * D, D, D, D, (bf16_t*)(wb + W_OUT), nullptr, scr, r, lane); continue; } r -= I_OUT;
        if (r < I_UQ) { cvt_item<0>(A.in[17] + (size_t)l * 256 * 576, 256, 576, 768, (bf16_t*)(wb + W_UQ), A.in[15] + l * 256, scr, r, lane); continue; } r -= I_UQ;
        if (r < I_UKV) { cvt_item<0>(A.in[18] + (size_t)l * 128 * 768, 128, 768, 768, (bf16_t*)(wb + W_UKV), A.in[16] + l * 128, scr, r, lane); continue; } r -= I_UKV;
        if (r < 2 * I_C1) { const int kv = r / I_C1; cvt_item<0>(A.in[20] + (size_t)(l * 2 + kv) * 2048 * 128, 2048, 128, 128, (bf16_t*)(wb + W_C1) + (size_t)kv * 128 * 2048, nullptr, scr, r % I_C1, lane); continue; } r -= 2 * I_C1;
        { const int kv = r / I_C2; cvt_item<0>(A.in[21] + (size_t)(l * 2 + kv) * 128 * 64, 128, 64, 64, (bf16_t*)(wb + W_C2) + (size_t)kv * 64 * 128, nullptr, scr, r % I_C2, lane); }
    }
}
__device__ __forceinline__ void mods_task(const Args& A, int task, LAS unsigned char* lds) {
    const int tid = opq(threadIdx.x), lane = tid & 63, wid = __builtin_amdgcn_readfirstlane(tid >> 6);
    const int l = task / 72, chunk = task % 72;
    LAS float* cond = (LAS float*)lds;
    LAS float* red = (LAS float*)(lds + 16384);
    __syncthreads();
    for (int i = tid; i < 4096; i += NTHR) { const float c = A.in[1][i]; cond[i] = c / (1.0f + expf(-c)); }
    __syncthreads();
    const float* W = A.in[2] + (size_t)l * D * 9216 + chunk * 128 + 2 * lane;
    float acc[4][2] = {{0.f, 0.f}, {0.f, 0.f}, {0.f, 0.f}, {0.f, 0.f}};
#pragma unroll 4
    for (int kk = 0; kk < 128; ++kk) {
        const int k = wid * 128 + kk;
        const f32x2 w = *(const f32x2*)(W + (size_t)k * 9216);
#pragma unroll
        for (int b = 0; b < 4; ++b) { const float s = cond[b * 1024 + k]; acc[b][0] += s * w.x; acc[b][1] += s * w.y; }
    }
#pragma unroll
    for (int b = 0; b < 4; ++b) { red[(wid * 4 + b) * 128 + 2 * lane] = acc[b][0]; red[(wid * 4 + b) * 128 + 2 * lane + 1] = acc[b][1]; }
    __syncthreads();
    {
        const int b = tid >> 7, col = tid & 127; float s = 0.f;
#pragma unroll
        for (int w = 0; w < 8; ++w) s += red[(w * 4 + b) * 128 + col];
        s += A.in[3][(size_t)l * 9216 + chunk * 128 + col];
        ((float*)(WSB(A) + WS_MODS))[(size_t)(l * 4 + b) * 9216 + chunk * 128 + col] = s;
    }
    __syncthreads();
}
__device__ __forceinline__ void posb_task(const Args& A, int task, LAS unsigned char* lds) {
    const int tid = opq(threadIdx.x);
    const int hid = tid & 127, part = tid >> 7;
    const float* pos = A.in[19] + (size_t)task * 2048; const float* w1 = A.in[20] + (size_t)task * 2048 * 128;
    float s = 0.f;
    for (int k = part * 512; k < part * 512 + 512; ++k) s += pos[k] * w1[(size_t)k * 128 + hid];
    LAS float* red = (LAS float*)lds;
    __syncthreads();
    red[tid] = s;
    __syncthreads();
    if (tid < 128) ((float*)(WSB(A) + WS_POSB))[task * 128 + tid] = red[tid] + red[tid + 128] + red[tid + 256] + red[tid + 384];
    __syncthreads();
}
__device__ __forceinline__ void rope_entries(const Args& A) {
    const int gtid = blockIdx.x * NTHR + opq(threadIdx.x), gn = gridDim.x * NTHR;
    float* tab = (float*)(WSB(A) + WS_ROPE);
    for (int e = gtid; e < T * 16; e += gn) {
        const int t = e >> 4, i = e & 15;
        double inv = 1.0; for (int j = 0; j < i; ++j) inv *= 0.5623413251903491;
        const float ang = (float)t * (float)inv;
        const double rev = (double)ang * 0.15915494309189535; const double fr = rev - __builtin_rint(rev);
        tab[e] = __builtin_amdgcn_cosf((float)fr); tab[T * 16 + e] = __builtin_amdgcn_sinf((float)fr);
    }
}
__device__ __forceinline__ void norm_rows(const float* X, bf16_t* out, const float* g, const float* modl, int ish, int isc) {
    const int tid = opq(threadIdx.x), lane = tid & 63, wid = __builtin_amdgcn_readfirstlane(tid >> 6), gw = blockIdx.x * NWAVE + wid, ngw = gridDim.x * NWAVE;
    for (int row = gw; row < M; row += ngw) {
        const int b = row >> 12;
        const f32x4* xr = (const f32x4*)(X + (size_t)row * D) + lane;
        f32x4 v[4]; float ss = 0.f;
#pragma unroll
        for (int j = 0; j < 4; ++j) { v[j] = xr[64 * j]; ss += (v[j].x * v[j].x + v[j].y * v[j].y) + (v[j].z * v[j].z + v[j].w * v[j].w); }
        const float rstd = rsqrtf(wave_sum(ss) * (1.0f / D) + RMS_EPS);
#pragma unroll
        for (int j = 0; j < 4; ++j) {
            const int col = 4 * lane + 256 * j;
            const f32x4 g4 = *(const f32x4*)(g + col), sc = *(const f32x4*)(modl + (size_t)b * 9216 + isc * 1024 + col), sh = *(const f32x4*)(modl + (size_t)b * 9216 + ish * 1024 + col);
            const f32x4 y = (v[j] * rstd) * g4 * (sc + 1.0f) + sh;
            u32x2 w; w.x = cvtpk(y.x, y.y); w.y = cvtpk(y.z, y.w);
            *(u32x2*)(out + (size_t)row * D + col) = w;
        }
    }
}
__device__ __forceinline__ void final_norm_rows(float* X, const float* g) {
    const int tid = opq(threadIdx.x), lane = tid & 63, wid = __builtin_amdgcn_readfirstlane(tid >> 6), gw = blockIdx.x * NWAVE + wid, ngw = gridDim.x * NWAVE;
    for (int row = gw; row < M; row += ngw) {
        f32x4* xr = (f32x4*)(X + (size_t)row * D) + lane;
        f32x4 v[4]; float ss = 0.f;
#pragma unroll
        for (int j = 0; j < 4; ++j) { v[j] = xr[64 * j]; ss += (v[j].x * v[j].x + v[j].y * v[j].y) + (v[j].z * v[j].z + v[j].w * v[j].w); }
        const float rstd = rsqrtf(wave_sum(ss) * (1.0f / D) + RMS_EPS);
#pragma unroll
        for (int j = 0; j < 4; ++j) { const f32x4 g4 = *(const f32x4*)(g + 4 * lane + 256 * j); xr[64 * j] = (v[j] * rstd) * g4; }
    }
}

__device__ __forceinline__ void norm_block(const float* X, bf16_t* out, const float* g, const float* modl, int ish, int isc, int row0) {
    const int tid = opq(threadIdx.x), lane = tid & 63, wid = __builtin_amdgcn_readfirstlane(tid >> 6);
    const int b = row0 >> 12;
#pragma unroll 1
    for (int rr = 0; rr < 8; ++rr) {
        const int row = row0 + rr * 8 + wid;
        const f32x4* xr = (const f32x4*)(X + (size_t)row * D) + lane;
        f32x4 v[4]; float ss = 0.f;
#pragma unroll
        for (int j = 0; j < 4; ++j) { v[j] = xr[64 * j]; ss += (v[j].x * v[j].x + v[j].y * v[j].y) + (v[j].z * v[j].z + v[j].w * v[j].w); }
        const float rstd = rsqrtf(wave_sum(ss) * (1.0f / D) + RMS_EPS);
#pragma unroll
        for (int j = 0; j < 4; ++j) {
            const int col = 4 * lane + 256 * j;
            const f32x4 g4 = *(const f32x4*)(g + col), sc = *(const f32x4*)(modl + (size_t)b * 9216 + isc * 1024 + col), sh = *(const f32x4*)(modl + (size_t)b * 9216 + ish * 1024 + col);
            const f32x4 y = (v[j] * rstd) * g4 * (sc + 1.0f) + sh;
            u32x2 w; w.x = cvtpk(y.x, y.y); w.y = cvtpk(y.z, y.w);
            *(u32x2*)(out + (size_t)row * D + col) = w;
        }
    }
}
__device__ __forceinline__ void final_norm_block(float* X, const float* g, int row0) {
    const int tid = opq(threadIdx.x), lane = tid & 63, wid = __builtin_amdgcn_readfirstlane(tid >> 6);
#pragma unroll 1
    for (int rr = 0; rr < 8; ++rr) {
        const int row = row0 + rr * 8 + wid;
        f32x4* xr = (f32x4*)(X + (size_t)row * D) + lane;
        f32x4 v[4]; float ss = 0.f;
#pragma unroll
        for (int j = 0; j < 4; ++j) { v[j] = xr[64 * j]; ss += (v[j].x * v[j].x + v[j].y * v[j].y) + (v[j].z * v[j].z + v[j].w * v[j].w); }
        const float rstd = rsqrtf(wave_sum(ss) * (1.0f / D) + RMS_EPS);
#pragma unroll
        for (int j = 0; j < 4; ++j) { const f32x4 g4 = *(const f32x4*)(g + 4 * lane + 256 * j); xr[64 * j] = (v[j] * rstd) * g4; }
    }
}
struct CountedOrder : pg8::StaticOrder {
    unsigned* cnt;
    __device__ __forceinline__ void done(const pg8::Unit& u) const {
        __builtin_amdgcn_fence(__ATOMIC_RELEASE, "agent");
        if ((threadIdx.x & 63) == 0) __hip_atomic_fetch_add(cnt + u.pm, 1u, __ATOMIC_RELAXED, __HIP_MEMORY_SCOPE_AGENT);
    }
};
__device__ __forceinline__ void panel_wait(unsigned* cnt, int pm) {
    if (threadIdx.x == 0) {
        unsigned sp = 0;
        while (__hip_atomic_load(cnt + pm, __ATOMIC_RELAXED, __HIP_MEMORY_SCOPE_AGENT) < 32u) { __builtin_amdgcn_s_sleep(2); if (++sp > (1u << 22)) break; }
    }
    __syncthreads();
    __builtin_amdgcn_fence(__ATOMIC_ACQUIRE, "agent");
}
#define XB_TMO      128
#define XB_XCNT(j)  (256  + 64 * (j))
#define XB_XSUB(j)  (1280 + 64 * (j))
#define XB_XGEN(j)  (2304 + 64 * (j))
#define XB_TOP      3328
#define XB_TOPGEN   3392
#define XCD_BAR_WORDS 3456
#define XB_SPIN_CAP (1u << 18)

__device__ __forceinline__ unsigned xb_ld(unsigned* p)              { return __hip_atomic_load(p, __ATOMIC_RELAXED, __HIP_MEMORY_SCOPE_AGENT); }
__device__ __forceinline__ unsigned xb_add(unsigned* p, unsigned v) { return __hip_atomic_fetch_add(p, v, __ATOMIC_RELAXED, __HIP_MEMORY_SCOPE_AGENT); }
__device__ __forceinline__ unsigned xb_xcc_id() { return (unsigned)__builtin_amdgcn_s_getreg((3 << 11) | 20) & 0xFu; }
#define XB_SPIN(cond, bar) do { unsigned _sp = 0; while (cond) { __builtin_amdgcn_s_sleep(1); \
    if ((++_sp & 255u) == 0u) { if (xb_ld(&(bar)[XB_TMO])) break; if (_sp > XB_SPIN_CAP) { atomicAdd(&(bar)[XB_TMO], 1u); break; } } } } while (0)

struct XcdBarrier {
    unsigned* bar; unsigned x;
    volatile LAS unsigned* st;
};

__device__ __forceinline__ XcdBarrier xcd_barrier_post(unsigned* bar, volatile LAS unsigned* st) {
    XcdBarrier b; b.bar = bar; b.x = xb_xcc_id(); b.st = st;
    if (threadIdx.x == 0) (void)xb_add(&bar[XB_XCNT(b.x)], 1u);
    return b;
}
__device__ __forceinline__ void xcd_barrier_complete(unsigned* bar, unsigned x, unsigned& nloc, unsigned& nx) {
    const unsigned G = gridDim.x * gridDim.y * gridDim.z;
    unsigned sum, cnt, mine, sp = 0u;
    for (;;) {
        sum = 0u; cnt = 0u; mine = 0u;
#pragma unroll
        for (unsigned j = 0; j < 16; ++j) { const unsigned c = xb_ld(&bar[XB_XCNT(j)]); sum += c; cnt += (c > 0u) ? 1u : 0u; mine = (j == x) ? c : mine; }
        if (sum == G) break;
        __builtin_amdgcn_s_sleep(1);
        if ((++sp & 255u) == 0u) { if (xb_ld(&bar[XB_TMO])) break; if (sp > XB_SPIN_CAP) { atomicAdd(&bar[XB_TMO], 1u); break; } }
    }
    nloc = mine > 0u ? mine : 1u; nx = cnt > 0u ? cnt : 1u;
}

__device__ __forceinline__ void xcd_barrier(const XcdBarrier& b) {
    asm volatile("s_waitcnt vmcnt(0)" ::: "memory");
    __syncthreads();
    if (threadIdx.x == 0) {
        unsigned* bar = b.bar;
        __builtin_amdgcn_s_waitcnt(0);
        unsigned nloc = b.st[0], nx = b.st[1];
        if (nloc == 0u) { xcd_barrier_complete(bar, b.x, nloc, nx); b.st[0] = nloc; b.st[1] = nx; }
        const unsigned old = xb_add(&bar[XB_XSUB(b.x)], 1u);
        const unsigned gen = old / nloc;
        if (old + 1u == (gen + 1u) * nloc) {
            __builtin_amdgcn_fence(__ATOMIC_RELEASE, "agent");
            asm volatile("s_waitcnt vmcnt(0)" ::: "memory");
            const unsigned og = xb_add(&bar[XB_TOP], 1u);
            const unsigned tg = og / nx;
            if (og + 1u == (tg + 1u) * nx) xb_add(&bar[XB_TOPGEN], 1u);
            else XB_SPIN(xb_ld(&bar[XB_TOPGEN]) == tg, bar);
            __builtin_amdgcn_fence(__ATOMIC_ACQUIRE, "agent");
            xb_add(&bar[XB_XGEN(b.x)], 1u);
            asm volatile("s_waitcnt vmcnt(0)" ::: "memory");
        } else {
            XB_SPIN(xb_ld(&bar[XB_XGEN(b.x)]) == gen, bar);
            __builtin_amdgcn_fence(__ATOMIC_ACQUIRE, "agent");
            asm volatile("s_waitcnt vmcnt(0)" ::: "memory");
        }
    }
    __syncthreads();
}

struct AttnArgs {
    const bf16_t* Q; int qpitch;
    const bf16_t* K1; int k1pitch;
    const bf16_t* K2; int k2pitch;
    const bf16_t* V; int vpitch;
    const float* rope;
    const unsigned long long* sel;
    float scale2, slope2; int window;
};
constexpr int ATT_K_OFF = 0, ATT_V_OFF = 16384, ATT_BUF = 24576;

__device__ __forceinline__ s16x4 vtr(const LAS unsigned char* p) {
    typedef short v4i16_t __attribute__((ext_vector_type(4)));
    return __builtin_bit_cast(s16x4, __builtin_amdgcn_ds_read_tr16_b64_v4i16((LAS v4i16_t*)p));
}
__device__ __forceinline__ void pv_tile(f32x16 (&o)[2], const f32x16& p0, const f32x16& p1, const LAS unsigned char* vl, int lane) {
    const int h = lane >> 5, i16 = lane & 15, q4 = i16 >> 2, p4 = i16 & 3, blk = (lane >> 4) & 1;
    const LAS unsigned char* vb = vl + (4 * h + q4) * 64 + blk * 32 + p4 * 8;
#pragma unroll
    for (int s = 0; s < 4; ++s) {
        u32x4 pw;
        if (s == 0) { pw.x = cvtpk(p0[0], p0[1]); pw.y = cvtpk(p0[2], p0[3]); pw.z = cvtpk(p0[4], p0[5]); pw.w = cvtpk(p0[6], p0[7]); }
        else if (s == 1) { pw.x = cvtpk(p0[8], p0[9]); pw.y = cvtpk(p0[10], p0[11]); pw.z = cvtpk(p0[12], p0[13]); pw.w = cvtpk(p0[14], p0[15]); }
        else if (s == 2) { pw.x = cvtpk(p1[0], p1[1]); pw.y = cvtpk(p1[2], p1[3]); pw.z = cvtpk(p1[4], p1[5]); pw.w = cvtpk(p1[6], p1[7]); }
        else { pw.x = cvtpk(p1[8], p1[9]); pw.y = cvtpk(p1[10], p1[11]); pw.z = cvtpk(p1[12], p1[13]); pw.w = cvtpk(p1[14], p1[15]); }
        const bf16x8 pf = __builtin_bit_cast(bf16x8, pw);
#pragma unroll
        for (int db = 0; db < 2; ++db) {
            const s16x4 lo = vtr(vb + db * 4096 + (16 * s) * 64), hi = vtr(vb + db * 4096 + (16 * s + 8) * 64);
            const bf16x8 vf = __builtin_shufflevector(lo, hi, 0, 1, 2, 3, 4, 5, 6, 7);
            o[db] = MFMA32(vf, pf, o[db]);
        }
    }
}
template <int MODE> __device__ __forceinline__ void store_o(const f32x16 (&o)[2], bf16_t* out_row, int h, float sc) {
#pragma unroll
    for (int db = 0; db < 2; ++db)
#pragma unroll
        for (int g4 = 0; g4 < 4; ++g4) {
            bf16_t* p = out_row + 32 * db + 8 * g4 + 4 * h;
            float v0 = o[db][4 * g4] * sc, v1 = o[db][4 * g4 + 1] * sc, v2 = o[db][4 * g4 + 2] * sc, v3 = o[db][4 * g4 + 3] * sc;
            if (MODE == 1) { const u32x2 old = *(const u32x2*)p; v0 += __uint_as_float(old.x << 16); v1 += __uint_as_float(old.x & 0xffff0000u); v2 += __uint_as_float(old.y << 16); v3 += __uint_as_float(old.y & 0xffff0000u); }
            u32x2 w; w.x = cvtpk(v0, v1); w.y = cvtpk(v2, v3);
            *(u32x2*)p = w;
        }
}

template <int DQK, bool ROPE, bool SEL, bool DUAL = false>
__device__ __forceinline__ void attn_core(const AttnArgs& a, int q0, LAS unsigned char* lds, f32x16 (&o)[2]) {
    constexpr int KS = DQK / 16, DK = DUAL ? 2 * DQK : DQK, KP = DK * 2 + 16, D1 = DK < 64 ? DK : 64, NCH1 = D1 / 8, QROWS = DUAL ? 128 : 256;
    const int tid = opq(threadIdx.x), lane = tid & 63, wid = __builtin_amdgcn_readfirstlane(tid >> 6), r = lane & 31, h = lane >> 5;
    const int wq = DUAL ? (wid & 3) : wid, coff = DUAL ? (wid >> 2) * DQK : 0;
    const int qw0 = q0 + 32 * wq, qpos = qw0 + r;
    LAS unsigned char* Kl = lds + ATT_K_OFF; LAS unsigned char* Vl = lds + ATT_V_OFF;
    bf16x8 qf[KS];
    {
        const bf16_t* qrow = a.Q + (size_t)qpos * a.qpitch + coff;
#pragma unroll
        for (int ks = 0; ks < KS; ++ks) qf[ks] = *(const bf16x8*)(qrow + 16 * ks + 8 * h);
        if (ROPE) {
            const float* cs = a.rope + (size_t)qpos * 16 + 8 * h; const float* sn = cs + T * 16;
            float y0[8], y1[8];
#pragma unroll
            for (int j = 0; j < 8; ++j) { const float x0 = bf2f(qf[KS - 2][j]), x1 = bf2f(qf[KS - 1][j]), c = cs[j], s = sn[j]; y0[j] = x0 * c - x1 * s; y1[j] = x1 * c + x0 * s; }
            u32x4 w0, w1;
            w0.x = cvtpk(y0[0], y0[1]); w0.y = cvtpk(y0[2], y0[3]); w0.z = cvtpk(y0[4], y0[5]); w0.w = cvtpk(y0[6], y0[7]);
            w1.x = cvtpk(y1[0], y1[1]); w1.y = cvtpk(y1[2], y1[3]); w1.z = cvtpk(y1[4], y1[5]); w1.w = cvtpk(y1[6], y1[7]);
            qf[KS - 2] = __builtin_bit_cast(bf16x8, w0); qf[KS - 1] = __builtin_bit_cast(bf16x8, w1);
        }
    }
    unsigned long long selm = ~0ull;
    if (SEL) selm = a.sel[qpos];
    const int t_hi = (q0 + QROWS - 1) >> 6;
    int t_lo = 0;
    if (a.window) { const int lo = q0 - a.window + 1; t_lo = lo > 0 ? (lo >> 6) : 0; }
    const bool kA_on = tid < 64 * NCH1; const int rowA = tid / NCH1, chA = tid % NCH1;
    const bool kB_on = ROPE && tid < 128; const int rowB = tid >> 1, prB = tid & 1;
    const int rowV = tid >> 3, chV = tid & 7;
    u32x4 kA = {0, 0, 0, 0}, kB0 = {0, 0, 0, 0}, kB1 = {0, 0, 0, 0}, vR = {0, 0, 0, 0};
#define ATT_PREFETCH(t) do { \
        if (kA_on) kA = *(const u32x4*)(a.K1 + (size_t)(64 * (t) + rowA) * a.k1pitch + chA * 8); \
        if (kB_on) { const bf16_t* kp = a.K2 + (size_t)(64 * (t) + rowB) * a.k2pitch + prB * 8; kB0 = *(const u32x4*)kp; kB1 = *(const u32x4*)(kp + 16); } \
        vR = *(const u32x4*)(a.V + (size_t)(64 * (t) + rowV) * a.vpitch + chV * 8); } while (0)
#define ATT_STORE(tt, KL, VL) do { \
        if (kA_on) *(LAS u32x4*)((KL) + rowA * KP + chA * 16) = kA; \
        if (ROPE) { if (kB_on) { \
                const float* cs = a.rope + (size_t)(64 * (tt) + rowB) * 16 + prB * 8; const float* sn = cs + T * 16; \
                const bf16x8 x0v = __builtin_bit_cast(bf16x8, kB0), x1v = __builtin_bit_cast(bf16x8, kB1); \
                float y0[8], y1[8]; \
                _Pragma("unroll") for (int j = 0; j < 8; ++j) { const float x0 = bf2f(x0v[j]), x1 = bf2f(x1v[j]), c = cs[j], sv = sn[j]; y0[j] = x0 * c - x1 * sv; y1[j] = x1 * c + x0 * sv; } \
                u32x4 w0, w1; \
                w0.x = cvtpk(y0[0], y0[1]); w0.y = cvtpk(y0[2], y0[3]); w0.z = cvtpk(y0[4], y0[5]); w0.w = cvtpk(y0[6], y0[7]); \
                w1.x = cvtpk(y1[0], y1[1]); w1.y = cvtpk(y1[2], y1[3]); w1.z = cvtpk(y1[4], y1[5]); w1.w = cvtpk(y1[6], y1[7]); \
                *(LAS u32x4*)((KL) + rowB * KP + (64 + prB * 8) * 2) = w0; \
                *(LAS u32x4*)((KL) + rowB * KP + (80 + prB * 8) * 2) = w1; } } \
        *(LAS u32x4*)((VL) + (chV >> 2) * 4096 + rowV * 64 + (chV & 3) * 16) = vR; } while (0)
    float m = NEGBIG, l = 0.f;
#pragma unroll
    for (int i = 0; i < 16; ++i) { o[0][i] = 0.f; o[1][i] = 0.f; }
    float cbv[16];
#pragma unroll
    for (int i = 0; i < 16; ++i) cbv[i] = a.slope2 * (float)((i & 3) + 8 * (i >> 2) + 4 * h);
    ATT_PREFETCH(t_lo);
    __syncthreads();
    ATT_STORE(t_lo, Kl, Vl);
    __syncthreads();
    if (t_lo < t_hi) ATT_PREFETCH(t_lo + 1);
    for (int t = t_lo; t <= t_hi; ++t) {
        const int cur = (t - t_lo) & 1;
        const LAS unsigned char* Kc = Kl + cur * ATT_BUF; const LAS unsigned char* Vc = Vl + cur * ATT_BUF;
        bool need = (64 * t <= qw0 + 31);
        if (a.window) need = need && (64 * t + 63 >= qw0 - a.window + 1);
        const bool selbit = SEL ? (((selm >> t) & 1ull) != 0ull) : true;
        if (SEL) need = need && (__ballot(selbit) != 0ull);
        if (need) {
            f32x16 p0, p1;
#pragma unroll
            for (int i = 0; i < 16; ++i) { p0[i] = 0.f; p1[i] = 0.f; }
#pragma unroll
            for (int ks = 0; ks < KS; ++ks) {
                const bf16x8 a0 = *(const LAS bf16x8*)(Kc + r * KP + coff * 2 + ks * 32 + h * 16);
                const bf16x8 a1 = *(const LAS bf16x8*)(Kc + (32 + r) * KP + coff * 2 + ks * 32 + h * 16);
                p0 = MFMA32(a0, qf[ks], p0); p1 = MFMA32(a1, qf[ks], p1);
            }
#pragma unroll
            for (int i = 0; i < 16; ++i) { p0[i] = p0[i] * a.scale2 + cbv[i]; p1[i] = p1[i] * a.scale2 + cbv[i]; }
            const float base0 = a.slope2 * (float)(64 * t - qpos), base1 = base0 + 32.0f * a.slope2;
            bool bnd = (64 * t + 63 > qw0);
            if (a.window) bnd = bnd || (64 * t < qw0 + 31 - a.window + 1);
            if (SEL) bnd = bnd || (__ballot(!selbit) != 0ull);
            if (bnd) {
                const int wlim = a.window ? a.window : (1 << 30);
#pragma unroll
                for (int i = 0; i < 16; ++i) {
                    const int kv0 = 64 * t + crow(i, h), d0 = qpos - kv0, d1 = d0 - 32;
                    const bool ok0 = selbit && d0 >= 0 && d0 < wlim, ok1 = selbit && d1 >= 0 && d1 < wlim;
                    p0[i] = ok0 ? p0[i] : NEGBIG; p1[i] = ok1 ? p1[i] : NEGBIG;
                }
            }
            float mx0 = p0[0], mx1 = p1[0];
#pragma unroll
            for (int i = 1; i < 16; ++i) { mx0 = fmaxf(mx0, p0[i]); mx1 = fmaxf(mx1, p1[i]); }
            float mloc = fmaxf(mx0 + base0, mx1 + base1);
            mloc = fmaxf(mloc, __shfl_xor(mloc, 32));
            const float mnew = fmaxf(m, mloc);
            if (__ballot(mnew > m) != 0ull) {
                const float alpha = fast_exp2(m - mnew);
                l *= alpha;
#pragma unroll
                for (int i = 0; i < 16; ++i) { o[0][i] *= alpha; o[1][i] *= alpha; }
            }
            m = mnew;
            const float r0 = mnew - base0, r1 = mnew - base1;
            float ls = 0.f;
#pragma unroll
            for (int i = 0; i < 16; ++i) { p0[i] = fast_exp2(p0[i] - r0); p1[i] = fast_exp2(p1[i] - r1); ls += p0[i] + p1[i]; }
            l += ls;
            pv_tile(o, p0, p1, Vc, lane);
        }
        if (t < t_hi) ATT_STORE(t + 1, Kl + (cur ^ 1) * ATT_BUF, Vl + (cur ^ 1) * ATT_BUF);
        __syncthreads();
        if (t + 1 < t_hi) ATT_PREFETCH(t + 2);
    }
#undef ATT_STORE
#undef ATT_PREFETCH
    const float lt = l + __shfl_xor(l, 32);
    const float inv = 1.0f / lt;
#pragma unroll
    for (int i = 0; i < 16; ++i) { o[0][i] *= inv; o[1][i] *= inv; }
}

__device__ __forceinline__ float da_slope(int hd) { return hd == 0 ? 0.25f : hd == 1 ? 0.0625f : hd == 2 ? 0.015625f : 0.00390625f; }
__device__ __forceinline__ float nsa_slope(int hh) { return hh == 0 ? 0.25f : hh == 1 ? 0.0625f : hh == 2 ? 0.015625f : hh == 3 ? 0.00390625f : hh == 4 ? 0.5f : 0.125f; }

constexpr int DA_X_OFF = 49152;
__device__ __forceinline__ void da_unit(const Args& A, int l, int b, int hd, int qb, LAS unsigned char* lds) {
    const int tid_ = opq(threadIdx.x), lane = tid_ & 63, wid = __builtin_amdgcn_readfirstlane(tid_ >> 6), r = lane & 31, h = lane >> 5;
    const bf16_t* P = (const bf16_t*)(WSB(A) + WS_U) + (size_t)b * T * DINP;
    const float lam = ((const float*)(WSB(A) + WS_CTL))[64 + l];
    const float one_m_li = ((const float*)(WSB(A) + WS_CTL))[66 + l];
    f32x16 o[2];
    AttnArgs a; a.Q = P + C_AQ + hd * 64; a.qpitch = DINP; a.K1 = P + C_AK + hd * 64; a.k1pitch = DINP; a.K2 = nullptr; a.k2pitch = 0;
    a.V = P + C_AV + hd * 64; a.vpitch = DINP; a.rope = nullptr; a.sel = nullptr; a.scale2 = 0.17677669529663687f * LOG2E; a.slope2 = da_slope(hd) * LOG2E; a.window = 0;
    attn_core<32, false, false, true>(a, qb * 128, lds, o);
    LAS float* xb = (LAS float*)(lds + DA_X_OFF) + (32 * (wid & 3) + r) * 65;
    if (wid >= 4) {
#pragma unroll
        for (int db = 0; db < 2; ++db)
#pragma unroll
            for (int i = 0; i < 16; ++i) xb[32 * db + crow(i, h)] = o[db][i];
    }
    __syncthreads();
    if (wid < 4) {
        float ss = 0.f;
#pragma unroll
        for (int db = 0; db < 2; ++db)
#pragma unroll
            for (int i = 0; i < 16; ++i) { o[db][i] = o[db][i] - lam * xb[32 * db + crow(i, h)]; ss += o[db][i] * o[db][i]; }
        ss += __shfl_xor(ss, 32);
        const float rs = rsqrtf(ss * (1.0f / 64.0f) + RMS_EPS) * one_m_li;
        const float* sg = A.in[14] + l * 64;
#pragma unroll
        for (int db = 0; db < 2; ++db)
#pragma unroll
            for (int i = 0; i < 16; ++i) o[db][i] *= rs * sg[32 * db + crow(i, h)];
        bf16_t* orow = (bf16_t*)(WSB(A) + WS_XN) + (size_t)(b * T + qb * 128 + 32 * wid + r) * D + hd * 64;
        store_o<0>(o, orow, h, EN_DA ? 1.0f : 0.0f);
    }
}
__device__ __forceinline__ void mla_unit(const Args& A, int b, int hd, int qb, LAS unsigned char* lds) {
    const int tid_ = opq(threadIdx.x), lane = tid_ & 63, wid = __builtin_amdgcn_readfirstlane(tid_ >> 6), r = lane & 31, h = lane >> 5;
    AttnArgs a; a.Q = (const bf16_t*)(WSB(A) + WS_MQ) + (size_t)b * T * 768 + hd * 96; a.qpitch = 768;
    a.K1 = (const bf16_t*)(WSB(A) + WS_MKV) + (size_t)b * T * 768 + hd * 128; a.k1pitch = 768;
    a.K2 = (const bf16_t*)(WSB(A) + WS_U) + (size_t)b * T * DINP + C_BKR; a.k2pitch = DINP;
    a.V = a.K1 + 64; a.vpitch = 768; a.rope = (const float*)(WSB(A) + WS_ROPE); a.sel = nullptr; a.scale2 = 0.10206207261596575f * LOG2E; a.slope2 = 0.f; a.window = 0;
    f32x16 o[2];
    attn_core<96, true, false>(a, qb * 256, lds, o);
    bf16_t* orow = (bf16_t*)(WSB(A) + WS_XN) + (size_t)(b * T + qb * 256 + 32 * wid + r) * D + 256 + hd * 64;
    store_o<0>(o, orow, h, EN_MLA ? 1.0f : 0.0f);
}
template <int BR> __device__ __forceinline__ void nsa_unit(const Args& A, int b, int hh, int qb, LAS unsigned char* lds) {
    const int tid_ = opq(threadIdx.x), lane = tid_ & 63, wid = __builtin_amdgcn_readfirstlane(tid_ >> 6), r = lane & 31, h = lane >> 5, g = hh / 3;
    const bf16_t* P = (const bf16_t*)(WSB(A) + WS_U) + (size_t)b * T * DINP;
    AttnArgs a; a.Q = P + C_CQ + hh * 64; a.qpitch = DINP; a.K1 = P + (BR == 2 ? C_KW : C_KS) + g * 64; a.k1pitch = DINP; a.K2 = nullptr; a.k2pitch = 0;
    a.V = P + (BR == 2 ? C_VW : C_VS) + g * 64; a.vpitch = DINP; a.rope = nullptr; a.sel = (const unsigned long long*)(WSB(A) + WS_SEL) + (size_t)(b * 2 + g) * T;
    a.scale2 = 0.125f * LOG2E; a.slope2 = nsa_slope(hh) * LOG2E; a.window = (BR == 2) ? 512 : 0;
    f32x16 o[2];
    attn_core<64, false, BR == 1>(a, qb * 256, lds, o);
    const int qpos = qb * 256 + 32 * wid + r;
    const float gl = bf2f((short)P[(size_t)qpos * DINP + C_G + BR * 6 + hh]);
    bf16_t* orow = (bf16_t*)(WSB(A) + WS_XN) + (size_t)(b * T + qpos) * D + 640 + hh * 64;
    if (BR == 2) store_o<0>(o, orow, h, EN_WIN ? sigmoid_f(gl) : 0.0f);
    else store_o<1>(o, orow, h, EN_SLC ? sigmoid_f(gl) : 0.0f);
}

__device__ __forceinline__ void cmp_mlp_task(const Args& A, int l, int wt, LAS unsigned char* lds) {
    const int tid_ = opq(threadIdx.x), lane = tid_ & 63, wid = __builtin_amdgcn_readfirstlane(tid_ >> 6);
    const int kv = wt >> 7, bg = (wt >> 4) & 7, rg = wt & 15, b = bg >> 1, g = bg & 1, i16 = lane & 15, quad = lane >> 4;
    const bf16_t* P = (const bf16_t*)(WSB(A) + WS_U) + (size_t)b * T * DINP + (kv ? C_VC : C_KC) + g * 64;
    const bf16_t* W1 = (const bf16_t*)(WSB(A) + WS_W + W_C1) + (size_t)kv * 128 * 2048;
    const bf16_t* W2 = (const bf16_t*)(WSB(A) + WS_W + W_C2) + (size_t)kv * 64 * 128;
    const float* posb = (const float*)(WSB(A) + WS_POSB) + (l * 2 + kv) * 128;
    const int n = 16 * rg + i16;
    const bf16_t* arow = P + (size_t)(16 * n) * DINP + 8 * quad;
    const bf16_t* wrow1 = W1 + (size_t)i16 * 2048 + 8 * quad;
    f32x4 acc[8];
#pragma unroll
    for (int i = 0; i < 8; ++i) acc[i] = (f32x4){0.f, 0.f, 0.f, 0.f};
#pragma unroll 2
    for (int kk = 0; kk < 8; ++kk) {
        const int ks = 8 * wid + kk;
        const bf16x8 bfrag = *(const bf16x8*)(arow + (size_t)(ks >> 1) * DINP + 32 * (ks & 1));
#pragma unroll
        for (int ht = 0; ht < 8; ++ht) {
            const bf16x8 afrag = *(const bf16x8*)(wrow1 + (size_t)(16 * ht) * 2048 + 32 * ks);
            acc[ht] = MFMA16(afrag, bfrag, acc[ht]);
        }
    }
    {
        LAS float* red = (LAS float*)lds;
        if (wid > 0) {
#pragma unroll
            for (int ht = 0; ht < 8; ++ht)
#pragma unroll
                for (int j = 0; j < 4; ++j) red[(wid * 64 + lane) * 33 + ht * 4 + j] = acc[ht][j];
        }
        __syncthreads();
        if (wid > 0) return;
#pragma unroll 1
        for (int w = 1; w < 8; ++w)
#pragma unroll
            for (int ht = 0; ht < 8; ++ht)
#pragma unroll
                for (int j = 0; j < 4; ++j) acc[ht][j] += red[(w * 64 + lane) * 33 + ht * 4 + j];
    }
    bf16x8 hf[4];
#pragma unroll
    for (int ks2 = 0; ks2 < 4; ++ks2) {
        float v[8];
#pragma unroll
        for (int e = 0; e < 8; ++e) {
            const int ht = 2 * ks2 + (e >> 2), j = e & 3;
            const float x = acc[ht][j] + posb[16 * ht + 4 * quad + j];
            const float u2 = 0.7978845608028654f * (x + 0.044715f * x * x * x);
            const float ex = fast_exp2(2.0f * LOG2E * u2);
            const float th = 1.0f - 2.0f * fast_rcp(ex + 1.0f);
            v[e] = 0.5f * x * (1.0f + th);
        }
        u32x4 w; w.x = cvtpk(v[0], v[1]); w.y = cvtpk(v[2], v[3]); w.z = cvtpk(v[4], v[5]); w.w = cvtpk(v[6], v[7]);
        hf[ks2] = __builtin_bit_cast(bf16x8, w);
    }
    bf16_t* outp = (bf16_t*)(WSB(A) + WS_KCMP) + ((size_t)(kv * 8 + bg) * 256 + n) * 64;
#pragma unroll
    for (int ot = 0; ot < 4; ++ot) {
        f32x4 c2 = (f32x4){0.f, 0.f, 0.f, 0.f};
        const bf16_t* w2r = W2 + (size_t)(16 * ot + i16) * 128 + 4 * quad;
#pragma unroll
        for (int ks2 = 0; ks2 < 4; ++ks2) {
            const u32x2 lo = *(const u32x2*)(w2r + 32 * ks2), hi = *(const u32x2*)(w2r + 32 * ks2 + 16);
            u32x4 w; w.x = lo.x; w.y = lo.y; w.z = hi.x; w.w = hi.y;
            c2 = MFMA16(__builtin_bit_cast(bf16x8, w), hf[ks2], c2);
        }
        if (n < 255) { u32x2 w; w.x = cvtpk(c2[0], c2[1]); w.y = cvtpk(c2[2], c2[3]); *(u32x2*)(outp + 16 * ot + 4 * quad) = w; }
    }
}

constexpr int CMP_K_OFF = 0, CMP_V_OFF = 36864, CMP_IMP_OFF = 69632;
__device__ __forceinline__ void cmp_unit(const Args& A, int b, int g, int qb, LAS unsigned char* lds, float gmul = 1.0f) {
    const int tid = opq(threadIdx.x), lane = tid & 63, wid = __builtin_amdgcn_readfirstlane(tid >> 6), r = lane & 31, h = lane >> 5;
    const int q0 = qb * 256, qw0 = q0 + 32 * wid, qpos = qw0 + r, qloc = 32 * wid + r;
    const int ntile = (((q0 + 224) >> 4) >> 6) + 1;
    LAS unsigned char* Kl = lds + CMP_K_OFF; LAS unsigned char* Vl = lds + CMP_V_OFF; LAS float* imp = (LAS float*)(lds + CMP_IMP_OFF);
    const bf16_t* KC = (const bf16_t*)(WSB(A) + WS_KCMP) + (size_t)(b * 2 + g) * 256 * 64;
    const bf16_t* VC = KC + (size_t)8 * 256 * 64;
    __syncthreads();
    for (int idx = tid; idx < 512 * ntile; idx += NTHR) {
        const int n = idx >> 3, ch = idx & 7;
        u32x4 kx = {0, 0, 0, 0}, vx = {0, 0, 0, 0};
        if (n < 255) { kx = *(const u32x4*)(KC + (size_t)n * 64 + ch * 8); vx = *(const u32x4*)(VC + (size_t)n * 64 + ch * 8); }
        *(LAS u32x4*)(Kl + n * 144 + ch * 16) = kx;
        *(LAS u32x4*)(Vl + (n >> 6) * 8192 + (ch >> 2) * 4096 + (n & 63) * 64 + (ch & 3) * 16) = vx;
    }
    for (int idx = tid; idx < 256 * 65; idx += NTHR) imp[idx] = 0.f;
    __syncthreads();
    const bf16_t* P = (const bf16_t*)(WSB(A) + WS_U) + (size_t)b * T * DINP;
    const float scale2 = 0.125f * LOG2E;
#pragma unroll 1
    for (int rr = 0; rr < 3; ++rr) {
        const int hh = 3 * g + rr; const float slope2 = nsa_slope(hh) * LOG2E;
        bf16x8 qf[4];
        { const bf16_t* qrow = P + (size_t)qpos * DINP + C_CQ + hh * 64;
#pragma unroll
          for (int ks = 0; ks < 4; ++ks) qf[ks] = *(const bf16x8*)(qrow + 16 * ks + 8 * h); }
        float m = NEGBIG, lsum = 0.f, invl = 0.f;
        f32x16 o[2];
#pragma unroll
        for (int i = 0; i < 16; ++i) { o[0][i] = 0.f; o[1][i] = 0.f; }
#pragma unroll 1
        for (int pass = 0; pass < 2; ++pass) {
#pragma unroll 1
            for (int tt = 0; tt < ntile; ++tt) {
                if (16 * (64 * tt) + 31 > qw0 + 31) continue;
                f32x16 p0, p1;
#pragma unroll
                for (int i = 0; i < 16; ++i) { p0[i] = 0.f; p1[i] = 0.f; }
#pragma unroll
                for (int ks = 0; ks < 4; ++ks) {
                    const bf16x8 a0 = *(const LAS bf16x8*)(Kl + (64 * tt + r) * 144 + ks * 32 + h * 16);
                    const bf16x8 a1 = *(const LAS bf16x8*)(Kl + (64 * tt + 32 + r) * 144 + ks * 32 + h * 16);
                    p0 = MFMA32(a0, qf[ks], p0); p1 = MFMA32(a1, qf[ks], p1);
                }
#pragma unroll
                for (int i = 0; i < 16; ++i) {
                    const int n0 = 64 * tt + crow(i, h), d0 = qpos - (16 * n0 + 31), d1 = d0 - 512;
                    p0[i] = d0 >= 0 ? p0[i] * scale2 - slope2 * (float)d0 : NEGBIG;
                    p1[i] = d1 >= 0 ? p1[i] * scale2 - slope2 * (float)d1 : NEGBIG;
                }
                if (pass == 0) {
                    float mloc = fmaxf(p0[0], p1[0]);
#pragma unroll
                    for (int i = 1; i < 16; ++i) mloc = fmaxf(mloc, fmaxf(p0[i], p1[i]));
                    mloc = fmaxf(mloc, __shfl_xor(mloc, 32));
                    const float mnew = fmaxf(m, mloc), alpha = fast_exp2(m - mnew);
                    m = mnew;
                    float ls = 0.f;
#pragma unroll
                    for (int i = 0; i < 16; ++i) ls += fast_exp2(p0[i] - mnew) + fast_exp2(p1[i] - mnew);
                    lsum = lsum * alpha + ls;
                } else {
#pragma unroll
                    for (int i = 0; i < 16; ++i) {
                        p0[i] = p0[i] > -1e29f ? fast_exp2(p0[i] - m) * invl : 0.f;
                        p1[i] = p1[i] > -1e29f ? fast_exp2(p1[i] - m) * invl : 0.f;
                    }
                    pv_tile(o, p0, p1, Vl + tt * 8192, lane);
#pragma unroll
                    for (int blk = 0; blk < 2; ++blk)
#pragma unroll
                        for (int g4 = 0; g4 < 4; ++g4) {
                            const int j = 16 * tt + 8 * blk + 2 * g4 + h;
                            const float G = blk == 0 ? (p0[4 * g4] + p0[4 * g4 + 1]) + (p0[4 * g4 + 2] + p0[4 * g4 + 3]) : (p1[4 * g4] + p1[4 * g4 + 1]) + (p1[4 * g4 + 2] + p1[4 * g4 + 3]);
                            imp[qloc * 65 + j] += G;
                        }
                    asm volatile("s_waitcnt lgkmcnt(0)" ::: "memory");
#pragma unroll
                    for (int blk = 0; blk < 2; ++blk)
#pragma unroll
                        for (int g4 = 0; g4 < 4; ++g4) {
                            const int j = 16 * tt + 8 * blk + 2 * g4 + h;
                            const float Lst = blk == 0 ? p0[4 * g4 + 3] : p1[4 * g4 + 3];
                            if (j + 1 < 64) imp[qloc * 65 + j + 1] += Lst;
                        }
                    asm volatile("s_waitcnt lgkmcnt(0)" ::: "memory");
                }
            }
            if (pass == 0) { const float lt = lsum + __shfl_xor(lsum, 32); invl = (qpos >= 31) ? 1.0f / lt : 0.f; }
        }
        const float gl = bf2f((short)P[(size_t)qpos * DINP + C_G + 0 * 6 + hh]);
        bf16_t* orow = (bf16_t*)(WSB(A) + WS_XN) + (size_t)(b * T + qpos) * D + 640 + hh * 64;
        store_o<1>(o, orow, h, EN_CMP ? sigmoid_f(gl) * gmul : 0.0f);
    }
    __syncthreads();
    if (qb < 4) {
        if (tid < 256) { const int t = q0 + tid, cur = t >> 6; ((unsigned long long*)(WSB(A) + WS_SEL))[(size_t)(b * 2 + g) * T + t] = (1ull << (cur + 1)) - 1ull; }
    } else {
        const int qi = tid >> 1, hf = tid & 1, t = q0 + qi, cur = t >> 6;
        float v[32];
#pragma unroll
        for (int i = 0; i < 32; ++i) { const int j = 32 * hf + i; const float x = imp[qi * 65 + j]; v[i] = (j >= 1 && j <= cur - 2) ? x : -1.0f; }
        unsigned long long mask = 1ull | (1ull << cur) | (1ull << (cur - 1));
#pragma unroll 1
        for (int it = 0; it < 13; ++it) {
            float bv = v[0]; int bi = 0;
#pragma unroll
            for (int i = 1; i < 32; ++i) { const bool gt = v[i] > bv; bv = gt ? v[i] : bv; bi = gt ? i : bi; }
            const float ov = __shfl_xor(bv, 1); const int oi = __shfl_xor(bi, 1);
            const float v0 = hf ? ov : bv, v1 = hf ? bv : ov; const int i0 = hf ? oi : bi, i1 = hf ? bi : oi;
            const bool win0 = v0 >= v1;
            const int wj = win0 ? i0 : 32 + i1;
            mask |= 1ull << wj;
            const int clr = (win0 == (hf == 0)) ? (win0 ? i0 : i1) : -1;
#pragma unroll
            for (int i = 0; i < 32; ++i) v[i] = (i == clr) ? -1.0f : v[i];
        }
        if (hf == 0) ((unsigned long long*)(WSB(A) + WS_SEL))[(size_t)(b * 2 + g) * T + t] = mask;
    }
    __syncthreads();
}

__device__ __forceinline__ int fetch_unit(unsigned* ctr, LAS unsigned char* lds) {
    volatile LAS int* w = (volatile LAS int*)(lds + FETCH_OFF);
    __syncthreads();
    if (threadIdx.x == 0) *w = (int)atomicAdd(ctr, 1u);
    __syncthreads();
    return __builtin_amdgcn_readfirstlane(*w);
}
template <class Epi>
__device__ __forceinline__ void run_gemm_counted(LAS unsigned char* lds, const bf16_t* Am, const bf16_t* Bt, int N, int K, const Epi& E, unsigned* cnt) {
    pg8::Gemm g{Am, Bt, M, N, K}; CountedOrder S; S.init(M, N, (int)gridDim.x, (int)blockIdx.x); S.cnt = cnt;
    pg8::gemm_phase<Epi, CountedOrder, true, true>(lds, g, S, E);
}
template <class Epi>
__device__ __forceinline__ void run_gemm(LAS unsigned char* lds, const bf16_t* Am, const bf16_t* Bt, int N, int K, const Epi& E) {
    pg8::Gemm g{Am, Bt, M, N, K}; pg8::StaticOrder S; S.init(M, N, (int)gridDim.x, (int)blockIdx.x);
    pg8::gemm_phase<Epi, pg8::StaticOrder, true, true>(lds, g, S, E);
}

#define WSX WSB(A)
#define ctl ((unsigned*)(WSX + WS_CTL))
#define XN ((bf16_t*)(WSX + WS_XN))
#define U ((bf16_t*)(WSX + WS_U))
#define mods ((const float*)(WSX + WS_MODS))
#define wb (WSX + WS_W)
#define modl (mods + (size_t)l * 4 * 9216)
__global__ void __launch_bounds__(NTHR, 2) fwd_megakernel(Args A) {
    extern __shared__ __attribute__((aligned(16))) unsigned char lds_raw[];
    LAS unsigned char* lds = (LAS unsigned char*)lds_raw;
    cg::grid_group grid = cg::this_grid();
    const int G = gridDim.x;
    { volatile LAS unsigned* st0 = (volatile LAS unsigned*)(lds + FETCH_OFF + 16); if (threadIdx.x < 2) st0[threadIdx.x] = 0u; }
    __syncthreads();
    const unsigned xbar_x = (unsigned)__builtin_amdgcn_readfirstlane((int)xcd_barrier_post((unsigned*)(WSB(A) + WS_CTL) + 1024, (volatile LAS unsigned*)(lds + FETCH_OFF + 16)).x);
#define GSYNC() do { XcdBarrier xb_; unsigned xx_ = xbar_x; asm volatile("" : "+s"(xx_)); xb_.bar = (unsigned*)(WSB(A) + WS_CTL) + 1024; xb_.x = xx_; \
                     xb_.st = (volatile LAS unsigned*)(lds + FETCH_OFF + 16); xcd_barrier(xb_); } while (0)
    float* X = A.out;

    for (int task = blockIdx.x; task < 144; task += G) mods_task(A, task, lds);
    for (int task = blockIdx.x; task < 4; task += G) posb_task(A, task, lds);
    rope_entries(A);
    { float* ssq = (float*)(WSX + WS_SSQ); for (int i = blockIdx.x * NTHR + opq(threadIdx.x); i < 4 * M; i += G * NTHR) ssq[i] = 0.f; }
    if (blockIdx.x == 0 && threadIdx.x < 2) {
        const int tid = opq(threadIdx.x);
        const float* lp = A.in[13] + tid * 128; float s1 = 0.f, s2 = 0.f;
        for (int i = 0; i < 32; ++i) { s1 += lp[i] * lp[32 + i]; s2 += lp[64 + i] * lp[96 + i]; }
        const float lam_init = tid == 0 ? 0.2f : 0.35550907f;
        ((float*)ctl)[64 + tid] = expf(s1) - expf(s2) + lam_init;
        ((float*)ctl)[66 + tid] = 1.0f - lam_init;
    }
    __syncthreads();
    convert_layer(A, 0, lds);
#ifdef PROBE_DUPCVT
    for (int i = 0; i < PROBE_DUPCVT; ++i) { __syncthreads(); convert_layer(A, 0, lds); }
#endif
#ifdef PROBE_DUPMODS
    for (int task = blockIdx.x; task < 144; task += G) mods_task(A, task, lds);
#endif
    if (A.out == nullptr) grid.sync();
    GSYNC();

#pragma unroll 1
    for (int l = 0; l < 2; ++l) {
        if (l == 1) { __syncthreads(); convert_layer(A, 1, lds); }
#pragma unroll 1
        for (int s = 0; s < 2; ++s) {
            const float* xin = (l == 0 && s == 0) ? A.in[0] : X;
            norm_rows(xin, XN, A.in[s == 0 ? 4 : 6] + l * D, modl, s == 0 ? 0 : 6, s == 0 ? 1 : 7);
            GSYNC();
            { EpiSwiGLU E{U}; run_gemm(lds, XN, (const bf16_t*)(wb + (s == 0 ? W_1A : W_2A)), F2, D, E); }
            GSYNC();
            { EpiResid E{xin, X, modl + (s == 0 ? 2 : 8) * 1024, 0.5f}; run_gemm(lds, U, (const bf16_t*)(wb + (s == 0 ? W_1B : W_2B)), D, F, E); }
            GSYNC();
            if (s == 0 && EN_MIX) {
                norm_rows(X, XN, A.in[5] + l * D, modl, 3, 4);
                GSYNC();
                float* ssq = (float*)(WSX + WS_SSQ) + (size_t)l * 2 * M;
                { EpiProj E{U, (bf16_t*)(WSX + WS_CQ), (bf16_t*)(WSX + WS_CKV), ssq, ssq + M}; run_gemm(lds, XN, (const bf16_t*)(wb + W_IN), DINP, D, E); }
                GSYNC();
                { EpiRowScale E{(bf16_t*)(WSX + WS_MQ), 768, ssq, 1.0f / 256.0f}; run_gemm(lds, (const bf16_t*)(WSX + WS_CQ), (const bf16_t*)(wb + W_UQ), 768, 256, E); }
                { EpiRowScale E{(bf16_t*)(WSX + WS_MKV), 768, ssq + M, 1.0f / 128.0f}; run_gemm(lds, (const bf16_t*)(WSX + WS_CKV), (const bf16_t*)(wb + W_UKV), 768, 128, E); }
                for (;;) {
                    int u = fetch_unit(ctl + l * 4 + 0, lds);
                    if (u >= 256 + 512 + 384) break;
                    if (u < 256) { cmp_mlp_task(A, l, u, lds); continue; } u -= 256;
                    if (u < 512) { da_unit(A, l, (u & 15) >> 2, u & 3, 31 - (u >> 4), lds); continue; } u -= 512;
                    nsa_unit<2>(A, (u % 24) / 6, u % 6, 15 - u / 24, lds);
                }
                GSYNC();
                for (;;) {
                    int u = fetch_unit(ctl + l * 4 + 1, lds);
                    if (u >= 384 + 128) break;
                    if (u >= 128) { u -= 128; mla_unit(A, (u % 24) / 6, u % 6, 15 - u / 24, lds); continue; }
                    cmp_unit(A, (u & 7) >> 1, u & 1, 15 - (u >> 3), lds);
                }
                GSYNC();
                for (;;) {
                    const int u = fetch_unit(ctl + l * 4 + 2, lds);
                    if (u >= 384) break;
                    nsa_unit<1>(A, (u % 24) / 6, u % 6, 15 - u / 24, lds);
                }
                GSYNC();
                { EpiResid E{X, X, modl + 5 * 1024, 1.0f}; run_gemm(lds, XN, (const bf16_t*)(wb + W_OUT), D, D, E); }
                GSYNC();
            }
        }
    }
    final_norm_rows(X, A.in[22]);
#ifdef PROBE_SYNCS
    for (int i = 0; i < PROBE_SYNCS; ++i) GSYNC();
#endif
}

#undef WSX
#undef ctl
#undef XN
#undef U
#undef mods
#undef wb
#undef modl
extern "C" void kernel_launch(void* const* d_in, const int* in_sizes, int n_in, void* d_out, int out_size, void* d_ws, size_t ws_size, hipStream_t stream) {
    static int grid = 0;
    if (grid == 0) {
        if (n_in != 23 || out_size != M * D || ws_size < WS_END) { fprintf(stderr, "kernel_launch: unexpected problem shape (n_in %d out %d ws %zu)\n", n_in, out_size, ws_size); grid = -1; return; }
        int dev = 0, cus = 0, per_cu = 0;
        hipGetDevice(&dev);
        hipDeviceGetAttribute(&cus, hipDeviceAttributeMultiprocessorCount, dev);
        hipFuncSetAttribute((const void*)fwd_megakernel, hipFuncAttributeMaxDynamicSharedMemorySize, LDS_BYTES);
        hipOccupancyMaxActiveBlocksPerMultiprocessor(&per_cu, (const void*)fwd_megakernel, NTHR, LDS_BYTES);
        if (per_cu < 1) per_cu = 1;
        grid = cus * per_cu;
        (void)hipGetLastError();
    }
    if (grid < 0) return;
    hipMemsetAsync(d_ws, 0, 32768, stream);
    Args a{};
    for (int i = 0; i < 23; ++i) a.in[i] = (const float*)d_in[i];
    a.out = (float*)d_out; a.ws = (unsigned char*)d_ws;
    void* args[] = {&a};
    hipError_t e = hipLaunchCooperativeKernel((const void*)fwd_megakernel, dim3(grid), dim3(NTHR), args, LDS_BYTES, stream);
    if (e != hipSuccess) fprintf(stderr, "cooperative launch failed: %s (grid %d)\n", hipGetErrorString(e), grid);
}
```

```cpp
#include <hip/hip_runtime.h>
#include <hip/hip_cooperative_groups.h>
#include <cstdio>
#include <cstdint>
namespace cg = cooperative_groups;
extern __shared__ __attribute__((aligned(16))) unsigned char lds_raw[];
constexpr int WIDTAB_OFF = 140200;
__device__ __forceinline__ int lane_id() { return (int)__builtin_amdgcn_mbcnt_hi(~0u, __builtin_amdgcn_mbcnt_lo(~0u, 0u)); }
__device__ __forceinline__ int hw_slot() { return (int)(__builtin_amdgcn_s_getreg((5 << 11) | 4) & 63u); }
__device__ __forceinline__ int get_tid() {
    const int wid = __builtin_amdgcn_readfirstlane(*(volatile __attribute__((address_space(3))) int*)((__attribute__((address_space(3))) unsigned char*)lds_raw + WIDTAB_OFF + 4 * hw_slot()));
    return wid * 64 + lane_id();
}
__device__ __forceinline__ int pg8_opq_tid() { int v = get_tid(); asm volatile("" : "+v"(v)); return v; }
namespace pg8 {
#define PG8_LAS __attribute__((address_space(3)))
typedef unsigned short bf16_t;
typedef short bf16x8 __attribute__((ext_vector_type(8)));
typedef float f32x4 __attribute__((ext_vector_type(4)));
typedef unsigned u32x4 __attribute__((ext_vector_type(4)));
constexpr int BM = 256, BK = 64, HALF = 128, HTB = HALF * BK * 2  , STAGE_BYTES = 8 * HTB, NXCD = 8, WGM = 8;

__host__ __device__ __forceinline__ int lds_byte(int r, int c) { const int st = (r >> 4) * 2 + (c >> 5), rr = r & 15, cc = c & 31, ob = rr * 64 + cc * 2; return st * 1024 + (ob ^ (((ob >> 9) & 1) << 5)); }
__host__ __device__ __forceinline__ void stage_rc(int b, int& R, int& C) { const int st = b / 1024, sb = b % 1024, swz = sb ^ (((sb >> 9) & 1) << 5); R = (st >> 1) * 16 + swz / 64; C = (st & 1) * 32 + (swz % 64) / 2; }
__host__ __device__ __forceinline__ int perm32(int rho) { const int n = rho >> 4, i = rho & 15; return 8 * (i >> 2) + 4 * n + (i & 3); }

struct Unit { int pm, pn; };
struct Gemm { const bf16_t* A; const bf16_t* Bt; int M, N, K; };

struct StaticOrder {
    int nM, nN, nwg, G, c;
    __host__ __device__ void init(int M, int N, int G_, int c_) { nM = M / BM; nN = N / BM; nwg = nM * nN; G = G_; c = c_; }
    __host__ __device__ bool next(int i, Unit& u) const {
        const long L = (long)i * G + c; if (L >= nwg) return false;
        int wgid = (int)L; { const int q = nwg / NXCD, r = nwg % NXCD, xcd = wgid % NXCD, off = wgid / NXCD; wgid = (xcd < r ? xcd * (q + 1) : r * (q + 1) + (xcd - r) * q) + off; }
        const int nig = WGM * nN, gid = wgid / nig, fm = gid * WGM, gsz = (nM - fm) < WGM ? (nM - fm) : WGM;
        u.pm = fm + ((wgid % nig) % gsz); u.pn = (wgid % nig) / gsz; return true;
    }
    __device__ __forceinline__ void a_ready(const Unit&) const {}
    __device__ __forceinline__ void done(const Unit&) const {}
};

__device__ __forceinline__ unsigned cvt_pk_bf16(float lo, float hi) { unsigned r; asm volatile("v_cvt_pk_bf16_f32 %0, %1, %2" : "=v"(r) : "v"(lo), "v"(hi)); return r; }
typedef float f32x2 __attribute__((ext_vector_type(2)));
__device__ __forceinline__ f32x2 gelu_pk(f32x2 v) {
    const f32x2 av = __builtin_elementwise_abs(v), d = av * 0.2316418882f + 1.0f;
    f32x2 t; t.x = __builtin_amdgcn_rcpf(d.x); t.y = __builtin_amdgcn_rcpf(d.y);
    f32x2 q = t * 0.5307027145f + (-0.7265760135f); q = q * t + 0.7107068705f; q = q * t + (-0.142248368f); q = q * t + 0.127414796f; q = q * t;
    const f32x2 s = (v * v) * (-0.72134752044f);
    f32x2 e; e.x = __builtin_amdgcn_exp2f(s.x); e.y = __builtin_amdgcn_exp2f(s.y);
    const f32x2 m = v * (q * e), r = v - m;
    f32x2 o; o.x = v.x < 0.f ? m.x : r.x; o.y = v.y < 0.f ? m.y : r.y; return o;
}

template <int ACT  > struct EpiBf16 {
    static constexpr bool PERM = true, AFTER_DRAIN = false; static_assert(ACT == 0 || ACT == 1, "EpiBf16: ACT is 0 (none) or 1 (gelu_pk)");
    bf16_t* O; int ldc; const float* bias; int split_cols; size_t split_stride; float scale0;
    __device__ __forceinline__ void operator()(const f32x4 (&acc)[2][2][4][2], const Unit& u, int wr, int wc, int fr, int fq) const {
        const int row0 = u.pm * BM + wr * 64 + fr; int colt = u.pn * BM; bf16_t* base = O;
        float sc = 1.f; if (split_cols) { const int t = colt / split_cols; base += (size_t)t * split_stride; colt -= t * split_cols; if (t == 0) sc = scale0; }
        const int col0 = colt + wc * 32 + 8 * fq, bcol0 = u.pn * BM + wc * 32 + 8 * fq;
        f32x4 bv[2][2];
#pragma unroll
        for (int bj = 0; bj < 2; ++bj)
#pragma unroll
            for (int n = 0; n < 2; ++n) bv[bj][n] = bias ? *(const f32x4*)(bias + bcol0 + bj * HALF + 4 * n) : (f32x4){0.f, 0.f, 0.f, 0.f};
#pragma unroll
        for (int ai = 0; ai < 2; ++ai)
#pragma unroll
            for (int m = 0; m < 4; ++m) { bf16_t* rowp = base + (size_t)(row0 + ai * HALF + m * 16) * ldc + col0;
#pragma unroll
                for (int bj = 0; bj < 2; ++bj) { f32x4 v0 = acc[ai][bj][m][0] + bv[bj][0], v1 = acc[ai][bj][m][1] + bv[bj][1];
                    if (ACT == 1) { f32x2 a = gelu_pk((f32x2){v0[0], v0[1]}), b = gelu_pk((f32x2){v0[2], v0[3]}), c = gelu_pk((f32x2){v1[0], v1[1]}), d = gelu_pk((f32x2){v1[2], v1[3]});
                        v0 = (f32x4){a.x, a.y, b.x, b.y}; v1 = (f32x4){c.x, c.y, d.x, d.y}; }
                    v0 = v0 * sc; v1 = v1 * sc; u32x4 w; w.x = cvt_pk_bf16(v0[0], v0[1]); w.y = cvt_pk_bf16(v0[2], v0[3]); w.z = cvt_pk_bf16(v1[0], v1[1]); w.w = cvt_pk_bf16(v1[2], v1[3]);
                    *(u32x4*)(rowp + bj * HALF) = w; } }
    }
};
template <class Epi, class Sched, bool ALIGN_EPI = false, bool SP2 = false>
__device__ __forceinline__ void gemm_phase(PG8_LAS unsigned char* lds, const Gemm g, const Sched& S, const Epi& E) {
    const int tid = pg8_opq_tid(), wid = __builtin_amdgcn_readfirstlane(tid >> 6), lane = tid & 63, wr = wid >> 2, wc = wid & 3, fr = lane & 15, fq = lane >> 4;
    const int K = g.K, nt = K / BK;
    unsigned voffA[2], voffB[2];
#pragma unroll
    for (int i = 0; i < 2; ++i) { int R, C; stage_rc(tid * 16 + i * 8192, R, C); const int Rb = Epi::PERM ? ((R & ~31) + perm32(R & 31)) : R;
        voffA[i] = (unsigned)(R * K + C) * 2u; voffB[i] = (unsigned)(Rb * K + C) * 2u; }
    const size_t kstep = (size_t)(BK * 2);
    const size_t hstep = (size_t)HALF * K * 2;
    const size_t tstep = 2 * hstep;
    const unsigned ldsw = (unsigned)wid * 1024u;
    const int aoff = lds_byte(wr * 64 + fr, fq * 8), boff = lds_byte(wc * 32 + fr, fq * 8);
#define PG8_SA(b, h) (((b) * 2 + (h)) * HTB)
#define PG8_SB(b, h) ((4 + (b) * 2 + (h)) * HTB)
#define PG8_STAGE(bufoff, gbase, voff) do { _Pragma("unroll") for (int _i = 0; _i < 2; ++_i) \
        __builtin_amdgcn_global_load_lds((const unsigned*)((const char*)(gbase) + (voff)[_i]), (PG8_LAS unsigned*)(lds + (bufoff) + ldsw + _i * 8192), 16, 0, 0); } while (0)
#define PG8_LDA(dst, b, h) do { _Pragma("unroll") for (int m = 0; m < 4; ++m) _Pragma("unroll") for (int k = 0; k < 2; ++k) dst[m][k] = *(const PG8_LAS bf16x8*)(lds + PG8_SA(b, h) + aoff + m * 2048 + k * 1024); } while (0)
#define PG8_LDB(dst, b, h) do { _Pragma("unroll") for (int n = 0; n < 2; ++n) _Pragma("unroll") for (int k = 0; k < 2; ++k) dst[n][k] = *(const PG8_LAS bf16x8*)(lds + PG8_SB(b, h) + boff + n * 2048 + k * 1024); } while (0)
#define PG8_MMA(ai, bj, At, Bt) do { __builtin_amdgcn_s_setprio(1); _Pragma("unroll") for (int m = 0; m < 4; ++m) _Pragma("unroll") for (int n = 0; n < 2; ++n) _Pragma("unroll") for (int k = 0; k < 2; ++k) \
        acc[ai][bj][m][n] = __builtin_amdgcn_mfma_f32_16x16x32_bf16(Bt[n][k], At[m][k], acc[ai][bj][m][n], 0, 0, 0); __builtin_amdgcn_s_setprio(0); } while (0)
#define PG8_WAIT_V(n) asm volatile("s_waitcnt vmcnt(" #n ")" ::: "memory")
#define PG8_WAIT_L(n) asm volatile("s_waitcnt lgkmcnt(" #n ")" ::: "memory")
#define PG8_BAR __builtin_amdgcn_s_barrier()
#define PG8_SCHED __builtin_amdgcn_sched_barrier(0)
    Unit cur, nxt; int ui = 0;
    if (!S.next(0, cur)) return;
    f32x4 acc[2][2][4][2];
#pragma unroll
    for (int a = 0; a < 2; ++a)
#pragma unroll
        for (int b = 0; b < 2; ++b)
#pragma unroll
            for (int m = 0; m < 4; ++m)
#pragma unroll
                for (int n = 0; n < 2; ++n) acc[a][b][m][n] = (f32x4){0.f, 0.f, 0.f, 0.f};
    bf16x8 At[4][2], B0[2][2], B1[2][2];
    const char* cA = (const char*)g.A + (size_t)cur.pm * tstep; const char* cB = (const char*)g.Bt + (size_t)cur.pn * tstep;
    S.a_ready(cur);
    if constexpr (SP2) {
        PG8_STAGE(PG8_SB(0, 0), cB, voffB); PG8_STAGE(PG8_SB(0, 1), cB + hstep, voffB); PG8_STAGE(PG8_SA(0, 0), cA, voffA); PG8_STAGE(PG8_SA(0, 1), cA + hstep, voffA);
        if (wr == 1) PG8_BAR;
        PG8_WAIT_V(2); PG8_BAR;
        PG8_STAGE(PG8_SB(1, 0), cB + kstep, voffB); PG8_STAGE(PG8_SA(1, 0), cA + kstep, voffA); PG8_STAGE(PG8_SB(1, 1), cB + hstep + kstep, voffB);
        PG8_WAIT_V(6); PG8_BAR;
    } else {
        PG8_STAGE(PG8_SB(0, 0), cB, voffB); PG8_STAGE(PG8_SA(0, 0), cA, voffA); PG8_STAGE(PG8_SB(0, 1), cB + hstep, voffB); PG8_STAGE(PG8_SA(0, 1), cA + hstep, voffA);
        if (wr == 1) PG8_BAR;
        PG8_WAIT_V(4); PG8_BAR;
        PG8_STAGE(PG8_SB(1, 0), cB + kstep, voffB); PG8_STAGE(PG8_SA(1, 0), cA + kstep, voffA); PG8_STAGE(PG8_SB(1, 1), cB + hstep + kstep, voffB);
        PG8_WAIT_V(6); PG8_BAR;
    }
    for (;;) {
        const bool has_next = S.next(ui + 1, nxt);
        const char* nA = has_next ? (const char*)g.A + (size_t)nxt.pm * tstep : cA; const char* nB = has_next ? (const char*)g.Bt + (size_t)nxt.pn * tstep : cB;
        for (int t = 0; t < nt; t += 2) {
            const bool last = (t == nt - 2);
            const char* a1 = cA + (size_t)(t + 1) * kstep;
            const char* a2 = last ? nA : cA + (size_t)(t + 2) * kstep; const char* b2 = last ? nB : cB + (size_t)(t + 2) * kstep;
            const char* a3 = a2 + kstep; const char* b3 = b2 + kstep;
            if (last && has_next) S.a_ready(nxt);
            if constexpr (SP2) {
            PG8_LDB(B0, 0, 0); PG8_LDB(B1, 0, 1); PG8_SCHED; PG8_LDA(At, 0, 0); PG8_STAGE(PG8_SA(1, 1), a1 + hstep, voffA);
            PG8_WAIT_V(8); PG8_WAIT_L(0); PG8_BAR; PG8_MMA(0, 0, At, B0); PG8_MMA(0, 1, At, B1); PG8_BAR; PG8_SCHED;
            PG8_LDA(At, 0, 1); PG8_STAGE(PG8_SB(0, 0), b2, voffB); PG8_STAGE(PG8_SB(0, 1), b2 + hstep, voffB); PG8_STAGE(PG8_SA(0, 0), a2, voffA);
            PG8_WAIT_V(8); PG8_WAIT_L(0); PG8_BAR; PG8_MMA(1, 0, At, B0); PG8_MMA(1, 1, At, B1); PG8_BAR; PG8_SCHED;
            PG8_LDB(B0, 1, 0); PG8_LDB(B1, 1, 1); PG8_SCHED; PG8_LDA(At, 1, 0); PG8_STAGE(PG8_SA(0, 1), a2 + hstep, voffA);
            PG8_WAIT_V(8); PG8_WAIT_L(0); PG8_BAR; PG8_MMA(0, 0, At, B0); PG8_MMA(0, 1, At, B1); PG8_BAR; PG8_SCHED;
            PG8_LDA(At, 1, 1); PG8_STAGE(PG8_SB(1, 0), b3, voffB); PG8_STAGE(PG8_SB(1, 1), b3 + hstep, voffB); PG8_STAGE(PG8_SA(1, 0), a3, voffA);
            PG8_WAIT_V(8); PG8_WAIT_L(0); PG8_BAR; PG8_MMA(1, 0, At, B0); PG8_MMA(1, 1, At, B1); PG8_BAR; PG8_SCHED;
            } else {
            PG8_LDB(B0, 0, 0); PG8_SCHED; PG8_LDA(At, 0, 0); PG8_STAGE(PG8_SA(1, 1), a1 + hstep, voffA);
            PG8_WAIT_L(8); PG8_BAR; PG8_WAIT_L(0); PG8_MMA(0, 0, At, B0); PG8_BAR; PG8_SCHED;
            PG8_LDB(B1, 0, 1); PG8_STAGE(PG8_SB(0, 0), b2, voffB);
            PG8_BAR; PG8_WAIT_L(0); PG8_MMA(0, 1, At, B1); PG8_BAR;
            PG8_LDA(At, 0, 1); PG8_STAGE(PG8_SA(0, 0), a2, voffA);
            PG8_BAR; PG8_WAIT_L(0); PG8_MMA(1, 0, At, B0); PG8_BAR; PG8_SCHED;
            PG8_STAGE(PG8_SB(0, 1), b2 + hstep, voffB);
            PG8_WAIT_V(6); PG8_BAR; PG8_MMA(1, 1, At, B1); PG8_BAR;
            PG8_LDB(B0, 1, 0); PG8_SCHED; PG8_LDA(At, 1, 0); PG8_STAGE(PG8_SA(0, 1), a2 + hstep, voffA);
            PG8_WAIT_L(8); PG8_BAR; PG8_WAIT_L(0); PG8_MMA(0, 0, At, B0); PG8_BAR; PG8_SCHED;
            PG8_LDB(B1, 1, 1); PG8_STAGE(PG8_SB(1, 0), b3, voffB);
            PG8_BAR; PG8_WAIT_L(0); PG8_MMA(0, 1, At, B1); PG8_BAR;
            PG8_LDA(At, 1, 1); PG8_STAGE(PG8_SA(1, 0), a3, voffA);
            PG8_BAR; PG8_WAIT_L(0); PG8_MMA(1, 0, At, B0); PG8_BAR; PG8_SCHED;
            PG8_STAGE(PG8_SB(1, 1), b3 + hstep, voffB);
            PG8_WAIT_V(6); PG8_BAR; PG8_MMA(1, 1, At, B1); PG8_BAR;
            }
        }
        if constexpr (ALIGN_EPI) { if (wr == 0) PG8_BAR; }
        if constexpr (!Epi::AFTER_DRAIN) { E(acc, cur, wr, wc, fr, fq); S.done(cur); }
        if (!has_next) break;
#pragma unroll
        for (int a = 0; a < 2; ++a)
#pragma unroll
            for (int b = 0; b < 2; ++b)
#pragma unroll
                for (int m = 0; m < 4; ++m)
#pragma unroll
                    for (int n = 0; n < 2; ++n) acc[a][b][m][n] = (f32x4){0.f, 0.f, 0.f, 0.f};
        cur = nxt; cA = nA; cB = nB; ++ui;
        if constexpr (ALIGN_EPI) { if (wr == 1) PG8_BAR; }
    }
    PG8_WAIT_V(0);
    if constexpr (!ALIGN_EPI) { if (wr == 0) PG8_BAR; }
    PG8_BAR;
    if constexpr (Epi::AFTER_DRAIN) { E.fused(acc, cur, wr, wc, fr, fq, lds, wid, lane); S.done(cur); }
#undef PG8_SA
#undef PG8_SB
#undef PG8_STAGE
#undef PG8_LDA
#undef PG8_LDB
#undef PG8_MMA
#undef PG8_WAIT_V
#undef PG8_WAIT_L
#undef PG8_BAR
#undef PG8_SCHED
}
}

#define LAS __attribute__((address_space(3)))
typedef unsigned short bf16_t;
typedef short bf16x8 __attribute__((ext_vector_type(8)));
typedef short s16x4 __attribute__((ext_vector_type(4)));
typedef float f32x4 __attribute__((ext_vector_type(4)));
typedef float f32x2 __attribute__((ext_vector_type(2)));
typedef float f32x16 __attribute__((ext_vector_type(16)));
typedef unsigned u32x4 __attribute__((ext_vector_type(4)));
typedef unsigned u32x2 __attribute__((ext_vector_type(2)));
typedef __bf16 bf16x2_t __attribute__((ext_vector_type(2)));

#ifndef EN_MIX
#define EN_MIX 1
#endif
#ifndef EN_DA
#define EN_DA 1
#endif
#ifndef EN_MLA
#define EN_MLA 1
#endif
#ifndef EN_WIN
#define EN_WIN 1
#endif
#ifndef EN_CMP
#define EN_CMP 1
#endif
#ifndef EN_SLC
#define EN_SLC 1
#endif

constexpr int NB = 4, T = 4096, D = 1024, M = NB * T, F = 2816, F2 = 5632, DIN = 2354, DINP = 2560;
constexpr int NTHR = 512, NWAVE = 8, LDS_BYTES = 147456, FETCH_OFF = LDS_BYTES - 64;
constexpr int C_AQ = 0, C_AK = 256, C_AV = 512, C_BKR = 1152, C_CQ = 1184, C_KC = 1568, C_VC = 1696, C_KS = 1824, C_VS = 1952, C_KW = 2080, C_VW = 2208, C_G = 2336;
constexpr float LOG2E = 1.4426950408889634f, RMS_EPS = 1e-6f, NEGBIG = -1e30f;

constexpr size_t MiB = 1u << 20, KiB = 1u << 10;
constexpr size_t WS_CTL = 0;
constexpr size_t WS_MODS = 64 * KiB;
constexpr size_t WS_ROPE = 512 * KiB;
constexpr size_t WS_POSB = 1 * MiB;
constexpr size_t WS_SSQ = 1 * MiB + 64 * KiB;
constexpr size_t WS_KCMP = 2 * MiB;
constexpr size_t WS_SEL = 3 * MiB;
constexpr size_t WS_W = 4 * MiB;
constexpr size_t W_1A = 0, W_1B = W_1A + (size_t)F2 * D * 2, W_2A = W_1B + (size_t)D * F * 2, W_2B = W_2A + (size_t)F2 * D * 2,
                 W_IN = W_2B + (size_t)D * F * 2, W_OUT = W_IN + (size_t)DINP * D * 2, W_UQ = W_OUT + (size_t)D * D * 2, W_UKV = W_UQ + 768 * 256 * 2,
                 W_C1 = W_UKV + 768 * 128 * 2, W_C2 = W_C1 + 2 * 128 * 2048 * 2, W_END = W_C2 + 2 * 64 * 128 * 2;
static_assert(WS_W + W_END <= 48 * MiB, "weights");
constexpr size_t WS_XN = 48 * MiB;
constexpr size_t WS_U = 80 * MiB;
constexpr size_t WS_CQ = 168 * MiB;
constexpr size_t WS_CKV = 176 * MiB;
constexpr size_t WS_MQ = 180 * MiB;
constexpr size_t WS_MKV = 204 * MiB;
constexpr size_t WS_KPE = 228 * MiB;
constexpr size_t WS_END = 229 * MiB;

__device__ __forceinline__ unsigned cvtpk(float lo, float hi) { f32x2 v = {lo, hi}; bf16x2_t b = __builtin_convertvector(v, bf16x2_t); return __builtin_bit_cast(unsigned, b); }
__device__ __forceinline__ float bf2f(short b) { return __uint_as_float(((unsigned)(unsigned short)b) << 16); }
__device__ __forceinline__ float wave_sum(float v) {
#pragma unroll
    for (int o = 1; o < 64; o <<= 1) v += __shfl_xor(v, o);
    return v;
}
__device__ __forceinline__ float fast_exp2(float x) { return __builtin_amdgcn_exp2f(x); }
__device__ __forceinline__ float fast_rcp(float x) { return __builtin_amdgcn_rcpf(x); }
__device__ __forceinline__ float sigmoid_f(float x) { return fast_rcp(1.0f + fast_exp2(-x * LOG2E)); }
__device__ __forceinline__ int crow(int i, int h) { return (i & 3) + 8 * (i >> 2) + 4 * h; }
__device__ __forceinline__ int opq(int v) { asm volatile("" : "+v"(v)); return v; }
#define MFMA32(a, b, c) __builtin_amdgcn_mfma_f32_32x32x16_bf16((a), (b), (c), 0, 0, 0)
#define MFMA16(a, b, c) __builtin_amdgcn_mfma_f32_16x16x32_bf16((a), (b), (c), 0, 0, 0)

struct Args { const float* in[23]; float* out; unsigned char* ws; };
__device__ __forceinline__ unsigned char* ws_opq(unsigned char* p) {
    const unsigned long long v = (unsigned long long)p;
    unsigned lo = (unsigned)__builtin_amdgcn_readfirstlane((int)(unsigned)v), hi = (unsigned)__builtin_amdgcn_readfirstlane((int)(unsigned)(v >> 32));
    asm volatile("" : "+s"(lo), "+s"(hi));
    return (unsigned char*)(((unsigned long long)hi << 32) | (unsigned long long)lo);
}

struct EpiSwiGLU {
    static constexpr bool PERM = true, AFTER_DRAIN = false;
    bf16_t* O;
    __device__ __forceinline__ void operator()(const f32x4 (&acc)[2][2][4][2], const pg8::Unit& u, int wr_, int wc_, int fr_, int fq_) const {
        const int t_ = opq(get_tid()), w_ = __builtin_amdgcn_readfirstlane(t_ >> 6), wr = w_ >> 2, wc = w_ & 3, fr = t_ & 15, fq = (t_ >> 4) & 3;
        const int row0 = u.pm * 256 + wr * 64 + fr, col0 = u.pn * 128 + wc * 32 + 8 * fq;
#pragma unroll
        for (int ai = 0; ai < 2; ++ai)
#pragma unroll
            for (int m = 0; m < 4; ++m) {
                bf16_t* rowp = O + (size_t)(row0 + ai * 128 + m * 16) * F + col0;
                float r[8];
#pragma unroll
                for (int n = 0; n < 2; ++n)
#pragma unroll
                    for (int j = 0; j < 4; ++j) { const float g = acc[ai][0][m][n][j], up = acc[ai][1][m][n][j]; r[n * 4 + j] = g * sigmoid_f(g) * up; }
                u32x4 w; w.x = cvtpk(r[0], r[1]); w.y = cvtpk(r[2], r[3]); w.z = cvtpk(r[4], r[5]); w.w = cvtpk(r[6], r[7]);
                *(u32x4*)rowp = w;
            }
    }
};
struct EpiResid {
    static constexpr bool PERM = false, AFTER_DRAIN = false;
    const float* resid; float* out; const float* gate; float coef;
    __device__ __forceinline__ void operator()(const f32x4 (&acc)[2][2][4][2], const pg8::Unit& u, int wr_, int wc_, int fr_, int fq_) const {
        const int t_ = opq(get_tid()), w_ = __builtin_amdgcn_readfirstlane(t_ >> 6), wr = w_ >> 2, wc = w_ & 3, fr = t_ & 15, fq = (t_ >> 4) & 3;
        const int row0 = u.pm * 256 + wr * 64 + fr, b = (u.pm * 256) >> 12, col0 = u.pn * 256 + wc * 32 + 4 * fq;
#pragma unroll
        for (int bj = 0; bj < 2; ++bj)
#pragma unroll
            for (int n = 0; n < 2; ++n) {
                const int c = col0 + bj * 128 + n * 16;
                const f32x4 gv = *(const f32x4*)(gate + (size_t)b * 9216 + c) * coef;
#pragma unroll
                for (int ai = 0; ai < 2; ++ai)
#pragma unroll
                    for (int m = 0; m < 4; ++m) {
                        const size_t off = (size_t)(row0 + ai * 128 + m * 16) * D + c;
                        const f32x4 o = *(const f32x4*)(resid + off) + gv * acc[ai][bj][m][n];
                        *(f32x4*)(out + off) = o;
                        if (m & 1) asm volatile("" ::: "memory");
                    }
            }
    }
};
struct EpiProj {
    static constexpr bool PERM = true, AFTER_DRAIN = false;
    bf16_t* PROJ; bf16_t* CQ; bf16_t* CKV; float* ssq_q; float* ssq_kv;
    __device__ __forceinline__ void operator()(const f32x4 (&acc)[2][2][4][2], const pg8::Unit& u, int wr_, int wc_, int fr_, int fq_) const {
        const int t_ = opq(get_tid()), w_ = __builtin_amdgcn_readfirstlane(t_ >> 6), wr = w_ >> 2, wc = w_ & 3, fr = t_ & 15, fq = (t_ >> 4) & 3;
        const int row0 = u.pm * 256 + wr * 64 + fr;
#pragma unroll
        for (int bj = 0; bj < 2; ++bj) {
            bf16_t* base; int ld, cb; float* ssq;
            if (u.pn == 3) { base = CQ; ld = 256; cb = bj * 128; ssq = ssq_q; }
            else if (u.pn == 4 && bj == 0) { base = CKV; ld = 128; cb = 0; ssq = ssq_kv; }
            else { base = PROJ; ld = DINP; cb = u.pn * 256 + bj * 128; ssq = nullptr; }
            const int col0 = cb + wc * 32 + 8 * fq;
#pragma unroll
            for (int ai = 0; ai < 2; ++ai)
#pragma unroll
                for (int m = 0; m < 4; ++m) {
                    const int row = row0 + ai * 128 + m * 16;
                    const f32x4 v0 = acc[ai][bj][m][0], v1 = acc[ai][bj][m][1];
                    u32x4 w; w.x = cvtpk(v0[0], v0[1]); w.y = cvtpk(v0[2], v0[3]); w.z = cvtpk(v1[0], v1[1]); w.w = cvtpk(v1[2], v1[3]);
                    *(u32x4*)(base + (size_t)row * ld + col0) = w;
                    if (ssq) {
                        float s = (v0[0] * v0[0] + v0[1] * v0[1]) + (v0[2] * v0[2] + v0[3] * v0[3]) + (v1[0] * v1[0] + v1[1] * v1[1]) + (v1[2] * v1[2] + v1[3] * v1[3]);
                        s += __shfl_xor(s, 16); s += __shfl_xor(s, 32);
                        if (fq == 0) atomicAdd(ssq + row, s);
                    }
                    asm volatile("" ::: "memory");
                }
        }
    }
};
struct EpiRowScale {
    static constexpr bool PERM = true, AFTER_DRAIN = false;
    bf16_t* O; int ldc; const float* ssq; float inv_n;
    __device__ __forceinline__ void operator()(const f32x4 (&acc)[2][2][4][2], const pg8::Unit& u, int wr_, int wc_, int fr_, int fq_) const {
        const int t_ = opq(get_tid()), w_ = __builtin_amdgcn_readfirstlane(t_ >> 6), wr = w_ >> 2, wc = w_ & 3, fr = t_ & 15, fq = (t_ >> 4) & 3;
        const int row0 = u.pm * 256 + wr * 64 + fr, col0 = u.pn * 256 + wc * 32 + 8 * fq;
#pragma unroll
        for (int ai = 0; ai < 2; ++ai)
#pragma unroll
            for (int m = 0; m < 4; ++m) {
                const int row = row0 + ai * 128 + m * 16;
                const float rs = rsqrtf(ssq[row] * inv_n + RMS_EPS);
#pragma unroll
                for (int bj = 0; bj < 2; ++bj) {
                    const f32x4 v0 = acc[ai][bj][m][0] * rs, v1 = acc[ai][bj][m][1] * rs;
                    u32x4 w; w.x = cvtpk(v0[0], v0[1]); w.y = cvtpk(v0[2], v0[3]); w.z = cvtpk(v1[0], v1[1]); w.w = cvtpk(v1[2], v1[3]);
                    *(u32x4*)(O + (size_t)row * ldc + col0 + bj * 128) = w;
                }
                asm volatile("" ::: "memory");
            }
    }
};

template <int MODE> __device__ __forceinline__ int wrow(int n) {
    if (MODE == 1) return n < F ? ((n >> 7) * 256 + (n & 127)) : (((n - F) >> 7) * 256 + 128 + ((n - F) & 127));
    return n;
}
template <int MODE>
__device__ __forceinline__ void cvt_item(const float* W, int K, int N, int NP, bf16_t* WT, const float* kscale, LAS float* scr, int item, int lane) {
    const int nblk = NP / 32, kb = item / nblk, nb = item % nblk, k0 = 64 * kb, n0 = 32 * nb;
    const int n_rd = n0 + (lane & 31);
#pragma unroll 8
    for (int i = 0; i < 32; ++i) {
        const int kk = 2 * i + (lane >> 5);
        float v = (n_rd < N) ? W[(size_t)(k0 + kk) * N + n_rd] : 0.f;
        if (kscale) v *= kscale[k0 + kk];
        scr[kk * 33 + (lane & 31)] = v;
    }
    asm volatile("s_waitcnt lgkmcnt(0)" ::: "memory");
    const int c = lane & 7;
#pragma unroll
    for (int j = 0; j < 4; ++j) {
        const int n = (lane >> 3) + 8 * j; const LAS float* s = scr + (8 * c) * 33 + n;
        u32x4 o; o.x = cvtpk(s[0 * 33], s[1 * 33]); o.y = cvtpk(s[2 * 33], s[3 * 33]); o.z = cvtpk(s[4 * 33], s[5 * 33]); o.w = cvtpk(s[6 * 33], s[7 * 33]);
        *(u32x4*)(WT + (size_t)wrow<MODE>(n0 + n) * K + k0 + 8 * c) = o;
    }
    asm volatile("s_waitcnt lgkmcnt(0)" ::: "memory");
}
__device__ __forceinline__ void convert_layer(const Args& A, int l, LAS unsigned char* lds) {
    const int tid = opq(get_tid()), lane = tid & 63, wid = __builtin_amdgcn_readfirstlane(tid >> 6), gw = blockIdx.x * NWAVE + wid, ngw = gridDim.x * NWAVE;
    LAS float* scr = (LAS float*)(lds + wid * 8704);
    unsigned char* wb = A.ws + WS_W;
    constexpr int I_A = 16 * 176, I_B = 44 * 32, I_IN = 16 * 80, I_OUT = 16 * 32, I_UQ = 4 * 24, I_UKV = 2 * 24, I_C1 = 32 * 4, I_C2 = 2 * 2;
    constexpr int NITEMS = 2 * I_A + 2 * I_B + I_IN + I_OUT + I_UQ + I_UKV + 2 * I_C1 + 2 * I_C2;
    for (int it = gw; it < NITEMS; it += ngw) {
        int r = it;
        if (r < I_A) { cvt_item<1>(A.in[7] + (size_t)l * D * F2, D, F2, F2, (bf16_t*)(wb + W_1A), nullptr, scr, r, lane); continue; } r -= I_A;
        if (r < I_A) { cvt_item<1>(A.in[9] + (size_t)l * D * F2, D, F2, F2, (bf16_t*)(wb + W_2A), nullptr, scr, r, lane); continue; } r -= I_A;
        if (r < I_B) { cvt_item<0>(A.in[8] + (size_t)l * F * D, F, D, D, (bf16_t*)(wb + W_1B), nullptr, scr, r, lane); continue; } r -= I_B;
        if (r < I_B) { cvt_item<0>(A.in[10] + (size_t)l * F * D, F, D, D, (bf16_t*)(wb + W_2B), nullptr, scr, r, lane); continue; } r -= I_B;
        if (r < I_IN) { cvt_item<0>(A.in[11] + (size_t)l * D * DIN, D, DIN, DINP, (bf16_t*)(wb + W_IN), nullptr, scr, r, lane); continue; } r -= I_IN;
        if (r < I_OUT) { cvt_item<0>(A.in[12] + (size_t)l * D * D, D, D, D, (bf16_t*)(wb + W_OUT), nullptr, scr, r, lane); continue; } r -= I_OUT;
        if (r < I_UQ) { cvt_item<0>(A.in[17] + (size_t)l * 256 * 576, 256, 576, 768, (bf16_t*)(wb + W_UQ), A.in[15] + l * 256, scr, r, lane); continue; } r -= I_UQ;
        if (r < I_UKV) { cvt_item<0>(A.in[18] + (size_t)l * 128 * 768, 128, 768, 768, (bf16_t*)(wb + W_UKV), A.in[16] + l * 128, scr, r, lane); continue; } r -= I_UKV;
        if (r < 2 * I_C1) { const int kv = r / I_C1; cvt_item<0>(A.in[20] + (size_t)(l * 2 + kv) * 2048 * 128, 2048, 128, 128, (bf16_t*)(wb + W_C1) + (size_t)kv * 128 * 2048, nullptr, scr, r % I_C1, lane); continue; } r -= 2 * I_C1;
        { const int kv = r / I_C2; cvt_item<0>(A.in[21] + (size_t)(l * 2 + kv) * 128 * 64, 128, 64, 64, (bf16_t*)(wb + W_C2) + (size_t)kv * 64 * 128, nullptr, scr, r % I_C2, lane); }
    }
}
__device__ __forceinline__ void mods_task(const Args& A, int task, LAS unsigned char* lds) {
    const int tid = opq(get_tid()), lane = tid & 63, wid = __builtin_amdgcn_readfirstlane(tid >> 6);
    const int l = task / 144, chunk = task % 144;
    LAS float* cond = (LAS float*)lds;
    LAS float* red = (LAS float*)(lds + 16384);
    __syncthreads();
    for (int i = tid; i < 4096; i += NTHR) { const float c = A.in[1][i]; cond[i] = c / (1.0f + expf(-c)); }
    __syncthreads();
    const float* W = A.in[2] + (size_t)l * D * 9216 + chunk * 64 + lane;
    float acc[4] = {0.f, 0.f, 0.f, 0.f};
#pragma unroll 16
    for (int kk = 0; kk < 128; ++kk) {
        const int k = wid * 128 + kk;
        const float w = W[(size_t)k * 9216];
#pragma unroll
        for (int b = 0; b < 4; ++b) acc[b] += cond[b * 1024 + k] * w;
    }
#pragma unroll
    for (int b = 0; b < 4; ++b) red[(wid * 4 + b) * 64 + lane] = acc[b];
    __syncthreads();
    if (tid < 256) {
        const int b = tid >> 6, col = tid & 63; float s = 0.f;
#pragma unroll
        for (int w = 0; w < 8; ++w) s += red[(w * 4 + b) * 64 + col];
        s += A.in[3][(size_t)l * 9216 + chunk * 64 + col];
        ((float*)(A.ws + WS_MODS))[(size_t)(l * 4 + b) * 9216 + chunk * 64 + col] = s;
    }
    __syncthreads();
}
__device__ __forceinline__ void posb_task(const Args& A, int task, LAS unsigned char* lds) {
    const int tid = opq(get_tid());
    const int lkv = task >> 4, kp = task & 15, hid = tid & 127, sub = tid >> 7;
    const float* pos = A.in[19] + (size_t)lkv * 2048 + kp * 128 + sub * 32; const float* w1 = A.in[20] + ((size_t)lkv * 2048 + kp * 128 + sub * 32) * 128 + hid;
    float s = 0.f;
#pragma unroll
    for (int k = 0; k < 32; ++k) s += pos[k] * w1[(size_t)k * 128];
    LAS float* red = (LAS float*)lds;
    __syncthreads();
    red[tid] = s;
    __syncthreads();
    if (tid < 128) ((float*)(A.ws + WS_POSB + 4096))[task * 128 + tid] = red[tid] + red[tid + 128] + red[tid + 256] + red[tid + 384];
    __syncthreads();
}
__device__ __forceinline__ void posb_final(const Args& A) {
    const int o = opq(get_tid());
    const float* part = (const float*)(A.ws + WS_POSB + 4096) + (size_t)(o >> 7) * 16 * 128 + (o & 127);
    float s = 0.f;
#pragma unroll
    for (int p = 0; p < 16; ++p) s += part[p * 128];
    ((float*)(A.ws + WS_POSB))[o] = s;
}
__device__ __forceinline__ void rope_entries(const Args& A) {
    const int gtid = blockIdx.x * NTHR + opq(get_tid()), gn = gridDim.x * NTHR;
    float* tab = (float*)(A.ws + WS_ROPE);
    for (int e = gtid; e < T * 16; e += gn) {
        const int t = e >> 4, i = e & 15;
        double inv = 1.0; for (int j = 0; j < i; ++j) inv *= 0.5623413251903491;
        const float ang = (float)t * (float)inv;
        const double rev = (double)ang * 0.15915494309189535; const double fr = rev - __builtin_rint(rev);
        tab[e] = __builtin_amdgcn_cosf((float)fr); tab[T * 16 + e] = __builtin_amdgcn_sinf((float)fr);
    }
}
__device__ __forceinline__ void norm_rows(const float* X, bf16_t* out, const float* g, const float* modl, int ish, int isc) {
    const int tid = opq(get_tid()), lane = tid & 63, wid = __builtin_amdgcn_readfirstlane(tid >> 6), gw = blockIdx.x * NWAVE + wid, ngw = gridDim.x * NWAVE;
    for (int row = gw; row < M; row += ngw) {
        const int b = row >> 12;
        const f32x4* xr = (const f32x4*)(X + (size_t)row * D) + lane;
        f32x4 v[4]; float ss = 0.f;
#pragma unroll
        for (int j = 0; j < 4; ++j) { v[j] = xr[64 * j]; ss += (v[j].x * v[j].x + v[j].y * v[j].y) + (v[j].z * v[j].z + v[j].w * v[j].w); }
        const float rstd = rsqrtf(wave_sum(ss) * (1.0f / D) + RMS_EPS);
#pragma unroll
        for (int j = 0; j < 4; ++j) {
            const int col = 4 * lane + 256 * j;
            const f32x4 g4 = *(const f32x4*)(g + col), sc = *(const f32x4*)(modl + (size_t)b * 9216 + isc * 1024 + col), sh = *(const f32x4*)(modl + (size_t)b * 9216 + ish * 1024 + col);
            const f32x4 y = (v[j] * rstd) * g4 * (sc + 1.0f) + sh;
            u32x2 w; w.x = cvtpk(y.x, y.y); w.y = cvtpk(y.z, y.w);
            *(u32x2*)(out + (size_t)row * D + col) = w;
        }
    }
}
__device__ __forceinline__ void final_norm_rows(float* X, const float* g) {
    const int tid = opq(get_tid()), lane = tid & 63, wid = __builtin_amdgcn_readfirstlane(tid >> 6), gw = blockIdx.x * NWAVE + wid, ngw = gridDim.x * NWAVE;
    for (int row = gw; row < M; row += ngw) {
        f32x4* xr = (f32x4*)(X + (size_t)row * D) + lane;
        f32x4 v[4]; float ss = 0.f;
#pragma unroll
        for (int j = 0; j < 4; ++j) { v[j] = xr[64 * j]; ss += (v[j].x * v[j].x + v[j].y * v[j].y) + (v[j].z * v[j].z + v[j].w * v[j].w); }
        const float rstd = rsqrtf(wave_sum(ss) * (1.0f / D) + RMS_EPS);
#pragma unroll
        for (int j = 0; j < 4; ++j) { const f32x4 g4 = *(const f32x4*)(g + 4 * lane + 256 * j); xr[64 * j] = (v[j] * rstd) * g4; }
    }
}

__device__ __forceinline__ void norm_block(const float* X, bf16_t* out, const float* g, const float* modl, int ish, int isc, int row0) {
    const int tid = opq(get_tid()), lane = tid & 63, wid = __builtin_amdgcn_readfirstlane(tid >> 6);
    const int b = row0 >> 12;
#pragma unroll 1
    for (int rr = 0; rr < 8; ++rr) {
        const int row = row0 + rr * 8 + wid;
        const f32x4* xr = (const f32x4*)(X + (size_t)row * D) + lane;
        f32x4 v[4]; float ss = 0.f;
#pragma unroll
        for (int j = 0; j < 4; ++j) { v[j] = xr[64 * j]; ss += (v[j].x * v[j].x + v[j].y * v[j].y) + (v[j].z * v[j].z + v[j].w * v[j].w); }
        const float rstd = rsqrtf(wave_sum(ss) * (1.0f / D) + RMS_EPS);
#pragma unroll
        for (int j = 0; j < 4; ++j) {
            const int col = 4 * lane + 256 * j;
            const f32x4 g4 = *(const f32x4*)(g + col), sc = *(const f32x4*)(modl + (size_t)b * 9216 + isc * 1024 + col), sh = *(const f32x4*)(modl + (size_t)b * 9216 + ish * 1024 + col);
            const f32x4 y = (v[j] * rstd) * g4 * (sc + 1.0f) + sh;
            u32x2 w; w.x = cvtpk(y.x, y.y); w.y = cvtpk(y.z, y.w);
            *(u32x2*)(out + (size_t)row * D + col) = w;
        }
    }
}
__device__ __forceinline__ void final_norm_block(float* X, const float* g, int row0) {
    const int tid = opq(get_tid()), lane = tid & 63, wid = __builtin_amdgcn_readfirstlane(tid >> 6);
#pragma unroll 1
    for (int rr = 0; rr < 8; ++rr) {
        const int row = row0 + rr * 8 + wid;
        f32x4* xr = (f32x4*)(X + (size_t)row * D) + lane;
        f32x4 v[4]; float ss = 0.f;
#pragma unroll
        for (int j = 0; j < 4; ++j) { v[j] = xr[64 * j]; ss += (v[j].x * v[j].x + v[j].y * v[j].y) + (v[j].z * v[j].z + v[j].w * v[j].w); }
        const float rstd = rsqrtf(wave_sum(ss) * (1.0f / D) + RMS_EPS);
#pragma unroll
        for (int j = 0; j < 4; ++j) { const f32x4 g4 = *(const f32x4*)(g + 4 * lane + 256 * j); xr[64 * j] = (v[j] * rstd) * g4; }
    }
}
struct CountedOrder : pg8::StaticOrder {
    unsigned* cnt;
    __device__ __forceinline__ void done(const pg8::Unit& u) const {
        __builtin_amdgcn_fence(__ATOMIC_RELEASE, "agent");
        if ((get_tid() & 63) == 0) __hip_atomic_fetch_add(cnt + u.pm, 1u, __ATOMIC_RELAXED, __HIP_MEMORY_SCOPE_AGENT);
    }
};
__device__ __forceinline__ void panel_wait(unsigned* cnt, int pm) {
    if (get_tid() == 0) {
        unsigned sp = 0;
        while (__hip_atomic_load(cnt + pm, __ATOMIC_RELAXED, __HIP_MEMORY_SCOPE_AGENT) < 32u) { __builtin_amdgcn_s_sleep(2); if (++sp > (1u << 22)) break; }
    }
    __syncthreads();
    __builtin_amdgcn_fence(__ATOMIC_ACQUIRE, "agent");
}

__device__ __forceinline__ void kpe_unit(const Args& A, int unit) {
    const int tid = opq(get_tid());
    unsigned char* w_ = ws_opq(A.ws);
    const bf16_t* P = (const bf16_t*)(w_ + WS_U); bf16_t* KPE = (bf16_t*)(w_ + WS_KPE); const float* rope = (const float*)(w_ + WS_ROPE);
#pragma unroll 2
    for (int k = 0; k < 8; ++k) {
        const int e = unit * 4096 + k * 512 + tid;
        const int row = e >> 4, i = e & 15, t = row & (T - 1);
        const float x0 = bf2f((short)P[(size_t)row * DINP + C_BKR + i]), x1 = bf2f((short)P[(size_t)row * DINP + C_BKR + 16 + i]);
        const float c = rope[t * 16 + i], sn = rope[T * 16 + t * 16 + i];
        KPE[(size_t)row * 32 + i] = (bf16_t)(cvtpk(x0 * c - x1 * sn, 0.f) & 0xffffu);
        KPE[(size_t)row * 32 + 16 + i] = (bf16_t)(cvtpk(x1 * c + x0 * sn, 0.f) & 0xffffu);
    }
}

constexpr int CTL_KN = 128;
__device__ __forceinline__ void kn_rows(const Args& A, int l) {
    const int tid = opq(get_tid()), lane = tid & 63, wid = __builtin_amdgcn_readfirstlane(tid >> 6), gw = blockIdx.x * NWAVE + wid, ngw = gridDim.x * NWAVE;
    unsigned char* w_ = ws_opq(A.ws);
    const bf16_t* P = (const bf16_t*)(w_ + WS_U); unsigned* kn = (unsigned*)(w_ + WS_CTL) + CTL_KN + l * 48;
    const int col2 = lane < 32 ? C_KS + 4 * lane : C_KW + 4 * (lane - 32);
    for (int it = gw; it < M / 16; it += ngw) {
        float m1 = 0.f, m2 = 0.f;
#pragma unroll 4
        for (int rr = 0; rr < 16; ++rr) {
            const bf16_t* rp = P + (size_t)(it * 16 + rr) * DINP;
            const s16x4 v1 = *(const s16x4*)(rp + C_AK + 4 * lane), v2 = *(const s16x4*)(rp + col2);
            float s1 = 0.f, s2 = 0.f;
#pragma unroll
            for (int j = 0; j < 4; ++j) { const float x = bf2f(v1[j]), y = bf2f(v2[j]); s1 += x * x; s2 += y * y; }
            s1 += __shfl_xor(s1, 1); s1 += __shfl_xor(s1, 2); s1 += __shfl_xor(s1, 4);
            s2 += __shfl_xor(s2, 1); s2 += __shfl_xor(s2, 2); s2 += __shfl_xor(s2, 4); s2 += __shfl_xor(s2, 8);
            m1 = fmaxf(m1, s1); m2 = fmaxf(m2, s2);
        }
        const int b = (it * 16) >> 12;
        if ((lane & 7) == 0) atomicMax(kn + b * 12 + (lane >> 3), __float_as_uint(m1));
        if ((lane & 15) == 0) atomicMax(kn + b * 12 + (lane < 32 ? 10 + (lane >> 4) : 8 + ((lane - 32) >> 4)), __float_as_uint(m2));
    }
}
#define XB_TMO      128
#define XB_XCNT(j)  (256  + 64 * (j))
#define XB_XSUB(j)  (1280 + 64 * (j))
#define XB_XGEN(j)  (2304 + 64 * (j))
#define XB_TOP      3328
#define XB_TOPGEN   3392
#define XCD_BAR_WORDS 3456
#define XB_SPIN_CAP (1u << 18)

__device__ __forceinline__ unsigned xb_ld(unsigned* p)              { return __hip_atomic_load(p, __ATOMIC_RELAXED, __HIP_MEMORY_SCOPE_AGENT); }
__device__ __forceinline__ unsigned xb_add(unsigned* p, unsigned v) { return __hip_atomic_fetch_add(p, v, __ATOMIC_RELAXED, __HIP_MEMORY_SCOPE_AGENT); }
__device__ __forceinline__ unsigned xb_xcc_id() { return (unsigned)__builtin_amdgcn_s_getreg((3 << 11) | 20) & 0xFu; }
#define XB_SPIN(cond, bar) do { unsigned _sp = 0; while (cond) { __builtin_amdgcn_s_sleep(1); \
    if ((++_sp & 255u) == 0u) { if (xb_ld(&(bar)[XB_TMO])) break; if (_sp > XB_SPIN_CAP) { atomicAdd(&(bar)[XB_TMO], 1u); break; } } } } while (0)

struct XcdBarrier {
    unsigned* bar; unsigned x;
    volatile LAS unsigned* st;
};

__device__ __forceinline__ XcdBarrier xcd_barrier_post(unsigned* bar, volatile LAS unsigned* st) {
    XcdBarrier b; b.bar = bar; b.x = xb_xcc_id(); b.st = st;
    if (get_tid() == 0) (void)xb_add(&bar[XB_XCNT(b.x)], 1u);
    return b;
}
__device__ __forceinline__ void xcd_barrier_complete(unsigned* bar, unsigned x, unsigned& nloc, unsigned& nx) {
    const unsigned G = gridDim.x * gridDim.y * gridDim.z;
    unsigned sum, cnt, mine, sp = 0u;
    for (;;) {
        sum = 0u; cnt = 0u; mine = 0u;
#pragma unroll
        for (unsigned j = 0; j < 16; ++j) { const unsigned c = xb_ld(&bar[XB_XCNT(j)]); sum += c; cnt += (c > 0u) ? 1u : 0u; mine = (j == x) ? c : mine; }
        if (sum == G) break;
        __builtin_amdgcn_s_sleep(1);
        if ((++sp & 255u) == 0u) { if (xb_ld(&bar[XB_TMO])) break; if (sp > XB_SPIN_CAP) { atomicAdd(&bar[XB_TMO], 1u); break; } }
    }
    nloc = mine > 0u ? mine : 1u; nx = cnt > 0u ? cnt : 1u;
}

__device__ __forceinline__ void xcd_barrier(const XcdBarrier& b) {
    asm volatile("s_waitcnt vmcnt(0)" ::: "memory");
    __syncthreads();
    if (get_tid() == 0) {
        unsigned* bar = b.bar;
        __builtin_amdgcn_s_waitcnt(0);
        unsigned nloc = b.st[0], nx = b.st[1];
        if (nloc == 0u) { xcd_barrier_complete(bar, b.x, nloc, nx); b.st[0] = nloc; b.st[1] = nx; }
        const unsigned old = xb_add(&bar[XB_XSUB(b.x)], 1u);
        const unsigned gen = old / nloc;
        if (old + 1u == (gen + 1u) * nloc) {
            __builtin_amdgcn_fence(__ATOMIC_RELEASE, "agent");
            asm volatile("s_waitcnt vmcnt(0)" ::: "memory");
            const unsigned og = xb_add(&bar[XB_TOP], 1u);
            const unsigned tg = og / nx;
            if (og + 1u == (tg + 1u) * nx) xb_add(&bar[XB_TOPGEN], 1u);
            else XB_SPIN(xb_ld(&bar[XB_TOPGEN]) == tg, bar);
            __builtin_amdgcn_fence(__ATOMIC_ACQUIRE, "agent");
            xb_add(&bar[XB_XGEN(b.x)], 1u);
            asm volatile("s_waitcnt vmcnt(0)" ::: "memory");
        } else {
            XB_SPIN(xb_ld(&bar[XB_XGEN(b.x)]) == gen, bar);
            __builtin_amdgcn_fence(__ATOMIC_ACQUIRE, "agent");
            asm volatile("s_waitcnt vmcnt(0)" ::: "memory");
        }
    }
    __syncthreads();
}

struct AttnArgs {
    const bf16_t* Q; int qpitch;
    const bf16_t* K1; int k1pitch;
    const bf16_t* K2; int k2pitch;
    const bf16_t* V; int vpitch;
    const float* rope;
    const unsigned long long* sel;
    float scale2, slope2; int window;
    float kmax;
};
constexpr int ATT_K_OFF = 0, ATT_V_OFF = 16384, ATT_BUF = 24576;

__device__ __forceinline__ s16x4 vtr(const LAS unsigned char* p) {
    typedef short v4i16_t __attribute__((ext_vector_type(4)));
    return __builtin_bit_cast(s16x4, __builtin_amdgcn_ds_read_tr16_b64_v4i16((LAS v4i16_t*)p));
}
template <bool ROWSUM> __device__ __forceinline__ void pv_tile_t(f32x16 (&o)[2], f32x16& osum, const f32x16& p0, const f32x16& p1, const LAS unsigned char* vl, int lane) {
    const int h = lane >> 5, i16 = lane & 15, q4 = i16 >> 2, p4 = i16 & 3, blk = (lane >> 4) & 1;
    const unsigned onew = ((lane & 31) == 0) ? 0x3f803f80u : 0u;
    const bf16x8 ones = __builtin_bit_cast(bf16x8, (u32x4){onew, onew, onew, onew});
    const LAS unsigned char* vb = vl + (4 * h + q4) * 64 + blk * 32 + p4 * 8;
#pragma unroll
    for (int s = 0; s < 4; ++s) {
        u32x4 pw;
        if (s == 0) { pw.x = cvtpk(p0[0], p0[1]); pw.y = cvtpk(p0[2], p0[3]); pw.z = cvtpk(p0[4], p0[5]); pw.w = cvtpk(p0[6], p0[7]); }
        else if (s == 1) { pw.x = cvtpk(p0[8], p0[9]); pw.y = cvtpk(p0[10], p0[11]); pw.z = cvtpk(p0[12], p0[13]); pw.w = cvtpk(p0[14], p0[15]); }
        else if (s == 2) { pw.x = cvtpk(p1[0], p1[1]); pw.y = cvtpk(p1[2], p1[3]); pw.z = cvtpk(p1[4], p1[5]); pw.w = cvtpk(p1[6], p1[7]); }
        else { pw.x = cvtpk(p1[8], p1[9]); pw.y = cvtpk(p1[10], p1[11]); pw.z = cvtpk(p1[12], p1[13]); pw.w = cvtpk(p1[14], p1[15]); }
        const bf16x8 pf = __builtin_bit_cast(bf16x8, pw);
#pragma unroll
        for (int db = 0; db < 2; ++db) {
            const s16x4 lo = vtr(vb + db * 4096 + (16 * s) * 64), hi = vtr(vb + db * 4096 + (16 * s + 8) * 64);
            const bf16x8 vf = __builtin_shufflevector(lo, hi, 0, 1, 2, 3, 4, 5, 6, 7);
            o[db] = MFMA32(vf, pf, o[db]);
        }
        if (ROWSUM) osum = MFMA32(ones, pf, osum);
    }
}
__device__ __forceinline__ void pv_tile(f32x16 (&o)[2], const f32x16& p0, const f32x16& p1, const LAS unsigned char* vl, int lane) {
    f32x16 dummy; pv_tile_t<false>(o, dummy, p0, p1, vl, lane);
}
template <int MODE> __device__ __forceinline__ void store_o(const f32x16 (&o)[2], bf16_t* out_row, int h, float sc) {
#pragma unroll
    for (int db = 0; db < 2; ++db)
#pragma unroll
        for (int g4 = 0; g4 < 4; ++g4) {
            bf16_t* p = out_row + 32 * db + 8 * g4 + 4 * h;
            float v0 = o[db][4 * g4] * sc, v1 = o[db][4 * g4 + 1] * sc, v2 = o[db][4 * g4 + 2] * sc, v3 = o[db][4 * g4 + 3] * sc;
            if (MODE == 1) { const u32x2 old = *(const u32x2*)p; v0 += __uint_as_float(old.x << 16); v1 += __uint_as_float(old.x & 0xffff0000u); v2 += __uint_as_float(old.y << 16); v3 += __uint_as_float(old.y & 0xffff0000u); }
            u32x2 w; w.x = cvtpk(v0, v1); w.y = cvtpk(v2, v3);
            *(u32x2*)p = w;
        }
}

constexpr int ATT_FLAG_OFF = 140480;
template <int DQK, bool ROPE, bool SEL, bool DUAL = false, bool EARLY = false>
__device__ __forceinline__ void attn_core(const AttnArgs& a, int q0, LAS unsigned char* lds, f32x16 (&o)[2]) {
    constexpr int KS = DQK / 16, DK = DUAL ? 2 * DQK : DQK, KP = DK * 2 + 16, D1 = DK < 64 ? DK : 64, NCH1 = D1 / 8, QROWS = DUAL ? 128 : 256;
    const int tid = opq(get_tid()), lane = tid & 63, wid = __builtin_amdgcn_readfirstlane(tid >> 6), r = lane & 31, h = lane >> 5;
    const int wq = DUAL ? (wid & 3) : wid, coff = DUAL ? (wid >> 2) * DQK : 0;
    const int qw0 = q0 + 32 * wq, qpos = qw0 + r;
    LAS unsigned char* Kl = lds + ATT_K_OFF; LAS unsigned char* Vl = lds + ATT_V_OFF;
    bf16x8 qf[KS];
    {
        const bf16_t* qrow = a.Q + (size_t)qpos * a.qpitch + coff;
#pragma unroll
        for (int ks = 0; ks < KS; ++ks) qf[ks] = *(const bf16x8*)(qrow + 16 * ks + 8 * h);
        if (ROPE) {
            const float* cs = a.rope + (size_t)qpos * 16 + 8 * h; const float* sn = cs + T * 16;
            float y0[8], y1[8];
#pragma unroll
            for (int j = 0; j < 8; ++j) { const float x0 = bf2f(qf[KS - 2][j]), x1 = bf2f(qf[KS - 1][j]), c = cs[j], s = sn[j]; y0[j] = x0 * c - x1 * s; y1[j] = x1 * c + x0 * s; }
            u32x4 w0, w1;
            w0.x = cvtpk(y0[0], y0[1]); w0.y = cvtpk(y0[2], y0[3]); w0.z = cvtpk(y0[4], y0[5]); w0.w = cvtpk(y0[6], y0[7]);
            w1.x = cvtpk(y1[0], y1[1]); w1.y = cvtpk(y1[2], y1[3]); w1.z = cvtpk(y1[4], y1[5]); w1.w = cvtpk(y1[6], y1[7]);
            qf[KS - 2] = __builtin_bit_cast(bf16x8, w0); qf[KS - 1] = __builtin_bit_cast(bf16x8, w1);
        }
    }
    float qk_bound = 0.f;
    if (EARLY) {
        float qq = 0.f;
#pragma unroll
        for (int ks = 0; ks < KS; ++ks)
#pragma unroll
            for (int j = 0; j < 8; ++j) { const float x = bf2f(qf[ks][j]); qq += x * x; }
        qq += __shfl_xor(qq, 32);
        qk_bound = sqrtf(qq) * a.kmax * a.scale2 * 1.001f + 0.01f;
    }
    unsigned long long selm = ~0ull;
    if (SEL) selm = a.sel[qpos];
    const int t_hi = (q0 + QROWS - 1) >> 6;
    int t_lo = 0;
    if (a.window) { const int lo = q0 - a.window + 1; t_lo = lo > 0 ? (lo >> 6) : 0; }
    const bool kA_on = tid < 64 * NCH1; const int rowA = tid / NCH1, chA = tid % NCH1;
    const bool kB_on = ROPE && tid < 128; const int rowB = tid >> 1, prB = tid & 1;
    const int rowV = tid >> 3, chV = tid & 7;
    u32x4 kA = {0, 0, 0, 0}, kB0 = {0, 0, 0, 0}, kB1 = {0, 0, 0, 0}, vR = {0, 0, 0, 0};
#define ATT_PREFETCH(t) do { \
        if (kA_on) kA = *(const u32x4*)(a.K1 + (size_t)(64 * (t) + rowA) * a.k1pitch + chA * 8); \
        if (kB_on) { const bf16_t* kp = a.K2 + (size_t)(64 * (t) + rowB) * a.k2pitch + prB * 8; kB0 = *(const u32x4*)kp; kB1 = *(const u32x4*)(kp + 16); } \
        vR = *(const u32x4*)(a.V + (size_t)(64 * (t) + rowV) * a.vpitch + chV * 8); } while (0)
#define ATT_STORE(tt, KL, VL) do { \
        if (kA_on) *(LAS u32x4*)((KL) + rowA * KP + chA * 16) = kA; \
        if (ROPE) { if (kB_on) { \
                *(LAS u32x4*)((KL) + rowB * KP + (64 + prB * 8) * 2) = kB0; \
                *(LAS u32x4*)((KL) + rowB * KP + (80 + prB * 8) * 2) = kB1; } } \
        *(LAS u32x4*)((VL) + (chV >> 2) * 4096 + rowV * 64 + (chV & 3) * 16) = vR; } while (0)
    float m = NEGBIG;
    f32x16 osum;
#pragma unroll
    for (int i = 0; i < 16; ++i) { o[0][i] = 0.f; o[1][i] = 0.f; osum[i] = 0.f; }
    float cbv[16];
#pragma unroll
    for (int i = 0; i < 16; ++i) cbv[i] = a.slope2 * (float)((i & 3) + 8 * (i >> 2) + 4 * h);
    volatile LAS unsigned* eflag = (volatile LAS unsigned*)(lds + ATT_FLAG_OFF);
    const int nsteps = t_hi - t_lo + 1;
    ATT_PREFETCH(t_hi);
    if (EARLY) { if (lane == 0) { eflag[wid] = 0u; eflag[8 + wid] = 0u; } }
    __syncthreads();
    ATT_STORE(t_hi, Kl, Vl);
    __syncthreads();
    if (1 < nsteps) ATT_PREFETCH(t_hi - 1);
    for (int step = 0; step < nsteps; ++step) {
        const int cur = step & 1, t = t_hi - step;
        const LAS unsigned char* Kc = Kl + cur * ATT_BUF; const LAS unsigned char* Vc = Vl + cur * ATT_BUF;
        bool need = (64 * t <= qw0 + 31);
        if (a.window) need = need && (64 * t + 63 >= qw0 - a.window + 1);
        const bool selbit = SEL ? (((selm >> t) & 1ull) != 0ull) : true;
        if (SEL) need = need && (__ballot(selbit) != 0ull);
        if (need) {
            f32x16 p0, p1;
#pragma unroll
            for (int i = 0; i < 16; ++i) { p0[i] = 0.f; p1[i] = 0.f; }
#pragma unroll
            for (int ks = 0; ks < KS; ++ks) {
                const bf16x8 a0 = *(const LAS bf16x8*)(Kc + r * KP + coff * 2 + ks * 32 + h * 16);
                const bf16x8 a1 = *(const LAS bf16x8*)(Kc + (32 + r) * KP + coff * 2 + ks * 32 + h * 16);
                p0 = MFMA32(a0, qf[ks], p0); p1 = MFMA32(a1, qf[ks], p1);
            }
#pragma unroll
            for (int i = 0; i < 16; ++i) { p0[i] = p0[i] * a.scale2 + cbv[i]; p1[i] = p1[i] * a.scale2 + cbv[i]; }
            const float base0 = a.slope2 * (float)(64 * t - qpos), base1 = base0 + 32.0f * a.slope2;
            bool bnd = (64 * t + 63 > qw0);
            if (a.window) bnd = bnd || (64 * t < qw0 + 31 - a.window + 1);
            if (SEL) bnd = bnd || (__ballot(!selbit) != 0ull);
            if (bnd) {
                const int wlim = a.window ? a.window : (1 << 30);
#pragma unroll
                for (int i = 0; i < 16; ++i) {
                    const int kv0 = 64 * t + crow(i, h), d0 = qpos - kv0, d1 = d0 - 32;
                    const bool ok0 = selbit && d0 >= 0 && d0 < wlim, ok1 = selbit && d1 >= 0 && d1 < wlim;
                    p0[i] = ok0 ? p0[i] : NEGBIG; p1[i] = ok1 ? p1[i] : NEGBIG;
                }
            }
            float mx0 = p0[0], mx1 = p1[0];
#pragma unroll
            for (int i = 1; i < 16; ++i) { mx0 = fmaxf(mx0, p0[i]); mx1 = fmaxf(mx1, p1[i]); }
            float mloc = fmaxf(mx0 + base0, mx1 + base1);
            mloc = fmaxf(mloc, __shfl_xor(mloc, 32));
            const float mnew = fmaxf(m, mloc);
            if (__ballot(mnew > m) != 0ull) {
                const float alpha = fast_exp2(m - mnew);
                osum[0] *= alpha;
#pragma unroll
                for (int i = 0; i < 16; ++i) { o[0][i] *= alpha; o[1][i] *= alpha; }
            }
            m = mnew;
            const float r0 = mnew - base0, r1 = mnew - base1;
#pragma unroll
            for (int i = 0; i < 16; ++i) { p0[i] = fast_exp2(p0[i] - r0); p1[i] = fast_exp2(p1[i] - r1); }
            pv_tile_t<true>(o, osum, p0, p1, Vc, lane);
        }
        if (EARLY) {
            const bool live = !(qk_bound - a.slope2 * (float)(qpos - 64 * t + 1) - m < -64.0f);
            const bool wdone = (__ballot(live) == 0ull);
            if (lane == 0) eflag[8 * cur + wid] = wdone ? 1u : 0u;
        }
        if (step + 1 < nsteps) ATT_STORE(t - 1, Kl + (cur ^ 1) * ATT_BUF, Vl + (cur ^ 1) * ATT_BUF);
        __syncthreads();
        if (EARLY) {
            const unsigned alld = eflag[8 * cur] & eflag[8 * cur + 1] & eflag[8 * cur + 2] & eflag[8 * cur + 3] & eflag[8 * cur + 4] & eflag[8 * cur + 5] & eflag[8 * cur + 6] & eflag[8 * cur + 7];
            if (__builtin_amdgcn_readfirstlane((int)alld) != 0) break;
        }
        if (step + 2 < nsteps) ATT_PREFETCH(t - 2);
    }
#undef ATT_STORE
#undef ATT_PREFETCH
    const float lt = __shfl(osum[0], lane & 31);
    const float inv = 1.0f / lt;
#pragma unroll
    for (int i = 0; i < 16; ++i) { o[0][i] *= inv; o[1][i] *= inv; }
}

__device__ __forceinline__ float da_slope(int hd) { return hd == 0 ? 0.25f : hd == 1 ? 0.0625f : hd == 2 ? 0.015625f : 0.00390625f; }
__device__ __forceinline__ float nsa_slope(int hh) { return hh == 0 ? 0.25f : hh == 1 ? 0.0625f : hh == 2 ? 0.015625f : hh == 3 ? 0.00390625f : hh == 4 ? 0.5f : 0.125f; }

constexpr int DA_X_OFF = 49152;
__device__ __forceinline__ void da_unit(const Args& A, int l, int b, int hd, int qb, LAS unsigned char* lds) {
    const int tid_ = opq(get_tid()), lane = tid_ & 63, wid = __builtin_amdgcn_readfirstlane(tid_ >> 6), r = lane & 31, h = lane >> 5;
    const bf16_t* P = (const bf16_t*)(A.ws + WS_U) + (size_t)b * T * DINP;
    const float lam = ((const float*)(A.ws + WS_CTL))[64 + l];
    const float one_m_li = ((const float*)(A.ws + WS_CTL))[66 + l];
    f32x16 o[2];
    AttnArgs a; a.Q = P + C_AQ + hd * 64; a.qpitch = DINP; a.K1 = P + C_AK + hd * 64; a.k1pitch = DINP; a.K2 = nullptr; a.k2pitch = 0;
    a.V = P + C_AV + hd * 64; a.vpitch = DINP; a.rope = nullptr; a.sel = nullptr; a.scale2 = 0.17677669529663687f * LOG2E; a.slope2 = da_slope(hd) * LOG2E; a.window = 0;
    { const unsigned* kn = (const unsigned*)(A.ws + WS_CTL) + CTL_KN + l * 48 + b * 12 + 2 * hd; a.kmax = sqrtf(fmaxf(__uint_as_float(kn[0]), __uint_as_float(kn[1]))); }
    attn_core<32, false, false, true, true>(a, qb * 128, lds, o);
    LAS float* xb = (LAS float*)(lds + DA_X_OFF) + (32 * (wid & 3) + r) * 65;
    if (wid >= 4) {
#pragma unroll
        for (int db = 0; db < 2; ++db)
#pragma unroll
            for (int i = 0; i < 16; ++i) xb[32 * db + crow(i, h)] = o[db][i];
    }
    __syncthreads();
    if (wid < 4) {
        float ss = 0.f;
#pragma unroll
        for (int db = 0; db < 2; ++db)
#pragma unroll
            for (int i = 0; i < 16; ++i) { o[db][i] = o[db][i] - lam * xb[32 * db + crow(i, h)]; ss += o[db][i] * o[db][i]; }
        ss += __shfl_xor(ss, 32);
        const float rs = rsqrtf(ss * (1.0f / 64.0f) + RMS_EPS) * one_m_li;
        const float* sg = A.in[14] + l * 64;
#pragma unroll
        for (int db = 0; db < 2; ++db)
#pragma unroll
            for (int i = 0; i < 16; ++i) o[db][i] *= rs * sg[32 * db + crow(i, h)];
        bf16_t* orow = (bf16_t*)(A.ws + WS_XN) + (size_t)(b * T + qb * 128 + 32 * wid + r) * D + hd * 64;
        store_o<0>(o, orow, h, EN_DA ? 1.0f : 0.0f);
    }
}
__device__ __forceinline__ void mla_unit(const Args& A, int b, int hd, int qb, LAS unsigned char* lds) {
    const int tid_ = opq(get_tid()), lane = tid_ & 63, wid = __builtin_amdgcn_readfirstlane(tid_ >> 6), r = lane & 31, h = lane >> 5;
    AttnArgs a; a.Q = (const bf16_t*)(A.ws + WS_MQ) + (size_t)b * T * 768 + hd * 96; a.qpitch = 768;
    a.K1 = (const bf16_t*)(A.ws + WS_MKV) + (size_t)b * T * 768 + hd * 128; a.k1pitch = 768;
    a.K2 = (const bf16_t*)(A.ws + WS_KPE) + (size_t)b * T * 32; a.k2pitch = 32;
    a.V = a.K1 + 64; a.vpitch = 768; a.rope = (const float*)(A.ws + WS_ROPE); a.sel = nullptr; a.scale2 = 0.10206207261596575f * LOG2E; a.slope2 = 0.f; a.window = 0; a.kmax = 0.f;
    f32x16 o[2];
    attn_core<96, true, false>(a, qb * 256, lds, o);
    bf16_t* orow = (bf16_t*)(A.ws + WS_XN) + (size_t)(b * T + qb * 256 + 32 * wid + r) * D + 256 + hd * 64;
    store_o<0>(o, orow, h, EN_MLA ? 1.0f : 0.0f);
}
template <int BR> __device__ __forceinline__ void nsa_unit(const Args& A, int l, int b, int hh, int qb, LAS unsigned char* lds) {
    const int tid_ = opq(get_tid()), lane = tid_ & 63, wid = __builtin_amdgcn_readfirstlane(tid_ >> 6), r = lane & 31, h = lane >> 5, g = hh / 3;
    const bf16_t* P = (const bf16_t*)(A.ws + WS_U) + (size_t)b * T * DINP;
    AttnArgs a; a.Q = P + C_CQ + hh * 64; a.qpitch = DINP; a.K1 = P + (BR == 2 ? C_KW : C_KS) + g * 64; a.k1pitch = DINP; a.K2 = nullptr; a.k2pitch = 0;
    a.V = P + (BR == 2 ? C_VW : C_VS) + g * 64; a.vpitch = DINP; a.rope = nullptr; a.sel = (const unsigned long long*)(A.ws + WS_SEL) + (size_t)(b * 2 + g) * T;
    a.scale2 = 0.125f * LOG2E; a.slope2 = nsa_slope(hh) * LOG2E; a.window = (BR == 2) ? 512 : 0;
    f32x16 o[2];
    a.kmax = sqrtf(__uint_as_float(((const unsigned*)(A.ws + WS_CTL))[CTL_KN + l * 48 + b * 12 + (BR == 2 ? 8 : 10) + g]));
    attn_core<64, false, BR == 1, false, true>(a, qb * 256, lds, o);
    const int qpos = qb * 256 + 32 * wid + r;
    const float gl = bf2f((short)P[(size_t)qpos * DINP + C_G + BR * 6 + hh]);
    bf16_t* orow = (bf16_t*)(A.ws + WS_XN) + (size_t)(b * T + qpos) * D + 640 + hh * 64;
    if (BR == 2) store_o<0>(o, orow, h, EN_WIN ? sigmoid_f(gl) : 0.0f);
    else store_o<1>(o, orow, h, EN_SLC ? sigmoid_f(gl) : 0.0f);
}

__device__ __forceinline__ void cmp_mlp_task(const Args& A, int l, int wt, LAS unsigned char* lds) {
    const int tid_ = opq(get_tid()), lane = tid_ & 63, wid = __builtin_amdgcn_readfirstlane(tid_ >> 6);
    const int kv = wt >> 7, bg = (wt >> 4) & 7, rg = wt & 15, b = bg >> 1, g = bg & 1, i16 = lane & 15, quad = lane >> 4;
    const bf16_t* P = (const bf16_t*)(A.ws + WS_U) + (size_t)b * T * DINP + (kv ? C_VC : C_KC) + g * 64;
    const bf16_t* W1 = (const bf16_t*)(A.ws + WS_W + W_C1) + (size_t)kv * 128 * 2048;
    const bf16_t* W2 = (const bf16_t*)(A.ws + WS_W + W_C2) + (size_t)kv * 64 * 128;
    const float* posb = (const float*)(A.ws + WS_POSB) + (l * 2 + kv) * 128;
    const int n = 16 * rg + i16;
    const bf16_t* arow = P + (size_t)(16 * n) * DINP + 8 * quad;
    const bf16_t* wrow1 = W1 + (size_t)i16 * 2048 + 8 * quad;
    f32x4 acc[8];
#pragma unroll
    for (int i = 0; i < 8; ++i) acc[i] = (f32x4){0.f, 0.f, 0.f, 0.f};
#pragma unroll 2
    for (int kk = 0; kk < 8; ++kk) {
        const int ks = 8 * wid + kk;
        const bf16x8 bfrag = *(const bf16x8*)(arow + (size_t)(ks >> 1) * DINP + 32 * (ks & 1));
#pragma unroll
        for (int ht = 0; ht < 8; ++ht) {
            const bf16x8 afrag = *(const bf16x8*)(wrow1 + (size_t)(16 * ht) * 2048 + 32 * ks);
            acc[ht] = MFMA16(afrag, bfrag, acc[ht]);
        }
    }
    {
        LAS float* red = (LAS float*)lds;
        if (wid > 0) {
#pragma unroll
            for (int ht = 0; ht < 8; ++ht)
#pragma unroll
                for (int j = 0; j < 4; ++j) red[(wid * 64 + lane) * 33 + ht * 4 + j] = acc[ht][j];
        }
        __syncthreads();
        if (wid > 0) return;
#pragma unroll 1
        for (int w = 1; w < 8; ++w)
#pragma unroll
            for (int ht = 0; ht < 8; ++ht)
#pragma unroll
                for (int j = 0; j < 4; ++j) acc[ht][j] += red[(w * 64 + lane) * 33 + ht * 4 + j];
    }
    bf16x8 hf[4];
#pragma unroll
    for (int ks2 = 0; ks2 < 4; ++ks2) {
        float v[8];
#pragma unroll
        for (int e = 0; e < 8; ++e) {
            const int ht = 2 * ks2 + (e >> 2), j = e & 3;
            const float x = acc[ht][j] + posb[16 * ht + 4 * quad + j];
            const float u2 = 0.7978845608028654f * (x + 0.044715f * x * x * x);
            const float ex = fast_exp2(2.0f * LOG2E * u2);
            const float th = 1.0f - 2.0f * fast_rcp(ex + 1.0f);
            v[e] = 0.5f * x * (1.0f + th);
        }
        u32x4 w; w.x = cvtpk(v[0], v[1]); w.y = cvtpk(v[2], v[3]); w.z = cvtpk(v[4], v[5]); w.w = cvtpk(v[6], v[7]);
        hf[ks2] = __builtin_bit_cast(bf16x8, w);
    }
    bf16_t* outp = (bf16_t*)(A.ws + WS_KCMP) + ((size_t)(kv * 8 + bg) * 256 + n) * 64;
#pragma unroll
    for (int ot = 0; ot < 4; ++ot) {
        f32x4 c2 = (f32x4){0.f, 0.f, 0.f, 0.f};
        const bf16_t* w2r = W2 + (size_t)(16 * ot + i16) * 128 + 4 * quad;
#pragma unroll
        for (int ks2 = 0; ks2 < 4; ++ks2) {
            const u32x2 lo = *(const u32x2*)(w2r + 32 * ks2), hi = *(const u32x2*)(w2r + 32 * ks2 + 16);
            u32x4 w; w.x = lo.x; w.y = lo.y; w.z = hi.x; w.w = hi.y;
            c2 = MFMA16(__builtin_bit_cast(bf16x8, w), hf[ks2], c2);
        }
        if (n < 255) { u32x2 w; w.x = cvtpk(c2[0], c2[1]); w.y = cvtpk(c2[2], c2[3]); *(u32x2*)(outp + 16 * ot + 4 * quad) = w; }
    }
}

constexpr int CMP_K_OFF = 0, CMP_V_OFF = 36864, CMP_IMP_OFF = 69632;
__device__ __forceinline__ void cmp_unit(const Args& A, int b, int g, int qb, LAS unsigned char* lds, float gmul = 1.0f) {
    const int tid = opq(get_tid()), lane = tid & 63, wid = __builtin_amdgcn_readfirstlane(tid >> 6), r = lane & 31, h = lane >> 5;
    const int q0 = qb * 256, qw0 = q0 + 32 * wid, qpos = qw0 + r, qloc = 32 * wid + r;
    const int ntile = (((q0 + 224) >> 4) >> 6) + 1;
    LAS unsigned char* Kl = lds + CMP_K_OFF; LAS unsigned char* Vl = lds + CMP_V_OFF; LAS float* imp = (LAS float*)(lds + CMP_IMP_OFF);
    const bf16_t* KC = (const bf16_t*)(A.ws + WS_KCMP) + (size_t)(b * 2 + g) * 256 * 64;
    const bf16_t* VC = KC + (size_t)8 * 256 * 64;
    __syncthreads();
    for (int idx = tid; idx < 512 * ntile; idx += NTHR) {
        const int n = idx >> 3, ch = idx & 7;
        u32x4 kx = {0, 0, 0, 0}, vx = {0, 0, 0, 0};
        if (n < 255) { kx = *(const u32x4*)(KC + (size_t)n * 64 + ch * 8); vx = *(const u32x4*)(VC + (size_t)n * 64 + ch * 8); }
        *(LAS u32x4*)(Kl + n * 144 + ch * 16) = kx;
        *(LAS u32x4*)(Vl + (n >> 6) * 8192 + (ch >> 2) * 4096 + (n & 63) * 64 + (ch & 3) * 16) = vx;
    }
    for (int idx = tid; idx < 256 * 65; idx += NTHR) imp[idx] = 0.f;
    __syncthreads();
    const bf16_t* P = (const bf16_t*)(A.ws + WS_U) + (size_t)b * T * DINP;
    const float scale2 = 0.125f * LOG2E;
#pragma unroll 1
    for (int rr = 0; rr < 3; ++rr) {
        const int hh = 3 * g + rr; const float slope2 = nsa_slope(hh) * LOG2E;
        bf16x8 qf[4];
        { const bf16_t* qrow = P + (size_t)qpos * DINP + C_CQ + hh * 64;
#pragma unroll
          for (int ks = 0; ks < 4; ++ks) qf[ks] = *(const bf16x8*)(qrow + 16 * ks + 8 * h); }
        float m = NEGBIG, lsum = 0.f, invl = 0.f;
        f32x16 o[2];
#pragma unroll
        for (int i = 0; i < 16; ++i) { o[0][i] = 0.f; o[1][i] = 0.f; }
#pragma unroll 1
        for (int pass = 0; pass < 2; ++pass) {
#pragma unroll 1
            for (int tt = 0; tt < ntile; ++tt) {
                if (16 * (64 * tt) + 31 > qw0 + 31) continue;
                f32x16 p0, p1;
#pragma unroll
                for (int i = 0; i < 16; ++i) { p0[i] = 0.f; p1[i] = 0.f; }
#pragma unroll
                for (int ks = 0; ks < 4; ++ks) {
                    const bf16x8 a0 = *(const LAS bf16x8*)(Kl + (64 * tt + r) * 144 + ks * 32 + h * 16);
                    const bf16x8 a1 = *(const LAS bf16x8*)(Kl + (64 * tt + 32 + r) * 144 + ks * 32 + h * 16);
                    p0 = MFMA32(a0, qf[ks], p0); p1 = MFMA32(a1, qf[ks], p1);
                }
#pragma unroll
                for (int i = 0; i < 16; ++i) {
                    const int n0 = 64 * tt + crow(i, h), d0 = qpos - (16 * n0 + 31), d1 = d0 - 512;
                    p0[i] = d0 >= 0 ? p0[i] * scale2 - slope2 * (float)d0 : NEGBIG;
                    p1[i] = d1 >= 0 ? p1[i] * scale2 - slope2 * (float)d1 : NEGBIG;
                }
                if (pass == 0) {
                    float mloc = fmaxf(p0[0], p1[0]);
#pragma unroll
                    for (int i = 1; i < 16; ++i) mloc = fmaxf(mloc, fmaxf(p0[i], p1[i]));
                    mloc = fmaxf(mloc, __shfl_xor(mloc, 32));
                    const float mnew = fmaxf(m, mloc), alpha = fast_exp2(m - mnew);
                    m = mnew;
                    float ls = 0.f;
#pragma unroll
                    for (int i = 0; i < 16; ++i) ls += fast_exp2(p0[i] - mnew) + fast_exp2(p1[i] - mnew);
                    lsum = lsum * alpha + ls;
                } else {
#pragma unroll
                    for (int i = 0; i < 16; ++i) {
                        p0[i] = p0[i] > -1e29f ? fast_exp2(p0[i] - m) * invl : 0.f;
                        p1[i] = p1[i] > -1e29f ? fast_exp2(p1[i] - m) * invl : 0.f;
                    }
                    pv_tile(o, p0, p1, Vl + tt * 8192, lane);
#pragma unroll
                    for (int blk = 0; blk < 2; ++blk)
#pragma unroll
                        for (int g4 = 0; g4 < 4; ++g4) {
                            const int j = 16 * tt + 8 * blk + 2 * g4 + h;
                            const float G = blk == 0 ? (p0[4 * g4] + p0[4 * g4 + 1]) + (p0[4 * g4 + 2] + p0[4 * g4 + 3]) : (p1[4 * g4] + p1[4 * g4 + 1]) + (p1[4 * g4 + 2] + p1[4 * g4 + 3]);
                            imp[qloc * 65 + j] += G;
                        }
                    asm volatile("s_waitcnt lgkmcnt(0)" ::: "memory");
#pragma unroll
                    for (int blk = 0; blk < 2; ++blk)
#pragma unroll
                        for (int g4 = 0; g4 < 4; ++g4) {
                            const int j = 16 * tt + 8 * blk + 2 * g4 + h;
                            const float Lst = blk == 0 ? p0[4 * g4 + 3] : p1[4 * g4 + 3];
                            if (j + 1 < 64) imp[qloc * 65 + j + 1] += Lst;
                        }
                    asm volatile("s_waitcnt lgkmcnt(0)" ::: "memory");
                }
            }
            if (pass == 0) { const float lt = lsum + __shfl_xor(lsum, 32); invl = (qpos >= 31) ? 1.0f / lt : 0.f; }
        }
        const float gl = bf2f((short)P[(size_t)qpos * DINP + C_G + 0 * 6 + hh]);
        bf16_t* orow = (bf16_t*)(A.ws + WS_XN) + (size_t)(b * T + qpos) * D + 640 + hh * 64;
        store_o<1>(o, orow, h, EN_CMP ? sigmoid_f(gl) * gmul : 0.0f);
    }
    __syncthreads();
    if (qb < 4) {
        if (tid < 256) { const int t = q0 + tid, cur = t >> 6; ((unsigned long long*)(A.ws + WS_SEL))[(size_t)(b * 2 + g) * T + t] = (1ull << (cur + 1)) - 1ull; }
    } else {
        const int qi = tid >> 1, hf = tid & 1, t = q0 + qi, cur = t >> 6;
        float v[32];
#pragma unroll
        for (int i = 0; i < 32; ++i) { const int j = 32 * hf + i; const float x = imp[qi * 65 + j]; v[i] = (j >= 1 && j <= cur - 2) ? x : -1.0f; }
        unsigned long long mask = 1ull | (1ull << cur) | (1ull << (cur - 1));
#pragma unroll 1
        for (int it = 0; it < 13; ++it) {
            float bv = v[0]; int bi = 0;
#pragma unroll
            for (int i = 1; i < 32; ++i) { const bool gt = v[i] > bv; bv = gt ? v[i] : bv; bi = gt ? i : bi; }
            const float ov = __shfl_xor(bv, 1); const int oi = __shfl_xor(bi, 1);
            const float v0 = hf ? ov : bv, v1 = hf ? bv : ov; const int i0 = hf ? oi : bi, i1 = hf ? bi : oi;
            const bool win0 = v0 >= v1;
            const int wj = win0 ? i0 : 32 + i1;
            mask |= 1ull << wj;
            const int clr = (win0 == (hf == 0)) ? (win0 ? i0 : i1) : -1;
#pragma unroll
            for (int i = 0; i < 32; ++i) v[i] = (i == clr) ? -1.0f : v[i];
        }
        if (hf == 0) ((unsigned long long*)(A.ws + WS_SEL))[(size_t)(b * 2 + g) * T + t] = mask;
    }
    __syncthreads();
}

__device__ __forceinline__ int fetch_unit(unsigned* ctr, LAS unsigned char* lds) {
    volatile LAS int* w = (volatile LAS int*)(lds + FETCH_OFF);
    __syncthreads();
    if (get_tid() == 0) *w = (int)atomicAdd(ctr, 1u);
    __syncthreads();
    return __builtin_amdgcn_readfirstlane(*w);
}
template <class Epi>
__device__ __forceinline__ void run_gemm_counted(LAS unsigned char* lds, const bf16_t* Am, const bf16_t* Bt, int N, int K, const Epi& E, unsigned* cnt) {
    pg8::Gemm g{Am, Bt, M, N, K}; CountedOrder S; S.init(M, N, (int)gridDim.x, (int)blockIdx.x); S.cnt = cnt;
    pg8::gemm_phase<Epi, CountedOrder, true, true>(lds, g, S, E);
}
template <class Epi>
__device__ __forceinline__ void run_gemm(LAS unsigned char* lds, const bf16_t* Am, const bf16_t* Bt, int N, int K, const Epi& E) {
    pg8::Gemm g{Am, Bt, M, N, K}; pg8::StaticOrder S; S.init(M, N, (int)gridDim.x, (int)blockIdx.x);
    pg8::gemm_phase<Epi, pg8::StaticOrder, true, true>(lds, g, S, E);
}

__global__ void __launch_bounds__(NTHR, 2) fwd_megakernel(Args A) {
    LAS unsigned char* lds = (LAS unsigned char*)lds_raw;
    if (lane_id() == 0) *(volatile LAS int*)(lds + WIDTAB_OFF + 4 * hw_slot()) = (int)(threadIdx.x >> 6);
    __syncthreads();
    cg::grid_group grid = cg::this_grid();
    const int G = gridDim.x;
    { volatile LAS unsigned* st0 = (volatile LAS unsigned*)(lds + FETCH_OFF + 16); if (get_tid() < 2) st0[get_tid()] = 0u; }
    __syncthreads();
#ifdef PROBE_PHASE
    if (get_tid() < 32) { volatile LAS unsigned* ta_ = (volatile LAS unsigned*)(lds + 140000); ta_[get_tid()] = 0u; }
    __syncthreads();
    if (get_tid() == 0) { volatile LAS unsigned* ta_ = (volatile LAS unsigned*)(lds + 140000); ta_[31] = (unsigned)__builtin_amdgcn_s_memrealtime(); }
    __syncthreads();
#endif
    const unsigned xbar_x = (unsigned)__builtin_amdgcn_readfirstlane((int)xcd_barrier_post((unsigned*)(A.ws + WS_CTL) + 1024, (volatile LAS unsigned*)(lds + FETCH_OFF + 16)).x);
#ifdef PROBE_PHASE
#define STAMP(id) do { if (blockIdx.x == 0 && get_tid() == 0) { volatile LAS unsigned* ta_ = (volatile LAS unsigned*)(lds + 140000); const unsigned now_ = (unsigned)__builtin_amdgcn_s_memrealtime(); ta_[id] += now_ - ta_[31]; ta_[31] = now_; } } while (0)
#else
#define STAMP(id) do {} while (0)
#endif
#define GSYNC() do { XcdBarrier xb_; unsigned xx_ = xbar_x; asm volatile("" : "+s"(xx_)); xb_.bar = (unsigned*)(A.ws + WS_CTL) + 1024; xb_.x = xx_; \
                     xb_.st = (volatile LAS unsigned*)(lds + FETCH_OFF + 16); xcd_barrier(xb_); } while (0)
    unsigned char* ws = A.ws;
    unsigned* ctl = (unsigned*)(ws + WS_CTL);
    float* X = A.out;
    bf16_t* XN = (bf16_t*)(ws + WS_XN);
    bf16_t* U = (bf16_t*)(ws + WS_U);
    const float* mods = (const float*)(ws + WS_MODS);

    for (int task = blockIdx.x; task < 288; task += G) mods_task(A, task, lds);
    for (int task = G - 1 - (int)blockIdx.x; task < 64; task += G) posb_task(A, task, lds);
    rope_entries(A);
    { float* ssq = (float*)(ws + WS_SSQ); for (int i = blockIdx.x * NTHR + opq(get_tid()); i < 4 * M; i += G * NTHR) ssq[i] = 0.f; }
    if (blockIdx.x == 0 && get_tid() < 2) {
        const int tid = opq(get_tid());
        const float* lp = A.in[13] + tid * 128; float s1 = 0.f, s2 = 0.f;
        for (int i = 0; i < 32; ++i) { s1 += lp[i] * lp[32 + i]; s2 += lp[64 + i] * lp[96 + i]; }
        const float lam_init = tid == 0 ? 0.2f : 0.35550907f;
        ((float*)ctl)[64 + tid] = expf(s1) - expf(s2) + lam_init;
        ((float*)ctl)[66 + tid] = 1.0f - lam_init;
    }
    __syncthreads();
    convert_layer(A, 0, lds);
#ifdef PROBE_DUPCVT
    for (int i = 0; i < PROBE_DUPCVT; ++i) { __syncthreads(); convert_layer(A, 0, lds); }
#endif
#ifdef PROBE_DUPMODS
    for (int task = blockIdx.x; task < 288; task += G) mods_task(A, task, lds);
#endif
    grid.sync();
    STAMP(0);

    if (blockIdx.x == 0) posb_final(A);
#pragma unroll 1
    for (int l = 0; l < 2; ++l) {
        const float* modl = mods + (size_t)l * 4 * 9216;
        unsigned char* wb = ws + WS_W;
        if (l == 1) { __syncthreads(); convert_layer(A, 1, lds); }
#pragma unroll 1
        for (int s = 0; s < 2; ++s) {
            const float* xin = (l == 0 && s == 0) ? A.in[0] : X;
            norm_rows(xin, XN, A.in[s == 0 ? 4 : 6] + l * D, modl, s == 0 ? 0 : 6, s == 0 ? 1 : 7);
            GSYNC();
            STAMP(1);
            { EpiSwiGLU E{U}; run_gemm(lds, XN, (const bf16_t*)(wb + (s == 0 ? W_1A : W_2A)), F2, D, E); }
            GSYNC();
            STAMP(2);
            { EpiResid E{xin, X, modl + (s == 0 ? 2 : 8) * 1024, 0.5f}; run_gemm(lds, U, (const bf16_t*)(wb + (s == 0 ? W_1B : W_2B)), D, F, E); }
            GSYNC();
            STAMP(3);
            if (s == 0 && EN_MIX) {
                norm_rows(X, XN, A.in[5] + l * D, modl, 3, 4);
                GSYNC();
                STAMP(4);
                float* ssq = (float*)(ws + WS_SSQ) + (size_t)l * 2 * M;
                { EpiProj E{U, (bf16_t*)(ws + WS_CQ), (bf16_t*)(ws + WS_CKV), ssq, ssq + M}; run_gemm(lds, XN, (const bf16_t*)(wb + W_IN), DINP, D, E); }
                GSYNC();
                STAMP(5);
                kn_rows(A, l);
                GSYNC();
                STAMP(12);
                { EpiRowScale E{(bf16_t*)(ws + WS_MQ), 768, ssq, 1.0f / 256.0f}; run_gemm(lds, (const bf16_t*)(ws + WS_CQ), (const bf16_t*)(wb + W_UQ), 768, 256, E); }
                { EpiRowScale E{(bf16_t*)(ws + WS_MKV), 768, ssq + M, 1.0f / 128.0f}; run_gemm(lds, (const bf16_t*)(ws + WS_CKV), (const bf16_t*)(wb + W_UKV), 768, 128, E); }
                STAMP(11);
                for (;;) {
                    int u = fetch_unit(ctl + l * 4 + 0, lds);
                    if (u >= 64 + 256 + 512 + 384) break;
                    if (u < 512) { da_unit(A, l, (u & 15) >> 2, u & 3, 31 - (u >> 4), lds); continue; } u -= 512;
                    if (u < 384) { nsa_unit<2>(A, l, (u % 24) / 6, u % 6, 15 - u / 24, lds); continue; } u -= 384;
                    if (u < 256) { cmp_mlp_task(A, l, u, lds); continue; } u -= 256;
                    kpe_unit(A, u);
                }
                GSYNC();
                STAMP(6);
                for (;;) {
                    int u = fetch_unit(ctl + l * 4 + 1, lds);
                    if (u >= 384 + 128) break;
                    if (u < 192) { mla_unit(A, (u % 24) / 6, u % 6, 15 - u / 24, lds); continue; } u -= 192;
                    if (u < 128) { cmp_unit(A, (u & 7) >> 1, u & 1, 15 - (u >> 3), lds); continue; } u -= 128;
                    u += 192; mla_unit(A, (u % 24) / 6, u % 6, 15 - u / 24, lds);
                }
                GSYNC();
                STAMP(7);
                for (;;) {
                    const int u = fetch_unit(ctl + l * 4 + 2, lds);
                    if (u >= 384) break;
                    nsa_unit<1>(A, l, (u % 24) / 6, u % 6, 15 - u / 24, lds);
                }
                GSYNC();
                STAMP(8);
                { EpiResid E{X, X, modl + 5 * 1024, 1.0f}; run_gemm(lds, XN, (const bf16_t*)(wb + W_OUT), D, D, E); }
                GSYNC();
                STAMP(9);
            }
        }
    }
    final_norm_rows(X, A.in[22]);
#ifdef PROBE_PHASE
    STAMP(10);
    __syncthreads();
    if (blockIdx.x == 0 && get_tid() == 0) { volatile LAS unsigned* ta_ = (volatile LAS unsigned*)(lds + 140000); X[0] += (float)ta_[PROBE_PHASE] * 0.0001f; }
#endif
#ifdef PROBE_SYNCS
    for (int i = 0; i < PROBE_SYNCS; ++i) GSYNC();
#endif
}

extern "C" void kernel_launch(void* const* d_in, const int* in_sizes, int n_in, void* d_out, int out_size, void* d_ws, size_t ws_size, hipStream_t stream) {
    static int grid = 0;
    if (grid == 0) {
        if (n_in != 23 || out_size != M * D || ws_size < WS_END) { fprintf(stderr, "kernel_launch: unexpected problem shape (n_in %d out %d ws %zu)\n", n_in, out_size, ws_size); grid = -1; return; }
        int dev = 0, cus = 0, per_cu = 0;
        hipGetDevice(&dev);
        hipDeviceGetAttribute(&cus, hipDeviceAttributeMultiprocessorCount, dev);
        hipFuncSetAttribute((const void*)fwd_megakernel, hipFuncAttributeMaxDynamicSharedMemorySize, LDS_BYTES);
        hipOccupancyMaxActiveBlocksPerMultiprocessor(&per_cu, (const void*)fwd_megakernel, NTHR, LDS_BYTES);
        if (per_cu < 1) per_cu = 1;
        grid = cus * per_cu;
        (void)hipGetLastError();
    }
    if (grid < 0) return;
    hipMemsetAsync(d_ws, 0, 32768, stream);
    Args a{};
    for (int i = 0; i < 23; ++i) a.in[i] = (const float*)d_in[i];
    a.out = (float*)d_out; a.ws = (unsigned char*)d_ws;
    void* args[] = {&a};
    hipError_t e = hipLaunchCooperativeKernel((const void*)fwd_megakernel, dim3(grid), dim3(NTHR), args, LDS_BYTES, stream);
    if (e != hipSuccess) fprintf(stderr, "cooperative launch failed: %s (grid %d)\n", hipGetErrorString(e), grid);
}
```

```cpp
#include <hip/hip_runtime.h>
#include <hip/hip_cooperative_groups.h>
#include <cstdio>
#include <cstdint>
namespace cg = cooperative_groups;
extern __shared__ __attribute__((aligned(16))) unsigned char lds_raw[];
constexpr int WIDTAB_OFF = 140200;
__device__ __forceinline__ int lane_id() { return (int)__builtin_amdgcn_mbcnt_hi(~0u, __builtin_amdgcn_mbcnt_lo(~0u, 0u)); }
__device__ __forceinline__ int hw_slot() { return (int)(__builtin_amdgcn_s_getreg((5 << 11) | 4) & 63u); }
__device__ __forceinline__ int get_tid() {
    const int wid = __builtin_amdgcn_readfirstlane(*(volatile __attribute__((address_space(3))) int*)((__attribute__((address_space(3))) unsigned char*)lds_raw + WIDTAB_OFF + 4 * hw_slot()));
    return wid * 64 + lane_id();
}
__device__ __forceinline__ int pg8_opq_tid() { int v = get_tid(); asm volatile("" : "+v"(v)); return v; }
namespace pg8 {
#define PG8_LAS __attribute__((address_space(3)))
typedef unsigned short bf16_t;
typedef short bf16x8 __attribute__((ext_vector_type(8)));
typedef float f32x4 __attribute__((ext_vector_type(4)));
typedef unsigned u32x4 __attribute__((ext_vector_type(4)));
constexpr int BM = 256, BK = 64, HALF = 128, HTB = HALF * BK * 2  , STAGE_BYTES = 8 * HTB, NXCD = 8, WGM = 8;

__host__ __device__ __forceinline__ int lds_byte(int r, int c) { const int st = (r >> 4) * 2 + (c >> 5), rr = r & 15, cc = c & 31, ob = rr * 64 + cc * 2; return st * 1024 + (ob ^ (((ob >> 9) & 1) << 5)); }
__host__ __device__ __forceinline__ void stage_rc(int b, int& R, int& C) { const int st = b / 1024, sb = b % 1024, swz = sb ^ (((sb >> 9) & 1) << 5); R = (st >> 1) * 16 + swz / 64; C = (st & 1) * 32 + (swz % 64) / 2; }
__host__ __device__ __forceinline__ int perm32(int rho) { const int n = rho >> 4, i = rho & 15; return 8 * (i >> 2) + 4 * n + (i & 3); }

struct Unit { int pm, pn; };
struct Gemm { const bf16_t* A; const bf16_t* Bt; int M, N, K; };

struct StaticOrder {
    int nM, nN, nwg, G, c;
    __host__ __device__ void init(int M, int N, int G_, int c_) { nM = M / BM; nN = N / BM; nwg = nM * nN; G = G_; c = c_; }
    __host__ __device__ bool next(int i, Unit& u) const {
        const long L = (long)i * G + c; if (L >= nwg) return false;
        int wgid = (int)L; { const int q = nwg / NXCD, r = nwg % NXCD, xcd = wgid % NXCD, off = wgid / NXCD; wgid = (xcd < r ? xcd * (q + 1) : r * (q + 1) + (xcd - r) * q) + off; }
        const int nig = WGM * nN, gid = wgid / nig, fm = gid * WGM, gsz = (nM - fm) < WGM ? (nM - fm) : WGM;
        u.pm = fm + ((wgid % nig) % gsz); u.pn = (wgid % nig) / gsz; return true;
    }
    __device__ __forceinline__ void a_ready(const Unit&) const {}
    __device__ __forceinline__ void done(const Unit&) const {}
};

__device__ __forceinline__ unsigned cvt_pk_bf16(float lo, float hi) { unsigned r; asm volatile("v_cvt_pk_bf16_f32 %0, %1, %2" : "=v"(r) : "v"(lo), "v"(hi)); return r; }
typedef float f32x2 __attribute__((ext_vector_type(2)));
__device__ __forceinline__ f32x2 gelu_pk(f32x2 v) {
    const f32x2 av = __builtin_elementwise_abs(v), d = av * 0.2316418882f + 1.0f;
    f32x2 t; t.x = __builtin_amdgcn_rcpf(d.x); t.y = __builtin_amdgcn_rcpf(d.y);
    f32x2 q = t * 0.5307027145f + (-0.7265760135f); q = q * t + 0.7107068705f; q = q * t + (-0.142248368f); q = q * t + 0.127414796f; q = q * t;
    const f32x2 s = (v * v) * (-0.72134752044f);
    f32x2 e; e.x = __builtin_amdgcn_exp2f(s.x); e.y = __builtin_amdgcn_exp2f(s.y);
    const f32x2 m = v * (q * e), r = v - m;
    f32x2 o; o.x = v.x < 0.f ? m.x : r.x; o.y = v.y < 0.f ? m.y : r.y; return o;
}

template <int ACT  > struct EpiBf16 {
    static constexpr bool PERM = true, AFTER_DRAIN = false; static_assert(ACT == 0 || ACT == 1, "EpiBf16: ACT is 0 (none) or 1 (gelu_pk)");
    bf16_t* O; int ldc; const float* bias; int split_cols; size_t split_stride; float scale0;
    __device__ __forceinline__ void operator()(const f32x4 (&acc)[2][2][4][2], const Unit& u, int wr, int wc, int fr, int fq) const {
        const int row0 = u.pm * BM + wr * 64 + fr; int colt = u.pn * BM; bf16_t* base = O;
        float sc = 1.f; if (split_cols) { const int t = colt / split_cols; base += (size_t)t * split_stride; colt -= t * split_cols; if (t == 0) sc = scale0; }
        const int col0 = colt + wc * 32 + 8 * fq, bcol0 = u.pn * BM + wc * 32 + 8 * fq;
        f32x4 bv[2][2];
#pragma unroll
        for (int bj = 0; bj < 2; ++bj)
#pragma unroll
            for (int n = 0; n < 2; ++n) bv[bj][n] = bias ? *(const f32x4*)(bias + bcol0 + bj * HALF + 4 * n) : (f32x4){0.f, 0.f, 0.f, 0.f};
#pragma unroll
        for (int ai = 0; ai < 2; ++ai)
#pragma unroll
            for (int m = 0; m < 4; ++m) { bf16_t* rowp = base + (size_t)(row0 + ai * HALF + m * 16) * ldc + col0;
#pragma unroll
                for (int bj = 0; bj < 2; ++bj) { f32x4 v0 = acc[ai][bj][m][0] + bv[bj][0], v1 = acc[ai][bj][m][1] + bv[bj][1];
                    if (ACT == 1) { f32x2 a = gelu_pk((f32x2){v0[0], v0[1]}), b = gelu_pk((f32x2){v0[2], v0[3]}), c = gelu_pk((f32x2){v1[0], v1[1]}), d = gelu_pk((f32x2){v1[2], v1[3]});
                        v0 = (f32x4){a.x, a.y, b.x, b.y}; v1 = (f32x4){c.x, c.y, d.x, d.y}; }
                    v0 = v0 * sc; v1 = v1 * sc; u32x4 w; w.x = cvt_pk_bf16(v0[0], v0[1]); w.y = cvt_pk_bf16(v0[2], v0[3]); w.z = cvt_pk_bf16(v1[0], v1[1]); w.w = cvt_pk_bf16(v1[2], v1[3]);
                    *(u32x4*)(rowp + bj * HALF) = w; } }
    }
};
template <class Epi, class Sched, bool ALIGN_EPI = false, bool SP2 = false>
__device__ __forceinline__ void gemm_phase(PG8_LAS unsigned char* lds, const Gemm g, const Sched& S, const Epi& E) {
    const int tid = pg8_opq_tid(), wid = __builtin_amdgcn_readfirstlane(tid >> 6), lane = tid & 63, wr = wid >> 2, wc = wid & 3, fr = lane & 15, fq = lane >> 4;
    const int K = g.K, nt = K / BK;
    unsigned voffA[2], voffB[2];
#pragma unroll
    for (int i = 0; i < 2; ++i) { int R, C; stage_rc(tid * 16 + i * 8192, R, C); const int Rb = Epi::PERM ? ((R & ~31) + perm32(R & 31)) : R;
        voffA[i] = (unsigned)(R * K + C) * 2u; voffB[i] = (unsigned)(Rb * K + C) * 2u; }
    const size_t kstep = (size_t)(BK * 2);
    const size_t hstep = (size_t)HALF * K * 2;
    const size_t tstep = 2 * hstep;
    const unsigned ldsw = (unsigned)wid * 1024u;
    const int aoff = lds_byte(wr * 64 + fr, fq * 8), boff = lds_byte(wc * 32 + fr, fq * 8);
#define PG8_SA(b, h) (((b) * 2 + (h)) * HTB)
#define PG8_SB(b, h) ((4 + (b) * 2 + (h)) * HTB)
#define PG8_STAGE(bufoff, gbase, voff) do { _Pragma("unroll") for (int _i = 0; _i < 2; ++_i) \
        __builtin_amdgcn_global_load_lds((const unsigned*)((const char*)(gbase) + (voff)[_i]), (PG8_LAS unsigned*)(lds + (bufoff) + ldsw + _i * 8192), 16, 0, 0); } while (0)
#define PG8_LDA(dst, b, h) do { _Pragma("unroll") for (int m = 0; m < 4; ++m) _Pragma("unroll") for (int k = 0; k < 2; ++k) dst[m][k] = *(const PG8_LAS bf16x8*)(lds + PG8_SA(b, h) + aoff + m * 2048 + k * 1024); } while (0)
#define PG8_LDB(dst, b, h) do { _Pragma("unroll") for (int n = 0; n < 2; ++n) _Pragma("unroll") for (int k = 0; k < 2; ++k) dst[n][k] = *(const PG8_LAS bf16x8*)(lds + PG8_SB(b, h) + boff + n * 2048 + k * 1024); } while (0)
#define PG8_MMA(ai, bj, At, Bt) do { __builtin_amdgcn_s_setprio(1); _Pragma("unroll") for (int m = 0; m < 4; ++m) _Pragma("unroll") for (int n = 0; n < 2; ++n) _Pragma("unroll") for (int k = 0; k < 2; ++k) \
        acc[ai][bj][m][n] = __builtin_amdgcn_mfma_f32_16x16x32_bf16(Bt[n][k], At[m][k], acc[ai][bj][m][n], 0, 0, 0); __builtin_amdgcn_s_setprio(0); } while (0)
#define PG8_WAIT_V(n) asm volatile("s_waitcnt vmcnt(" #n ")" ::: "memory")
#define PG8_WAIT_L(n) asm volatile("s_waitcnt lgkmcnt(" #n ")" ::: "memory")
#define PG8_BAR __builtin_amdgcn_s_barrier()
#define PG8_SCHED __builtin_amdgcn_sched_barrier(0)
    Unit cur, nxt; int ui = 0;
    if (!S.next(0, cur)) return;
    f32x4 acc[2][2][4][2];
#pragma unroll
    for (int a = 0; a < 2; ++a)
#pragma unroll
        for (int b = 0; b < 2; ++b)
#pragma unroll
            for (int m = 0; m < 4; ++m)
#pragma unroll
                for (int n = 0; n < 2; ++n) acc[a][b][m][n] = (f32x4){0.f, 0.f, 0.f, 0.f};
    bf16x8 At[4][2], B0[2][2], B1[2][2];
    const char* cA = (const char*)g.A + (size_t)cur.pm * tstep; const char* cB = (const char*)g.Bt + (size_t)cur.pn * tstep;
    S.a_ready(cur);
    if constexpr (SP2) {
        PG8_STAGE(PG8_SB(0, 0), cB, voffB); PG8_STAGE(PG8_SB(0, 1), cB + hstep, voffB); PG8_STAGE(PG8_SA(0, 0), cA, voffA); PG8_STAGE(PG8_SA(0, 1), cA + hstep, voffA);
        if (wr == 1) PG8_BAR;
        PG8_WAIT_V(2); PG8_BAR;
        PG8_STAGE(PG8_SB(1, 0), cB + kstep, voffB); PG8_STAGE(PG8_SA(1, 0), cA + kstep, voffA); PG8_STAGE(PG8_SB(1, 1), cB + hstep + kstep, voffB);
        PG8_WAIT_V(6); PG8_BAR;
    } else {
        PG8_STAGE(PG8_SB(0, 0), cB, voffB); PG8_STAGE(PG8_SA(0, 0), cA, voffA); PG8_STAGE(PG8_SB(0, 1), cB + hstep, voffB); PG8_STAGE(PG8_SA(0, 1), cA + hstep, voffA);
        if (wr == 1) PG8_BAR;
        PG8_WAIT_V(4); PG8_BAR;
        PG8_STAGE(PG8_SB(1, 0), cB + kstep, voffB); PG8_STAGE(PG8_SA(1, 0), cA + kstep, voffA); PG8_STAGE(PG8_SB(1, 1), cB + hstep + kstep, voffB);
        PG8_WAIT_V(6); PG8_BAR;
    }
    for (;;) {
        const bool has_next = S.next(ui + 1, nxt);
        const char* nA = has_next ? (const char*)g.A + (size_t)nxt.pm * tstep : cA; const char* nB = has_next ? (const char*)g.Bt + (size_t)nxt.pn * tstep : cB;
        for (int t = 0; t < nt; t += 2) {
            const bool last = (t == nt - 2);
            const char* a1 = cA + (size_t)(t + 1) * kstep;
            const char* a2 = last ? nA : cA + (size_t)(t + 2) * kstep; const char* b2 = last ? nB : cB + (size_t)(t + 2) * kstep;
            const char* a3 = a2 + kstep; const char* b3 = b2 + kstep;
            if (last && has_next) S.a_ready(nxt);
            if constexpr (SP2) {
            PG8_LDB(B0, 0, 0); PG8_LDB(B1, 0, 1); PG8_SCHED; PG8_LDA(At, 0, 0); PG8_STAGE(PG8_SA(1, 1), a1 + hstep, voffA);
            PG8_WAIT_V(8); PG8_WAIT_L(0); PG8_BAR; PG8_MMA(0, 0, At, B0); PG8_MMA(0, 1, At, B1); PG8_BAR; PG8_SCHED;
            PG8_LDA(At, 0, 1); PG8_STAGE(PG8_SB(0, 0), b2, voffB); PG8_STAGE(PG8_SB(0, 1), b2 + hstep, voffB); PG8_STAGE(PG8_SA(0, 0), a2, voffA);
            PG8_WAIT_V(8); PG8_WAIT_L(0); PG8_BAR; PG8_MMA(1, 0, At, B0); PG8_MMA(1, 1, At, B1); PG8_BAR; PG8_SCHED;
            PG8_LDB(B0, 1, 0); PG8_LDB(B1, 1, 1); PG8_SCHED; PG8_LDA(At, 1, 0); PG8_STAGE(PG8_SA(0, 1), a2 + hstep, voffA);
            PG8_WAIT_V(8); PG8_WAIT_L(0); PG8_BAR; PG8_MMA(0, 0, At, B0); PG8_MMA(0, 1, At, B1); PG8_BAR; PG8_SCHED;
            PG8_LDA(At, 1, 1); PG8_STAGE(PG8_SB(1, 0), b3, voffB); PG8_STAGE(PG8_SB(1, 1), b3 + hstep, voffB); PG8_STAGE(PG8_SA(1, 0), a3, voffA);
            PG8_WAIT_V(8); PG8_WAIT_L(0); PG8_BAR; PG8_MMA(1, 0, At, B0); PG8_MMA(1, 1, At, B1); PG8_BAR; PG8_SCHED;
            } else {
            PG8_LDB(B0, 0, 0); PG8_SCHED; PG8_LDA(At, 0, 0); PG8_STAGE(PG8_SA(1, 1), a1 + hstep, voffA);
            PG8_WAIT_L(8); PG8_BAR; PG8_WAIT_L(0); PG8_MMA(0, 0, At, B0); PG8_BAR; PG8_SCHED;
            PG8_LDB(B1, 0, 1); PG8_STAGE(PG8_SB(0, 0), b2, voffB);
            PG8_BAR; PG8_WAIT_L(0); PG8_MMA(0, 1, At, B1); PG8_BAR;
            PG8_LDA(At, 0, 1); PG8_STAGE(PG8_SA(0, 0), a2, voffA);
            PG8_BAR; PG8_WAIT_L(0); PG8_MMA(1, 0, At, B0); PG8_BAR; PG8_SCHED;
            PG8_STAGE(PG8_SB(0, 1), b2 + hstep, voffB);
            PG8_WAIT_V(6); PG8_BAR; PG8_MMA(1, 1, At, B1); PG8_BAR;
            PG8_LDB(B0, 1, 0); PG8_SCHED; PG8_LDA(At, 1, 0); PG8_STAGE(PG8_SA(0, 1), a2 + hstep, voffA);
            PG8_WAIT_L(8); PG8_BAR; PG8_WAIT_L(0); PG8_MMA(0, 0, At, B0); PG8_BAR; PG8_SCHED;
            PG8_LDB(B1, 1, 1); PG8_STAGE(PG8_SB(1, 0), b3, voffB);
            PG8_BAR; PG8_WAIT_L(0); PG8_MMA(0, 1, At, B1); PG8_BAR;
            PG8_LDA(At, 1, 1); PG8_STAGE(PG8_SA(1, 0), a3, voffA);
            PG8_BAR; PG8_WAIT_L(0); PG8_MMA(1, 0, At, B0); PG8_BAR; PG8_SCHED;
            PG8_STAGE(PG8_SB(1, 1), b3 + hstep, voffB);
            PG8_WAIT_V(6); PG8_BAR; PG8_MMA(1, 1, At, B1); PG8_BAR;
            }
        }
        if constexpr (ALIGN_EPI) { if (wr == 0) PG8_BAR; }
        if constexpr (!Epi::AFTER_DRAIN) { E(acc, cur, wr, wc, fr, fq); S.done(cur); }
        if (!has_next) break;
#pragma unroll
        for (int a = 0; a < 2; ++a)
#pragma unroll
            for (int b = 0; b < 2; ++b)
#pragma unroll
                for (int m = 0; m < 4; ++m)
#pragma unroll
                    for (int n = 0; n < 2; ++n) acc[a][b][m][n] = (f32x4){0.f, 0.f, 0.f, 0.f};
        cur = nxt; cA = nA; cB = nB; ++ui;
        if constexpr (ALIGN_EPI) { if (wr == 1) PG8_BAR; }
    }
    PG8_WAIT_V(0);
    if constexpr (!ALIGN_EPI) { if (wr == 0) PG8_BAR; }
    PG8_BAR;
    if constexpr (Epi::AFTER_DRAIN) { E.fused(acc, cur, wr, wc, fr, fq, lds, wid, lane); S.done(cur); }
#undef PG8_SA
#undef PG8_SB
#undef PG8_STAGE
#undef PG8_LDA
#undef PG8_LDB
#undef PG8_MMA
#undef PG8_WAIT_V
#undef PG8_WAIT_L
#undef PG8_BAR
#undef PG8_SCHED
}
}

#define LAS __attribute__((address_space(3)))
typedef unsigned short bf16_t;
typedef short bf16x8 __attribute__((ext_vector_type(8)));
typedef short s16x4 __attribute__((ext_vector_type(4)));
typedef float f32x4 __attribute__((ext_vector_type(4)));
typedef float f32x2 __attribute__((ext_vector_type(2)));
typedef float f32x16 __attribute__((ext_vector_type(16)));
typedef unsigned u32x4 __attribute__((ext_vector_type(4)));
typedef unsigned u32x2 __attribute__((ext_vector_type(2)));
typedef __bf16 bf16x2_t __attribute__((ext_vector_type(2)));

#ifndef EN_MIX
#define EN_MIX 1
#endif
#ifndef EN_DA
#define EN_DA 1
#endif
#ifndef EN_MLA
#define EN_MLA 1
#endif
#ifndef EN_WIN
#define EN_WIN 1
#endif
#ifndef EN_CMP
#define EN_CMP 1
#endif
#ifndef EN_SLC
#define EN_SLC 1
#endif

constexpr int NB = 4, T = 4096, D = 1024, M = NB * T, F = 2816, F2 = 5632, DIN = 2354, DINP = 2560;
constexpr int NTHR = 512, NWAVE = 8, LDS_BYTES = 147456, FETCH_OFF = LDS_BYTES - 64;
constexpr int C_AQ = 0, C_AK = 256, C_AV = 512, C_BKR = 1152, C_CQ = 1184, C_KC = 1568, C_VC = 1696, C_KS = 1824, C_VS = 1952, C_KW = 2080, C_VW = 2208, C_G = 2336;
constexpr float LOG2E = 1.4426950408889634f, RMS_EPS = 1e-6f, NEGBIG = -1e30f;

constexpr size_t MiB = 1u << 20, KiB = 1u << 10;
constexpr size_t WS_CTL = 0;
constexpr size_t WS_MODS = 64 * KiB;
constexpr size_t WS_ROPE = 512 * KiB;
constexpr size_t WS_POSB = 1 * MiB;
constexpr size_t WS_SSQ = 1 * MiB + 64 * KiB;
constexpr size_t WS_KCMP = 2 * MiB;
constexpr size_t WS_SEL = 3 * MiB;
constexpr size_t WS_W = 4 * MiB;
constexpr size_t W_1A = 0, W_1B = W_1A + (size_t)F2 * D * 2, W_2A = W_1B + (size_t)D * F * 2, W_2B = W_2A + (size_t)F2 * D * 2,
                 W_IN = W_2B + (size_t)D * F * 2, W_OUT = W_IN + (size_t)DINP * D * 2, W_UQ = W_OUT + (size_t)D * D * 2, W_UKV = W_UQ + 768 * 256 * 2,
                 W_C1 = W_UKV + 768 * 128 * 2, W_C2 = W_C1 + 2 * 128 * 2048 * 2, W_END = W_C2 + 2 * 64 * 128 * 2;
static_assert(WS_W + W_END <= 48 * MiB, "weights");
constexpr size_t WS_XN = 48 * MiB;
constexpr size_t WS_U = 80 * MiB;
constexpr size_t WS_CQ = 168 * MiB;
constexpr size_t WS_CKV = 176 * MiB;
constexpr size_t WS_MQ = 180 * MiB;
constexpr size_t WS_MKV = 204 * MiB;
constexpr size_t WS_KPE = 228 * MiB;
constexpr size_t WS_END = 229 * MiB;

__device__ __forceinline__ unsigned cvtpk(float lo, float hi) { f32x2 v = {lo, hi}; bf16x2_t b = __builtin_convertvector(v, bf16x2_t); return __builtin_bit_cast(unsigned, b); }
__device__ __forceinline__ float bf2f(short b) { return __uint_as_float(((unsigned)(unsigned short)b) << 16); }
__device__ __forceinline__ float wave_sum(float v) {
#pragma unroll
    for (int o = 1; o < 64; o <<= 1) v += __shfl_xor(v, o);
    return v;
}
__device__ __forceinline__ float fast_exp2(float x) { return __builtin_amdgcn_exp2f(x); }
__device__ __forceinline__ float fast_rcp(float x) { return __builtin_amdgcn_rcpf(x); }
__device__ __forceinline__ float sigmoid_f(float x) { return fast_rcp(1.0f + fast_exp2(-x * LOG2E)); }
__device__ __forceinline__ int crow(int i, int h) { return (i & 3) + 8 * (i >> 2) + 4 * h; }
__device__ __forceinline__ int opq(int v) { asm volatile("" : "+v"(v)); return v; }
#define MFMA32(a, b, c) __builtin_amdgcn_mfma_f32_32x32x16_bf16((a), (b), (c), 0, 0, 0)
#define MFMA16(a, b, c) __builtin_amdgcn_mfma_f32_16x16x32_bf16((a), (b), (c), 0, 0, 0)

struct Args { const float* in[23]; float* out; unsigned char* ws; };
__device__ __forceinline__ unsigned char* ws_opq(unsigned char* p) {
    const unsigned long long v = (unsigned long long)p;
    unsigned lo = (unsigned)__builtin_amdgcn_readfirstlane((int)(unsigned)v), hi = (unsigned)__builtin_amdgcn_readfirstlane((int)(unsigned)(v >> 32));
    asm volatile("" : "+s"(lo), "+s"(hi));
    return (unsigned char*)(((unsigned long long)hi << 32) | (unsigned long long)lo);
}

struct EpiSwiGLU {
    static constexpr bool PERM = true, AFTER_DRAIN = false;
    bf16_t* O;
    __device__ __forceinline__ void operator()(const f32x4 (&acc)[2][2][4][2], const pg8::Unit& u, int wr_, int wc_, int fr_, int fq_) const {
        const int t_ = opq(get_tid()), w_ = __builtin_amdgcn_readfirstlane(t_ >> 6), wr = w_ >> 2, wc = w_ & 3, fr = t_ & 15, fq = (t_ >> 4) & 3;
        const int row0 = u.pm * 256 + wr * 64 + fr, col0 = u.pn * 128 + wc * 32 + 8 * fq;
#pragma unroll
        for (int ai = 0; ai < 2; ++ai)
#pragma unroll
            for (int m = 0; m < 4; ++m) {
                bf16_t* rowp = O + (size_t)(row0 + ai * 128 + m * 16) * F + col0;
                float r[8];
#pragma unroll
                for (int n = 0; n < 2; ++n)
#pragma unroll
                    for (int j = 0; j < 4; ++j) { const float g = acc[ai][0][m][n][j], up = acc[ai][1][m][n][j]; r[n * 4 + j] = g * sigmoid_f(g) * up; }
                u32x4 w; w.x = cvtpk(r[0], r[1]); w.y = cvtpk(r[2], r[3]); w.z = cvtpk(r[4], r[5]); w.w = cvtpk(r[6], r[7]);
                *(u32x4*)rowp = w;
            }
    }
};
struct EpiResid {
    static constexpr bool PERM = false, AFTER_DRAIN = false;
    const float* resid; float* out; const float* gate; float coef;
    __device__ __forceinline__ void operator()(const f32x4 (&acc)[2][2][4][2], const pg8::Unit& u, int wr_, int wc_, int fr_, int fq_) const {
        const int t_ = opq(get_tid()), w_ = __builtin_amdgcn_readfirstlane(t_ >> 6), wr = w_ >> 2, wc = w_ & 3, fr = t_ & 15, fq = (t_ >> 4) & 3;
        const int row0 = u.pm * 256 + wr * 64 + fr, b = (u.pm * 256) >> 12, col0 = u.pn * 256 + wc * 32 + 4 * fq;
#pragma unroll
        for (int bj = 0; bj < 2; ++bj)
#pragma unroll
            for (int n = 0; n < 2; ++n) {
                const int c = col0 + bj * 128 + n * 16;
                const f32x4 gv = *(const f32x4*)(gate + (size_t)b * 9216 + c) * coef;
#pragma unroll
                for (int ai = 0; ai < 2; ++ai)
#pragma unroll
                    for (int m = 0; m < 4; ++m) {
                        const size_t off = (size_t)(row0 + ai * 128 + m * 16) * D + c;
                        const f32x4 o = *(const f32x4*)(resid + off) + gv * acc[ai][bj][m][n];
                        *(f32x4*)(out + off) = o;
                        if (m & 1) asm volatile("" ::: "memory");
                    }
            }
    }
};
struct EpiProj {
    static constexpr bool PERM = true, AFTER_DRAIN = false;
    bf16_t* PROJ; bf16_t* CQ; bf16_t* CKV; float* ssq_q; float* ssq_kv;
    __device__ __forceinline__ void operator()(const f32x4 (&acc)[2][2][4][2], const pg8::Unit& u, int wr_, int wc_, int fr_, int fq_) const {
        const int t_ = opq(get_tid()), w_ = __builtin_amdgcn_readfirstlane(t_ >> 6), wr = w_ >> 2, wc = w_ & 3, fr = t_ & 15, fq = (t_ >> 4) & 3;
        const int row0 = u.pm * 256 + wr * 64 + fr;
#pragma unroll
        for (int bj = 0; bj < 2; ++bj) {
            bf16_t* base; int ld, cb; float* ssq;
            if (u.pn == 3) { base = CQ; ld = 256; cb = bj * 128; ssq = ssq_q; }
            else if (u.pn == 4 && bj == 0) { base = CKV; ld = 128; cb = 0; ssq = ssq_kv; }
            else { base = PROJ; ld = DINP; cb = u.pn * 256 + bj * 128; ssq = nullptr; }
            const int col0 = cb + wc * 32 + 8 * fq;
#pragma unroll
            for (int ai = 0; ai < 2; ++ai)
#pragma unroll
                for (int m = 0; m < 4; ++m) {
                    const int row = row0 + ai * 128 + m * 16;
                    const f32x4 v0 = acc[ai][bj][m][0], v1 = acc[ai][bj][m][1];
                    u32x4 w; w.x = cvtpk(v0[0], v0[1]); w.y = cvtpk(v0[2], v0[3]); w.z = cvtpk(v1[0], v1[1]); w.w = cvtpk(v1[2], v1[3]);
                    *(u32x4*)(base + (size_t)row * ld + col0) = w;
                    if (ssq) {
                        float s = (v0[0] * v0[0] + v0[1] * v0[1]) + (v0[2] * v0[2] + v0[3] * v0[3]) + (v1[0] * v1[0] + v1[1] * v1[1]) + (v1[2] * v1[2] + v1[3] * v1[3]);
                        s += __shfl_xor(s, 16); s += __shfl_xor(s, 32);
                        if (fq == 0) atomicAdd(ssq + row, s);
                    }
                    asm volatile("" ::: "memory");
                }
        }
    }
};
struct EpiRowScale {
    static constexpr bool PERM = true, AFTER_DRAIN = false;
    bf16_t* O; int ldc; const float* ssq; float inv_n;
    __device__ __forceinline__ void operator()(const f32x4 (&acc)[2][2][4][2], const pg8::Unit& u, int wr_, int wc_, int fr_, int fq_) const {
        const int t_ = opq(get_tid()), w_ = __builtin_amdgcn_readfirstlane(t_ >> 6), wr = w_ >> 2, wc = w_ & 3, fr = t_ & 15, fq = (t_ >> 4) & 3;
        const int row0 = u.pm * 256 + wr * 64 + fr, col0 = u.pn * 256 + wc * 32 + 8 * fq;
#pragma unroll
        for (int ai = 0; ai < 2; ++ai)
#pragma unroll
            for (int m = 0; m < 4; ++m) {
                const int row = row0 + ai * 128 + m * 16;
                const float rs = rsqrtf(ssq[row] * inv_n + RMS_EPS);
#pragma unroll
                for (int bj = 0; bj < 2; ++bj) {
                    const f32x4 v0 = acc[ai][bj][m][0] * rs, v1 = acc[ai][bj][m][1] * rs;
                    u32x4 w; w.x = cvtpk(v0[0], v0[1]); w.y = cvtpk(v0[2], v0[3]); w.z = cvtpk(v1[0], v1[1]); w.w = cvtpk(v1[2], v1[3]);
                    *(u32x4*)(O + (size_t)row * ldc + col0 + bj * 128) = w;
                }
                asm volatile("" ::: "memory");
            }
    }
};

template <int MODE> __device__ __forceinline__ int wrow(int n) {
    if (MODE == 1) return n < F ? ((n >> 7) * 256 + (n & 127)) : (((n - F) >> 7) * 256 + 128 + ((n - F) & 127));
    return n;
}
template <int MODE>
__device__ __forceinline__ void cvt_item(const float* W, int K, int N, int NP, bf16_t* WT, const float* kscale, LAS float* scr, int item, int lane) {
    const int nblk = NP / 32, kb = item / nblk, nb = item % nblk, k0 = 64 * kb, n0 = 32 * nb;
    const int n_rd = n0 + (lane & 31);
#pragma unroll 8
    for (int i = 0; i < 32; ++i) {
        const int kk = 2 * i + (lane >> 5);
        float v = (n_rd < N) ? W[(size_t)(k0 + kk) * N + n_rd] : 0.f;
        if (kscale) v *= kscale[k0 + kk];
        scr[kk * 33 + (lane & 31)] = v;
    }
    asm volatile("s_waitcnt lgkmcnt(0)" ::: "memory");
    const int c = lane & 7;
#pragma unroll
    for (int j = 0; j < 4; ++j) {
        const int n = (lane >> 3) + 8 * j; const LAS float* s = scr + (8 * c) * 33 + n;
        u32x4 o; o.x = cvtpk(s[0 * 33], s[1 * 33]); o.y = cvtpk(s[2 * 33], s[3 * 33]); o.z = cvtpk(s[4 * 33], s[5 * 33]); o.w = cvtpk(s[6 * 33], s[7 * 33]);
        *(u32x4*)(WT + (size_t)wrow<MODE>(n0 + n) * K + k0 + 8 * c) = o;
    }
    asm volatile("s_waitcnt lgkmcnt(0)" ::: "memory");
}
__device__ __forceinline__ void convert_layer(const Args& A, int l, LAS unsigned char* lds) {
    const int tid = opq(get_tid()), lane = tid & 63, wid = __builtin_amdgcn_readfirstlane(tid >> 6), gw = blockIdx.x * NWAVE + wid, ngw = gridDim.x * NWAVE;
    LAS float* scr = (LAS float*)(lds + wid * 8704);
    unsigned char* wb = A.ws + WS_W;
    constexpr int I_A = 16 * 176, I_B = 44 * 32, I_IN = 16 * 80, I_OUT = 16 * 32, I_UQ = 4 * 24, I_UKV = 2 * 24, I_C1 = 32 * 4, I_C2 = 2 * 2;
    constexpr int NITEMS = 2 * I_A + 2 * I_B + I_IN + I_OUT + I_UQ + I_UKV + 2 * I_C1 + 2 * I_C2;
    for (int it = gw; it < NITEMS; it += ngw) {
        int r = it;
        if (r < I_A) { cvt_item<1>(A.in[7] + (size_t)l * D * F2, D, F2, F2, (bf16_t*)(wb + W_1A), nullptr, scr, r, lane); continue; } r -= I_A;
        if (r < I_A) { cvt_item<1>(A.in[9] + (size_t)l * D * F2, D, F2, F2, (bf16_t*)(wb + W_2A), nullptr, scr, r, lane); continue; } r -= I_A;
        if (r < I_B) { cvt_item<0>(A.in[8] + (size_t)l * F * D, F, D, D, (bf16_t*)(wb + W_1B), nullptr, scr, r, lane); continue; } r -= I_B;
        if (r < I_B) { cvt_item<0>(A.in[10] + (size_t)l * F * D, F, D, D, (bf16_t*)(wb + W_2B), nullptr, scr, r, lane); continue; } r -= I_B;
        if (r < I_IN) { cvt_item<0>(A.in[11] + (size_t)l * D * DIN, D, DIN, DINP, (bf16_t*)(wb + W_IN), nullptr, scr, r, lane); continue; } r -= I_IN;
        if (r < I_OUT) { cvt_item<0>(A.in[12] + (size_t)l * D * D, D, D, D, (bf16_t*)(wb + W_OUT), nullptr, scr, r, lane); continue; } r -= I_OUT;
        if (r < I_UQ) { cvt_item<0>(A.in[17] + (size_t)l * 256 * 576, 256, 576, 768, (bf16_t*)(wb + W_UQ), A.in[15] + l * 256, scr, r, lane); continue; } r -= I_UQ;
        if (r < I_UKV) { cvt_item<0>(A.in[18] + (size_t)l * 128 * 768, 128, 768, 768, (bf16_t*)(wb + W_UKV), A.in[16] + l * 128, scr, r, lane); continue; } r -= I_UKV;
        if (r < 2 * I_C1) { const int kv = r / I_C1; cvt_item<0>(A.in[20] + (size_t)(l * 2 + kv) * 2048 * 128, 2048, 128, 128, (bf16_t*)(wb + W_C1) + (size_t)kv * 128 * 2048, nullptr, scr, r % I_C1, lane); continue; } r -= 2 * I_C1;
        { const int kv = r / I_C2; cvt_item<0>(A.in[21] + (size_t)(l * 2 + kv) * 128 * 64, 128, 64, 64, (bf16_t*)(wb + W_C2) + (size_t)kv * 64 * 128, nullptr, scr, r % I_C2, lane); }
    }
}
__device__ __forceinline__ void mods_task(const Args& A, int task, LAS unsigned char* lds) {
    const int tid = opq(get_tid()), lane = tid & 63, wid = __builtin_amdgcn_readfirstlane(tid >> 6);
    const int l = task / 144, chunk = task % 144;
    LAS float* cond = (LAS float*)lds;
    LAS float* red = (LAS float*)(lds + 16384);
    __syncthreads();
    for (int i = tid; i < 4096; i += NTHR) { const float c = A.in[1][i]; cond[i] = c / (1.0f + expf(-c)); }
    __syncthreads();
    const float* W = A.in[2] + (size_t)l * D * 9216 + chunk * 64 + lane;
    float acc[4] = {0.f, 0.f, 0.f, 0.f};
#pragma unroll 16
    for (int kk = 0; kk < 128; ++kk) {
        const int k = wid * 128 + kk;
        const float w = W[(size_t)k * 9216];
#pragma unroll
        for (int b = 0; b < 4; ++b) acc[b] += cond[b * 1024 + k] * w;
    }
#pragma unroll
    for (int b = 0; b < 4; ++b) red[(wid * 4 + b) * 64 + lane] = acc[b];
    __syncthreads();
    if (tid < 256) {
        const int b = tid >> 6, col = tid & 63; float s = 0.f;
#pragma unroll
        for (int w = 0; w < 8; ++w) s += red[(w * 4 + b) * 64 + col];
        s += A.in[3][(size_t)l * 9216 + chunk * 64 + col];
        ((float*)(A.ws + WS_MODS))[(size_t)(l * 4 + b) * 9216 + chunk * 64 + col] = s;
    }
    __syncthreads();
}
__device__ __forceinline__ void posb_task(const Args& A, int task, LAS unsigned char* lds) {
    const int tid = opq(get_tid());
    const int lkv = task >> 4, kp = task & 15, hid = tid & 127, sub = tid >> 7;
    const float* pos = A.in[19] + (size_t)lkv * 2048 + kp * 128 + sub * 32; const float* w1 = A.in[20] + ((size_t)lkv * 2048 + kp * 128 + sub * 32) * 128 + hid;
    float s = 0.f;
#pragma unroll
    for (int k = 0; k < 32; ++k) s += pos[k] * w1[(size_t)k * 128];
    LAS float* red = (LAS float*)lds;
    __syncthreads();
    red[tid] = s;
    __syncthreads();
    if (tid < 128) ((float*)(A.ws + WS_POSB + 4096))[task * 128 + tid] = red[tid] + red[tid + 128] + red[tid + 256] + red[tid + 384];
    __syncthreads();
}
__device__ __forceinline__ void posb_final(const Args& A) {
    const int o = opq(get_tid());
    const float* part = (const float*)(A.ws + WS_POSB + 4096) + (size_t)(o >> 7) * 16 * 128 + (o & 127);
    float s = 0.f;
#pragma unroll
    for (int p = 0; p < 16; ++p) s += part[p * 128];
    ((float*)(A.ws + WS_POSB))[o] = s;
}
__device__ __forceinline__ void rope_entries(const Args& A) {
    const int gtid = blockIdx.x * NTHR + opq(get_tid()), gn = gridDim.x * NTHR;
    float* tab = (float*)(A.ws + WS_ROPE);
    for (int e = gtid; e < T * 16; e += gn) {
        const int t = e >> 4, i = e & 15;
        double inv = 1.0; for (int j = 0; j < i; ++j) inv *= 0.5623413251903491;
        const float ang = (float)t * (float)inv;
        const double rev = (double)ang * 0.15915494309189535; const double fr = rev - __builtin_rint(rev);
        tab[e] = __builtin_amdgcn_cosf((float)fr); tab[T * 16 + e] = __builtin_amdgcn_sinf((float)fr);
    }
}
__device__ __forceinline__ void norm_rows(const float* X, bf16_t* out, const float* g, const float* modl, int ish, int isc) {
    const int tid = opq(get_tid()), lane = tid & 63, wid = __builtin_amdgcn_readfirstlane(tid >> 6), gw = blockIdx.x * NWAVE + wid, ngw = gridDim.x * NWAVE;
    for (int row = gw; row < M; row += ngw) {
        const int b = row >> 12;
        const f32x4* xr = (const f32x4*)(X + (size_t)row * D) + lane;
        f32x4 v[4]; float ss = 0.f;
#pragma unroll
        for (int j = 0; j < 4; ++j) { v[j] = xr[64 * j]; ss += (v[j].x * v[j].x + v[j].y * v[j].y) + (v[j].z * v[j].z + v[j].w * v[j].w); }
        const float rstd = rsqrtf(wave_sum(ss) * (1.0f / D) + RMS_EPS);
#pragma unroll
        for (int j = 0; j < 4; ++j) {
            const int col = 4 * lane + 256 * j;
            const f32x4 g4 = *(const f32x4*)(g + col), sc = *(const f32x4*)(modl + (size_t)b * 9216 + isc * 1024 + col), sh = *(const f32x4*)(modl + (size_t)b * 9216 + ish * 1024 + col);
            const f32x4 y = (v[j] * rstd) * g4 * (sc + 1.0f) + sh;
            u32x2 w; w.x = cvtpk(y.x, y.y); w.y = cvtpk(y.z, y.w);
            *(u32x2*)(out + (size_t)row * D + col) = w;
        }
    }
}
__device__ __forceinline__ void final_norm_rows(float* X, const float* g) {
    const int tid = opq(get_tid()), lane = tid & 63, wid = __builtin_amdgcn_readfirstlane(tid >> 6), gw = blockIdx.x * NWAVE + wid, ngw = gridDim.x * NWAVE;
    for (int row = gw; row < M; row += ngw) {
        f32x4* xr = (f32x4*)(X + (size_t)row * D) + lane;
        f32x4 v[4]; float ss = 0.f;
#pragma unroll
        for (int j = 0; j < 4; ++j) { v[j] = xr[64 * j]; ss += (v[j].x * v[j].x + v[j].y * v[j].y) + (v[j].z * v[j].z + v[j].w * v[j].w); }
        const float rstd = rsqrtf(wave_sum(ss) * (1.0f / D) + RMS_EPS);
#pragma unroll
        for (int j = 0; j < 4; ++j) { const f32x4 g4 = *(const f32x4*)(g + 4 * lane + 256 * j); xr[64 * j] = (v[j] * rstd) * g4; }
    }
}

__device__ __forceinline__ void norm_block(const float* X, bf16_t* out, const float* g, const float* modl, int ish, int isc, int row0) {
    const int tid = opq(get_tid()), lane = tid & 63, wid = __builtin_amdgcn_readfirstlane(tid >> 6);
    const int b = row0 >> 12;
#pragma unroll 1
    for (int rr = 0; rr < 8; ++rr) {
        const int row = row0 + rr * 8 + wid;
        const f32x4* xr = (const f32x4*)(X + (size_t)row * D) + lane;
        f32x4 v[4]; float ss = 0.f;
#pragma unroll
        for (int j = 0; j < 4; ++j) { v[j] = xr[64 * j]; ss += (v[j].x * v[j].x + v[j].y * v[j].y) + (v[j].z * v[j].z + v[j].w * v[j].w); }
        const float rstd = rsqrtf(wave_sum(ss) * (1.0f / D) + RMS_EPS);
#pragma unroll
        for (int j = 0; j < 4; ++j) {
            const int col = 4 * lane + 256 * j;
            const f32x4 g4 = *(const f32x4*)(g + col), sc = *(const f32x4*)(modl + (size_t)b * 9216 + isc * 1024 + col), sh = *(const f32x4*)(modl + (size_t)b * 9216 + ish * 1024 + col);
            const f32x4 y = (v[j] * rstd) * g4 * (sc + 1.0f) + sh;
            u32x2 w; w.x = cvtpk(y.x, y.y); w.y = cvtpk(y.z, y.w);
            *(u32x2*)(out + (size_t)row * D + col) = w;
        }
    }
}
__device__ __forceinline__ void final_norm_block(float* X, const float* g, int row0) {
    const int tid = opq(get_tid()), lane = tid & 63, wid = __builtin_amdgcn_readfirstlane(tid >> 6);
#pragma unroll 1
    for (int rr = 0; rr < 8; ++rr) {
        const int row = row0 + rr * 8 + wid;
        f32x4* xr = (f32x4*)(X + (size_t)row * D) + lane;
        f32x4 v[4]; float ss = 0.f;
#pragma unroll
        for (int j = 0; j < 4; ++j) { v[j] = xr[64 * j]; ss += (v[j].x * v[j].x + v[j].y * v[j].y) + (v[j].z * v[j].z + v[j].w * v[j].w); }
        const float rstd = rsqrtf(wave_sum(ss) * (1.0f / D) + RMS_EPS);
#pragma unroll
        for (int j = 0; j < 4; ++j) { const f32x4 g4 = *(const f32x4*)(g + 4 * lane + 256 * j); xr[64 * j] = (v[j] * rstd) * g4; }
    }
}
struct CountedOrder : pg8::StaticOrder {
    unsigned* cnt;
    __device__ __forceinline__ void done(const pg8::Unit& u) const {
        __builtin_amdgcn_fence(__ATOMIC_RELEASE, "agent");
        if ((get_tid() & 63) == 0) __hip_atomic_fetch_add(cnt + u.pm, 1u, __ATOMIC_RELAXED, __HIP_MEMORY_SCOPE_AGENT);
    }
};
__device__ __forceinline__ void panel_wait(unsigned* cnt, int pm) {
    if (get_tid() == 0) {
        unsigned sp = 0;
        while (__hip_atomic_load(cnt + pm, __ATOMIC_RELAXED, __HIP_MEMORY_SCOPE_AGENT) < 32u) { __builtin_amdgcn_s_sleep(2); if (++sp > (1u << 22)) break; }
    }
    __syncthreads();
    __builtin_amdgcn_fence(__ATOMIC_ACQUIRE, "agent");
}

__device__ __forceinline__ void kpe_unit(const Args& A, int unit) {
    const int tid = opq(get_tid());
    unsigned char* w_ = ws_opq(A.ws);
    const bf16_t* P = (const bf16_t*)(w_ + WS_U); bf16_t* KPE = (bf16_t*)(w_ + WS_KPE); const float* rope = (const float*)(w_ + WS_ROPE);
#pragma unroll 2
    for (int k = 0; k < 8; ++k) {
        const int e = unit * 4096 + k * 512 + tid;
        const int row = e >> 4, i = e & 15, t = row & (T - 1);
        const float x0 = bf2f((short)P[(size_t)row * DINP + C_BKR + i]), x1 = bf2f((short)P[(size_t)row * DINP + C_BKR + 16 + i]);
        const float c = rope[t * 16 + i], sn = rope[T * 16 + t * 16 + i];
        KPE[(size_t)row * 32 + i] = (bf16_t)(cvtpk(x0 * c - x1 * sn, 0.f) & 0xffffu);
        KPE[(size_t)row * 32 + 16 + i] = (bf16_t)(cvtpk(x1 * c + x0 * sn, 0.f) & 0xffffu);
    }
}

constexpr int CTL_KN = 128;
__device__ __forceinline__ void kn_rows(const Args& A, int l) {
    const int tid = opq(get_tid()), lane = tid & 63, wid = __builtin_amdgcn_readfirstlane(tid >> 6), gw = blockIdx.x * NWAVE + wid, ngw = gridDim.x * NWAVE;
    unsigned char* w_ = ws_opq(A.ws);
    const bf16_t* P = (const bf16_t*)(w_ + WS_U); unsigned* kn = (unsigned*)(w_ + WS_CTL) + CTL_KN + l * 48;
    const int col2 = lane < 32 ? C_KS + 4 * lane : C_KW + 4 * (lane - 32);
    for (int it = gw; it < M / 16; it += ngw) {
        float m1 = 0.f, m2 = 0.f;
#pragma unroll 4
        for (int rr = 0; rr < 16; ++rr) {
            const bf16_t* rp = P + (size_t)(it * 16 + rr) * DINP;
            const s16x4 v1 = *(const s16x4*)(rp + C_AK + 4 * lane), v2 = *(const s16x4*)(rp + col2);
            float s1 = 0.f, s2 = 0.f;
#pragma unroll
            for (int j = 0; j < 4; ++j) { const float x = bf2f(v1[j]), y = bf2f(v2[j]); s1 += x * x; s2 += y * y; }
            s1 += __shfl_xor(s1, 1); s1 += __shfl_xor(s1, 2); s1 += __shfl_xor(s1, 4);
            s2 += __shfl_xor(s2, 1); s2 += __shfl_xor(s2, 2); s2 += __shfl_xor(s2, 4); s2 += __shfl_xor(s2, 8);
            m1 = fmaxf(m1, s1); m2 = fmaxf(m2, s2);
        }
        const int b = (it * 16) >> 12;
        if ((lane & 7) == 0) atomicMax(kn + b * 12 + (lane >> 3), __float_as_uint(m1));
        if ((lane & 15) == 0) atomicMax(kn + b * 12 + (lane < 32 ? 10 + (lane >> 4) : 8 + ((lane - 32) >> 4)), __float_as_uint(m2));
    }
}
#define XB_TMO      128
#define XB_XCNT(j)  (256  + 64 * (j))
#define XB_XSUB(j)  (1280 + 64 * (j))
#define XB_XGEN(j)  (2304 + 64 * (j))
#define XB_TOP      3328
#define XB_TOPGEN   3392
#define XCD_BAR_WORDS 3456
#define XB_SPIN_CAP (1u << 18)

__device__ __forceinline__ unsigned xb_ld(unsigned* p)              { return __hip_atomic_load(p, __ATOMIC_RELAXED, __HIP_MEMORY_SCOPE_AGENT); }
__device__ __forceinline__ unsigned xb_add(unsigned* p, unsigned v) { return __hip_atomic_fetch_add(p, v, __ATOMIC_RELAXED, __HIP_MEMORY_SCOPE_AGENT); }
__device__ __forceinline__ unsigned xb_xcc_id() { return (unsigned)__builtin_amdgcn_s_getreg((3 << 11) | 20) & 0xFu; }
#define XB_SPIN(cond, bar) do { unsigned _sp = 0; while (cond) { __builtin_amdgcn_s_sleep(1); \
    if ((++_sp & 255u) == 0u) { if (xb_ld(&(bar)[XB_TMO])) break; if (_sp > XB_SPIN_CAP) { atomicAdd(&(bar)[XB_TMO], 1u); break; } } } } while (0)

struct XcdBarrier {
    unsigned* bar; unsigned x;
    volatile LAS unsigned* st;
};

__device__ __forceinline__ XcdBarrier xcd_barrier_post(unsigned* bar, volatile LAS unsigned* st) {
    XcdBarrier b; b.bar = bar; b.x = xb_xcc_id(); b.st = st;
    if (get_tid() == 0) (void)xb_add(&bar[XB_XCNT(b.x)], 1u);
    return b;
}
__device__ __forceinline__ void xcd_barrier_complete(unsigned* bar, unsigned x, unsigned& nloc, unsigned& nx) {
    const unsigned G = gridDim.x * gridDim.y * gridDim.z;
    unsigned sum, cnt, mine, sp = 0u;
    for (;;) {
        sum = 0u; cnt = 0u; mine = 0u;
#pragma unroll
        for (unsigned j = 0; j < 16; ++j) { const unsigned c = xb_ld(&bar[XB_XCNT(j)]); sum += c; cnt += (c > 0u) ? 1u : 0u; mine = (j == x) ? c : mine; }
        if (sum == G) break;
        __builtin_amdgcn_s_sleep(1);
        if ((++sp & 255u) == 0u) { if (xb_ld(&bar[XB_TMO])) break; if (sp > XB_SPIN_CAP) { atomicAdd(&bar[XB_TMO], 1u); break; } }
    }
    nloc = mine > 0u ? mine : 1u; nx = cnt > 0u ? cnt : 1u;
}

__device__ __forceinline__ void xcd_barrier(const XcdBarrier& b) {
    asm volatile("s_waitcnt vmcnt(0)" ::: "memory");
    __syncthreads();
    if (get_tid() == 0) {
        unsigned* bar = b.bar;
        __builtin_amdgcn_s_waitcnt(0);
        unsigned nloc = b.st[0], nx = b.st[1];
        if (nloc == 0u) { xcd_barrier_complete(bar, b.x, nloc, nx); b.st[0] = nloc; b.st[1] = nx; }
        const unsigned old = xb_add(&bar[XB_XSUB(b.x)], 1u);
        const unsigned gen = old / nloc;
        if (old + 1u == (gen + 1u) * nloc) {
            __builtin_amdgcn_fence(__ATOMIC_RELEASE, "agent");
            asm volatile("s_waitcnt vmcnt(0)" ::: "memory");
            const unsigned og = xb_add(&bar[XB_TOP], 1u);
            const unsigned tg = og / nx;
            if (og + 1u == (tg + 1u) * nx) xb_add(&bar[XB_TOPGEN], 1u);
            else XB_SPIN(xb_ld(&bar[XB_TOPGEN]) == tg, bar);
            __builtin_amdgcn_fence(__ATOMIC_ACQUIRE, "agent");
            xb_add(&bar[XB_XGEN(b.x)], 1u);
            asm volatile("s_waitcnt vmcnt(0)" ::: "memory");
        } else {
            XB_SPIN(xb_ld(&bar[XB_XGEN(b.x)]) == gen, bar);
            __builtin_amdgcn_fence(__ATOMIC_ACQUIRE, "agent");
            asm volatile("s_waitcnt vmcnt(0)" ::: "memory");
        }
    }
    __syncthreads();
}

struct AttnArgs {
    const bf16_t* Q; int qpitch;
    const bf16_t* K1; int k1pitch;
    const bf16_t* K2; int k2pitch;
    const bf16_t* V; int vpitch;
    const float* rope;
    const unsigned long long* sel;
    float scale2, slope2; int window;
    float kmax;
};
constexpr int ATT_K_OFF = 0, ATT_V_OFF = 16384, ATT_BUF = 24576;

__device__ __forceinline__ s16x4 vtr(const LAS unsigned char* p) {
    typedef short v4i16_t __attribute__((ext_vector_type(4)));
    return __builtin_bit_cast(s16x4, __builtin_amdgcn_ds_read_tr16_b64_v4i16((LAS v4i16_t*)p));
}
template <bool ROWSUM> __device__ __forceinline__ void pv_tile_t(f32x16 (&o)[2], f32x16& osum, const f32x16& p0, const f32x16& p1, const LAS unsigned char* vl, int lane) {
    const int h = lane >> 5, i16 = lane & 15, q4 = i16 >> 2, p4 = i16 & 3, blk = (lane >> 4) & 1;
    const unsigned onew = ((lane & 31) == 0) ? 0x3f803f80u : 0u;
    const bf16x8 ones = __builtin_bit_cast(bf16x8, (u32x4){onew, onew, onew, onew});
    const LAS unsigned char* vb = vl + (4 * h + q4) * 64 + blk * 32 + p4 * 8;
#pragma unroll
    for (int s = 0; s < 4; ++s) {
        u32x4 pw;
        if (s == 0) { pw.x = cvtpk(p0[0], p0[1]); pw.y = cvtpk(p0[2], p0[3]); pw.z = cvtpk(p0[4], p0[5]); pw.w = cvtpk(p0[6], p0[7]); }
        else if (s == 1) { pw.x = cvtpk(p0[8], p0[9]); pw.y = cvtpk(p0[10], p0[11]); pw.z = cvtpk(p0[12], p0[13]); pw.w = cvtpk(p0[14], p0[15]); }
        else if (s == 2) { pw.x = cvtpk(p1[0], p1[1]); pw.y = cvtpk(p1[2], p1[3]); pw.z = cvtpk(p1[4], p1[5]); pw.w = cvtpk(p1[6], p1[7]); }
        else { pw.x = cvtpk(p1[8], p1[9]); pw.y = cvtpk(p1[10], p1[11]); pw.z = cvtpk(p1[12], p1[13]); pw.w = cvtpk(p1[14], p1[15]); }
        const bf16x8 pf = __builtin_bit_cast(bf16x8, pw);
#pragma unroll
        for (int db = 0; db < 2; ++db) {
            const s16x4 lo = vtr(vb + db * 4096 + (16 * s) * 64), hi = vtr(vb + db * 4096 + (16 * s + 8) * 64);
            const bf16x8 vf = __builtin_shufflevector(lo, hi, 0, 1, 2, 3, 4, 5, 6, 7);
            o[db] = MFMA32(vf, pf, o[db]);
        }
        if (ROWSUM) osum = MFMA32(ones, pf, osum);
    }
}
__device__ __forceinline__ void pv_tile(f32x16 (&o)[2], const f32x16& p0, const f32x16& p1, const LAS unsigned char* vl, int lane) {
    f32x16 dummy; pv_tile_t<false>(o, dummy, p0, p1, vl, lane);
}
template <int MODE> __device__ __forceinline__ void store_o(const f32x16 (&o)[2], bf16_t* out_row, int h, float sc) {
#pragma unroll
    for (int db = 0; db < 2; ++db)
#pragma unroll
        for (int g4 = 0; g4 < 4; ++g4) {
            bf16_t* p = out_row + 32 * db + 8 * g4 + 4 * h;
            float v0 = o[db][4 * g4] * sc, v1 = o[db][4 * g4 + 1] * sc, v2 = o[db][4 * g4 + 2] * sc, v3 = o[db][4 * g4 + 3] * sc;
            if (MODE == 1) { const u32x2 old = *(const u32x2*)p; v0 += __uint_as_float(old.x << 16); v1 += __uint_as_float(old.x & 0xffff0000u); v2 += __uint_as_float(old.y << 16); v3 += __uint_as_float(old.y & 0xffff0000u); }
            u32x2 w; w.x = cvtpk(v0, v1); w.y = cvtpk(v2, v3);
            *(u32x2*)p = w;
        }
}

constexpr int ATT_FLAG_OFF = 140480;
template <int DQK, bool ROPE, bool SEL, bool DUAL = false, bool EARLY = false>
__device__ __forceinline__ void attn_core(const AttnArgs& a, int q0, LAS unsigned char* lds, f32x16 (&o)[2]) {
    constexpr int KS = DQK / 16, DK = DUAL ? 2 * DQK : DQK, KP = DK * 2 + 16, D1 = DK < 64 ? DK : 64, NCH1 = D1 / 8, QROWS = DUAL ? 128 : 256;
    const int tid = opq(get_tid()), lane = tid & 63, wid = __builtin_amdgcn_readfirstlane(tid >> 6), r = lane & 31, h = lane >> 5;
    const int wq = DUAL ? (wid & 3) : wid, coff = DUAL ? (wid >> 2) * DQK : 0;
    const int qw0 = q0 + 32 * wq, qpos = qw0 + r;
    LAS unsigned char* Kl = lds + ATT_K_OFF; LAS unsigned char* Vl = lds + ATT_V_OFF;
    bf16x8 qf[KS];
    {
        const bf16_t* qrow = a.Q + (size_t)qpos * a.qpitch + coff;
#pragma unroll
        for (int ks = 0; ks < KS; ++ks) qf[ks] = *(const bf16x8*)(qrow + 16 * ks + 8 * h);
        if (ROPE) {
            const float* cs = a.rope + (size_t)qpos * 16 + 8 * h; const float* sn = cs + T * 16;
            float y0[8], y1[8];
#pragma unroll
            for (int j = 0; j < 8; ++j) { const float x0 = bf2f(qf[KS - 2][j]), x1 = bf2f(qf[KS - 1][j]), c = cs[j], s = sn[j]; y0[j] = x0 * c - x1 * s; y1[j] = x1 * c + x0 * s; }
            u32x4 w0, w1;
            w0.x = cvtpk(y0[0], y0[1]); w0.y = cvtpk(y0[2], y0[3]); w0.z = cvtpk(y0[4], y0[5]); w0.w = cvtpk(y0[6], y0[7]);
            w1.x = cvtpk(y1[0], y1[1]); w1.y = cvtpk(y1[2], y1[3]); w1.z = cvtpk(y1[4], y1[5]); w1.w = cvtpk(y1[6], y1[7]);
            qf[KS - 2] = __builtin_bit_cast(bf16x8, w0); qf[KS - 1] = __builtin_bit_cast(bf16x8, w1);
        }
    }
    float qk_bound = 0.f;
    if (EARLY) {
        float qq = 0.f;
#pragma unroll
        for (int ks = 0; ks < KS; ++ks)
#pragma unroll
            for (int j = 0; j < 8; ++j) { const float x = bf2f(qf[ks][j]); qq += x * x; }
        qq += __shfl_xor(qq, 32);
        qk_bound = sqrtf(qq) * a.kmax * a.scale2 * 1.001f + 0.01f;
    }
    unsigned long long selm = ~0ull;
    if (SEL) selm = a.sel[qpos];
    const int t_hi = (q0 + QROWS - 1) >> 6;
    int t_lo = 0;
    if (a.window) { const int lo = q0 - a.window + 1; t_lo = lo > 0 ? (lo >> 6) : 0; }
    const bool kA_on = tid < 64 * NCH1; const int rowA = tid / NCH1, chA = tid % NCH1;
    const bool kB_on = ROPE && tid < 128; const int rowB = tid >> 1, prB = tid & 1;
    const int rowV = tid >> 3, chV = tid & 7;
    u32x4 kA = {0, 0, 0, 0}, kB0 = {0, 0, 0, 0}, kB1 = {0, 0, 0, 0}, vR = {0, 0, 0, 0};
#define ATT_PREFETCH(t) do { \
        if (kA_on) kA = *(const u32x4*)(a.K1 + (size_t)(64 * (t) + rowA) * a.k1pitch + chA * 8); \
        if (kB_on) { const bf16_t* kp = a.K2 + (size_t)(64 * (t) + rowB) * a.k2pitch + prB * 8; kB0 = *(const u32x4*)kp; kB1 = *(const u32x4*)(kp + 16); } \
        vR = *(const u32x4*)(a.V + (size_t)(64 * (t) + rowV) * a.vpitch + chV * 8); } while (0)
#define ATT_STORE(tt, KL, VL) do { \
        if (kA_on) *(LAS u32x4*)((KL) + rowA * KP + chA * 16) = kA; \
        if (ROPE) { if (kB_on) { \
                *(LAS u32x4*)((KL) + rowB * KP + (64 + prB * 8) * 2) = kB0; \
                *(LAS u32x4*)((KL) + rowB * KP + (80 + prB * 8) * 2) = kB1; } } \
        *(LAS u32x4*)((VL) + (chV >> 2) * 4096 + rowV * 64 + (chV & 3) * 16) = vR; } while (0)
    float m = NEGBIG;
    f32x16 osum;
#pragma unroll
    for (int i = 0; i < 16; ++i) { o[0][i] = 0.f; o[1][i] = 0.f; osum[i] = 0.f; }
    float cbv[16];
#pragma unroll
    for (int i = 0; i < 16; ++i) cbv[i] = a.slope2 * (float)((i & 3) + 8 * (i >> 2) + 4 * h);
    volatile LAS unsigned* eflag = (volatile LAS unsigned*)(lds + ATT_FLAG_OFF);
    unsigned long long um = (t_hi >= 63 ? ~0ull : ((1ull << (t_hi + 1)) - 1ull)) & ~((1ull << t_lo) - 1ull);
    if (SEL) {
        LAS unsigned* uw = (LAS unsigned*)(lds + ATT_FLAG_OFF + 64);
        __syncthreads();
        if (tid < 2) uw[tid] = 0u;
        __syncthreads();
        __hip_atomic_fetch_or(uw, (unsigned)selm, __ATOMIC_RELAXED, __HIP_MEMORY_SCOPE_WORKGROUP);
        __hip_atomic_fetch_or(uw + 1, (unsigned)(selm >> 32), __ATOMIC_RELAXED, __HIP_MEMORY_SCOPE_WORKGROUP);
        __syncthreads();
        const unsigned lo_ = (unsigned)__builtin_amdgcn_readfirstlane((int)uw[0]), hi_ = (unsigned)__builtin_amdgcn_readfirstlane((int)uw[1]);
        um &= ((unsigned long long)hi_ << 32) | (unsigned long long)lo_;
    }
#define ATT_NEXT(tt) ((((tt) > 0) && (um & ((1ull << (tt)) - 1ull))) ? 63 - __builtin_clzll(um & ((1ull << (tt)) - 1ull)) : -1)
    int t = 63 - __builtin_clzll(um);
    int t1 = ATT_NEXT(t);
    ATT_PREFETCH(t);
    if (EARLY) { if (lane == 0) { eflag[wid] = 0u; eflag[8 + wid] = 0u; } }
    __syncthreads();
    ATT_STORE(t, Kl, Vl);
    __syncthreads();
    if (t1 >= 0) ATT_PREFETCH(t1);
    for (int step = 0; t >= 0; ++step) {
        const int cur = step & 1;
        const int t2 = (t1 >= 0) ? ATT_NEXT(t1) : -1;
        const LAS unsigned char* Kc = Kl + cur * ATT_BUF; const LAS unsigned char* Vc = Vl + cur * ATT_BUF;
        bool need = (64 * t <= qw0 + 31);
        if (a.window) need = need && (64 * t + 63 >= qw0 - a.window + 1);
        const bool selbit = SEL ? (((selm >> t) & 1ull) != 0ull) : true;
        if (SEL) need = need && (__ballot(selbit) != 0ull);
        if (need) {
            f32x16 p0, p1;
#pragma unroll
            for (int i = 0; i < 16; ++i) { p0[i] = 0.f; p1[i] = 0.f; }
#pragma unroll
            for (int ks = 0; ks < KS; ++ks) {
                const bf16x8 a0 = *(const LAS bf16x8*)(Kc + r * KP + coff * 2 + ks * 32 + h * 16);
                const bf16x8 a1 = *(const LAS bf16x8*)(Kc + (32 + r) * KP + coff * 2 + ks * 32 + h * 16);
                p0 = MFMA32(a0, qf[ks], p0); p1 = MFMA32(a1, qf[ks], p1);
            }
#pragma unroll
            for (int i = 0; i < 16; ++i) { p0[i] = p0[i] * a.scale2 + cbv[i]; p1[i] = p1[i] * a.scale2 + cbv[i]; }
            const float base0 = a.slope2 * (float)(64 * t - qpos), base1 = base0 + 32.0f * a.slope2;
            bool bnd = (64 * t + 63 > qw0);
            if (a.window) bnd = bnd || (64 * t < qw0 + 31 - a.window + 1);
            if (SEL) bnd = bnd || (__ballot(!selbit) != 0ull);
            if (bnd) {
                const int wlim = a.window ? a.window : (1 << 30);
#pragma unroll
                for (int i = 0; i < 16; ++i) {
                    const int kv0 = 64 * t + crow(i, h), d0 = qpos - kv0, d1 = d0 - 32;
                    const bool ok0 = selbit && d0 >= 0 && d0 < wlim, ok1 = selbit && d1 >= 0 && d1 < wlim;
                    p0[i] = ok0 ? p0[i] : NEGBIG; p1[i] = ok1 ? p1[i] : NEGBIG;
                }
            }
            float mx0 = p0[0], mx1 = p1[0];
#pragma unroll
            for (int i = 1; i < 16; ++i) { mx0 = fmaxf(mx0, p0[i]); mx1 = fmaxf(mx1, p1[i]); }
            float mloc = fmaxf(mx0 + base0, mx1 + base1);
            mloc = fmaxf(mloc, __shfl_xor(mloc, 32));
            const float mnew = fmaxf(m, mloc);
            if (__ballot(mnew > m) != 0ull) {
                const float alpha = fast_exp2(m - mnew);
                osum[0] *= alpha;
#pragma unroll
                for (int i = 0; i < 16; ++i) { o[0][i] *= alpha; o[1][i] *= alpha; }
            }
            m = mnew;
            const float r0 = mnew - base0, r1 = mnew - base1;
#pragma unroll
            for (int i = 0; i < 16; ++i) { p0[i] = fast_exp2(p0[i] - r0); p1[i] = fast_exp2(p1[i] - r1); }
            pv_tile_t<true>(o, osum, p0, p1, Vc, lane);
        }
        if (EARLY) {
            const bool live = !(qk_bound - a.slope2 * (float)(qpos - 64 * t + 1) - m < -64.0f);
            const bool wdone = (__ballot(live) == 0ull);
            if (lane == 0) eflag[8 * cur + wid] = wdone ? 1u : 0u;
        }
        if (t1 >= 0) ATT_STORE(t1, Kl + (cur ^ 1) * ATT_BUF, Vl + (cur ^ 1) * ATT_BUF);
        __syncthreads();
        if (EARLY) {
            const unsigned alld = eflag[8 * cur] & eflag[8 * cur + 1] & eflag[8 * cur + 2] & eflag[8 * cur + 3] & eflag[8 * cur + 4] & eflag[8 * cur + 5] & eflag[8 * cur + 6] & eflag[8 * cur + 7];
            if (__builtin_amdgcn_readfirstlane((int)alld) != 0) break;
        }
        if (t2 >= 0) ATT_PREFETCH(t2);
        t = t1; t1 = t2;
    }
#undef ATT_NEXT
#undef ATT_STORE
#undef ATT_PREFETCH
    const float lt = __shfl(osum[0], lane & 31);
    const float inv = 1.0f / lt;
#pragma unroll
    for (int i = 0; i < 16; ++i) { o[0][i] *= inv; o[1][i] *= inv; }
}

__device__ __forceinline__ float da_slope(int hd) { return hd == 0 ? 0.25f : hd == 1 ? 0.0625f : hd == 2 ? 0.015625f : 0.00390625f; }
__device__ __forceinline__ float nsa_slope(int hh) { return hh == 0 ? 0.25f : hh == 1 ? 0.0625f : hh == 2 ? 0.015625f : hh == 3 ? 0.00390625f : hh == 4 ? 0.5f : 0.125f; }

constexpr int DA_X_OFF = 49152;
__device__ __forceinline__ void da_unit(const Args& A, int l, int b, int hd, int qb, LAS unsigned char* lds) {
    const int tid_ = opq(get_tid()), lane = tid_ & 63, wid = __builtin_amdgcn_readfirstlane(tid_ >> 6), r = lane & 31, h = lane >> 5;
    const bf16_t* P = (const bf16_t*)(A.ws + WS_U) + (size_t)b * T * DINP;
    const float lam = ((const float*)(A.ws + WS_CTL))[64 + l];
    const float one_m_li = ((const float*)(A.ws + WS_CTL))[66 + l];
    f32x16 o[2];
    AttnArgs a; a.Q = P + C_AQ + hd * 64; a.qpitch = DINP; a.K1 = P + C_AK + hd * 64; a.k1pitch = DINP; a.K2 = nullptr; a.k2pitch = 0;
    a.V = P + C_AV + hd * 64; a.vpitch = DINP; a.rope = nullptr; a.sel = nullptr; a.scale2 = 0.17677669529663687f * LOG2E; a.slope2 = da_slope(hd) * LOG2E; a.window = 0;
    { const unsigned* kn = (const unsigned*)(A.ws + WS_CTL) + CTL_KN + l * 48 + b * 12 + 2 * hd; a.kmax = sqrtf(fmaxf(__uint_as_float(kn[0]), __uint_as_float(kn[1]))); }
    attn_core<32, false, false, true, true>(a, qb * 128, lds, o);
    LAS float* xb = (LAS float*)(lds + DA_X_OFF) + (32 * (wid & 3) + r) * 65;
    if (wid >= 4) {
#pragma unroll
        for (int db = 0; db < 2; ++db)
#pragma unroll
            for (int i = 0; i < 16; ++i) xb[32 * db + crow(i, h)] = o[db][i];
    }
    __syncthreads();
    if (wid < 4) {
        float ss = 0.f;
#pragma unroll
        for (int db = 0; db < 2; ++db)
#pragma unroll
            for (int i = 0; i < 16; ++i) { o[db][i] = o[db][i] - lam * xb[32 * db + crow(i, h)]; ss += o[db][i] * o[db][i]; }
        ss += __shfl_xor(ss, 32);
        const float rs = rsqrtf(ss * (1.0f / 64.0f) + RMS_EPS) * one_m_li;
        const float* sg = A.in[14] + l * 64;
#pragma unroll
        for (int db = 0; db < 2; ++db)
#pragma unroll
            for (int i = 0; i < 16; ++i) o[db][i] *= rs * sg[32 * db + crow(i, h)];
        bf16_t* orow = (bf16_t*)(A.ws + WS_XN) + (size_t)(b * T + qb * 128 + 32 * wid + r) * D + hd * 64;
        store_o<0>(o, orow, h, EN_DA ? 1.0f : 0.0f);
    }
}
__device__ __forceinline__ void mla_unit(const Args& A, int b, int hd, int qb, LAS unsigned char* lds) {
    const int tid_ = opq(get_tid()), lane = tid_ & 63, wid = __builtin_amdgcn_readfirstlane(tid_ >> 6), r = lane & 31, h = lane >> 5;
    AttnArgs a; a.Q = (const bf16_t*)(A.ws + WS_MQ) + (size_t)b * T * 768 + hd * 96; a.qpitch = 768;
    a.K1 = (const bf16_t*)(A.ws + WS_MKV) + (size_t)b * T * 768 + hd * 128; a.k1pitch = 768;
    a.K2 = (const bf16_t*)(A.ws + WS_KPE) + (size_t)b * T * 32; a.k2pitch = 32;
    a.V = a.K1 + 64; a.vpitch = 768; a.rope = (const float*)(A.ws + WS_ROPE); a.sel = nullptr; a.scale2 = 0.10206207261596575f * LOG2E; a.slope2 = 0.f; a.window = 0; a.kmax = 0.f;
    f32x16 o[2];
    attn_core<96, true, false>(a, qb * 256, lds, o);
    bf16_t* orow = (bf16_t*)(A.ws + WS_XN) + (size_t)(b * T + qb * 256 + 32 * wid + r) * D + 256 + hd * 64;
    store_o<0>(o, orow, h, EN_MLA ? 1.0f : 0.0f);
}
template <int BR> __device__ __forceinline__ void nsa_unit(const Args& A, int l, int b, int hh, int qb, LAS unsigned char* lds) {
    const int tid_ = opq(get_tid()), lane = tid_ & 63, wid = __builtin_amdgcn_readfirstlane(tid_ >> 6), r = lane & 31, h = lane >> 5, g = hh / 3;
    const bf16_t* P = (const bf16_t*)(A.ws + WS_U) + (size_t)b * T * DINP;
    AttnArgs a; a.Q = P + C_CQ + hh * 64; a.qpitch = DINP; a.K1 = P + (BR == 2 ? C_KW : C_KS) + g * 64; a.k1pitch = DINP; a.K2 = nullptr; a.k2pitch = 0;
    a.V = P + (BR == 2 ? C_VW : C_VS) + g * 64; a.vpitch = DINP; a.rope = nullptr; a.sel = (const unsigned long long*)(A.ws + WS_SEL) + (size_t)(b * 2 + g) * T;
    a.scale2 = 0.125f * LOG2E; a.slope2 = nsa_slope(hh) * LOG2E; a.window = (BR == 2) ? 512 : 0;
    f32x16 o[2];
    a.kmax = sqrtf(__uint_as_float(((const unsigned*)(A.ws + WS_CTL))[CTL_KN + l * 48 + b * 12 + (BR == 2 ? 8 : 10) + g]));
    attn_core<64, false, BR == 1, false, true>(a, qb * 256, lds, o);
    const int qpos = qb * 256 + 32 * wid + r;
    const float gl = bf2f((short)P[(size_t)qpos * DINP + C_G + BR * 6 + hh]);
    bf16_t* orow = (bf16_t*)(A.ws + WS_XN) + (size_t)(b * T + qpos) * D + 640 + hh * 64;
    if (BR == 2) store_o<0>(o, orow, h, EN_WIN ? sigmoid_f(gl) : 0.0f);
    else store_o<1>(o, orow, h, EN_SLC ? sigmoid_f(gl) : 0.0f);
}

__device__ __forceinline__ void cmp_mlp_task(const Args& A, int l, int wt, LAS unsigned char* lds) {
    const int tid_ = opq(get_tid()), lane = tid_ & 63, wid = __builtin_amdgcn_readfirstlane(tid_ >> 6);
    const int kv = wt >> 7, bg = (wt >> 4) & 7, rg = wt & 15, b = bg >> 1, g = bg & 1, i16 = lane & 15, quad = lane >> 4;
    const bf16_t* P = (const bf16_t*)(A.ws + WS_U) + (size_t)b * T * DINP + (kv ? C_VC : C_KC) + g * 64;
    const bf16_t* W1 = (const bf16_t*)(A.ws + WS_W + W_C1) + (size_t)kv * 128 * 2048;
    const bf16_t* W2 = (const bf16_t*)(A.ws + WS_W + W_C2) + (size_t)kv * 64 * 128;
    const float* posb = (const float*)(A.ws + WS_POSB) + (l * 2 + kv) * 128;
    const int n = 16 * rg + i16;
    const bf16_t* arow = P + (size_t)(16 * n) * DINP + 8 * quad;
    const bf16_t* wrow1 = W1 + (size_t)i16 * 2048 + 8 * quad;
    f32x4 acc[8];
#pragma unroll
    for (int i = 0; i < 8; ++i) acc[i] = (f32x4){0.f, 0.f, 0.f, 0.f};
#pragma unroll 2
    for (int kk = 0; kk < 8; ++kk) {
        const int ks = 8 * wid + kk;
        const bf16x8 bfrag = *(const bf16x8*)(arow + (size_t)(ks >> 1) * DINP + 32 * (ks & 1));
#pragma unroll
        for (int ht = 0; ht < 8; ++ht) {
            const bf16x8 afrag = *(const bf16x8*)(wrow1 + (size_t)(16 * ht) * 2048 + 32 * ks);
            acc[ht] = MFMA16(afrag, bfrag, acc[ht]);
        }
    }
    {
        LAS float* red = (LAS float*)lds;
        if (wid > 0) {
#pragma unroll
            for (int ht = 0; ht < 8; ++ht)
#pragma unroll
                for (int j = 0; j < 4; ++j) red[(wid * 64 + lane) * 33 + ht * 4 + j] = acc[ht][j];
        }
        __syncthreads();
        if (wid > 0) return;
#pragma unroll 1
        for (int w = 1; w < 8; ++w)
#pragma unroll
            for (int ht = 0; ht < 8; ++ht)
#pragma unroll
                for (int j = 0; j < 4; ++j) acc[ht][j] += red[(w * 64 + lane) * 33 + ht * 4 + j];
    }
    bf16x8 hf[4];
#pragma unroll
    for (int ks2 = 0; ks2 < 4; ++ks2) {
        float v[8];
#pragma unroll
        for (int e = 0; e < 8; ++e) {
            const int ht = 2 * ks2 + (e >> 2), j = e & 3;
            const float x = acc[ht][j] + posb[16 * ht + 4 * quad + j];
            const float u2 = 0.7978845608028654f * (x + 0.044715f * x * x * x);
            const float ex = fast_exp2(2.0f * LOG2E * u2);
            const float th = 1.0f - 2.0f * fast_rcp(ex + 1.0f);
            v[e] = 0.5f * x * (1.0f + th);
        }
        u32x4 w; w.x = cvtpk(v[0], v[1]); w.y = cvtpk(v[2], v[3]); w.z = cvtpk(v[4], v[5]); w.w = cvtpk(v[6], v[7]);
        hf[ks2] = __builtin_bit_cast(bf16x8, w);
    }
    bf16_t* outp = (bf16_t*)(A.ws + WS_KCMP) + ((size_t)(kv * 8 + bg) * 256 + n) * 64;
#pragma unroll
    for (int ot = 0; ot < 4; ++ot) {
        f32x4 c2 = (f32x4){0.f, 0.f, 0.f, 0.f};
        const bf16_t* w2r = W2 + (size_t)(16 * ot + i16) * 128 + 4 * quad;
#pragma unroll
        for (int ks2 = 0; ks2 < 4; ++ks2) {
            const u32x2 lo = *(const u32x2*)(w2r + 32 * ks2), hi = *(const u32x2*)(w2r + 32 * ks2 + 16);
            u32x4 w; w.x = lo.x; w.y = lo.y; w.z = hi.x; w.w = hi.y;
            c2 = MFMA16(__builtin_bit_cast(bf16x8, w), hf[ks2], c2);
        }
        if (n < 255) { u32x2 w; w.x = cvtpk(c2[0], c2[1]); w.y = cvtpk(c2[2], c2[3]); *(u32x2*)(outp + 16 * ot + 4 * quad) = w; }
    }
}

constexpr int CMP_K_OFF = 0, CMP_V_OFF = 36864, CMP_IMP_OFF = 69632;
__device__ __forceinline__ void cmp_unit(const Args& A, int b, int g, int qb, LAS unsigned char* lds, float gmul = 1.0f) {
    const int tid = opq(get_tid()), lane = tid & 63, wid = __builtin_amdgcn_readfirstlane(tid >> 6), r = lane & 31, h = lane >> 5;
    const int q0 = qb * 256, qw0 = q0 + 32 * wid, qpos = qw0 + r, qloc = 32 * wid + r;
    const int ntile = (((q0 + 224) >> 4) >> 6) + 1;
    LAS unsigned char* Kl = lds + CMP_K_OFF; LAS unsigned char* Vl = lds + CMP_V_OFF; LAS float* imp = (LAS float*)(lds + CMP_IMP_OFF);
    const bf16_t* KC = (const bf16_t*)(A.ws + WS_KCMP) + (size_t)(b * 2 + g) * 256 * 64;
    const bf16_t* VC = KC + (size_t)8 * 256 * 64;
    __syncthreads();
    for (int idx = tid; idx < 512 * ntile; idx += NTHR) {
        const int n = idx >> 3, ch = idx & 7;
        u32x4 kx = {0, 0, 0, 0}, vx = {0, 0, 0, 0};
        if (n < 255) { kx = *(const u32x4*)(KC + (size_t)n * 64 + ch * 8); vx = *(const u32x4*)(VC + (size_t)n * 64 + ch * 8); }
        *(LAS u32x4*)(Kl + n * 144 + ch * 16) = kx;
        *(LAS u32x4*)(Vl + (n >> 6) * 8192 + (ch >> 2) * 4096 + (n & 63) * 64 + (ch & 3) * 16) = vx;
    }
    for (int idx = tid; idx < 256 * 65; idx += NTHR) imp[idx] = 0.f;
    __syncthreads();
    const bf16_t* P = (const bf16_t*)(A.ws + WS_U) + (size_t)b * T * DINP;
    const float scale2 = 0.125f * LOG2E;
#pragma unroll 1
    for (int rr = 0; rr < 3; ++rr) {
        const int hh = 3 * g + rr; const float slope2 = nsa_slope(hh) * LOG2E;
        bf16x8 qf[4];
        { const bf16_t* qrow = P + (size_t)qpos * DINP + C_CQ + hh * 64;
#pragma unroll
          for (int ks = 0; ks < 4; ++ks) qf[ks] = *(const bf16x8*)(qrow + 16 * ks + 8 * h); }
        float m = NEGBIG, lsum = 0.f, invl = 0.f;
        f32x16 o[2];
#pragma unroll
        for (int i = 0; i < 16; ++i) { o[0][i] = 0.f; o[1][i] = 0.f; }
#pragma unroll 1
        for (int pass = 0; pass < 2; ++pass) {
#pragma unroll 1
            for (int tt = 0; tt < ntile; ++tt) {
                if (16 * (64 * tt) + 31 > qw0 + 31) continue;
                f32x16 p0, p1;
#pragma unroll
                for (int i = 0; i < 16; ++i) { p0[i] = 0.f; p1[i] = 0.f; }
#pragma unroll
                for (int ks = 0; ks < 4; ++ks) {
                    const bf16x8 a0 = *(const LAS bf16x8*)(Kl + (64 * tt + r) * 144 + ks * 32 + h * 16);
                    const bf16x8 a1 = *(const LAS bf16x8*)(Kl + (64 * tt + 32 + r) * 144 + ks * 32 + h * 16);
                    p0 = MFMA32(a0, qf[ks], p0); p1 = MFMA32(a1, qf[ks], p1);
                }
#pragma unroll
                for (int i = 0; i < 16; ++i) {
                    const int n0 = 64 * tt + crow(i, h), d0 = qpos - (16 * n0 + 31), d1 = d0 - 512;
                    p0[i] = d0 >= 0 ? p0[i] * scale2 - slope2 * (float)d0 : NEGBIG;
                    p1[i] = d1 >= 0 ? p1[i] * scale2 - slope2 * (float)d1 : NEGBIG;
                }
                if (pass == 0) {
                    float mloc = fmaxf(p0[0], p1[0]);
#pragma unroll
                    for (int i = 1; i < 16; ++i) mloc = fmaxf(mloc, fmaxf(p0[i], p1[i]));
                    mloc = fmaxf(mloc, __shfl_xor(mloc, 32));
                    const float mnew = fmaxf(m, mloc), alpha = fast_exp2(m - mnew);
                    m = mnew;
                    float ls = 0.f;
#pragma unroll
                    for (int i = 0; i < 16; ++i) ls += fast_exp2(p0[i] - mnew) + fast_exp2(p1[i] - mnew);
                    lsum = lsum * alpha + ls;
                } else {
#pragma unroll
                    for (int i = 0; i < 16; ++i) {
                        p0[i] = p0[i] > -1e29f ? fast_exp2(p0[i] - m) * invl : 0.f;
                        p1[i] = p1[i] > -1e29f ? fast_exp2(p1[i] - m) * invl : 0.f;
                    }
                    pv_tile(o, p0, p1, Vl + tt * 8192, lane);
#pragma unroll
                    for (int blk = 0; blk < 2; ++blk)
#pragma unroll
                        for (int g4 = 0; g4 < 4; ++g4) {
                            const int j = 16 * tt + 8 * blk + 2 * g4 + h;
                            const float G = blk == 0 ? (p0[4 * g4] + p0[4 * g4 + 1]) + (p0[4 * g4 + 2] + p0[4 * g4 + 3]) : (p1[4 * g4] + p1[4 * g4 + 1]) + (p1[4 * g4 + 2] + p1[4 * g4 + 3]);
                            imp[qloc * 65 + j] += G;
                        }
                    asm volatile("s_waitcnt lgkmcnt(0)" ::: "memory");
#pragma unroll
                    for (int blk = 0; blk < 2; ++blk)
#pragma unroll
                        for (int g4 = 0; g4 < 4; ++g4) {
                            const int j = 16 * tt + 8 * blk + 2 * g4 + h;
                            const float Lst = blk == 0 ? p0[4 * g4 + 3] : p1[4 * g4 + 3];
                            if (j + 1 < 64) imp[qloc * 65 + j + 1] += Lst;
                        }
                    asm volatile("s_waitcnt lgkmcnt(0)" ::: "memory");
                }
            }
            if (pass == 0) { const float lt = lsum + __shfl_xor(lsum, 32); invl = (qpos >= 31) ? 1.0f / lt : 0.f; }
        }
        const float gl = bf2f((short)P[(size_t)qpos * DINP + C_G + 0 * 6 + hh]);
        bf16_t* orow = (bf16_t*)(A.ws + WS_XN) + (size_t)(b * T + qpos) * D + 640 + hh * 64;
        store_o<1>(o, orow, h, EN_CMP ? sigmoid_f(gl) * gmul : 0.0f);
    }
    __syncthreads();
    if (qb < 4) {
        if (tid < 256) { const int t = q0 + tid, cur = t >> 6; ((unsigned long long*)(A.ws + WS_SEL))[(size_t)(b * 2 + g) * T + t] = (1ull << (cur + 1)) - 1ull; }
    } else {
        const int qi = tid >> 1, hf = tid & 1, t = q0 + qi, cur = t >> 6;
        float v[32];
#pragma unroll
        for (int i = 0; i < 32; ++i) { const int j = 32 * hf + i; const float x = imp[qi * 65 + j]; v[i] = (j >= 1 && j <= cur - 2) ? x : -1.0f; }
        unsigned long long mask = 1ull | (1ull << cur) | (1ull << (cur - 1));
#pragma unroll 1
        for (int it = 0; it < 13; ++it) {
            float bv = v[0]; int bi = 0;
#pragma unroll
            for (int i = 1; i < 32; ++i) { const bool gt = v[i] > bv; bv = gt ? v[i] : bv; bi = gt ? i : bi; }
            const float ov = __shfl_xor(bv, 1); const int oi = __shfl_xor(bi, 1);
            const float v0 = hf ? ov : bv, v1 = hf ? bv : ov; const int i0 = hf ? oi : bi, i1 = hf ? bi : oi;
            const bool win0 = v0 >= v1;
            const int wj = win0 ? i0 : 32 + i1;
            mask |= 1ull << wj;
            const int clr = (win0 == (hf == 0)) ? (win0 ? i0 : i1) : -1;
#pragma unroll
            for (int i = 0; i < 32; ++i) v[i] = (i == clr) ? -1.0f : v[i];
        }
        if (hf == 0) ((unsigned long long*)(A.ws + WS_SEL))[(size_t)(b * 2 + g) * T + t] = mask;
    }
    __syncthreads();
}

__device__ __forceinline__ int fetch_unit(unsigned* ctr, LAS unsigned char* lds) {
    volatile LAS int* w = (volatile LAS int*)(lds + FETCH_OFF);
    __syncthreads();
    if (get_tid() == 0) *w = (int)atomicAdd(ctr, 1u);
    __syncthreads();
    return __builtin_amdgcn_readfirstlane(*w);
}
template <class Epi>
__device__ __forceinline__ void run_gemm_counted(LAS unsigned char* lds, const bf16_t* Am, const bf16_t* Bt, int N, int K, const Epi& E, unsigned* cnt) {
    pg8::Gemm g{Am, Bt, M, N, K}; CountedOrder S; S.init(M, N, (int)gridDim.x, (int)blockIdx.x); S.cnt = cnt;
    pg8::gemm_phase<Epi, CountedOrder, true, true>(lds, g, S, E);
}
template <class Epi>
__device__ __forceinline__ void run_gemm(LAS unsigned char* lds, const bf16_t* Am, const bf16_t* Bt, int N, int K, const Epi& E) {
    pg8::Gemm g{Am, Bt, M, N, K}; pg8::StaticOrder S; S.init(M, N, (int)gridDim.x, (int)blockIdx.x);
    pg8::gemm_phase<Epi, pg8::StaticOrder, true, true>(lds, g, S, E);
}

__global__ void __launch_bounds__(NTHR, 2) fwd_megakernel(Args A) {
    LAS unsigned char* lds = (LAS unsigned char*)lds_raw;
    if (lane_id() == 0) *(volatile LAS int*)(lds + WIDTAB_OFF + 4 * hw_slot()) = (int)(threadIdx.x >> 6);
    __syncthreads();
    cg::grid_group grid = cg::this_grid();
    const int G = gridDim.x;
    { volatile LAS unsigned* st0 = (volatile LAS unsigned*)(lds + FETCH_OFF + 16); if (get_tid() < 2) st0[get_tid()] = 0u; }
    __syncthreads();
#ifdef PROBE_PHASE
    if (get_tid() < 32) { volatile LAS unsigned* ta_ = (volatile LAS unsigned*)(lds + 140000); ta_[get_tid()] = 0u; }
    __syncthreads();
    if (get_tid() == 0) { volatile LAS unsigned* ta_ = (volatile LAS unsigned*)(lds + 140000); ta_[31] = (unsigned)__builtin_amdgcn_s_memrealtime(); }
    __syncthreads();
#endif
    const unsigned xbar_x = (unsigned)__builtin_amdgcn_readfirstlane((int)xcd_barrier_post((unsigned*)(A.ws + WS_CTL) + 1024, (volatile LAS unsigned*)(lds + FETCH_OFF + 16)).x);
#ifdef PROBE_PHASE
#define STAMP(id) do { if (blockIdx.x == 0 && get_tid() == 0) { volatile LAS unsigned* ta_ = (volatile LAS unsigned*)(lds + 140000); const unsigned now_ = (unsigned)__builtin_amdgcn_s_memrealtime(); ta_[id] += now_ - ta_[31]; ta_[31] = now_; } } while (0)
#else
#define STAMP(id) do {} while (0)
#endif
#define GSYNC() do { XcdBarrier xb_; unsigned xx_ = xbar_x; asm volatile("" : "+s"(xx_)); xb_.bar = (unsigned*)(A.ws + WS_CTL) + 1024; xb_.x = xx_; \
                     xb_.st = (volatile LAS unsigned*)(lds + FETCH_OFF + 16); xcd_barrier(xb_); } while (0)
    unsigned char* ws = A.ws;
    unsigned* ctl = (unsigned*)(ws + WS_CTL);
    float* X = A.out;
    bf16_t* XN = (bf16_t*)(ws + WS_XN);
    bf16_t* U = (bf16_t*)(ws + WS_U);
    const float* mods = (const float*)(ws + WS_MODS);

    for (int task = blockIdx.x; task < 288; task += G) mods_task(A, task, lds);
    for (int task = G - 1 - (int)blockIdx.x; task < 64; task += G) posb_task(A, task, lds);
    rope_entries(A);
    { float* ssq = (float*)(ws + WS_SSQ); for (int i = blockIdx.x * NTHR + opq(get_tid()); i < 4 * M; i += G * NTHR) ssq[i] = 0.f; }
    if (blockIdx.x == 0 && get_tid() < 2) {
        const int tid = opq(get_tid());
        const float* lp = A.in[13] + tid * 128; float s1 = 0.f, s2 = 0.f;
        for (int i = 0; i < 32; ++i) { s1 += lp[i] * lp[32 + i]; s2 += lp[64 + i] * lp[96 + i]; }
        const float lam_init = tid == 0 ? 0.2f : 0.35550907f;
        ((float*)ctl)[64 + tid] = expf(s1) - expf(s2) + lam_init;
        ((float*)ctl)[66 + tid] = 1.0f - lam_init;
    }
    __syncthreads();
    convert_layer(A, 0, lds);
#ifdef PROBE_DUPCVT
    for (int i = 0; i < PROBE_DUPCVT; ++i) { __syncthreads(); convert_layer(A, 0, lds); }
#endif
#ifdef PROBE_DUPMODS
    for (int task = blockIdx.x; task < 288; task += G) mods_task(A, task, lds);
#endif
    grid.sync();
    STAMP(0);

    if (blockIdx.x == 0) posb_final(A);
#pragma unroll 1
    for (int l = 0; l < 2; ++l) {
        const float* modl = mods + (size_t)l * 4 * 9216;
        unsigned char* wb = ws + WS_W;
        if (l == 1) { __syncthreads(); convert_layer(A, 1, lds); }
#pragma unroll 1
        for (int s = 0; s < 2; ++s) {
            const float* xin = (l == 0 && s == 0) ? A.in[0] : X;
            norm_rows(xin, XN, A.in[s == 0 ? 4 : 6] + l * D, modl, s == 0 ? 0 : 6, s == 0 ? 1 : 7);
            GSYNC();
            STAMP(1);
            { EpiSwiGLU E{U}; run_gemm(lds, XN, (const bf16_t*)(wb + (s == 0 ? W_1A : W_2A)), F2, D, E); }
            GSYNC();
            STAMP(2);
            { EpiResid E{xin, X, modl + (s == 0 ? 2 : 8) * 1024, 0.5f}; run_gemm(lds, U, (const bf16_t*)(wb + (s == 0 ? W_1B : W_2B)), D, F, E); }
            GSYNC();
            STAMP(3);
            if (s == 0 && EN_MIX) {
                norm_rows(X, XN, A.in[5] + l * D, modl, 3, 4);
                GSYNC();
                STAMP(4);
                float* ssq = (float*)(ws + WS_SSQ) + (size_t)l * 2 * M;
                { EpiProj E{U, (bf16_t*)(ws + WS_CQ), (bf16_t*)(ws + WS_CKV), ssq, ssq + M}; run_gemm(lds, XN, (const bf16_t*)(wb + W_IN), DINP, D, E); }
                GSYNC();
                STAMP(5);
                kn_rows(A, l);
                GSYNC();
                STAMP(12);
                { EpiRowScale E{(bf16_t*)(ws + WS_MQ), 768, ssq, 1.0f / 256.0f}; run_gemm(lds, (const bf16_t*)(ws + WS_CQ), (const bf16_t*)(wb + W_UQ), 768, 256, E); }
                { EpiRowScale E{(bf16_t*)(ws + WS_MKV), 768, ssq + M, 1.0f / 128.0f}; run_gemm(lds, (const bf16_t*)(ws + WS_CKV), (const bf16_t*)(wb + W_UKV), 768, 128, E); }
                STAMP(11);
                for (;;) {
                    int u = fetch_unit(ctl + l * 4 + 0, lds);
                    if (u >= 64 + 256 + 512 + 384) break;
                    if (u < 512) { da_unit(A, l, (u & 15) >> 2, u & 3, 31 - (u >> 4), lds); continue; } u -= 512;
                    if (u < 384) { nsa_unit<2>(A, l, (u % 24) / 6, u % 6, 15 - u / 24, lds); continue; } u -= 384;
                    if (u < 256) { cmp_mlp_task(A, l, u, lds); continue; } u -= 256;
                    kpe_unit(A, u);
                }
                GSYNC();
                STAMP(6);
                for (;;) {
                    int u = fetch_unit(ctl + l * 4 + 1, lds);
                    if (u >= 384 + 128) break;
                    if (u < 192) { mla_unit(A, (u % 24) / 6, u % 6, 15 - u / 24, lds); continue; } u -= 192;
                    if (u < 128) { cmp_unit(A, (u & 7) >> 1, u & 1, 15 - (u >> 3), lds); continue; } u -= 128;
                    u += 192; mla_unit(A, (u % 24) / 6, u % 6, 15 - u / 24, lds);
                }
                GSYNC();
                STAMP(7);
                for (;;) {
                    const int u = fetch_unit(ctl + l * 4 + 2, lds);
                    if (u >= 384) break;
                    nsa_unit<1>(A, l, (u % 24) / 6, u % 6, 15 - u / 24, lds);
                }
                GSYNC();
                STAMP(8);
                { EpiResid E{X, X, modl + 5 * 1024, 1.0f}; run_gemm(lds, XN, (const bf16_t*)(wb + W_OUT), D, D, E); }
                GSYNC();
                STAMP(9);
            }
        }
    }
    final_norm_rows(X, A.in[22]);
#ifdef PROBE_PHASE
    STAMP(10);
    __syncthreads();
    if (blockIdx.x == 0 && get_tid() == 0) { volatile LAS unsigned* ta_ = (volatile LAS unsigned*)(lds + 140000); X[0] += (float)ta_[PROBE_PHASE] * 0.0001f; }
#endif
#ifdef PROBE_SYNCS
    for (int i = 0; i < PROBE_SYNCS; ++i) GSYNC();
#endif
}

extern "C" void kernel_launch(void* const* d_in, const int* in_sizes, int n_in, void* d_out, int out_size, void* d_ws, size_t ws_size, hipStream_t stream) {
    static int grid = 0;
    if (grid == 0) {
        if (n_in != 23 || out_size != M * D || ws_size < WS_END) { fprintf(stderr, "kernel_launch: unexpected problem shape (n_in %d out %d ws %zu)\n", n_in, out_size, ws_size); grid = -1; return; }
        int dev = 0, cus = 0, per_cu = 0;
        hipGetDevice(&dev);
        hipDeviceGetAttribute(&cus, hipDeviceAttributeMultiprocessorCount, dev);
        hipFuncSetAttribute((const void*)fwd_megakernel, hipFuncAttributeMaxDynamicSharedMemorySize, LDS_BYTES);
        hipOccupancyMaxActiveBlocksPerMultiprocessor(&per_cu, (const void*)fwd_megakernel, NTHR, LDS_BYTES);
        if (per_cu < 1) per_cu = 1;
        grid = cus * per_cu;
        (void)hipGetLastError();
    }
    if (grid < 0) return;
    hipMemsetAsync(d_ws, 0, 32768, stream);
    Args a{};
    for (int i = 0; i < 23; ++i) a.in[i] = (const float*)d_in[i];
    a.out = (float*)d_out; a.ws = (unsigned char*)d_ws;
    void* args[] = {&a};
    hipError_t e = hipLaunchCooperativeKernel((const void*)fwd_megakernel, dim3(grid), dim3(NTHR), args, LDS_BYTES, stream);
    if (e != hipSuccess) fprintf(stderr, "cooperative launch failed: %s (grid %d)\n", hipGetErrorString(e), grid);
}
```

```cpp
#include <hip/hip_runtime.h>
#include <hip/hip_cooperative_groups.h>
#include <cstdio>
#include <cstdint>
namespace cg = cooperative_groups;
extern __shared__ __attribute__((aligned(16))) unsigned char lds_raw[];
constexpr int WIDTAB_OFF = 140200;
__device__ __forceinline__ int lane_id() { return (int)__builtin_amdgcn_mbcnt_hi(~0u, __builtin_amdgcn_mbcnt_lo(~0u, 0u)); }
__device__ __forceinline__ int hw_slot() { return (int)(__builtin_amdgcn_s_getreg((5 << 11) | 4) & 63u); }
__device__ __forceinline__ int get_tid() {
    const int wid = __builtin_amdgcn_readfirstlane(*(volatile __attribute__((address_space(3))) int*)((__attribute__((address_space(3))) unsigned char*)lds_raw + WIDTAB_OFF + 4 * hw_slot()));
    return wid * 64 + lane_id();
}
__device__ __forceinline__ int pg8_opq_tid() { int v = get_tid(); asm volatile("" : "+v"(v)); return v; }
namespace pg8 {
#define PG8_LAS __attribute__((address_space(3)))
typedef unsigned short bf16_t;
typedef short bf16x8 __attribute__((ext_vector_type(8)));
typedef float f32x4 __attribute__((ext_vector_type(4)));
typedef unsigned u32x4 __attribute__((ext_vector_type(4)));
constexpr int BM = 256, BK = 64, HALF = 128, HTB = HALF * BK * 2  , STAGE_BYTES = 8 * HTB, NXCD = 8, WGM = 8;

__host__ __device__ __forceinline__ int lds_byte(int r, int c) { const int st = (r >> 4) * 2 + (c >> 5), rr = r & 15, cc = c & 31, ob = rr * 64 + cc * 2; return st * 1024 + (ob ^ (((ob >> 9) & 1) << 5)); }
__host__ __device__ __forceinline__ void stage_rc(int b, int& R, int& C) { const int st = b / 1024, sb = b % 1024, swz = sb ^ (((sb >> 9) & 1) << 5); R = (st >> 1) * 16 + swz / 64; C = (st & 1) * 32 + (swz % 64) / 2; }
__host__ __device__ __forceinline__ int perm32(int rho) { const int n = rho >> 4, i = rho & 15; return 8 * (i >> 2) + 4 * n + (i & 3); }

struct Unit { int pm, pn; };
struct Gemm { const bf16_t* A; const bf16_t* Bt; int M, N, K; };

struct StaticOrder {
    int nM, nN, nwg, G, c;
    __host__ __device__ void init(int M, int N, int G_, int c_) { nM = M / BM; nN = N / BM; nwg = nM * nN; G = G_; c = c_; }
    __host__ __device__ bool next(int i, Unit& u) const {
        const long L = (long)i * G + c; if (L >= nwg) return false;
        int wgid = (int)L; { const int q = nwg / NXCD, r = nwg % NXCD, xcd = wgid % NXCD, off = wgid / NXCD; wgid = (xcd < r ? xcd * (q + 1) : r * (q + 1) + (xcd - r) * q) + off; }
        const int nig = WGM * nN, gid = wgid / nig, fm = gid * WGM, gsz = (nM - fm) < WGM ? (nM - fm) : WGM;
        u.pm = fm + ((wgid % nig) % gsz); u.pn = (wgid % nig) / gsz; return true;
    }
    __device__ __forceinline__ void a_ready(const Unit&) const {}
    __device__ __forceinline__ void done(const Unit&) const {}
};

__device__ __forceinline__ unsigned cvt_pk_bf16(float lo, float hi) { unsigned r; asm volatile("v_cvt_pk_bf16_f32 %0, %1, %2" : "=v"(r) : "v"(lo), "v"(hi)); return r; }
typedef float f32x2 __attribute__((ext_vector_type(2)));
__device__ __forceinline__ f32x2 gelu_pk(f32x2 v) {
    const f32x2 av = __builtin_elementwise_abs(v), d = av * 0.2316418882f + 1.0f;
    f32x2 t; t.x = __builtin_amdgcn_rcpf(d.x); t.y = __builtin_amdgcn_rcpf(d.y);
    f32x2 q = t * 0.5307027145f + (-0.7265760135f); q = q * t + 0.7107068705f; q = q * t + (-0.142248368f); q = q * t + 0.127414796f; q = q * t;
    const f32x2 s = (v * v) * (-0.72134752044f);
    f32x2 e; e.x = __builtin_amdgcn_exp2f(s.x); e.y = __builtin_amdgcn_exp2f(s.y);
    const f32x2 m = v * (q * e), r = v - m;
    f32x2 o; o.x = v.x < 0.f ? m.x : r.x; o.y = v.y < 0.f ? m.y : r.y; return o;
}

template <int ACT  > struct EpiBf16 {
    static constexpr bool PERM = true, AFTER_DRAIN = false; static_assert(ACT == 0 || ACT == 1, "EpiBf16: ACT is 0 (none) or 1 (gelu_pk)");
    bf16_t* O; int ldc; const float* bias; int split_cols; size_t split_stride; float scale0;
    __device__ __forceinline__ void operator()(const f32x4 (&acc)[2][2][4][2], const Unit& u, int wr, int wc, int fr, int fq) const {
        const int row0 = u.pm * BM + wr * 64 + fr; int colt = u.pn * BM; bf16_t* base = O;
        float sc = 1.f; if (split_cols) { const int t = colt / split_cols; base += (size_t)t * split_stride; colt -= t * split_cols; if (t == 0) sc = scale0; }
        const int col0 = colt + wc * 32 + 8 * fq, bcol0 = u.pn * BM + wc * 32 + 8 * fq;
        f32x4 bv[2][2];
#pragma unroll
        for (int bj = 0; bj < 2; ++bj)
#pragma unroll
            for (int n = 0; n < 2; ++n) bv[bj][n] = bias ? *(const f32x4*)(bias + bcol0 + bj * HALF + 4 * n) : (f32x4){0.f, 0.f, 0.f, 0.f};
#pragma unroll
        for (int ai = 0; ai < 2; ++ai)
#pragma unroll
            for (int m = 0; m < 4; ++m) { bf16_t* rowp = base + (size_t)(row0 + ai * HALF + m * 16) * ldc + col0;
#pragma unroll
                for (int bj = 0; bj < 2; ++bj) { f32x4 v0 = acc[ai][bj][m][0] + bv[bj][0], v1 = acc[ai][bj][m][1] + bv[bj][1];
                    if (ACT == 1) { f32x2 a = gelu_pk((f32x2){v0[0], v0[1]}), b = gelu_pk((f32x2){v0[2], v0[3]}), c = gelu_pk((f32x2){v1[0], v1[1]}), d = gelu_pk((f32x2){v1[2], v1[3]});
                        v0 = (f32x4){a.x, a.y, b.x, b.y}; v1 = (f32x4){c.x, c.y, d.x, d.y}; }
                    v0 = v0 * sc; v1 = v1 * sc; u32x4 w; w.x = cvt_pk_bf16(v0[0], v0[1]); w.y = cvt_pk_bf16(v0[2], v0[3]); w.z = cvt_pk_bf16(v1[0], v1[1]); w.w = cvt_pk_bf16(v1[2], v1[3]);
                    *(u32x4*)(rowp + bj * HALF) = w; } }
    }
};
template <class Epi, class Sched, bool ALIGN_EPI = false, bool SP2 = false>
__device__ __forceinline__ void gemm_phase(PG8_LAS unsigned char* lds, const Gemm g, const Sched& S, const Epi& E) {
    const int tid = pg8_opq_tid(), wid = __builtin_amdgcn_readfirstlane(tid >> 6), lane = tid & 63, wr = wid >> 2, wc = wid & 3, fr = lane & 15, fq = lane >> 4;
    const int K = g.K, nt = K / BK;
    unsigned voffA[2], voffB[2];
#pragma unroll
    for (int i = 0; i < 2; ++i) { int R, C; stage_rc(tid * 16 + i * 8192, R, C); const int Rb = Epi::PERM ? ((R & ~31) + perm32(R & 31)) : R;
        voffA[i] = (unsigned)(R * K + C) * 2u; voffB[i] = (unsigned)(Rb * K + C) * 2u; }
    const size_t kstep = (size_t)(BK * 2);
    const size_t hstep = (size_t)HALF * K * 2;
    const size_t tstep = 2 * hstep;
    const unsigned ldsw = (unsigned)wid * 1024u;
    const int aoff = lds_byte(wr * 64 + fr, fq * 8), boff = lds_byte(wc * 32 + fr, fq * 8);
#define PG8_SA(b, h) (((b) * 2 + (h)) * HTB)
#define PG8_SB(b, h) ((4 + (b) * 2 + (h)) * HTB)
#define PG8_STAGE(bufoff, gbase, voff) do { _Pragma("unroll") for (int _i = 0; _i < 2; ++_i) \
        __builtin_amdgcn_global_load_lds((const unsigned*)((const char*)(gbase) + (voff)[_i]), (PG8_LAS unsigned*)(lds + (bufoff) + ldsw + _i * 8192), 16, 0, 0); } while (0)
#define PG8_LDA(dst, b, h) do { _Pragma("unroll") for (int m = 0; m < 4; ++m) _Pragma("unroll") for (int k = 0; k < 2; ++k) dst[m][k] = *(const PG8_LAS bf16x8*)(lds + PG8_SA(b, h) + aoff + m * 2048 + k * 1024); } while (0)
#define PG8_LDB(dst, b, h) do { _Pragma("unroll") for (int n = 0; n < 2; ++n) _Pragma("unroll") for (int k = 0; k < 2; ++k) dst[n][k] = *(const PG8_LAS bf16x8*)(lds + PG8_SB(b, h) + boff + n * 2048 + k * 1024); } while (0)
#define PG8_MMA(ai, bj, At, Bt) do { __builtin_amdgcn_s_setprio(1); _Pragma("unroll") for (int m = 0; m < 4; ++m) _Pragma("unroll") for (int n = 0; n < 2; ++n) _Pragma("unroll") for (int k = 0; k < 2; ++k) \
        acc[ai][bj][m][n] = __builtin_amdgcn_mfma_f32_16x16x32_bf16(Bt[n][k], At[m][k], acc[ai][bj][m][n], 0, 0, 0); __builtin_amdgcn_s_setprio(0); } while (0)
#define PG8_WAIT_V(n) asm volatile("s_waitcnt vmcnt(" #n ")" ::: "memory")
#define PG8_WAIT_L(n) asm volatile("s_waitcnt lgkmcnt(" #n ")" ::: "memory")
#define PG8_BAR __builtin_amdgcn_s_barrier()
#define PG8_SCHED __builtin_amdgcn_sched_barrier(0)
    Unit cur, nxt; int ui = 0;
    if (!S.next(0, cur)) return;
    f32x4 acc[2][2][4][2];
#pragma unroll
    for (int a = 0; a < 2; ++a)
#pragma unroll
        for (int b = 0; b < 2; ++b)
#pragma unroll
            for (int m = 0; m < 4; ++m)
#pragma unroll
                for (int n = 0; n < 2; ++n) acc[a][b][m][n] = (f32x4){0.f, 0.f, 0.f, 0.f};
    bf16x8 At[4][2], B0[2][2], B1[2][2];
    const char* cA = (const char*)g.A + (size_t)cur.pm * tstep; const char* cB = (const char*)g.Bt + (size_t)cur.pn * tstep;
    S.a_ready(cur);
    if constexpr (SP2) {
        PG8_STAGE(PG8_SB(0, 0), cB, voffB); PG8_STAGE(PG8_SB(0, 1), cB + hstep, voffB); PG8_STAGE(PG8_SA(0, 0), cA, voffA); PG8_STAGE(PG8_SA(0, 1), cA + hstep, voffA);
        if (wr == 1) PG8_BAR;
        PG8_WAIT_V(2); PG8_BAR;
        PG8_STAGE(PG8_SB(1, 0), cB + kstep, voffB); PG8_STAGE(PG8_SA(1, 0), cA + kstep, voffA); PG8_STAGE(PG8_SB(1, 1), cB + hstep + kstep, voffB);
        PG8_WAIT_V(6); PG8_BAR;
    } else {
        PG8_STAGE(PG8_SB(0, 0), cB, voffB); PG8_STAGE(PG8_SA(0, 0), cA, voffA); PG8_STAGE(PG8_SB(0, 1), cB + hstep, voffB); PG8_STAGE(PG8_SA(0, 1), cA + hstep, voffA);
        if (wr == 1) PG8_BAR;
        PG8_WAIT_V(4); PG8_BAR;
        PG8_STAGE(PG8_SB(1, 0), cB + kstep, voffB); PG8_STAGE(PG8_SA(1, 0), cA + kstep, voffA); PG8_STAGE(PG8_SB(1, 1), cB + hstep + kstep, voffB);
        PG8_WAIT_V(6); PG8_BAR;
    }
    for (;;) {
        const bool has_next = S.next(ui + 1, nxt);
        const char* nA = has_next ? (const char*)g.A + (size_t)nxt.pm * tstep : cA; const char* nB = has_next ? (const char*)g.Bt + (size_t)nxt.pn * tstep : cB;
        for (int t = 0; t < nt; t += 2) {
            const bool last = (t == nt - 2);
            const char* a1 = cA + (size_t)(t + 1) * kstep;
            const char* a2 = last ? nA : cA + (size_t)(t + 2) * kstep; const char* b2 = last ? nB : cB + (size_t)(t + 2) * kstep;
            const char* a3 = a2 + kstep; const char* b3 = b2 + kstep;
            if (last && has_next) S.a_ready(nxt);
            if constexpr (SP2) {
            PG8_LDB(B0, 0, 0); PG8_LDB(B1, 0, 1); PG8_SCHED; PG8_LDA(At, 0, 0); PG8_STAGE(PG8_SA(1, 1), a1 + hstep, voffA);
            PG8_WAIT_V(8); PG8_WAIT_L(0); PG8_BAR; PG8_MMA(0, 0, At, B0); PG8_MMA(0, 1, At, B1); PG8_BAR; PG8_SCHED;
            PG8_LDA(At, 0, 1); PG8_STAGE(PG8_SB(0, 0), b2, voffB); PG8_STAGE(PG8_SB(0, 1), b2 + hstep, voffB); PG8_STAGE(PG8_SA(0, 0), a2, voffA);
            PG8_WAIT_V(8); PG8_WAIT_L(0); PG8_BAR; PG8_MMA(1, 0, At, B0); PG8_MMA(1, 1, At, B1); PG8_BAR; PG8_SCHED;
            PG8_LDB(B0, 1, 0); PG8_LDB(B1, 1, 1); PG8_SCHED; PG8_LDA(At, 1, 0); PG8_STAGE(PG8_SA(0, 1), a2 + hstep, voffA);
            PG8_WAIT_V(8); PG8_WAIT_L(0); PG8_BAR; PG8_MMA(0, 0, At, B0); PG8_MMA(0, 1, At, B1); PG8_BAR; PG8_SCHED;
            PG8_LDA(At, 1, 1); PG8_STAGE(PG8_SB(1, 0), b3, voffB); PG8_STAGE(PG8_SB(1, 1), b3 + hstep, voffB); PG8_STAGE(PG8_SA(1, 0), a3, voffA);
            PG8_WAIT_V(8); PG8_WAIT_L(0); PG8_BAR; PG8_MMA(1, 0, At, B0); PG8_MMA(1, 1, At, B1); PG8_BAR; PG8_SCHED;
            } else {
            PG8_LDB(B0, 0, 0); PG8_SCHED; PG8_LDA(At, 0, 0); PG8_STAGE(PG8_SA(1, 1), a1 + hstep, voffA);
            PG8_WAIT_L(8); PG8_BAR; PG8_WAIT_L(0); PG8_MMA(0, 0, At, B0); PG8_BAR; PG8_SCHED;
            PG8_LDB(B1, 0, 1); PG8_STAGE(PG8_SB(0, 0), b2, voffB);
            PG8_BAR; PG8_WAIT_L(0); PG8_MMA(0, 1, At, B1); PG8_BAR;
            PG8_LDA(At, 0, 1); PG8_STAGE(PG8_SA(0, 0), a2, voffA);
            PG8_BAR; PG8_WAIT_L(0); PG8_MMA(1, 0, At, B0); PG8_BAR; PG8_SCHED;
            PG8_STAGE(PG8_SB(0, 1), b2 + hstep, voffB);
            PG8_WAIT_V(6); PG8_BAR; PG8_MMA(1, 1, At, B1); PG8_BAR;
            PG8_LDB(B0, 1, 0); PG8_SCHED; PG8_LDA(At, 1, 0); PG8_STAGE(PG8_SA(0, 1), a2 + hstep, voffA);
            PG8_WAIT_L(8); PG8_BAR; PG8_WAIT_L(0); PG8_MMA(0, 0, At, B0); PG8_BAR; PG8_SCHED;
            PG8_LDB(B1, 1, 1); PG8_STAGE(PG8_SB(1, 0), b3, voffB);
            PG8_BAR; PG8_WAIT_L(0); PG8_MMA(0, 1, At, B1); PG8_BAR;
            PG8_LDA(At, 1, 1); PG8_STAGE(PG8_SA(1, 0), a3, voffA);
            PG8_BAR; PG8_WAIT_L(0); PG8_MMA(1, 0, At, B0); PG8_BAR; PG8_SCHED;
            PG8_STAGE(PG8_SB(1, 1), b3 + hstep, voffB);
            PG8_WAIT_V(6); PG8_BAR; PG8_MMA(1, 1, At, B1); PG8_BAR;
            }
        }
        if constexpr (ALIGN_EPI) { if (wr == 0) PG8_BAR; }
        if constexpr (!Epi::AFTER_DRAIN) { E(acc, cur, wr, wc, fr, fq); S.done(cur); }
        if (!has_next) break;
#pragma unroll
        for (int a = 0; a < 2; ++a)
#pragma unroll
            for (int b = 0; b < 2; ++b)
#pragma unroll
                for (int m = 0; m < 4; ++m)
#pragma unroll
                    for (int n = 0; n < 2; ++n) acc[a][b][m][n] = (f32x4){0.f, 0.f, 0.f, 0.f};
        cur = nxt; cA = nA; cB = nB; ++ui;
        if constexpr (ALIGN_EPI) { if (wr == 1) PG8_BAR; }
    }
    PG8_WAIT_V(0);
    if constexpr (!ALIGN_EPI) { if (wr == 0) PG8_BAR; }
    PG8_BAR;
    if constexpr (Epi::AFTER_DRAIN) { E.fused(acc, cur, wr, wc, fr, fq, lds, wid, lane); S.done(cur); }
#undef PG8_SA
#undef PG8_SB
#undef PG8_STAGE
#undef PG8_LDA
#undef PG8_LDB
#undef PG8_MMA
#undef PG8_WAIT_V
#undef PG8_WAIT_L
#undef PG8_BAR
#undef PG8_SCHED
}
}

#define LAS __attribute__((address_space(3)))
typedef unsigned short bf16_t;
typedef short bf16x8 __attribute__((ext_vector_type(8)));
typedef short s16x4 __attribute__((ext_vector_type(4)));
typedef float f32x4 __attribute__((ext_vector_type(4)));
typedef float f32x2 __attribute__((ext_vector_type(2)));
typedef float f32x16 __attribute__((ext_vector_type(16)));
typedef unsigned u32x4 __attribute__((ext_vector_type(4)));
typedef unsigned u32x2 __attribute__((ext_vector_type(2)));
typedef __bf16 bf16x2_t __attribute__((ext_vector_type(2)));

#ifndef EN_MIX
#define EN_MIX 1
#endif
#ifndef EN_DA
#define EN_DA 1
#endif
#ifndef EN_MLA
#define EN_MLA 1
#endif
#ifndef EN_WIN
#define EN_WIN 1
#endif
#ifndef EN_CMP
#define EN_CMP 1
#endif
#ifndef EN_SLC
#define EN_SLC 1
#endif

constexpr int NB = 4, T = 4096, D = 1024, M = NB * T, F = 2816, F2 = 5632, DIN = 2354, DINP = 2560;
constexpr int NTHR = 512, NWAVE = 8, LDS_BYTES = 147456, FETCH_OFF = LDS_BYTES - 64;
constexpr int C_AQ = 0, C_AK = 256, C_AV = 512, C_BKR = 1152, C_CQ = 1184, C_KC = 1568, C_VC = 1696, C_KS = 1824, C_VS = 1952, C_KW = 2080, C_VW = 2208, C_G = 2336;
constexpr float LOG2E = 1.4426950408889634f, RMS_EPS = 1e-6f, NEGBIG = -1e30f;

constexpr size_t MiB = 1u << 20, KiB = 1u << 10;
constexpr size_t WS_CTL = 0;
constexpr size_t WS_MODS = 64 * KiB;
constexpr size_t WS_ROPE = 512 * KiB;
constexpr size_t WS_POSB = 1 * MiB;
constexpr size_t WS_SSQ = 1 * MiB + 64 * KiB;
constexpr size_t WS_KCMP = 2 * MiB;
constexpr size_t WS_SEL = 3 * MiB;
constexpr size_t WS_W = 4 * MiB;
constexpr size_t W_1A = 0, W_1B = W_1A + (size_t)F2 * D * 2, W_2A = W_1B + (size_t)D * F * 2, W_2B = W_2A + (size_t)F2 * D * 2,
                 W_IN = W_2B + (size_t)D * F * 2, W_OUT = W_IN + (size_t)DINP * D * 2, W_UQ = W_OUT + (size_t)D * D * 2, W_UKV = W_UQ + 768 * 256 * 2,
                 W_C1 = W_UKV + 768 * 128 * 2, W_C2 = W_C1 + 2 * 128 * 2048 * 2, W_END = W_C2 + 2 * 64 * 128 * 2;
static_assert(WS_W + W_END <= 48 * MiB, "weights");
constexpr size_t WS_XN = 48 * MiB;
constexpr size_t WS_U = 80 * MiB;
constexpr size_t WS_CQ = 168 * MiB;
constexpr size_t WS_CKV = 176 * MiB;
constexpr size_t WS_MQ = 180 * MiB;
constexpr size_t WS_MKV = 204 * MiB;
constexpr size_t WS_KPE = 228 * MiB;
constexpr size_t WS_END = 229 * MiB;

__device__ __forceinline__ unsigned cvtpk(float lo, float hi) { f32x2 v = {lo, hi}; bf16x2_t b = __builtin_convertvector(v, bf16x2_t); return __builtin_bit_cast(unsigned, b); }
__device__ __forceinline__ float bf2f(short b) { return __uint_as_float(((unsigned)(unsigned short)b) << 16); }
__device__ __forceinline__ float wave_sum(float v) {
#pragma unroll
    for (int o = 1; o < 64; o <<= 1) v += __shfl_xor(v, o);
    return v;
}
__device__ __forceinline__ float fast_exp2(float x) { return __builtin_amdgcn_exp2f(x); }
__device__ __forceinline__ float fast_rcp(float x) { return __builtin_amdgcn_rcpf(x); }
__device__ __forceinline__ float sigmoid_f(float x) { return fast_rcp(1.0f + fast_exp2(-x * LOG2E)); }
__device__ __forceinline__ int crow(int i, int h) { return (i & 3) + 8 * (i >> 2) + 4 * h; }
__device__ __forceinline__ int opq(int v) { asm volatile("" : "+v"(v)); return v; }
#define MFMA32(a, b, c) __builtin_amdgcn_mfma_f32_32x32x16_bf16((a), (b), (c), 0, 0, 0)
#define MFMA16(a, b, c) __builtin_amdgcn_mfma_f32_16x16x32_bf16((a), (b), (c), 0, 0, 0)

struct Args { const float* in[23]; float* out; unsigned char* ws; };
__device__ __forceinline__ unsigned char* ws_opq(unsigned char* p) {
    const unsigned long long v = (unsigned long long)p;
    unsigned lo = (unsigned)__builtin_amdgcn_readfirstlane((int)(unsigned)v), hi = (unsigned)__builtin_amdgcn_readfirstlane((int)(unsigned)(v >> 32));
    asm volatile("" : "+s"(lo), "+s"(hi));
    return (unsigned char*)(((unsigned long long)hi << 32) | (unsigned long long)lo);
}

struct EpiSwiGLU {
    static constexpr bool PERM = true, AFTER_DRAIN = false;
    bf16_t* O;
    __device__ __forceinline__ void operator()(const f32x4 (&acc)[2][2][4][2], const pg8::Unit& u, int wr_, int wc_, int fr_, int fq_) const {
        const int t_ = opq(get_tid()), w_ = __builtin_amdgcn_readfirstlane(t_ >> 6), wr = w_ >> 2, wc = w_ & 3, fr = t_ & 15, fq = (t_ >> 4) & 3;
        const int row0 = u.pm * 256 + wr * 64 + fr, col0 = u.pn * 128 + wc * 32 + 8 * fq;
#pragma unroll
        for (int ai = 0; ai < 2; ++ai)
#pragma unroll
            for (int m = 0; m < 4; ++m) {
                bf16_t* rowp = O + (size_t)(row0 + ai * 128 + m * 16) * F + col0;
                float r[8];
#pragma unroll
                for (int n = 0; n < 2; ++n)
#pragma unroll
                    for (int j = 0; j < 4; ++j) { const float g = acc[ai][0][m][n][j], up = acc[ai][1][m][n][j]; r[n * 4 + j] = g * sigmoid_f(g) * up; }
                u32x4 w; w.x = cvtpk(r[0], r[1]); w.y = cvtpk(r[2], r[3]); w.z = cvtpk(r[4], r[5]); w.w = cvtpk(r[6], r[7]);
                *(u32x4*)rowp = w;
            }
    }
};
struct EpiResid {
    static constexpr bool PERM = false, AFTER_DRAIN = false;
    const float* resid; float* out; const float* gate; float coef;
    __device__ __forceinline__ void operator()(const f32x4 (&acc)[2][2][4][2], const pg8::Unit& u, int wr_, int wc_, int fr_, int fq_) const {
        const int t_ = opq(get_tid()), w_ = __builtin_amdgcn_readfirstlane(t_ >> 6), wr = w_ >> 2, wc = w_ & 3, fr = t_ & 15, fq = (t_ >> 4) & 3;
        const int row0 = u.pm * 256 + wr * 64 + fr, b = (u.pm * 256) >> 12, col0 = u.pn * 256 + wc * 32 + 4 * fq;
#pragma unroll
        for (int bj = 0; bj < 2; ++bj)
#pragma unroll
            for (int n = 0; n < 2; ++n) {
                const int c = col0 + bj * 128 + n * 16;
                const f32x4 gv = *(const f32x4*)(gate + (size_t)b * 9216 + c) * coef;
#pragma unroll
                for (int ai = 0; ai < 2; ++ai)
#pragma unroll
                    for (int m = 0; m < 4; ++m) {
                        const size_t off = (size_t)(row0 + ai * 128 + m * 16) * D + c;
                        const f32x4 o = *(const f32x4*)(resid + off) + gv * acc[ai][bj][m][n];
                        *(f32x4*)(out + off) = o;
                        if (m & 1) asm volatile("" ::: "memory");
                    }
            }
    }
};
struct EpiProj {
    static constexpr bool PERM = true, AFTER_DRAIN = false;
    bf16_t* PROJ; bf16_t* CQ; bf16_t* CKV; float* ssq_q; float* ssq_kv;
    __device__ __forceinline__ void operator()(const f32x4 (&acc)[2][2][4][2], const pg8::Unit& u, int wr_, int wc_, int fr_, int fq_) const {
        const int t_ = opq(get_tid()), w_ = __builtin_amdgcn_readfirstlane(t_ >> 6), wr = w_ >> 2, wc = w_ & 3, fr = t_ & 15, fq = (t_ >> 4) & 3;
        const int row0 = u.pm * 256 + wr * 64 + fr;
#pragma unroll
        for (int bj = 0; bj < 2; ++bj) {
            bf16_t* base; int ld, cb; float* ssq;
            if (u.pn == 3) { base = CQ; ld = 256; cb = bj * 128; ssq = ssq_q; }
            else if (u.pn == 4 && bj == 0) { base = CKV; ld = 128; cb = 0; ssq = ssq_kv; }
            else { base = PROJ; ld = DINP; cb = u.pn * 256 + bj * 128; ssq = nullptr; }
            const int col0 = cb + wc * 32 + 8 * fq;
#pragma unroll
            for (int ai = 0; ai < 2; ++ai)
#pragma unroll
                for (int m = 0; m < 4; ++m) {
                    const int row = row0 + ai * 128 + m * 16;
                    const f32x4 v0 = acc[ai][bj][m][0], v1 = acc[ai][bj][m][1];
                    u32x4 w; w.x = cvtpk(v0[0], v0[1]); w.y = cvtpk(v0[2], v0[3]); w.z = cvtpk(v1[0], v1[1]); w.w = cvtpk(v1[2], v1[3]);
                    *(u32x4*)(base + (size_t)row * ld + col0) = w;
                    if (ssq) {
                        float s = (v0[0] * v0[0] + v0[1] * v0[1]) + (v0[2] * v0[2] + v0[3] * v0[3]) + (v1[0] * v1[0] + v1[1] * v1[1]) + (v1[2] * v1[2] + v1[3] * v1[3]);
                        s += __shfl_xor(s, 16); s += __shfl_xor(s, 32);
                        if (fq == 0) atomicAdd(ssq + row, s);
                    }
                    asm volatile("" ::: "memory");
                }
        }
    }
};
struct EpiRowScale {
    static constexpr bool PERM = true, AFTER_DRAIN = false;
    bf16_t* O; int ldc; const float* ssq; float inv_n;
    __device__ __forceinline__ void operator()(const f32x4 (&acc)[2][2][4][2], const pg8::Unit& u, int wr_, int wc_, int fr_, int fq_) const {
        const int t_ = opq(get_tid()), w_ = __builtin_amdgcn_readfirstlane(t_ >> 6), wr = w_ >> 2, wc = w_ & 3, fr = t_ & 15, fq = (t_ >> 4) & 3;
        const int row0 = u.pm * 256 + wr * 64 + fr, col0 = u.pn * 256 + wc * 32 + 8 * fq;
#pragma unroll
        for (int ai = 0; ai < 2; ++ai)
#pragma unroll
            for (int m = 0; m < 4; ++m) {
                const int row = row0 + ai * 128 + m * 16;
                const float rs = rsqrtf(ssq[row] * inv_n + RMS_EPS);
#pragma unroll
                for (int bj = 0; bj < 2; ++bj) {
                    const f32x4 v0 = acc[ai][bj][m][0] * rs, v1 = acc[ai][bj][m][1] * rs;
                    u32x4 w; w.x = cvtpk(v0[0], v0[1]); w.y = cvtpk(v0[2], v0[3]); w.z = cvtpk(v1[0], v1[1]); w.w = cvtpk(v1[2], v1[3]);
                    *(u32x4*)(O + (size_t)row * ldc + col0 + bj * 128) = w;
                }
                asm volatile("" ::: "memory");
            }
    }
};

template <int MODE> __device__ __forceinline__ int wrow(int n) {
    if (MODE == 1) return n < F ? ((n >> 7) * 256 + (n & 127)) : (((n - F) >> 7) * 256 + 128 + ((n - F) & 127));
    return n;
}
template <int MODE>
__device__ __forceinline__ void cvt_item(const float* W, int K, int N, int NP, bf16_t* WT, const float* kscale, LAS float* scr, int item, int lane) {
    const int nblk = NP / 32, kb = item / nblk, nb = item % nblk, k0 = 64 * kb, n0 = 32 * nb;
    const int n_rd = n0 + (lane & 31);
#pragma unroll 8
    for (int i = 0; i < 32; ++i) {
        const int kk = 2 * i + (lane >> 5);
        float v = (n_rd < N) ? W[(size_t)(k0 + kk) * N + n_rd] : 0.f;
        if (kscale) v *= kscale[k0 + kk];
        scr[kk * 33 + (lane & 31)] = v;
    }
    asm volatile("s_waitcnt lgkmcnt(0)" ::: "memory");
    const int c = lane & 7;
#pragma unroll
    for (int j = 0; j < 4; ++j) {
        const int n = (lane >> 3) + 8 * j; const LAS float* s = scr + (8 * c) * 33 + n;
        u32x4 o; o.x = cvtpk(s[0 * 33], s[1 * 33]); o.y = cvtpk(s[2 * 33], s[3 * 33]); o.z = cvtpk(s[4 * 33], s[5 * 33]); o.w = cvtpk(s[6 * 33], s[7 * 33]);
        *(u32x4*)(WT + (size_t)wrow<MODE>(n0 + n) * K + k0 + 8 * c) = o;
    }
    asm volatile("s_waitcnt lgkmcnt(0)" ::: "memory");
}
__device__ __forceinline__ void convert_layer(const Args& A, int l, LAS unsigned char* lds) {
    const int tid = opq(get_tid()), lane = tid & 63, wid = __builtin_amdgcn_readfirstlane(tid >> 6), gw = blockIdx.x * NWAVE + wid, ngw = gridDim.x * NWAVE;
    LAS float* scr = (LAS float*)(lds + wid * 8704);
    unsigned char* wb = A.ws + WS_W;
    constexpr int I_A = 16 * 176, I_B = 44 * 32, I_IN = 16 * 80, I_OUT = 16 * 32, I_UQ = 4 * 24, I_UKV = 2 * 24, I_C1 = 32 * 4, I_C2 = 2 * 2;
    constexpr int NITEMS = 2 * I_A + 2 * I_B + I_IN + I_OUT + I_UQ + I_UKV + 2 * I_C1 + 2 * I_C2;
    for (int it = gw; it < NITEMS; it += ngw) {
        int r = it;
        if (r < I_A) { cvt_item<1>(A.in[7] + (size_t)l * D * F2, D, F2, F2, (bf16_t*)(wb + W_1A), nullptr, scr, r, lane); continue; } r -= I_A;
        if (r < I_A) { cvt_item<1>(A.in[9] + (size_t)l * D * F2, D, F2, F2, (bf16_t*)(wb + W_2A), nullptr, scr, r, lane); continue; } r -= I_A;
        if (r < I_B) { cvt_item<0>(A.in[8] + (size_t)l * F * D, F, D, D, (bf16_t*)(wb + W_1B), nullptr, scr, r, lane); continue; } r -= I_B;
        if (r < I_B) { cvt_item<0>(A.in[10] + (size_t)l * F * D, F, D, D, (bf16_t*)(wb + W_2B), nullptr, scr, r, lane); continue; } r -= I_B;
        if (r < I_IN) { cvt_item<0>(A.in[11] + (size_t)l * D * DIN, D, DIN, DINP, (bf16_t*)(wb + W_IN), nullptr, scr, r, lane); continue; } r -= I_IN;
        if (r < I_OUT) { cvt_item<0>(A.in[12] + (size_t)l * D * D, D, D, D, (bf16_t*)(wb + W_OUT), nullptr, scr, r, lane); continue; } r -= I_OUT;
        if (r < I_UQ) { cvt_item<0>(A.in[17] + (size_t)l * 256 * 576, 256, 576, 768, (bf16_t*)(wb + W_UQ), A.in[15] + l * 256, scr, r, lane); continue; } r -= I_UQ;
        if (r < I_UKV) { cvt_item<0>(A.in[18] + (size_t)l * 128 * 768, 128, 768, 768, (bf16_t*)(wb + W_UKV), A.in[16] + l * 128, scr, r, lane); continue; } r -= I_UKV;
        if (r < 2 * I_C1) { const int kv = r / I_C1; cvt_item<0>(A.in[20] + (size_t)(l * 2 + kv) * 2048 * 128, 2048, 128, 128, (bf16_t*)(wb + W_C1) + (size_t)kv * 128 * 2048, nullptr, scr, r % I_C1, lane); continue; } r -= 2 * I_C1;
        { const int kv = r / I_C2; cvt_item<0>(A.in[21] + (size_t)(l * 2 + kv) * 128 * 64, 128, 64, 64, (bf16_t*)(wb + W_C2) + (size_t)kv * 64 * 128, nullptr, scr, r % I_C2, lane); }
    }
}
__device__ __forceinline__ void mods_task(const Args& A, int task, LAS unsigned char* lds) {
    const int tid = opq(get_tid()), lane = tid & 63, wid = __builtin_amdgcn_readfirstlane(tid >> 6);
    const int l = task / 144, chunk = task % 144;
    LAS float* cond = (LAS float*)lds;
    LAS float* red = (LAS float*)(lds + 16384);
    __syncthreads();
    for (int i = tid; i < 4096; i += NTHR) { const float c = A.in[1][i]; cond[i] = c / (1.0f + expf(-c)); }
    __syncthreads();
    const float* W = A.in[2] + (size_t)l * D * 9216 + chunk * 64 + lane;
    float acc[4] = {0.f, 0.f, 0.f, 0.f};
#pragma unroll 16
    for (int kk = 0; kk < 128; ++kk) {
        const int k = wid * 128 + kk;
        const float w = W[(size_t)k * 9216];
#pragma unroll
        for (int b = 0; b < 4; ++b) acc[b] += cond[b * 1024 + k] * w;
    }
#pragma unroll
    for (int b = 0; b < 4; ++b) red[(wid * 4 + b) * 64 + lane] = acc[b];
    __syncthreads();
    if (tid < 256) {
        const int b = tid >> 6, col = tid & 63; float s = 0.f;
#pragma unroll
        for (int w = 0; w < 8; ++w) s += red[(w * 4 + b) * 64 + col];
        s += A.in[3][(size_t)l * 9216 + chunk * 64 + col];
        ((float*)(A.ws + WS_MODS))[(size_t)(l * 4 + b) * 9216 + chunk * 64 + col] = s;
    }
    __syncthreads();
}
__device__ __forceinline__ void posb_task(const Args& A, int task, LAS unsigned char* lds) {
    const int tid = opq(get_tid());
    const int lkv = task >> 4, kp = task & 15, hid = tid & 127, sub = tid >> 7;
    const float* pos = A.in[19] + (size_t)lkv * 2048 + kp * 128 + sub * 32; const float* w1 = A.in[20] + ((size_t)lkv * 2048 + kp * 128 + sub * 32) * 128 + hid;
    float s = 0.f;
#pragma unroll
    for (int k = 0; k < 32; ++k) s += pos[k] * w1[(size_t)k * 128];
    LAS float* red = (LAS float*)lds;
    __syncthreads();
    red[tid] = s;
    __syncthreads();
    if (tid < 128) ((float*)(A.ws + WS_POSB + 4096))[task * 128 + tid] = red[tid] + red[tid + 128] + red[tid + 256] + red[tid + 384];
    __syncthreads();
}
__device__ __forceinline__ void posb_final(const Args& A) {
    const int o = opq(get_tid());
    const float* part = (const float*)(A.ws + WS_POSB + 4096) + (size_t)(o >> 7) * 16 * 128 + (o & 127);
    float s = 0.f;
#pragma unroll
    for (int p = 0; p < 16; ++p) s += part[p * 128];
    ((float*)(A.ws + WS_POSB))[o] = s;
}
__device__ __forceinline__ void rope_entries(const Args& A) {
    const int gtid = blockIdx.x * NTHR + opq(get_tid()), gn = gridDim.x * NTHR;
    float* tab = (float*)(A.ws + WS_ROPE);
    for (int e = gtid; e < T * 16; e += gn) {
        const int t = e >> 4, i = e & 15;
        double inv = 1.0; for (int j = 0; j < i; ++j) inv *= 0.5623413251903491;
        const float ang = (float)t * (float)inv;
        const double rev = (double)ang * 0.15915494309189535; const double fr = rev - __builtin_rint(rev);
        tab[e] = __builtin_amdgcn_cosf((float)fr); tab[T * 16 + e] = __builtin_amdgcn_sinf((float)fr);
    }
}
__device__ __forceinline__ void norm_rows(const float* X, bf16_t* out, const float* g, const float* modl, int ish, int isc) {
    const int tid = opq(get_tid()), lane = tid & 63, wid = __builtin_amdgcn_readfirstlane(tid >> 6), gw = blockIdx.x * NWAVE + wid, ngw = gridDim.x * NWAVE;
    for (int row = gw; row < M; row += ngw) {
        const int b = row >> 12;
        const f32x4* xr = (const f32x4*)(X + (size_t)row * D) + lane;
        f32x4 v[4]; float ss = 0.f;
#pragma unroll
        for (int j = 0; j < 4; ++j) { v[j] = xr[64 * j]; ss += (v[j].x * v[j].x + v[j].y * v[j].y) + (v[j].z * v[j].z + v[j].w * v[j].w); }
        const float rstd = rsqrtf(wave_sum(ss) * (1.0f / D) + RMS_EPS);
#pragma unroll
        for (int j = 0; j < 4; ++j) {
            const int col = 4 * lane + 256 * j;
            const f32x4 g4 = *(const f32x4*)(g + col), sc = *(const f32x4*)(modl + (size_t)b * 9216 + isc * 1024 + col), sh = *(const f32x4*)(modl + (size_t)b * 9216 + ish * 1024 + col);
            const f32x4 y = (v[j] * rstd) * g4 * (sc + 1.0f) + sh;
            u32x2 w; w.x = cvtpk(y.x, y.y); w.y = cvtpk(y.z, y.w);
            *(u32x2*)(out + (size_t)row * D + col) = w;
        }
    }
}
__device__ __forceinline__ void final_norm_rows(float* X, const float* g) {
    const int tid = opq(get_tid()), lane = tid & 63, wid = __builtin_amdgcn_readfirstlane(tid >> 6), gw = blockIdx.x * NWAVE + wid, ngw = gridDim.x * NWAVE;
    for (int row = gw; row < M; row += ngw) {
        f32x4* xr = (f32x4*)(X + (size_t)row * D) + lane;
        f32x4 v[4]; float ss = 0.f;
#pragma unroll
        for (int j = 0; j < 4; ++j) { v[j] = xr[64 * j]; ss += (v[j].x * v[j].x + v[j].y * v[j].y) + (v[j].z * v[j].z + v[j].w * v[j].w); }
        const float rstd = rsqrtf(wave_sum(ss) * (1.0f / D) + RMS_EPS);
#pragma unroll
        for (int j = 0; j < 4; ++j) { const f32x4 g4 = *(const f32x4*)(g + 4 * lane + 256 * j); xr[64 * j] = (v[j] * rstd) * g4; }
    }
}

__device__ __forceinline__ void norm_block(const float* X, bf16_t* out, const float* g, const float* modl, int ish, int isc, int row0) {
    const int tid = opq(get_tid()), lane = tid & 63, wid = __builtin_amdgcn_readfirstlane(tid >> 6);
    const int b = row0 >> 12;
#pragma unroll 1
    for (int rr = 0; rr < 8; ++rr) {
        const int row = row0 + rr * 8 + wid;
        const f32x4* xr = (const f32x4*)(X + (size_t)row * D) + lane;
        f32x4 v[4]; float ss = 0.f;
#pragma unroll
        for (int j = 0; j < 4; ++j) { v[j] = xr[64 * j]; ss += (v[j].x * v[j].x + v[j].y * v[j].y) + (v[j].z * v[j].z + v[j].w * v[j].w); }
        const float rstd = rsqrtf(wave_sum(ss) * (1.0f / D) + RMS_EPS);
#pragma unroll
        for (int j = 0; j < 4; ++j) {
            const int col = 4 * lane + 256 * j;
            const f32x4 g4 = *(const f32x4*)(g + col), sc = *(const f32x4*)(modl + (size_t)b * 9216 + isc * 1024 + col), sh = *(const f32x4*)(modl + (size_t)b * 9216 + ish * 1024 + col);
            const f32x4 y = (v[j] * rstd) * g4 * (sc + 1.0f) + sh;
            u32x2 w; w.x = cvtpk(y.x, y.y); w.y = cvtpk(y.z, y.w);
            *(u32x2*)(out + (size_t)row * D + col) = w;
        }
    }
}
__device__ __forceinline__ void final_norm_block(float* X, const float* g, int row0) {
    const int tid = opq(get_tid()), lane = tid & 63, wid = __builtin_amdgcn_readfirstlane(tid >> 6);
#pragma unroll 1
    for (int rr = 0; rr < 8; ++rr) {
        const int row = row0 + rr * 8 + wid;
        f32x4* xr = (f32x4*)(X + (size_t)row * D) + lane;
        f32x4 v[4]; float ss = 0.f;
#pragma unroll
        for (int j = 0; j < 4; ++j) { v[j] = xr[64 * j]; ss += (v[j].x * v[j].x + v[j].y * v[j].y) + (v[j].z * v[j].z + v[j].w * v[j].w); }
        const float rstd = rsqrtf(wave_sum(ss) * (1.0f / D) + RMS_EPS);
#pragma unroll
        for (int j = 0; j < 4; ++j) { const f32x4 g4 = *(const f32x4*)(g + 4 * lane + 256 * j); xr[64 * j] = (v[j] * rstd) * g4; }
    }
}
struct CountedOrder : pg8::StaticOrder {
    unsigned* cnt;
    __device__ __forceinline__ void done(const pg8::Unit& u) const {
        __builtin_amdgcn_fence(__ATOMIC_RELEASE, "agent");
        if ((get_tid() & 63) == 0) __hip_atomic_fetch_add(cnt + u.pm, 1u, __ATOMIC_RELAXED, __HIP_MEMORY_SCOPE_AGENT);
    }
};
__device__ __forceinline__ void panel_wait(unsigned* cnt, int pm) {
    if (get_tid() == 0) {
        unsigned sp = 0;
        while (__hip_atomic_load(cnt + pm, __ATOMIC_RELAXED, __HIP_MEMORY_SCOPE_AGENT) < 32u) { __builtin_amdgcn_s_sleep(2); if (++sp > (1u << 22)) break; }
    }
    __syncthreads();
    __builtin_amdgcn_fence(__ATOMIC_ACQUIRE, "agent");
}

__device__ __forceinline__ void kpe_unit(const Args& A, int unit) {
    const int tid = opq(get_tid());
    unsigned char* w_ = ws_opq(A.ws);
    const bf16_t* P = (const bf16_t*)(w_ + WS_U); bf16_t* KPE = (bf16_t*)(w_ + WS_KPE); const float* rope = (const float*)(w_ + WS_ROPE);
#pragma unroll 2
    for (int k = 0; k < 8; ++k) {
        const int e = unit * 4096 + k * 512 + tid;
        const int row = e >> 4, i = e & 15, t = row & (T - 1);
        const float x0 = bf2f((short)P[(size_t)row * DINP + C_BKR + i]), x1 = bf2f((short)P[(size_t)row * DINP + C_BKR + 16 + i]);
        const float c = rope[t * 16 + i], sn = rope[T * 16 + t * 16 + i];
        KPE[(size_t)row * 32 + i] = (bf16_t)(cvtpk(x0 * c - x1 * sn, 0.f) & 0xffffu);
        KPE[(size_t)row * 32 + 16 + i] = (bf16_t)(cvtpk(x1 * c + x0 * sn, 0.f) & 0xffffu);
    }
}

constexpr int CTL_KN = 128;
__device__ __forceinline__ void kn_rows(const Args& A, int l) {
    const int tid = opq(get_tid()), lane = tid & 63, wid = __builtin_amdgcn_readfirstlane(tid >> 6), gw = blockIdx.x * NWAVE + wid, ngw = gridDim.x * NWAVE;
    unsigned char* w_ = ws_opq(A.ws);
    const bf16_t* P = (const bf16_t*)(w_ + WS_U); unsigned* kn = (unsigned*)(w_ + WS_CTL) + CTL_KN + l * 48;
    const int col2 = lane < 32 ? C_KS + 4 * lane : C_KW + 4 * (lane - 32);
    for (int it = gw; it < M / 16; it += ngw) {
        float m1 = 0.f, m2 = 0.f;
#pragma unroll 4
        for (int rr = 0; rr < 16; ++rr) {
            const bf16_t* rp = P + (size_t)(it * 16 + rr) * DINP;
            const s16x4 v1 = *(const s16x4*)(rp + C_AK + 4 * lane), v2 = *(const s16x4*)(rp + col2);
            float s1 = 0.f, s2 = 0.f;
#pragma unroll
            for (int j = 0; j < 4; ++j) { const float x = bf2f(v1[j]), y = bf2f(v2[j]); s1 += x * x; s2 += y * y; }
            s1 += __shfl_xor(s1, 1); s1 += __shfl_xor(s1, 2); s1 += __shfl_xor(s1, 4);
            s2 += __shfl_xor(s2, 1); s2 += __shfl_xor(s2, 2); s2 += __shfl_xor(s2, 4); s2 += __shfl_xor(s2, 8);
            m1 = fmaxf(m1, s1); m2 = fmaxf(m2, s2);
        }
        const int b = (it * 16) >> 12;
        if ((lane & 7) == 0) atomicMax(kn + b * 12 + (lane >> 3), __float_as_uint(m1));
        if ((lane & 15) == 0) atomicMax(kn + b * 12 + (lane < 32 ? 10 + (lane >> 4) : 8 + ((lane - 32) >> 4)), __float_as_uint(m2));
    }
}
#define XB_TMO      128
#define XB_XCNT(j)  (256  + 64 * (j))
#define XB_XSUB(j)  (1280 + 64 * (j))
#define XB_XGEN(j)  (2304 + 64 * (j))
#define XB_TOP      3328
#define XB_TOPGEN   3392
#define XCD_BAR_WORDS 3456
#define XB_SPIN_CAP (1u << 18)

__device__ __forceinline__ unsigned xb_ld(unsigned* p)              { return __hip_atomic_load(p, __ATOMIC_RELAXED, __HIP_MEMORY_SCOPE_AGENT); }
__device__ __forceinline__ unsigned xb_add(unsigned* p, unsigned v) { return __hip_atomic_fetch_add(p, v, __ATOMIC_RELAXED, __HIP_MEMORY_SCOPE_AGENT); }
__device__ __forceinline__ unsigned xb_xcc_id() { return (unsigned)__builtin_amdgcn_s_getreg((3 << 11) | 20) & 0xFu; }
#define XB_SPIN(cond, bar) do { unsigned _sp = 0; while (cond) { __builtin_amdgcn_s_sleep(1); \
    if ((++_sp & 255u) == 0u) { if (xb_ld(&(bar)[XB_TMO])) break; if (_sp > XB_SPIN_CAP) { atomicAdd(&(bar)[XB_TMO], 1u); break; } } } } while (0)

struct XcdBarrier {
    unsigned* bar; unsigned x;
    volatile LAS unsigned* st;
};

__device__ __forceinline__ XcdBarrier xcd_barrier_post(unsigned* bar, volatile LAS unsigned* st) {
    XcdBarrier b; b.bar = bar; b.x = xb_xcc_id(); b.st = st;
    if (get_tid() == 0) (void)xb_add(&bar[XB_XCNT(b.x)], 1u);
    return b;
}
__device__ __forceinline__ void xcd_barrier_complete(unsigned* bar, unsigned x, unsigned& nloc, unsigned& nx) {
    const unsigned G = gridDim.x * gridDim.y * gridDim.z;
    unsigned sum, cnt, mine, sp = 0u;
    for (;;) {
        sum = 0u; cnt = 0u; mine = 0u;
#pragma unroll
        for (unsigned j = 0; j < 16; ++j) { const unsigned c = xb_ld(&bar[XB_XCNT(j)]); sum += c; cnt += (c > 0u) ? 1u : 0u; mine = (j == x) ? c : mine; }
        if (sum == G) break;
        __builtin_amdgcn_s_sleep(1);
        if ((++sp & 255u) == 0u) { if (xb_ld(&bar[XB_TMO])) break; if (sp > XB_SPIN_CAP) { atomicAdd(&bar[XB_TMO], 1u); break; } }
    }
    nloc = mine > 0u ? mine : 1u; nx = cnt > 0u ? cnt : 1u;
}

__device__ __forceinline__ void xcd_barrier(const XcdBarrier& b) {
    asm volatile("s_waitcnt vmcnt(0)" ::: "memory");
    __syncthreads();
    if (get_tid() == 0) {
        unsigned* bar = b.bar;
        __builtin_amdgcn_s_waitcnt(0);
        unsigned nloc = b.st[0], nx = b.st[1];
        if (nloc == 0u) { xcd_barrier_complete(bar, b.x, nloc, nx); b.st[0] = nloc; b.st[1] = nx; }
        const unsigned old = xb_add(&bar[XB_XSUB(b.x)], 1u);
        const unsigned gen = old / nloc;
        if (old + 1u == (gen + 1u) * nloc) {
            __builtin_amdgcn_fence(__ATOMIC_RELEASE, "agent");
            asm volatile("s_waitcnt vmcnt(0)" ::: "memory");
            const unsigned og = xb_add(&bar[XB_TOP], 1u);
            const unsigned tg = og / nx;
            if (og + 1u == (tg + 1u) * nx) xb_add(&bar[XB_TOPGEN], 1u);
            else XB_SPIN(xb_ld(&bar[XB_TOPGEN]) == tg, bar);
            __builtin_amdgcn_fence(__ATOMIC_ACQUIRE, "agent");
            xb_add(&bar[XB_XGEN(b.x)], 1u);
            asm volatile("s_waitcnt vmcnt(0)" ::: "memory");
        } else {
            XB_SPIN(xb_ld(&bar[XB_XGEN(b.x)]) == gen, bar);
            __builtin_amdgcn_fence(__ATOMIC_ACQUIRE, "agent");
            asm volatile("s_waitcnt vmcnt(0)" ::: "memory");
        }
    }
    __syncthreads();
}

struct AttnArgs {
    const bf16_t* Q; int qpitch;
    const bf16_t* K1; int k1pitch;
    const bf16_t* K2; int k2pitch;
    const bf16_t* V; int vpitch;
    const float* rope;
    const unsigned long long* sel;
    float scale2, slope2; int window;
    float kmax;
};
constexpr int ATT_K_OFF = 0, ATT_V_OFF = 16384, ATT_BUF = 24576;

__device__ __forceinline__ s16x4 vtr(const LAS unsigned char* p) {
    typedef short v4i16_t __attribute__((ext_vector_type(4)));
    return __builtin_bit_cast(s16x4, __builtin_amdgcn_ds_read_tr16_b64_v4i16((LAS v4i16_t*)p));
}
template <bool ROWSUM> __device__ __forceinline__ void pv_tile_t(f32x16 (&o)[2], f32x16& osum, const f32x16& p0, const f32x16& p1, const LAS unsigned char* vl, int lane) {
    const int h = lane >> 5, i16 = lane & 15, q4 = i16 >> 2, p4 = i16 & 3, blk = (lane >> 4) & 1;
    const unsigned onew = ((lane & 31) == 0) ? 0x3f803f80u : 0u;
    const bf16x8 ones = __builtin_bit_cast(bf16x8, (u32x4){onew, onew, onew, onew});
    const LAS unsigned char* vb = vl + (4 * h + q4) * 64 + blk * 32 + p4 * 8;
#pragma unroll
    for (int s = 0; s < 4; ++s) {
        u32x4 pw;
        if (s == 0) { pw.x = cvtpk(p0[0], p0[1]); pw.y = cvtpk(p0[2], p0[3]); pw.z = cvtpk(p0[4], p0[5]); pw.w = cvtpk(p0[6], p0[7]); }
        else if (s == 1) { pw.x = cvtpk(p0[8], p0[9]); pw.y = cvtpk(p0[10], p0[11]); pw.z = cvtpk(p0[12], p0[13]); pw.w = cvtpk(p0[14], p0[15]); }
        else if (s == 2) { pw.x = cvtpk(p1[0], p1[1]); pw.y = cvtpk(p1[2], p1[3]); pw.z = cvtpk(p1[4], p1[5]); pw.w = cvtpk(p1[6], p1[7]); }
        else { pw.x = cvtpk(p1[8], p1[9]); pw.y = cvtpk(p1[10], p1[11]); pw.z = cvtpk(p1[12], p1[13]); pw.w = cvtpk(p1[14], p1[15]); }
        const bf16x8 pf = __builtin_bit_cast(bf16x8, pw);
#pragma unroll
        for (int db = 0; db < 2; ++db) {
            const s16x4 lo = vtr(vb + db * 4096 + (16 * s) * 64), hi = vtr(vb + db * 4096 + (16 * s + 8) * 64);
            const bf16x8 vf = __builtin_shufflevector(lo, hi, 0, 1, 2, 3, 4, 5, 6, 7);
            o[db] = MFMA32(vf, pf, o[db]);
        }
        if (ROWSUM) osum = MFMA32(ones, pf, osum);
    }
}
__device__ __forceinline__ void pv_tile(f32x16 (&o)[2], const f32x16& p0, const f32x16& p1, const LAS unsigned char* vl, int lane) {
    f32x16 dummy; pv_tile_t<false>(o, dummy, p0, p1, vl, lane);
}
template <int MODE> __device__ __forceinline__ void store_o(const f32x16 (&o)[2], bf16_t* out_row, int h, float sc) {
#pragma unroll
    for (int db = 0; db < 2; ++db)
#pragma unroll
        for (int g4 = 0; g4 < 4; ++g4) {
            bf16_t* p = out_row + 32 * db + 8 * g4 + 4 * h;
            float v0 = o[db][4 * g4] * sc, v1 = o[db][4 * g4 + 1] * sc, v2 = o[db][4 * g4 + 2] * sc, v3 = o[db][4 * g4 + 3] * sc;
            if (MODE == 1) { const u32x2 old = *(const u32x2*)p; v0 += __uint_as_float(old.x << 16); v1 += __uint_as_float(old.x & 0xffff0000u); v2 += __uint_as_float(old.y << 16); v3 += __uint_as_float(old.y & 0xffff0000u); }
            u32x2 w; w.x = cvtpk(v0, v1); w.y = cvtpk(v2, v3);
            *(u32x2*)p = w;
        }
}

constexpr int ATT_FLAG_OFF = 140480;
template <int DQK, bool ROPE, bool SEL, bool DUAL = false, bool EARLY = false>
__device__ __forceinline__ void attn_core(const AttnArgs& a, int q0, LAS unsigned char* lds, f32x16 (&o)[2]) {
    constexpr int KS = DQK / 16, DK = DUAL ? 2 * DQK : DQK, KP = DK * 2 + 16, D1 = DK < 64 ? DK : 64, NCH1 = D1 / 8, QROWS = DUAL ? 128 : 256;
    const int tid = opq(get_tid()), lane = tid & 63, wid = __builtin_amdgcn_readfirstlane(tid >> 6), r = lane & 31, h = lane >> 5;
    const int wq = DUAL ? (wid & 3) : wid, coff = DUAL ? (wid >> 2) * DQK : 0;
    const int qw0 = q0 + 32 * wq, qpos = qw0 + r;
    LAS unsigned char* Kl = lds + ATT_K_OFF; LAS unsigned char* Vl = lds + ATT_V_OFF;
    bf16x8 qf[KS];
    {
        const bf16_t* qrow = a.Q + (size_t)qpos * a.qpitch + coff;
#pragma unroll
        for (int ks = 0; ks < KS; ++ks) qf[ks] = *(const bf16x8*)(qrow + 16 * ks + 8 * h);
        if (ROPE) {
            const float* cs = a.rope + (size_t)qpos * 16 + 8 * h; const float* sn = cs + T * 16;
            float y0[8], y1[8];
#pragma unroll
            for (int j = 0; j < 8; ++j) { const float x0 = bf2f(qf[KS - 2][j]), x1 = bf2f(qf[KS - 1][j]), c = cs[j], s = sn[j]; y0[j] = x0 * c - x1 * s; y1[j] = x1 * c + x0 * s; }
            u32x4 w0, w1;
            w0.x = cvtpk(y0[0], y0[1]); w0.y = cvtpk(y0[2], y0[3]); w0.z = cvtpk(y0[4], y0[5]); w0.w = cvtpk(y0[6], y0[7]);
            w1.x = cvtpk(y1[0], y1[1]); w1.y = cvtpk(y1[2], y1[3]); w1.z = cvtpk(y1[4], y1[5]); w1.w = cvtpk(y1[6], y1[7]);
            qf[KS - 2] = __builtin_bit_cast(bf16x8, w0); qf[KS - 1] = __builtin_bit_cast(bf16x8, w1);
        }
    }
    float qk_bound = 0.f;
    if (EARLY) {
        float qq = 0.f;
#pragma unroll
        for (int ks = 0; ks < KS; ++ks)
#pragma unroll
            for (int j = 0; j < 8; ++j) { const float x = bf2f(qf[ks][j]); qq += x * x; }
        qq += __shfl_xor(qq, 32);
        qk_bound = sqrtf(qq) * a.kmax * a.scale2 * 1.001f + 0.01f;
    }
    unsigned long long selm = ~0ull;
    if (SEL) selm = a.sel[qpos];
    const int t_hi = (q0 + QROWS - 1) >> 6;
    int t_lo = 0;
    if (a.window) { const int lo = q0 - a.window + 1; t_lo = lo > 0 ? (lo >> 6) : 0; }
    const bool kA_on = tid < 64 * NCH1; const int rowA = tid / NCH1, chA = tid % NCH1;
    const bool kB_on = ROPE && tid < 128; const int rowB = tid >> 1, prB = tid & 1;
    const int rowV = tid >> 3, chV = tid & 7;
    u32x4 kA = {0, 0, 0, 0}, kB0 = {0, 0, 0, 0}, kB1 = {0, 0, 0, 0}, vR = {0, 0, 0, 0};
#define ATT_PREFETCH(t) do { \
        if (kA_on) kA = *(const u32x4*)(a.K1 + (size_t)(64 * (t) + rowA) * a.k1pitch + chA * 8); \
        if (kB_on) { const bf16_t* kp = a.K2 + (size_t)(64 * (t) + rowB) * a.k2pitch + prB * 8; kB0 = *(const u32x4*)kp; kB1 = *(const u32x4*)(kp + 16); } \
        vR = *(const u32x4*)(a.V + (size_t)(64 * (t) + rowV) * a.vpitch + chV * 8); } while (0)
#define ATT_STORE(tt, KL, VL) do { \
        if (kA_on) *(LAS u32x4*)((KL) + rowA * KP + chA * 16) = kA; \
        if (ROPE) { if (kB_on) { \
                *(LAS u32x4*)((KL) + rowB * KP + (64 + prB * 8) * 2) = kB0; \
                *(LAS u32x4*)((KL) + rowB * KP + (80 + prB * 8) * 2) = kB1; } } \
        *(LAS u32x4*)((VL) + (chV >> 2) * 4096 + rowV * 64 + (chV & 3) * 16) = vR; } while (0)
    float m = NEGBIG;
    f32x16 osum;
#pragma unroll
    for (int i = 0; i < 16; ++i) { o[0][i] = 0.f; o[1][i] = 0.f; osum[i] = 0.f; }
    float cbv[16];
#pragma unroll
    for (int i = 0; i < 16; ++i) cbv[i] = a.slope2 * (float)((i & 3) + 8 * (i >> 2) + 4 * h);
    volatile LAS unsigned* eflag = (volatile LAS unsigned*)(lds + ATT_FLAG_OFF);
    unsigned long long um = (t_hi >= 63 ? ~0ull : ((1ull << (t_hi + 1)) - 1ull)) & ~((1ull << t_lo) - 1ull);
    if (SEL) {
        LAS unsigned* uw = (LAS unsigned*)(lds + ATT_FLAG_OFF + 64);
        __syncthreads();
        if (tid < 2) uw[tid] = 0u;
        __syncthreads();
        __hip_atomic_fetch_or(uw, (unsigned)selm, __ATOMIC_RELAXED, __HIP_MEMORY_SCOPE_WORKGROUP);
        __hip_atomic_fetch_or(uw + 1, (unsigned)(selm >> 32), __ATOMIC_RELAXED, __HIP_MEMORY_SCOPE_WORKGROUP);
        __syncthreads();
        const unsigned lo_ = (unsigned)__builtin_amdgcn_readfirstlane((int)uw[0]), hi_ = (unsigned)__builtin_amdgcn_readfirstlane((int)uw[1]);
        um &= ((unsigned long long)hi_ << 32) | (unsigned long long)lo_;
    }
#define ATT_NEXT(tt) ((((tt) > 0) && (um & ((1ull << (tt)) - 1ull))) ? 63 - __builtin_clzll(um & ((1ull << (tt)) - 1ull)) : -1)
    int t = 63 - __builtin_clzll(um);
    int t1 = ATT_NEXT(t);
    ATT_PREFETCH(t);
    if (EARLY) { if (lane == 0) { eflag[wid] = 0u; eflag[8 + wid] = 0u; } }
    __syncthreads();
    ATT_STORE(t, Kl, Vl);
    __syncthreads();
    if (t1 >= 0) ATT_PREFETCH(t1);
    for (int step = 0; t >= 0; ++step) {
        const int cur = step & 1;
        const int t2 = (t1 >= 0) ? ATT_NEXT(t1) : -1;
        const LAS unsigned char* Kc = Kl + cur * ATT_BUF; const LAS unsigned char* Vc = Vl + cur * ATT_BUF;
        bool need = (64 * t <= qw0 + 31);
        if (a.window) need = need && (64 * t + 63 >= qw0 - a.window + 1);
        const bool selbit = SEL ? (((selm >> t) & 1ull) != 0ull) : true;
        if (SEL) need = need && (__ballot(selbit) != 0ull);
        if (need) {
            f32x16 p0, p1;
#pragma unroll
            for (int i = 0; i < 16; ++i) { p0[i] = 0.f; p1[i] = 0.f; }
#pragma unroll
            for (int ks = 0; ks < KS; ++ks) {
                const bf16x8 a0 = *(const LAS bf16x8*)(Kc + r * KP + coff * 2 + ks * 32 + h * 16);
                const bf16x8 a1 = *(const LAS bf16x8*)(Kc + (32 + r) * KP + coff * 2 + ks * 32 + h * 16);
                p0 = MFMA32(a0, qf[ks], p0); p1 = MFMA32(a1, qf[ks], p1);
            }
            if (!ROPE) {
#pragma unroll
                for (int i = 0; i < 16; ++i) { p0[i] = p0[i] * a.scale2 + cbv[i]; p1[i] = p1[i] * a.scale2 + cbv[i]; }
            }
            const float base0 = a.slope2 * (float)(64 * t - qpos), base1 = base0 + 32.0f * a.slope2;
            bool bnd = (64 * t + 63 > qw0);
            if (a.window) bnd = bnd || (64 * t < qw0 + 31 - a.window + 1);
            if (SEL) bnd = bnd || (__ballot(!selbit) != 0ull);
            if (bnd) {
                const int wlim = a.window ? a.window : (1 << 30);
#pragma unroll
                for (int i = 0; i < 16; ++i) {
                    const int kv0 = 64 * t + crow(i, h), d0 = qpos - kv0, d1 = d0 - 32;
                    const bool ok0 = selbit && d0 >= 0 && d0 < wlim, ok1 = selbit && d1 >= 0 && d1 < wlim;
                    p0[i] = ok0 ? p0[i] : NEGBIG; p1[i] = ok1 ? p1[i] : NEGBIG;
                }
            }
            float mx0 = p0[0], mx1 = p1[0];
#pragma unroll
            for (int i = 1; i < 16; ++i) { mx0 = fmaxf(mx0, p0[i]); mx1 = fmaxf(mx1, p1[i]); }
            float mloc = ROPE ? fmaxf(mx0, mx1) * a.scale2 : fmaxf(mx0 + base0, mx1 + base1);
            mloc = fmaxf(mloc, __shfl_xor(mloc, 32));
            const float mnew = fmaxf(m, mloc);
            if (__ballot(mnew > m) != 0ull) {
                const float alpha = fast_exp2(m - mnew);
                osum[0] *= alpha;
#pragma unroll
                for (int i = 0; i < 16; ++i) { o[0][i] *= alpha; o[1][i] *= alpha; }
            }
            m = mnew;
            const float r0 = mnew - base0, r1 = mnew - base1;
            if (ROPE) {
#pragma unroll
                for (int i = 0; i < 16; ++i) { p0[i] = fast_exp2(p0[i] * a.scale2 - mnew); p1[i] = fast_exp2(p1[i] * a.scale2 - mnew); }
            } else {
#pragma unroll
                for (int i = 0; i < 16; ++i) { p0[i] = fast_exp2(p0[i] - r0); p1[i] = fast_exp2(p1[i] - r1); }
            }
            pv_tile_t<true>(o, osum, p0, p1, Vc, lane);
        }
        if (EARLY) {
            const bool live = !(qk_bound - a.slope2 * (float)(qpos - 64 * t + 1) - m < -64.0f);
            const bool wdone = (__ballot(live) == 0ull);
            if (lane == 0) eflag[8 * cur + wid] = wdone ? 1u : 0u;
        }
        if (t1 >= 0) ATT_STORE(t1, Kl + (cur ^ 1) * ATT_BUF, Vl + (cur ^ 1) * ATT_BUF);
        __syncthreads();
        if (EARLY) {
            const unsigned alld = eflag[8 * cur] & eflag[8 * cur + 1] & eflag[8 * cur + 2] & eflag[8 * cur + 3] & eflag[8 * cur + 4] & eflag[8 * cur + 5] & eflag[8 * cur + 6] & eflag[8 * cur + 7];
            if (__builtin_amdgcn_readfirstlane((int)alld) != 0) break;
        }
        if (t2 >= 0) ATT_PREFETCH(t2);
        t = t1; t1 = t2;
    }
#undef ATT_NEXT
#undef ATT_STORE
#undef ATT_PREFETCH
    const float lt = __shfl(osum[0], lane & 31);
    const float inv = 1.0f / lt;
#pragma unroll
    for (int i = 0; i < 16; ++i) { o[0][i] *= inv; o[1][i] *= inv; }
}

__device__ __forceinline__ float da_slope(int hd) { return hd == 0 ? 0.25f : hd == 1 ? 0.0625f : hd == 2 ? 0.015625f : 0.00390625f; }
__device__ __forceinline__ float nsa_slope(int hh) { return hh == 0 ? 0.25f : hh == 1 ? 0.0625f : hh == 2 ? 0.015625f : hh == 3 ? 0.00390625f : hh == 4 ? 0.5f : 0.125f; }

constexpr int DA_X_OFF = 49152;
__device__ __forceinline__ void da_unit(const Args& A, int l, int b, int hd, int qb, LAS unsigned char* lds) {
    const int tid_ = opq(get_tid()), lane = tid_ & 63, wid = __builtin_amdgcn_readfirstlane(tid_ >> 6), r = lane & 31, h = lane >> 5;
    const bf16_t* P = (const bf16_t*)(A.ws + WS_U) + (size_t)b * T * DINP;
    const float lam = ((const float*)(A.ws + WS_CTL))[64 + l];
    const float one_m_li = ((const float*)(A.ws + WS_CTL))[66 + l];
    f32x16 o[2];
    AttnArgs a; a.Q = P + C_AQ + hd * 64; a.qpitch = DINP; a.K1 = P + C_AK + hd * 64; a.k1pitch = DINP; a.K2 = nullptr; a.k2pitch = 0;
    a.V = P + C_AV + hd * 64; a.vpitch = DINP; a.rope = nullptr; a.sel = nullptr; a.scale2 = 0.17677669529663687f * LOG2E; a.slope2 = da_slope(hd) * LOG2E; a.window = 0;
    { const unsigned* kn = (const unsigned*)(A.ws + WS_CTL) + CTL_KN + l * 48 + b * 12 + 2 * hd; a.kmax = sqrtf(fmaxf(__uint_as_float(kn[0]), __uint_as_float(kn[1]))); }
    attn_core<32, false, false, true, true>(a, qb * 128, lds, o);
    LAS float* xb = (LAS float*)(lds + DA_X_OFF) + (32 * (wid & 3) + r) * 65;
    if (wid >= 4) {
#pragma unroll
        for (int db = 0; db < 2; ++db)
#pragma unroll
            for (int i = 0; i < 16; ++i) xb[32 * db + crow(i, h)] = o[db][i];
    }
    __syncthreads();
    if (wid < 4) {
        float ss = 0.f;
#pragma unroll
        for (int db = 0; db < 2; ++db)
#pragma unroll
            for (int i = 0; i < 16; ++i) { o[db][i] = o[db][i] - lam * xb[32 * db + crow(i, h)]; ss += o[db][i] * o[db][i]; }
        ss += __shfl_xor(ss, 32);
        const float rs = rsqrtf(ss * (1.0f / 64.0f) + RMS_EPS) * one_m_li;
        const float* sg = A.in[14] + l * 64;
#pragma unroll
        for (int db = 0; db < 2; ++db)
#pragma unroll
            for (int i = 0; i < 16; ++i) o[db][i] *= rs * sg[32 * db + crow(i, h)];
        bf16_t* orow = (bf16_t*)(A.ws + WS_XN) + (size_t)(b * T + qb * 128 + 32 * wid + r) * D + hd * 64;
        store_o<0>(o, orow, h, EN_DA ? 1.0f : 0.0f);
    }
}
__device__ __forceinline__ void mla_unit(const Args& A, int b, int hd, int qb, LAS unsigned char* lds) {
    const int tid_ = opq(get_tid()), lane = tid_ & 63, wid = __builtin_amdgcn_readfirstlane(tid_ >> 6), r = lane & 31, h = lane >> 5;
    AttnArgs a; a.Q = (const bf16_t*)(A.ws + WS_MQ) + (size_t)b * T * 768 + hd * 96; a.qpitch = 768;
    a.K1 = (const bf16_t*)(A.ws + WS_MKV) + (size_t)b * T * 768 + hd * 128; a.k1pitch = 768;
    a.K2 = (const bf16_t*)(A.ws + WS_KPE) + (size_t)b * T * 32; a.k2pitch = 32;
    a.V = a.K1 + 64; a.vpitch = 768; a.rope = (const float*)(A.ws + WS_ROPE); a.sel = nullptr; a.scale2 = 0.10206207261596575f * LOG2E; a.slope2 = 0.f; a.window = 0; a.kmax = 0.f;
    f32x16 o[2];
    attn_core<96, true, false>(a, qb * 256, lds, o);
    bf16_t* orow = (bf16_t*)(A.ws + WS_XN) + (size_t)(b * T + qb * 256 + 32 * wid + r) * D + 256 + hd * 64;
    store_o<0>(o, orow, h, EN_MLA ? 1.0f : 0.0f);
}
template <int BR> __device__ __forceinline__ void nsa_unit(const Args& A, int l, int b, int hh, int qb, LAS unsigned char* lds) {
    const int tid_ = opq(get_tid()), lane = tid_ & 63, wid = __builtin_amdgcn_readfirstlane(tid_ >> 6), r = lane & 31, h = lane >> 5, g = hh / 3;
    const bf16_t* P = (const bf16_t*)(A.ws + WS_U) + (size_t)b * T * DINP;
    AttnArgs a; a.Q = P + C_CQ + hh * 64; a.qpitch = DINP; a.K1 = P + (BR == 2 ? C_KW : C_KS) + g * 64; a.k1pitch = DINP; a.K2 = nullptr; a.k2pitch = 0;
    a.V = P + (BR == 2 ? C_VW : C_VS) + g * 64; a.vpitch = DINP; a.rope = nullptr; a.sel = (const unsigned long long*)(A.ws + WS_SEL) + (size_t)(b * 2 + g) * T;
    a.scale2 = 0.125f * LOG2E; a.slope2 = nsa_slope(hh) * LOG2E; a.window = (BR == 2) ? 512 : 0;
    f32x16 o[2];
    a.kmax = sqrtf(__uint_as_float(((const unsigned*)(A.ws + WS_CTL))[CTL_KN + l * 48 + b * 12 + (BR == 2 ? 8 : 10) + g]));
    attn_core<64, false, BR == 1, false, true>(a, qb * 256, lds, o);
    const int qpos = qb * 256 + 32 * wid + r;
    const float gl = bf2f((short)P[(size_t)qpos * DINP + C_G + BR * 6 + hh]);
    bf16_t* orow = (bf16_t*)(A.ws + WS_XN) + (size_t)(b * T + qpos) * D + 640 + hh * 64;
    if (BR == 2) store_o<0>(o, orow, h, EN_WIN ? sigmoid_f(gl) : 0.0f);
    else store_o<1>(o, orow, h, EN_SLC ? sigmoid_f(gl) : 0.0f);
}

__device__ __forceinline__ void cmp_mlp_task(const Args& A, int l, int wt, LAS unsigned char* lds) {
    const int tid_ = opq(get_tid()), lane = tid_ & 63, wid = __builtin_amdgcn_readfirstlane(tid_ >> 6);
    const int kv = wt >> 7, bg = (wt >> 4) & 7, rg = wt & 15, b = bg >> 1, g = bg & 1, i16 = lane & 15, quad = lane >> 4;
    const bf16_t* P = (const bf16_t*)(A.ws + WS_U) + (size_t)b * T * DINP + (kv ? C_VC : C_KC) + g * 64;
    const bf16_t* W1 = (const bf16_t*)(A.ws + WS_W + W_C1) + (size_t)kv * 128 * 2048;
    const bf16_t* W2 = (const bf16_t*)(A.ws + WS_W + W_C2) + (size_t)kv * 64 * 128;
    const float* posb = (const float*)(A.ws + WS_POSB) + (l * 2 + kv) * 128;
    const int n = 16 * rg + i16;
    const bf16_t* arow = P + (size_t)(16 * n) * DINP + 8 * quad;
    const bf16_t* wrow1 = W1 + (size_t)i16 * 2048 + 8 * quad;
    f32x4 acc[8];
#pragma unroll
    for (int i = 0; i < 8; ++i) acc[i] = (f32x4){0.f, 0.f, 0.f, 0.f};
#pragma unroll 2
    for (int kk = 0; kk < 8; ++kk) {
        const int ks = 8 * wid + kk;
        const bf16x8 bfrag = *(const bf16x8*)(arow + (size_t)(ks >> 1) * DINP + 32 * (ks & 1));
#pragma unroll
        for (int ht = 0; ht < 8; ++ht) {
            const bf16x8 afrag = *(const bf16x8*)(wrow1 + (size_t)(16 * ht) * 2048 + 32 * ks);
            acc[ht] = MFMA16(afrag, bfrag, acc[ht]);
        }
    }
    {
        LAS float* red = (LAS float*)lds;
        if (wid > 0) {
#pragma unroll
            for (int ht = 0; ht < 8; ++ht)
#pragma unroll
                for (int j = 0; j < 4; ++j) red[(wid * 64 + lane) * 33 + ht * 4 + j] = acc[ht][j];
        }
        __syncthreads();
        if (wid > 0) return;
#pragma unroll 1
        for (int w = 1; w < 8; ++w)
#pragma unroll
            for (int ht = 0; ht < 8; ++ht)
#pragma unroll
                for (int j = 0; j < 4; ++j) acc[ht][j] += red[(w * 64 + lane) * 33 + ht * 4 + j];
    }
    bf16x8 hf[4];
#pragma unroll
    for (int ks2 = 0; ks2 < 4; ++ks2) {
        float v[8];
#pragma unroll
        for (int e = 0; e < 8; ++e) {
            const int ht = 2 * ks2 + (e >> 2), j = e & 3;
            const float x = acc[ht][j] + posb[16 * ht + 4 * quad + j];
            const float u2 = 0.7978845608028654f * (x + 0.044715f * x * x * x);
            const float ex = fast_exp2(2.0f * LOG2E * u2);
            const float th = 1.0f - 2.0f * fast_rcp(ex + 1.0f);
            v[e] = 0.5f * x * (1.0f + th);
        }
        u32x4 w; w.x = cvtpk(v[0], v[1]); w.y = cvtpk(v[2], v[3]); w.z = cvtpk(v[4], v[5]); w.w = cvtpk(v[6], v[7]);
        hf[ks2] = __builtin_bit_cast(bf16x8, w);
    }
    bf16_t* outp = (bf16_t*)(A.ws + WS_KCMP) + ((size_t)(kv * 8 + bg) * 256 + n) * 64;
#pragma unroll
    for (int ot = 0; ot < 4; ++ot) {
        f32x4 c2 = (f32x4){0.f, 0.f, 0.f, 0.f};
        const bf16_t* w2r = W2 + (size_t)(16 * ot + i16) * 128 + 4 * quad;
#pragma unroll
        for (int ks2 = 0; ks2 < 4; ++ks2) {
            const u32x2 lo = *(const u32x2*)(w2r + 32 * ks2), hi = *(const u32x2*)(w2r + 32 * ks2 + 16);
            u32x4 w; w.x = lo.x; w.y = lo.y; w.z = hi.x; w.w = hi.y;
            c2 = MFMA16(__builtin_bit_cast(bf16x8, w), hf[ks2], c2);
        }
        if (n < 255) { u32x2 w; w.x = cvtpk(c2[0], c2[1]); w.y = cvtpk(c2[2], c2[3]); *(u32x2*)(outp + 16 * ot + 4 * quad) = w; }
    }
}

constexpr int CMP_K_OFF = 0, CMP_V_OFF = 36864, CMP_IMP_OFF = 69632;
__device__ __forceinline__ void cmp_unit(const Args& A, int b, int g, int qb, LAS unsigned char* lds, float gmul = 1.0f) {
    const int tid = opq(get_tid()), lane = tid & 63, wid = __builtin_amdgcn_readfirstlane(tid >> 6), r = lane & 31, h = lane >> 5;
    const int q0 = qb * 256, qw0 = q0 + 32 * wid, qpos = qw0 + r, qloc = 32 * wid + r;
    const int ntile = (((q0 + 224) >> 4) >> 6) + 1;
    LAS unsigned char* Kl = lds + CMP_K_OFF; LAS unsigned char* Vl = lds + CMP_V_OFF; LAS float* imp = (LAS float*)(lds + CMP_IMP_OFF);
    const bf16_t* KC = (const bf16_t*)(A.ws + WS_KCMP) + (size_t)(b * 2 + g) * 256 * 64;
    const bf16_t* VC = KC + (size_t)8 * 256 * 64;
    __syncthreads();
    for (int idx = tid; idx < 512 * ntile; idx += NTHR) {
        const int n = idx >> 3, ch = idx & 7;
        u32x4 kx = {0, 0, 0, 0}, vx = {0, 0, 0, 0};
        if (n < 255) { kx = *(const u32x4*)(KC + (size_t)n * 64 + ch * 8); vx = *(const u32x4*)(VC + (size_t)n * 64 + ch * 8); }
        *(LAS u32x4*)(Kl + n * 144 + ch * 16) = kx;
        *(LAS u32x4*)(Vl + (n >> 6) * 8192 + (ch >> 2) * 4096 + (n & 63) * 64 + (ch & 3) * 16) = vx;
    }
    for (int idx = tid; idx < 256 * 65; idx += NTHR) imp[idx] = 0.f;
    __syncthreads();
    const bf16_t* P = (const bf16_t*)(A.ws + WS_U) + (size_t)b * T * DINP;
    const float scale2 = 0.125f * LOG2E;
#pragma unroll 1
    for (int rr = 0; rr < 3; ++rr) {
        const int hh = 3 * g + rr; const float slope2 = nsa_slope(hh) * LOG2E;
        bf16x8 qf[4];
        { const bf16_t* qrow = P + (size_t)qpos * DINP + C_CQ + hh * 64;
#pragma unroll
          for (int ks = 0; ks < 4; ++ks) qf[ks] = *(const bf16x8*)(qrow + 16 * ks + 8 * h); }
        float m = NEGBIG, lsum = 0.f, invl = 0.f;
        f32x16 o[2];
#pragma unroll
        for (int i = 0; i < 16; ++i) { o[0][i] = 0.f; o[1][i] = 0.f; }
#pragma unroll 1
        for (int pass = 0; pass < 2; ++pass) {
#pragma unroll 1
            for (int tt = 0; tt < ntile; ++tt) {
                if (16 * (64 * tt) + 31 > qw0 + 31) continue;
                f32x16 p0, p1;
#pragma unroll
                for (int i = 0; i < 16; ++i) { p0[i] = 0.f; p1[i] = 0.f; }
#pragma unroll
                for (int ks = 0; ks < 4; ++ks) {
                    const bf16x8 a0 = *(const LAS bf16x8*)(Kl + (64 * tt + r) * 144 + ks * 32 + h * 16);
                    const bf16x8 a1 = *(const LAS bf16x8*)(Kl + (64 * tt + 32 + r) * 144 + ks * 32 + h * 16);
                    p0 = MFMA32(a0, qf[ks], p0); p1 = MFMA32(a1, qf[ks], p1);
                }
#pragma unroll
                for (int i = 0; i < 16; ++i) {
                    const int n0 = 64 * tt + crow(i, h), d0 = qpos - (16 * n0 + 31), d1 = d0 - 512;
                    p0[i] = d0 >= 0 ? p0[i] * scale2 - slope2 * (float)d0 : NEGBIG;
                    p1[i] = d1 >= 0 ? p1[i] * scale2 - slope2 * (float)d1 : NEGBIG;
                }
                if (pass == 0) {
                    float mloc = fmaxf(p0[0], p1[0]);
#pragma unroll
                    for (int i = 1; i < 16; ++i) mloc = fmaxf(mloc, fmaxf(p0[i], p1[i]));
                    mloc = fmaxf(mloc, __shfl_xor(mloc, 32));
                    const float mnew = fmaxf(m, mloc), alpha = fast_exp2(m - mnew);
                    m = mnew;
                    float ls = 0.f;
#pragma unroll
                    for (int i = 0; i < 16; ++i) ls += fast_exp2(p0[i] - mnew) + fast_exp2(p1[i] - mnew);
                    lsum = lsum * alpha + ls;
                } else {
#pragma unroll
                    for (int i = 0; i < 16; ++i) {
                        p0[i] = p0[i] > -1e29f ? fast_exp2(p0[i] - m) * invl : 0.f;
                        p1[i] = p1[i] > -1e29f ? fast_exp2(p1[i] - m) * invl : 0.f;
                    }
                    pv_tile(o, p0, p1, Vl + tt * 8192, lane);
#pragma unroll
                    for (int blk = 0; blk < 2; ++blk)
#pragma unroll
                        for (int g4 = 0; g4 < 4; ++g4) {
                            const int j = 16 * tt + 8 * blk + 2 * g4 + h;
                            const float G = blk == 0 ? (p0[4 * g4] + p0[4 * g4 + 1]) + (p0[4 * g4 + 2] + p0[4 * g4 + 3]) : (p1[4 * g4] + p1[4 * g4 + 1]) + (p1[4 * g4 + 2] + p1[4 * g4 + 3]);
                            imp[qloc * 65 + j] += G;
                        }
                    asm volatile("s_waitcnt lgkmcnt(0)" ::: "memory");
#pragma unroll
                    for (int blk = 0; blk < 2; ++blk)
#pragma unroll
                        for (int g4 = 0; g4 < 4; ++g4) {
                            const int j = 16 * tt + 8 * blk + 2 * g4 + h;
                            const float Lst = blk == 0 ? p0[4 * g4 + 3] : p1[4 * g4 + 3];
                            if (j + 1 < 64) imp[qloc * 65 + j + 1] += Lst;
                        }
                    asm volatile("s_waitcnt lgkmcnt(0)" ::: "memory");
                }
            }
            if (pass == 0) { const float lt = lsum + __shfl_xor(lsum, 32); invl = (qpos >= 31) ? 1.0f / lt : 0.f; }
        }
        const float gl = bf2f((short)P[(size_t)qpos * DINP + C_G + 0 * 6 + hh]);
        bf16_t* orow = (bf16_t*)(A.ws + WS_XN) + (size_t)(b * T + qpos) * D + 640 + hh * 64;
        store_o<1>(o, orow, h, EN_CMP ? sigmoid_f(gl) * gmul : 0.0f);
    }
    __syncthreads();
    if (qb < 4) {
        if (tid < 256) { const int t = q0 + tid, cur = t >> 6; ((unsigned long long*)(A.ws + WS_SEL))[(size_t)(b * 2 + g) * T + t] = (1ull << (cur + 1)) - 1ull; }
    } else {
        const int qi = tid >> 1, hf = tid & 1, t = q0 + qi, cur = t >> 6;
        float v[32];
#pragma unroll
        for (int i = 0; i < 32; ++i) { const int j = 32 * hf + i; const float x = imp[qi * 65 + j]; v[i] = (j >= 1 && j <= cur - 2) ? x : -1.0f; }
        unsigned long long mask = 1ull | (1ull << cur) | (1ull << (cur - 1));
#pragma unroll 1
        for (int it = 0; it < 13; ++it) {
            float bv = v[0]; int bi = 0;
#pragma unroll
            for (int i = 1; i < 32; ++i) { const bool gt = v[i] > bv; bv = gt ? v[i] : bv; bi = gt ? i : bi; }
            const float ov = __shfl_xor(bv, 1); const int oi = __shfl_xor(bi, 1);
            const float v0 = hf ? ov : bv, v1 = hf ? bv : ov; const int i0 = hf ? oi : bi, i1 = hf ? bi : oi;
            const bool win0 = v0 >= v1;
            const int wj = win0 ? i0 : 32 + i1;
            mask |= 1ull << wj;
            const int clr = (win0 == (hf == 0)) ? (win0 ? i0 : i1) : -1;
#pragma unroll
            for (int i = 0; i < 32; ++i) v[i] = (i == clr) ? -1.0f : v[i];
        }
        if (hf == 0) ((unsigned long long*)(A.ws + WS_SEL))[(size_t)(b * 2 + g) * T + t] = mask;
    }
    __syncthreads();
}

__device__ __forceinline__ int fetch_unit(unsigned* ctr, LAS unsigned char* lds) {
    volatile LAS int* w = (volatile LAS int*)(lds + FETCH_OFF);
    __syncthreads();
    if (get_tid() == 0) *w = (int)atomicAdd(ctr, 1u);
    __syncthreads();
    return __builtin_amdgcn_readfirstlane(*w);
}
template <class Epi>
__device__ __forceinline__ void run_gemm_counted(LAS unsigned char* lds, const bf16_t* Am, const bf16_t* Bt, int N, int K, const Epi& E, unsigned* cnt) {
    pg8::Gemm g{Am, Bt, M, N, K}; CountedOrder S; S.init(M, N, (int)gridDim.x, (int)blockIdx.x); S.cnt = cnt;
    pg8::gemm_phase<Epi, CountedOrder, true, true>(lds, g, S, E);
}
template <class Epi>
__device__ __forceinline__ void run_gemm(LAS unsigned char* lds, const bf16_t* Am, const bf16_t* Bt, int N, int K, const Epi& E) {
    pg8::Gemm g{Am, Bt, M, N, K}; pg8::StaticOrder S; S.init(M, N, (int)gridDim.x, (int)blockIdx.x);
    pg8::gemm_phase<Epi, pg8::StaticOrder, true, true>(lds, g, S, E);
}

__global__ void __launch_bounds__(NTHR, 2) fwd_megakernel(Args A) {
    LAS unsigned char* lds = (LAS unsigned char*)lds_raw;
    if (lane_id() == 0) *(volatile LAS int*)(lds + WIDTAB_OFF + 4 * hw_slot()) = (int)(threadIdx.x >> 6);
    __syncthreads();
    cg::grid_group grid = cg::this_grid();
    const int G = gridDim.x;
    { volatile LAS unsigned* st0 = (volatile LAS unsigned*)(lds + FETCH_OFF + 16); if (get_tid() < 2) st0[get_tid()] = 0u; }
    __syncthreads();
#ifdef PROBE_PHASE
    if (get_tid() < 32) { volatile LAS unsigned* ta_ = (volatile LAS unsigned*)(lds + 140000); ta_[get_tid()] = 0u; }
    __syncthreads();
    if (get_tid() == 0) { volatile LAS unsigned* ta_ = (volatile LAS unsigned*)(lds + 140000); ta_[31] = (unsigned)__builtin_amdgcn_s_memrealtime(); }
    __syncthreads();
#endif
    const unsigned xbar_x = (unsigned)__builtin_amdgcn_readfirstlane((int)xcd_barrier_post((unsigned*)(A.ws + WS_CTL) + 1024, (volatile LAS unsigned*)(lds + FETCH_OFF + 16)).x);
#ifdef PROBE_PHASE
#define STAMP(id) do { if (blockIdx.x == 0 && get_tid() == 0) { volatile LAS unsigned* ta_ = (volatile LAS unsigned*)(lds + 140000); const unsigned now_ = (unsigned)__builtin_amdgcn_s_memrealtime(); ta_[id] += now_ - ta_[31]; ta_[31] = now_; } } while (0)
#else
#define STAMP(id) do {} while (0)
#endif
#define GSYNC() do { XcdBarrier xb_; unsigned xx_ = xbar_x; asm volatile("" : "+s"(xx_)); xb_.bar = (unsigned*)(A.ws + WS_CTL) + 1024; xb_.x = xx_; \
                     xb_.st = (volatile LAS unsigned*)(lds + FETCH_OFF + 16); xcd_barrier(xb_); } while (0)
    unsigned char* ws = A.ws;
    unsigned* ctl = (unsigned*)(ws + WS_CTL);
    float* X = A.out;
    bf16_t* XN = (bf16_t*)(ws + WS_XN);
    bf16_t* U = (bf16_t*)(ws + WS_U);
    const float* mods = (const float*)(ws + WS_MODS);

    for (int task = blockIdx.x; task < 288; task += G) mods_task(A, task, lds);
    for (int task = G - 1 - (int)blockIdx.x; task < 64; task += G) posb_task(A, task, lds);
    rope_entries(A);
    { float* ssq = (float*)(ws + WS_SSQ); for (int i = blockIdx.x * NTHR + opq(get_tid()); i < 4 * M; i += G * NTHR) ssq[i] = 0.f; }
    if (blockIdx.x == 0 && get_tid() < 2) {
        const int tid = opq(get_tid());
        const float* lp = A.in[13] + tid * 128; float s1 = 0.f, s2 = 0.f;
        for (int i = 0; i < 32; ++i) { s1 += lp[i] * lp[32 + i]; s2 += lp[64 + i] * lp[96 + i]; }
        const float lam_init = tid == 0 ? 0.2f : 0.35550907f;
        ((float*)ctl)[64 + tid] = expf(s1) - expf(s2) + lam_init;
        ((float*)ctl)[66 + tid] = 1.0f - lam_init;
    }
    __syncthreads();
    convert_layer(A, 0, lds);
#ifdef PROBE_DUPCVT
    for (int i = 0; i < PROBE_DUPCVT; ++i) { __syncthreads(); convert_layer(A, 0, lds); }
#endif
#ifdef PROBE_DUPMODS
    for (int task = blockIdx.x; task < 288; task += G) mods_task(A, task, lds);
#endif
    grid.sync();
    STAMP(0);

    if (blockIdx.x == 0) posb_final(A);
#pragma unroll 1
    for (int l = 0; l < 2; ++l) {
        const float* modl = mods + (size_t)l * 4 * 9216;
        unsigned char* wb = ws + WS_W;
        if (l == 1) { __syncthreads(); convert_layer(A, 1, lds); }
#pragma unroll 1
        for (int s = 0; s < 2; ++s) {
            const float* xin = (l == 0 && s == 0) ? A.in[0] : X;
            norm_rows(xin, XN, A.in[s == 0 ? 4 : 6] + l * D, modl, s == 0 ? 0 : 6, s == 0 ? 1 : 7);
            GSYNC();
            STAMP(1);
            { EpiSwiGLU E{U}; run_gemm(lds, XN, (const bf16_t*)(wb + (s == 0 ? W_1A : W_2A)), F2, D, E); }
            GSYNC();
            STAMP(2);
            { EpiResid E{xin, X, modl + (s == 0 ? 2 : 8) * 1024, 0.5f}; run_gemm(lds, U, (const bf16_t*)(wb + (s == 0 ? W_1B : W_2B)), D, F, E); }
            GSYNC();
            STAMP(3);
            if (s == 0 && EN_MIX) {
                norm_rows(X, XN, A.in[5] + l * D, modl, 3, 4);
                GSYNC();
                STAMP(4);
                float* ssq = (float*)(ws + WS_SSQ) + (size_t)l * 2 * M;
                { EpiProj E{U, (bf16_t*)(ws + WS_CQ), (bf16_t*)(ws + WS_CKV), ssq, ssq + M}; run_gemm(lds, XN, (const bf16_t*)(wb + W_IN), DINP, D, E); }
                GSYNC();
                STAMP(5);
                kn_rows(A, l);
                GSYNC();
                STAMP(12);
                { EpiRowScale E{(bf16_t*)(ws + WS_MQ), 768, ssq, 1.0f / 256.0f}; run_gemm(lds, (const bf16_t*)(ws + WS_CQ), (const bf16_t*)(wb + W_UQ), 768, 256, E); }
                { EpiRowScale E{(bf16_t*)(ws + WS_MKV), 768, ssq + M, 1.0f / 128.0f}; run_gemm(lds, (const bf16_t*)(ws + WS_CKV), (const bf16_t*)(wb + W_UKV), 768, 128, E); }
                STAMP(11);
                for (;;) {
                    int u = fetch_unit(ctl + l * 4 + 0, lds);
                    if (u >= 64 + 256 + 512 + 384) break;
                    if (u < 512) { da_unit(A, l, (u & 15) >> 2, u & 3, 31 - (u >> 4), lds); continue; } u -= 512;
                    if (u < 384) { nsa_unit<2>(A, l, (u % 24) / 6, u % 6, 15 - u / 24, lds); continue; } u -= 384;
                    if (u < 256) { cmp_mlp_task(A, l, u, lds); continue; } u -= 256;
                    kpe_unit(A, u);
                }
                GSYNC();
                STAMP(6);
                for (;;) {
                    int u = fetch_unit(ctl + l * 4 + 1, lds);
                    if (u >= 384 + 128) break;
                    if (u < 192) { mla_unit(A, (u % 24) / 6, u % 6, 15 - u / 24, lds); continue; } u -= 192;
                    if (u < 128) { cmp_unit(A, (u & 7) >> 1, u & 1, 15 - (u >> 3), lds); continue; } u -= 128;
                    u += 192; mla_unit(A, (u % 24) / 6, u % 6, 15 - u / 24, lds);
                }
                GSYNC();
                STAMP(7);
                for (;;) {
                    const int u = fetch_unit(ctl + l * 4 + 2, lds);
                    if (u >= 384) break;
                    nsa_unit<1>(A, l, (u % 24) / 6, u % 6, 15 - u / 24, lds);
                }
                GSYNC();
                STAMP(8);
                { EpiResid E{X, X, modl + 5 * 1024, 1.0f}; run_gemm(lds, XN, (const bf16_t*)(wb + W_OUT), D, D, E); }
                GSYNC();
                STAMP(9);
            }
        }
    }
    final_norm_rows(X, A.in[22]);
#ifdef PROBE_PHASE
    STAMP(10);
    __syncthreads();
    if (blockIdx.x == 0 && get_tid() == 0) { volatile LAS unsigned* ta_ = (volatile LAS unsigned*)(lds + 140000); X[0] += (float)ta_[PROBE_PHASE] * 0.0001f; }
#endif
#ifdef PROBE_SYNCS
    for (int i = 0; i < PROBE_SYNCS; ++i) GSYNC();
#endif
}

extern "C" void kernel_launch(void* const* d_in, const int* in_sizes, int n_in, void* d_out, int out_size, void* d_ws, size_t ws_size, hipStream_t stream) {
    static int grid = 0;
    if (grid == 0) {
        if (n_in != 23 || out_size != M * D || ws_size < WS_END) { fprintf(stderr, "kernel_launch: unexpected problem shape (n_in %d out %d ws %zu)\n", n_in, out_size, ws_size); grid = -1; return; }
        int dev = 0, cus = 0, per_cu = 0;
        hipGetDevice(&dev);
        hipDeviceGetAttribute(&cus, hipDeviceAttributeMultiprocessorCount, dev);
        hipFuncSetAttribute((const void*)fwd_megakernel, hipFuncAttributeMaxDynamicSharedMemorySize, LDS_BYTES);
        hipOccupancyMaxActiveBlocksPerMultiprocessor(&per_cu, (const void*)fwd_megakernel, NTHR, LDS_BYTES);
        if (per_cu < 1) per_cu = 1;
        grid = cus * per_cu;
        (void)hipGetLastError();
    }
    if (grid < 0) return;
    hipMemsetAsync(d_ws, 0, 32768, stream);
    Args a{};
    for (int i = 0; i < 23; ++i) a.in[i] = (const float*)d_in[i];
    a.out = (float*)d_out; a.ws = (unsigned char*)d_ws;
    void* args[] = {&a};
    hipError_t e = hipLaunchCooperativeKernel((const void*)fwd_megakernel, dim3(grid), dim3(NTHR), args, LDS_BYTES, stream);
    if (e != hipSuccess) fprintf(stderr, "cooperative launch failed: %s (grid %d)\n", hipGetErrorString(e), grid);
}
```

```cpp
#include <hip/hip_runtime.h>
#include <hip/hip_cooperative_groups.h>
#include <cstdio>
#include <cstdint>
namespace cg = cooperative_groups;
extern __shared__ __attribute__((aligned(16))) unsigned char lds_raw[];
constexpr int WIDTAB_OFF = 140200;
__device__ __forceinline__ int lane_id() { return (int)__builtin_amdgcn_mbcnt_hi(~0u, __builtin_amdgcn_mbcnt_lo(~0u, 0u)); }
__device__ __forceinline__ int hw_slot() { return (int)(__builtin_amdgcn_s_getreg((5 << 11) | 4) & 63u); }
__device__ __forceinline__ int get_tid() {
    const int wid = __builtin_amdgcn_readfirstlane(*(volatile __attribute__((address_space(3))) int*)((__attribute__((address_space(3))) unsigned char*)lds_raw + WIDTAB_OFF + 4 * hw_slot()));
    return wid * 64 + lane_id();
}
__device__ __forceinline__ int pg8_opq_tid() { int v = get_tid(); asm volatile("" : "+v"(v)); return v; }
namespace pg8 {
#define PG8_LAS __attribute__((address_space(3)))
typedef unsigned short bf16_t;
typedef short bf16x8 __attribute__((ext_vector_type(8)));
typedef float f32x4 __attribute__((ext_vector_type(4)));
typedef unsigned u32x4 __attribute__((ext_vector_type(4)));
constexpr int BM = 256, BK = 64, HALF = 128, HTB = HALF * BK * 2  , STAGE_BYTES = 8 * HTB, NXCD = 8, WGM = 8;

__host__ __device__ __forceinline__ int lds_byte(int r, int c) { const int st = (r >> 4) * 2 + (c >> 5), rr = r & 15, cc = c & 31, ob = rr * 64 + cc * 2; return st * 1024 + (ob ^ (((ob >> 9) & 1) << 5)); }
__host__ __device__ __forceinline__ void stage_rc(int b, int& R, int& C) { const int st = b / 1024, sb = b % 1024, swz = sb ^ (((sb >> 9) & 1) << 5); R = (st >> 1) * 16 + swz / 64; C = (st & 1) * 32 + (swz % 64) / 2; }
__host__ __device__ __forceinline__ int perm32(int rho) { const int n = rho >> 4, i = rho & 15; return 8 * (i >> 2) + 4 * n + (i & 3); }

struct Unit { int pm, pn; };
struct Gemm { const bf16_t* A; const bf16_t* Bt; int M, N, K; };

struct StaticOrder {
    int nM, nN, nwg, G, c;
    __host__ __device__ void init(int M, int N, int G_, int c_) { nM = M / BM; nN = N / BM; nwg = nM * nN; G = G_; c = c_; }
    __host__ __device__ bool next(int i, Unit& u) const {
        const long L = (long)i * G + c; if (L >= nwg) return false;
        int wgid = (int)L; { const int q = nwg / NXCD, r = nwg % NXCD, xcd = wgid % NXCD, off = wgid / NXCD; wgid = (xcd < r ? xcd * (q + 1) : r * (q + 1) + (xcd - r) * q) + off; }
        const int nig = WGM * nN, gid = wgid / nig, fm = gid * WGM, gsz = (nM - fm) < WGM ? (nM - fm) : WGM;
        u.pm = fm + ((wgid % nig) % gsz); u.pn = (wgid % nig) / gsz; return true;
    }
    __device__ __forceinline__ void a_ready(const Unit&) const {}
    __device__ __forceinline__ void done(const Unit&) const {}
};

__device__ __forceinline__ unsigned cvt_pk_bf16(float lo, float hi) { unsigned r; asm volatile("v_cvt_pk_bf16_f32 %0, %1, %2" : "=v"(r) : "v"(lo), "v"(hi)); return r; }
typedef float f32x2 __attribute__((ext_vector_type(2)));
__device__ __forceinline__ f32x2 gelu_pk(f32x2 v) {
    const f32x2 av = __builtin_elementwise_abs(v), d = av * 0.2316418882f + 1.0f;
    f32x2 t; t.x = __builtin_amdgcn_rcpf(d.x); t.y = __builtin_amdgcn_rcpf(d.y);
    f32x2 q = t * 0.5307027145f + (-0.7265760135f); q = q * t + 0.7107068705f; q = q * t + (-0.142248368f); q = q * t + 0.127414796f; q = q * t;
    const f32x2 s = (v * v) * (-0.72134752044f);
    f32x2 e; e.x = __builtin_amdgcn_exp2f(s.x); e.y = __builtin_amdgcn_exp2f(s.y);
    const f32x2 m = v * (q * e), r = v - m;
    f32x2 o; o.x = v.x < 0.f ? m.x : r.x; o.y = v.y < 0.f ? m.y : r.y; return o;
}

template <int ACT  > struct EpiBf16 {
    static constexpr bool PERM = true, AFTER_DRAIN = false; static_assert(ACT == 0 || ACT == 1, "EpiBf16: ACT is 0 (none) or 1 (gelu_pk)");
    bf16_t* O; int ldc; const float* bias; int split_cols; size_t split_stride; float scale0;
    __device__ __forceinline__ void operator()(const f32x4 (&acc)[2][2][4][2], const Unit& u, int wr, int wc, int fr, int fq) const {
        const int row0 = u.pm * BM + wr * 64 + fr; int colt = u.pn * BM; bf16_t* base = O;
        float sc = 1.f; if (split_cols) { const int t = colt / split_cols; base += (size_t)t * split_stride; colt -= t * split_cols; if (t == 0) sc = scale0; }
        const int col0 = colt + wc * 32 + 8 * fq, bcol0 = u.pn * BM + wc * 32 + 8 * fq;
        f32x4 bv[2][2];
#pragma unroll
        for (int bj = 0; bj < 2; ++bj)
#pragma unroll
            for (int n = 0; n < 2; ++n) bv[bj][n] = bias ? *(const f32x4*)(bias + bcol0 + bj * HALF + 4 * n) : (f32x4){0.f, 0.f, 0.f, 0.f};
#pragma unroll
        for (int ai = 0; ai < 2; ++ai)
#pragma unroll
            for (int m = 0; m < 4; ++m) { bf16_t* rowp = base + (size_t)(row0 + ai * HALF + m * 16) * ldc + col0;
#pragma unroll
                for (int bj = 0; bj < 2; ++bj) { f32x4 v0 = acc[ai][bj][m][0] + bv[bj][0], v1 = acc[ai][bj][m][1] + bv[bj][1];
                    if (ACT == 1) { f32x2 a = gelu_pk((f32x2){v0[0], v0[1]}), b = gelu_pk((f32x2){v0[2], v0[3]}), c = gelu_pk((f32x2){v1[0], v1[1]}), d = gelu_pk((f32x2){v1[2], v1[3]});
                        v0 = (f32x4){a.x, a.y, b.x, b.y}; v1 = (f32x4){c.x, c.y, d.x, d.y}; }
                    v0 = v0 * sc; v1 = v1 * sc; u32x4 w; w.x = cvt_pk_bf16(v0[0], v0[1]); w.y = cvt_pk_bf16(v0[2], v0[3]); w.z = cvt_pk_bf16(v1[0], v1[1]); w.w = cvt_pk_bf16(v1[2], v1[3]);
                    *(u32x4*)(rowp + bj * HALF) = w; } }
    }
};
template <class Epi, class Sched, bool ALIGN_EPI = false, bool SP2 = false>
__device__ __forceinline__ void gemm_phase(PG8_LAS unsigned char* lds, const Gemm g, const Sched& S, const Epi& E) {
    const int tid = pg8_opq_tid(), wid = __builtin_amdgcn_readfirstlane(tid >> 6), lane = tid & 63, wr = wid >> 2, wc = wid & 3, fr = lane & 15, fq = lane >> 4;
    const int K = g.K, nt = K / BK;
    unsigned voffA[2], voffB[2];
#pragma unroll
    for (int i = 0; i < 2; ++i) { int R, C; stage_rc(tid * 16 + i * 8192, R, C); const int Rb = Epi::PERM ? ((R & ~31) + perm32(R & 31)) : R;
        voffA[i] = (unsigned)(R * K + C) * 2u; voffB[i] = (unsigned)(Rb * K + C) * 2u; }
    const size_t kstep = (size_t)(BK * 2);
    const size_t hstep = (size_t)HALF * K * 2;
    const size_t tstep = 2 * hstep;
    const unsigned ldsw = (unsigned)wid * 1024u;
    const int aoff = lds_byte(wr * 64 + fr, fq * 8), boff = lds_byte(wc * 32 + fr, fq * 8);
#define PG8_SA(b, h) (((b) * 2 + (h)) * HTB)
#define PG8_SB(b, h) ((4 + (b) * 2 + (h)) * HTB)
#define PG8_STAGE(bufoff, gbase, voff) do { _Pragma("unroll") for (int _i = 0; _i < 2; ++_i) \
        __builtin_amdgcn_global_load_lds((const unsigned*)((const char*)(gbase) + (voff)[_i]), (PG8_LAS unsigned*)(lds + (bufoff) + ldsw + _i * 8192), 16, 0, 0); } while (0)
#define PG8_LDA(dst, b, h) do { _Pragma("unroll") for (int m = 0; m < 4; ++m) _Pragma("unroll") for (int k = 0; k < 2; ++k) dst[m][k] = *(const PG8_LAS bf16x8*)(lds + PG8_SA(b, h) + aoff + m * 2048 + k * 1024); } while (0)
#define PG8_LDB(dst, b, h) do { _Pragma("unroll") for (int n = 0; n < 2; ++n) _Pragma("unroll") for (int k = 0; k < 2; ++k) dst[n][k] = *(const PG8_LAS bf16x8*)(lds + PG8_SB(b, h) + boff + n * 2048 + k * 1024); } while (0)
#define PG8_MMA(ai, bj, At, Bt) do { __builtin_amdgcn_s_setprio(1); _Pragma("unroll") for (int m = 0; m < 4; ++m) _Pragma("unroll") for (int n = 0; n < 2; ++n) _Pragma("unroll") for (int k = 0; k < 2; ++k) \
        acc[ai][bj][m][n] = __builtin_amdgcn_mfma_f32_16x16x32_bf16(Bt[n][k], At[m][k], acc[ai][bj][m][n], 0, 0, 0); __builtin_amdgcn_s_setprio(0); } while (0)
#define PG8_WAIT_V(n) asm volatile("s_waitcnt vmcnt(" #n ")" ::: "memory")
#define PG8_WAIT_L(n) asm volatile("s_waitcnt lgkmcnt(" #n ")" ::: "memory")
#define PG8_BAR __builtin_amdgcn_s_barrier()
#define PG8_SCHED __builtin_amdgcn_sched_barrier(0)
    Unit cur, nxt; int ui = 0;
    if (!S.next(0, cur)) return;
    f32x4 acc[2][2][4][2];
#pragma unroll
    for (int a = 0; a < 2; ++a)
#pragma unroll
        for (int b = 0; b < 2; ++b)
#pragma unroll
            for (int m = 0; m < 4; ++m)
#pragma unroll
                for (int n = 0; n < 2; ++n) acc[a][b][m][n] = (f32x4){0.f, 0.f, 0.f, 0.f};
    bf16x8 At[4][2], B0[2][2], B1[2][2];
    const char* cA = (const char*)g.A + (size_t)cur.pm * tstep; const char* cB = (const char*)g.Bt + (size_t)cur.pn * tstep;
    S.a_ready(cur);
    if constexpr (SP2) {
        PG8_STAGE(PG8_SB(0, 0), cB, voffB); PG8_STAGE(PG8_SB(0, 1), cB + hstep, voffB); PG8_STAGE(PG8_SA(0, 0), cA, voffA); PG8_STAGE(PG8_SA(0, 1), cA + hstep, voffA);
        if (wr == 1) PG8_BAR;
        PG8_WAIT_V(2); PG8_BAR;
        PG8_STAGE(PG8_SB(1, 0), cB + kstep, voffB); PG8_STAGE(PG8_SA(1, 0), cA + kstep, voffA); PG8_STAGE(PG8_SB(1, 1), cB + hstep + kstep, voffB);
        PG8_WAIT_V(6); PG8_BAR;
    } else {
        PG8_STAGE(PG8_SB(0, 0), cB, voffB); PG8_STAGE(PG8_SA(0, 0), cA, voffA); PG8_STAGE(PG8_SB(0, 1), cB + hstep, voffB); PG8_STAGE(PG8_SA(0, 1), cA + hstep, voffA);
        if (wr == 1) PG8_BAR;
        PG8_WAIT_V(4); PG8_BAR;
        PG8_STAGE(PG8_SB(1, 0), cB + kstep, voffB); PG8_STAGE(PG8_SA(1, 0), cA + kstep, voffA); PG8_STAGE(PG8_SB(1, 1), cB + hstep + kstep, voffB);
        PG8_WAIT_V(6); PG8_BAR;
    }
    for (;;) {
        const bool has_next = S.next(ui + 1, nxt);
        const char* nA = has_next ? (const char*)g.A + (size_t)nxt.pm * tstep : cA; const char* nB = has_next ? (const char*)g.Bt + (size_t)nxt.pn * tstep : cB;
        for (int t = 0; t < nt; t += 2) {
            const bool last = (t == nt - 2);
            const char* a1 = cA + (size_t)(t + 1) * kstep;
            const char* a2 = last ? nA : cA + (size_t)(t + 2) * kstep; const char* b2 = last ? nB : cB + (size_t)(t + 2) * kstep;
            const char* a3 = a2 + kstep; const char* b3 = b2 + kstep;
            if (last && has_next) S.a_ready(nxt);
            if constexpr (SP2) {
            PG8_LDB(B0, 0, 0); PG8_LDB(B1, 0, 1); PG8_SCHED; PG8_LDA(At, 0, 0); PG8_STAGE(PG8_SA(1, 1), a1 + hstep, voffA);
            PG8_WAIT_V(8); PG8_WAIT_L(0); PG8_BAR; PG8_MMA(0, 0, At, B0); PG8_MMA(0, 1, At, B1); PG8_BAR; PG8_SCHED;
            PG8_LDA(At, 0, 1); PG8_STAGE(PG8_SB(0, 0), b2, voffB); PG8_STAGE(PG8_SB(0, 1), b2 + hstep, voffB); PG8_STAGE(PG8_SA(0, 0), a2, voffA);
            PG8_WAIT_V(8); PG8_WAIT_L(0); PG8_BAR; PG8_MMA(1, 0, At, B0); PG8_MMA(1, 1, At, B1); PG8_BAR; PG8_SCHED;
            PG8_LDB(B0, 1, 0); PG8_LDB(B1, 1, 1); PG8_SCHED; PG8_LDA(At, 1, 0); PG8_STAGE(PG8_SA(0, 1), a2 + hstep, voffA);
            PG8_WAIT_V(8); PG8_WAIT_L(0); PG8_BAR; PG8_MMA(0, 0, At, B0); PG8_MMA(0, 1, At, B1); PG8_BAR; PG8_SCHED;
            PG8_LDA(At, 1, 1); PG8_STAGE(PG8_SB(1, 0), b3, voffB); PG8_STAGE(PG8_SB(1, 1), b3 + hstep, voffB); PG8_STAGE(PG8_SA(1, 0), a3, voffA);
            PG8_WAIT_V(8); PG8_WAIT_L(0); PG8_BAR; PG8_MMA(1, 0, At, B0); PG8_MMA(1, 1, At, B1); PG8_BAR; PG8_SCHED;
            } else {
            PG8_LDB(B0, 0, 0); PG8_SCHED; PG8_LDA(At, 0, 0); PG8_STAGE(PG8_SA(1, 1), a1 + hstep, voffA);
            PG8_WAIT_L(8); PG8_BAR; PG8_WAIT_L(0); PG8_MMA(0, 0, At, B0); PG8_BAR; PG8_SCHED;
            PG8_LDB(B1, 0, 1); PG8_STAGE(PG8_SB(0, 0), b2, voffB);
            PG8_BAR; PG8_WAIT_L(0); PG8_MMA(0, 1, At, B1); PG8_BAR;
            PG8_LDA(At, 0, 1); PG8_STAGE(PG8_SA(0, 0), a2, voffA);
            PG8_BAR; PG8_WAIT_L(0); PG8_MMA(1, 0, At, B0); PG8_BAR; PG8_SCHED;
            PG8_STAGE(PG8_SB(0, 1), b2 + hstep, voffB);
            PG8_WAIT_V(6); PG8_BAR; PG8_MMA(1, 1, At, B1); PG8_BAR;
            PG8_LDB(B0, 1, 0); PG8_SCHED; PG8_LDA(At, 1, 0); PG8_STAGE(PG8_SA(0, 1), a2 + hstep, voffA);
            PG8_WAIT_L(8); PG8_BAR; PG8_WAIT_L(0); PG8_MMA(0, 0, At, B0); PG8_BAR; PG8_SCHED;
            PG8_LDB(B1, 1, 1); PG8_STAGE(PG8_SB(1, 0), b3, voffB);
            PG8_BAR; PG8_WAIT_L(0); PG8_MMA(0, 1, At, B1); PG8_BAR;
            PG8_LDA(At, 1, 1); PG8_STAGE(PG8_SA(1, 0), a3, voffA);
            PG8_BAR; PG8_WAIT_L(0); PG8_MMA(1, 0, At, B0); PG8_BAR; PG8_SCHED;
            PG8_STAGE(PG8_SB(1, 1), b3 + hstep, voffB);
            PG8_WAIT_V(6); PG8_BAR; PG8_MMA(1, 1, At, B1); PG8_BAR;
            }
        }
        if constexpr (ALIGN_EPI) { if (wr == 0) PG8_BAR; }
        if constexpr (!Epi::AFTER_DRAIN) { E(acc, cur, wr, wc, fr, fq); S.done(cur); }
        if (!has_next) break;
#pragma unroll
        for (int a = 0; a < 2; ++a)
#pragma unroll
            for (int b = 0; b < 2; ++b)
#pragma unroll
                for (int m = 0; m < 4; ++m)
#pragma unroll
                    for (int n = 0; n < 2; ++n) acc[a][b][m][n] = (f32x4){0.f, 0.f, 0.f, 0.f};
        cur = nxt; cA = nA; cB = nB; ++ui;
        if constexpr (ALIGN_EPI) { if (wr == 1) PG8_BAR; }
    }
    PG8_WAIT_V(0);
    if constexpr (!ALIGN_EPI) { if (wr == 0) PG8_BAR; }
    PG8_BAR;
    if constexpr (Epi::AFTER_DRAIN) { E.fused(acc, cur, wr, wc, fr, fq, lds, wid, lane); S.done(cur); }
#undef PG8_SA
#undef PG8_SB
#undef PG8_STAGE
#undef PG8_LDA
#undef PG8_LDB
#undef PG8_MMA
#undef PG8_WAIT_V
#undef PG8_WAIT_L
#undef PG8_BAR
#undef PG8_SCHED
}
}

#define LAS __attribute__((address_space(3)))
typedef unsigned short bf16_t;
typedef short bf16x8 __attribute__((ext_vector_type(8)));
typedef short s16x4 __attribute__((ext_vector_type(4)));
typedef float f32x4 __attribute__((ext_vector_type(4)));
typedef float f32x2 __attribute__((ext_vector_type(2)));
typedef float f32x16 __attribute__((ext_vector_type(16)));
typedef unsigned u32x4 __attribute__((ext_vector_type(4)));
typedef unsigned u32x2 __attribute__((ext_vector_type(2)));
typedef __bf16 bf16x2_t __attribute__((ext_vector_type(2)));

#ifndef EN_MIX
#define EN_MIX 1
#endif
#ifndef EN_DA
#define EN_DA 1
#endif
#ifndef EN_MLA
#define EN_MLA 1
#endif
#ifndef EN_WIN
#define EN_WIN 1
#endif
#ifndef EN_CMP
#define EN_CMP 1
#endif
#ifndef EN_SLC
#define EN_SLC 1
#endif

constexpr int NB = 4, T = 4096, D = 1024, M = NB * T, F = 2816, F2 = 5632, DIN = 2354, DINP = 2560;
constexpr int NTHR = 512, NWAVE = 8, LDS_BYTES = 147456, FETCH_OFF = LDS_BYTES - 64;
constexpr int C_AQ = 0, C_AK = 256, C_AV = 512, C_BKR = 1152, C_CQ = 1184, C_KC = 1568, C_VC = 1696, C_KS = 1824, C_VS = 1952, C_KW = 2080, C_VW = 2208, C_G = 2336;
constexpr float LOG2E = 1.4426950408889634f, RMS_EPS = 1e-6f, NEGBIG = -1e30f;

constexpr size_t MiB = 1u << 20, KiB = 1u << 10;
constexpr size_t WS_CTL = 0;
constexpr size_t WS_MODS = 64 * KiB;
constexpr size_t WS_ROPE = 512 * KiB;
constexpr size_t WS_POSB = 1 * MiB;
constexpr size_t WS_SSQ = 1 * MiB + 64 * KiB;
constexpr size_t WS_KCMP = 2 * MiB;
constexpr size_t WS_SEL = 3 * MiB;
constexpr size_t WS_W = 4 * MiB;
constexpr size_t W_1A = 0, W_1B = W_1A + (size_t)F2 * D * 2, W_2A = W_1B + (size_t)D * F * 2, W_2B = W_2A + (size_t)F2 * D * 2,
                 W_IN = W_2B + (size_t)D * F * 2, W_OUT = W_IN + (size_t)DINP * D * 2, W_UQ = W_OUT + (size_t)D * D * 2, W_UKV = W_UQ + 768 * 256 * 2,
                 W_C1 = W_UKV + 768 * 128 * 2, W_C2 = W_C1 + 2 * 128 * 2048 * 2, W_END = W_C2 + 2 * 64 * 128 * 2;
static_assert(WS_W + W_END <= 48 * MiB, "weights");
constexpr size_t WS_XN = 48 * MiB;
constexpr size_t WS_U = 80 * MiB;
constexpr size_t WS_CQ = 168 * MiB;
constexpr size_t WS_CKV = 176 * MiB;
constexpr size_t WS_MQ = 180 * MiB;
constexpr size_t WS_MKV = 204 * MiB;
constexpr size_t WS_KPE = 228 * MiB;
constexpr size_t WS_END = 229 * MiB;

__device__ __forceinline__ unsigned cvtpk(float lo, float hi) { f32x2 v = {lo, hi}; bf16x2_t b = __builtin_convertvector(v, bf16x2_t); return __builtin_bit_cast(unsigned, b); }
__device__ __forceinline__ float bf2f(short b) { return __uint_as_float(((unsigned)(unsigned short)b) << 16); }
__device__ __forceinline__ float wave_sum(float v) {
#pragma unroll
    for (int o = 1; o < 64; o <<= 1) v += __shfl_xor(v, o);
    return v;
}
__device__ __forceinline__ float fast_exp2(float x) { return __builtin_amdgcn_exp2f(x); }
__device__ __forceinline__ float fast_rcp(float x) { return __builtin_amdgcn_rcpf(x); }
__device__ __forceinline__ float sigmoid_f(float x) { return fast_rcp(1.0f + fast_exp2(-x * LOG2E)); }
__device__ __forceinline__ int crow(int i, int h) { return (i & 3) + 8 * (i >> 2) + 4 * h; }
__device__ __forceinline__ int opq(int v) { asm volatile("" : "+v"(v)); return v; }
#define MFMA32(a, b, c) __builtin_amdgcn_mfma_f32_32x32x16_bf16((a), (b), (c), 0, 0, 0)
#define MFMA16(a, b, c) __builtin_amdgcn_mfma_f32_16x16x32_bf16((a), (b), (c), 0, 0, 0)

struct Args { const float* in[23]; float* out; unsigned char* ws; };
__device__ __forceinline__ unsigned char* ws_opq(unsigned char* p) {
    const unsigned long long v = (unsigned long long)p;
    unsigned lo = (unsigned)__builtin_amdgcn_readfirstlane((int)(unsigned)v), hi = (unsigned)__builtin_amdgcn_readfirstlane((int)(unsigned)(v >> 32));
    asm volatile("" : "+s"(lo), "+s"(hi));
    return (unsigned char*)(((unsigned long long)hi << 32) | (unsigned long long)lo);
}

struct EpiSwiGLU {
    static constexpr bool PERM = true, AFTER_DRAIN = false;
    bf16_t* O;
    __device__ __forceinline__ void operator()(const f32x4 (&acc)[2][2][4][2], const pg8::Unit& u, int wr_, int wc_, int fr_, int fq_) const {
        const int t_ = opq(get_tid()), w_ = __builtin_amdgcn_readfirstlane(t_ >> 6), wr = w_ >> 2, wc = w_ & 3, fr = t_ & 15, fq = (t_ >> 4) & 3;
        const int row0 = u.pm * 256 + wr * 64 + fr, col0 = u.pn * 128 + wc * 32 + 8 * fq;
#pragma unroll
        for (int ai = 0; ai < 2; ++ai)
#pragma unroll
            for (int m = 0; m < 4; ++m) {
                bf16_t* rowp = O + (size_t)(row0 + ai * 128 + m * 16) * F + col0;
                float r[8];
#pragma unroll
                for (int n = 0; n < 2; ++n)
#pragma unroll
                    for (int j = 0; j < 4; ++j) { const float g = acc[ai][0][m][n][j], up = acc[ai][1][m][n][j]; r[n * 4 + j] = g * sigmoid_f(g) * up; }
                u32x4 w; w.x = cvtpk(r[0], r[1]); w.y = cvtpk(r[2], r[3]); w.z = cvtpk(r[4], r[5]); w.w = cvtpk(r[6], r[7]);
                *(u32x4*)rowp = w;
            }
    }
};
struct EpiResid {
    static constexpr bool PERM = false, AFTER_DRAIN = false;
    const float* resid; float* out; const float* gate; float coef;
    __device__ __forceinline__ void operator()(const f32x4 (&acc)[2][2][4][2], const pg8::Unit& u, int wr_, int wc_, int fr_, int fq_) const {
        const int t_ = opq(get_tid()), w_ = __builtin_amdgcn_readfirstlane(t_ >> 6), wr = w_ >> 2, wc = w_ & 3, fr = t_ & 15, fq = (t_ >> 4) & 3;
        const int row0 = u.pm * 256 + wr * 64 + fr, b = (u.pm * 256) >> 12, col0 = u.pn * 256 + wc * 32 + 4 * fq;
#pragma unroll
        for (int bj = 0; bj < 2; ++bj)
#pragma unroll
            for (int n = 0; n < 2; ++n) {
                const int c = col0 + bj * 128 + n * 16;
                const f32x4 gv = *(const f32x4*)(gate + (size_t)b * 9216 + c) * coef;
#pragma unroll
                for (int ai = 0; ai < 2; ++ai)
#pragma unroll
                    for (int m = 0; m < 4; ++m) {
                        const size_t off = (size_t)(row0 + ai * 128 + m * 16) * D + c;
                        const f32x4 o = *(const f32x4*)(resid + off) + gv * acc[ai][bj][m][n];
                        *(f32x4*)(out + off) = o;
                        if (m & 1) asm volatile("" ::: "memory");
                    }
            }
    }
};
struct EpiProj {
    static constexpr bool PERM = true, AFTER_DRAIN = false;
    bf16_t* PROJ; bf16_t* CQ; bf16_t* CKV; float* ssq_q; float* ssq_kv;
    __device__ __forceinline__ void operator()(const f32x4 (&acc)[2][2][4][2], const pg8::Unit& u, int wr_, int wc_, int fr_, int fq_) const {
        const int t_ = opq(get_tid()), w_ = __builtin_amdgcn_readfirstlane(t_ >> 6), wr = w_ >> 2, wc = w_ & 3, fr = t_ & 15, fq = (t_ >> 4) & 3;
        const int row0 = u.pm * 256 + wr * 64 + fr;
#pragma unroll
        for (int bj = 0; bj < 2; ++bj) {
            bf16_t* base; int ld, cb; float* ssq;
            if (u.pn == 3) { base = CQ; ld = 256; cb = bj * 128; ssq = ssq_q; }
            else if (u.pn == 4 && bj == 0) { base = CKV; ld = 128; cb = 0; ssq = ssq_kv; }
            else { base = PROJ; ld = DINP; cb = u.pn * 256 + bj * 128; ssq = nullptr; }
            const int col0 = cb + wc * 32 + 8 * fq;
#pragma unroll
            for (int ai = 0; ai < 2; ++ai)
#pragma unroll
                for (int m = 0; m < 4; ++m) {
                    const int row = row0 + ai * 128 + m * 16;
                    const f32x4 v0 = acc[ai][bj][m][0], v1 = acc[ai][bj][m][1];
                    u32x4 w; w.x = cvtpk(v0[0], v0[1]); w.y = cvtpk(v0[2], v0[3]); w.z = cvtpk(v1[0], v1[1]); w.w = cvtpk(v1[2], v1[3]);
                    *(u32x4*)(base + (size_t)row * ld + col0) = w;
                    if (ssq) {
                        float s = (v0[0] * v0[0] + v0[1] * v0[1]) + (v0[2] * v0[2] + v0[3] * v0[3]) + (v1[0] * v1[0] + v1[1] * v1[1]) + (v1[2] * v1[2] + v1[3] * v1[3]);
                        s += __shfl_xor(s, 16); s += __shfl_xor(s, 32);
                        if (fq == 0) atomicAdd(ssq + row, s);
                    }
                    asm volatile("" ::: "memory");
                }
        }
    }
};
struct EpiRowScale {
    static constexpr bool PERM = true, AFTER_DRAIN = false;
    bf16_t* O; int ldc; const float* ssq; float inv_n;
    __device__ __forceinline__ void operator()(const f32x4 (&acc)[2][2][4][2], const pg8::Unit& u, int wr_, int wc_, int fr_, int fq_) const {
        const int t_ = opq(get_tid()), w_ = __builtin_amdgcn_readfirstlane(t_ >> 6), wr = w_ >> 2, wc = w_ & 3, fr = t_ & 15, fq = (t_ >> 4) & 3;
        const int row0 = u.pm * 256 + wr * 64 + fr, col0 = u.pn * 256 + wc * 32 + 8 * fq;
#pragma unroll
        for (int ai = 0; ai < 2; ++ai)
#pragma unroll
            for (int m = 0; m < 4; ++m) {
                const int row = row0 + ai * 128 + m * 16;
                const float rs = rsqrtf(ssq[row] * inv_n + RMS_EPS);
#pragma unroll
                for (int bj = 0; bj < 2; ++bj) {
                    const f32x4 v0 = acc[ai][bj][m][0] * rs, v1 = acc[ai][bj][m][1] * rs;
                    u32x4 w; w.x = cvtpk(v0[0], v0[1]); w.y = cvtpk(v0[2], v0[3]); w.z = cvtpk(v1[0], v1[1]); w.w = cvtpk(v1[2], v1[3]);
                    *(u32x4*)(O + (size_t)row * ldc + col0 + bj * 128) = w;
                }
                asm volatile("" ::: "memory");
            }
    }
};

template <int MODE> __device__ __forceinline__ int wrow(int n) {
    if (MODE == 1) return n < F ? ((n >> 7) * 256 + (n & 127)) : (((n - F) >> 7) * 256 + 128 + ((n - F) & 127));
    return n;
}
template <int MODE>
__device__ __forceinline__ void cvt_item(const float* W, int K, int N, int NP, bf16_t* WT, const float* kscale, LAS float* scr, int item, int lane) {
    const int nblk = NP / 32, kb = item / nblk, nb = item % nblk, k0 = 64 * kb, n0 = 32 * nb;
    const int n_rd = n0 + (lane & 31);
#pragma unroll 8
    for (int i = 0; i < 32; ++i) {
        const int kk = 2 * i + (lane >> 5);
        float v = (n_rd < N) ? W[(size_t)(k0 + kk) * N + n_rd] : 0.f;
        if (kscale) v *= kscale[k0 + kk];
        scr[kk * 33 + (lane & 31)] = v;
    }
    asm volatile("s_waitcnt lgkmcnt(0)" ::: "memory");
    const int c = lane & 7;
#pragma unroll
    for (int j = 0; j < 4; ++j) {
        const int n = (lane >> 3) + 8 * j; const LAS float* s = scr + (8 * c) * 33 + n;
        u32x4 o; o.x = cvtpk(s[0 * 33], s[1 * 33]); o.y = cvtpk(s[2 * 33], s[3 * 33]); o.z = cvtpk(s[4 * 33], s[5 * 33]); o.w = cvtpk(s[6 * 33], s[7 * 33]);
        *(u32x4*)(WT + (size_t)wrow<MODE>(n0 + n) * K + k0 + 8 * c) = o;
    }
    asm volatile("s_waitcnt lgkmcnt(0)" ::: "memory");
}
__device__ __forceinline__ void convert_layer(const Args& A, int l, LAS unsigned char* lds) {
    const int tid = opq(get_tid()), lane = tid & 63, wid = __builtin_amdgcn_readfirstlane(tid >> 6), gw = blockIdx.x * NWAVE + wid, ngw = gridDim.x * NWAVE;
    LAS float* scr = (LAS float*)(lds + wid * 8704);
    unsigned char* wb = A.ws + WS_W;
    constexpr int I_A = 16 * 176, I_B = 44 * 32, I_IN = 16 * 80, I_OUT = 16 * 32, I_UQ = 4 * 24, I_UKV = 2 * 24, I_C1 = 32 * 4, I_C2 = 2 * 2;
    constexpr int NITEMS = 2 * I_A + 2 * I_B + I_IN + I_OUT + I_UQ + I_UKV + 2 * I_C1 + 2 * I_C2;
    for (int it = gw; it < NITEMS; it += ngw) {
        int r = it;
        if (r < I_A) { cvt_item<1>(A.in[7] + (size_t)l * D * F2, D, F2, F2, (bf16_t*)(wb + W_1A), nullptr, scr, r, lane); continue; } r -= I_A;
        if (r < I_A) { cvt_item<1>(A.in[9] + (size_t)l * D * F2, D, F2, F2, (bf16_t*)(wb + W_2A), nullptr, scr, r, lane); continue; } r -= I_A;
        if (r < I_B) { cvt_item<0>(A.in[8] + (size_t)l * F * D, F, D, D, (bf16_t*)(wb + W_1B), nullptr, scr, r, lane); continue; } r -= I_B;
        if (r < I_B) { cvt_item<0>(A.in[10] + (size_t)l * F * D, F, D, D, (bf16_t*)(wb + W_2B), nullptr, scr, r, lane); continue; } r -= I_B;
        if (r < I_IN) { cvt_item<0>(A.in[11] + (size_t)l * D * DIN, D, DIN, DINP, (bf16_t*)(wb + W_IN), nullptr, scr, r, lane); continue; } r -= I_IN;
        if (r < I_OUT) { cvt_item<0>(A.in[12] + (size_t)l * D * D, D, D, D, (bf16_t*)(wb + W_OUT), nullptr, scr, r, lane); continue; } r -= I_OUT;
        if (r < I_UQ) { cvt_item<0>(A.in[17] + (size_t)l * 256 * 576, 256, 576, 768, (bf16_t*)(wb + W_UQ), A.in[15] + l * 256, scr, r, lane); continue; } r -= I_UQ;
        if (r < I_UKV) { cvt_item<0>(A.in[18] + (size_t)l * 128 * 768, 128, 768, 768, (bf16_t*)(wb + W_UKV), A.in[16] + l * 128, scr, r, lane); continue; } r -= I_UKV;
        if (r < 2 * I_C1) { const int kv = r / I_C1; cvt_item<0>(A.in[20] + (size_t)(l * 2 + kv) * 2048 * 128, 2048, 128, 128, (bf16_t*)(wb + W_C1) + (size_t)kv * 128 * 2048, nullptr, scr, r % I_C1, lane); continue; } r -= 2 * I_C1;
        { const int kv = r / I_C2; cvt_item<0>(A.in[21] + (size_t)(l * 2 + kv) * 128 * 64, 128, 64, 64, (bf16_t*)(wb + W_C2) + (size_t)kv * 64 * 128, nullptr, scr, r % I_C2, lane); }
    }
}
__device__ __forceinline__ void mods_task(const Args& A, int task, LAS unsigned char* lds) {
    const int tid = opq(get_tid()), lane = tid & 63, wid = __builtin_amdgcn_readfirstlane(tid >> 6);
    const int l = task / 144, chunk = task % 144;
    LAS float* cond = (LAS float*)lds;
    LAS float* red = (LAS float*)(lds + 16384);
    __syncthreads();
    for (int i = tid; i < 4096; i += NTHR) { const float c = A.in[1][i]; cond[i] = c / (1.0f + expf(-c)); }
    __syncthreads();
    const float* W = A.in[2] + (size_t)l * D * 9216 + chunk * 64 + lane;
    float acc[4] = {0.f, 0.f, 0.f, 0.f};
#pragma unroll 16
    for (int kk = 0; kk < 128; ++kk) {
        const int k = wid * 128 + kk;
        const float w = W[(size_t)k * 9216];
#pragma unroll
        for (int b = 0; b < 4; ++b) acc[b] += cond[b * 1024 + k] * w;
    }
#pragma unroll
    for (int b = 0; b < 4; ++b) red[(wid * 4 + b) * 64 + lane] = acc[b];
    __syncthreads();
    if (tid < 256) {
        const int b = tid >> 6, col = tid & 63; float s = 0.f;
#pragma unroll
        for (int w = 0; w < 8; ++w) s += red[(w * 4 + b) * 64 + col];
        s += A.in[3][(size_t)l * 9216 + chunk * 64 + col];
        ((float*)(A.ws + WS_MODS))[(size_t)(l * 4 + b) * 9216 + chunk * 64 + col] = s;
    }
    __syncthreads();
}
__device__ __forceinline__ void posb_task(const Args& A, int task, LAS unsigned char* lds) {
    const int tid = opq(get_tid());
    const int lkv = task >> 4, kp = task & 15, hid = tid & 127, sub = tid >> 7;
    const float* pos = A.in[19] + (size_t)lkv * 2048 + kp * 128 + sub * 32; const float* w1 = A.in[20] + ((size_t)lkv * 2048 + kp * 128 + sub * 32) * 128 + hid;
    float s = 0.f;
#pragma unroll
    for (int k = 0; k < 32; ++k) s += pos[k] * w1[(size_t)k * 128];
    LAS float* red = (LAS float*)lds;
    __syncthreads();
    red[tid] = s;
    __syncthreads();
    if (tid < 128) ((float*)(A.ws + WS_POSB + 4096))[task * 128 + tid] = red[tid] + red[tid + 128] + red[tid + 256] + red[tid + 384];
    __syncthreads();
}
__device__ __forceinline__ void posb_final(const Args& A) {
    const int o = opq(get_tid());
    const float* part = (const float*)(A.ws + WS_POSB + 4096) + (size_t)(o >> 7) * 16 * 128 + (o & 127);
    float s = 0.f;
#pragma unroll
    for (int p = 0; p < 16; ++p) s += part[p * 128];
    ((float*)(A.ws + WS_POSB))[o] = s;
}
__device__ __forceinline__ void rope_entries(const Args& A) {
    const int gtid = blockIdx.x * NTHR + opq(get_tid()), gn = gridDim.x * NTHR;
    float* tab = (float*)(A.ws + WS_ROPE);
    for (int e = gtid; e < T * 16; e += gn) {
        const int t = e >> 4, i = e & 15;
        double inv = 1.0; for (int j = 0; j < i; ++j) inv *= 0.5623413251903491;
        const float ang = (float)t * (float)inv;
        const double rev = (double)ang * 0.15915494309189535; const double fr = rev - __builtin_rint(rev);
        tab[e] = __builtin_amdgcn_cosf((float)fr); tab[T * 16 + e] = __builtin_amdgcn_sinf((float)fr);
    }
}
__device__ __forceinline__ void norm_rows(const float* X, bf16_t* out, const float* g, const float* modl, int ish, int isc) {
    const int tid = opq(get_tid()), lane = tid & 63, wid = __builtin_amdgcn_readfirstlane(tid >> 6), gw = blockIdx.x * NWAVE + wid, ngw = gridDim.x * NWAVE;
#pragma unroll 1
    for (int b = 0; b < NB; ++b) {
        f32x4 gs[4], sh[4];
#pragma unroll
        for (int j = 0; j < 4; ++j) {
            const int col = 4 * lane + 256 * j;
            gs[j] = *(const f32x4*)(g + col) * (*(const f32x4*)(modl + (size_t)b * 9216 + isc * 1024 + col) + 1.0f);
            sh[j] = *(const f32x4*)(modl + (size_t)b * 9216 + ish * 1024 + col);
        }
        for (int row = b * T + gw; row < (b + 1) * T; row += ngw) {
            const f32x4* xr = (const f32x4*)(X + (size_t)row * D) + lane;
            f32x4 v[4]; float ss = 0.f;
#pragma unroll
            for (int j = 0; j < 4; ++j) { v[j] = xr[64 * j]; ss += (v[j].x * v[j].x + v[j].y * v[j].y) + (v[j].z * v[j].z + v[j].w * v[j].w); }
            const float rstd = rsqrtf(wave_sum(ss) * (1.0f / D) + RMS_EPS);
#pragma unroll
            for (int j = 0; j < 4; ++j) {
                const f32x4 y = (v[j] * rstd) * gs[j] + sh[j];
                u32x2 w; w.x = cvtpk(y.x, y.y); w.y = cvtpk(y.z, y.w);
                *(u32x2*)(out + (size_t)row * D + 4 * lane + 256 * j) = w;
            }
        }
    }
}
__device__ __forceinline__ void final_norm_rows(float* X, const float* g) {
    const int tid = opq(get_tid()), lane = tid & 63, wid = __builtin_amdgcn_readfirstlane(tid >> 6), gw = blockIdx.x * NWAVE + wid, ngw = gridDim.x * NWAVE;
    for (int row = gw; row < M; row += ngw) {
        f32x4* xr = (f32x4*)(X + (size_t)row * D) + lane;
        f32x4 v[4]; float ss = 0.f;
#pragma unroll
        for (int j = 0; j < 4; ++j) { v[j] = xr[64 * j]; ss += (v[j].x * v[j].x + v[j].y * v[j].y) + (v[j].z * v[j].z + v[j].w * v[j].w); }
        const float rstd = rsqrtf(wave_sum(ss) * (1.0f / D) + RMS_EPS);
#pragma unroll
        for (int j = 0; j < 4; ++j) { const f32x4 g4 = *(const f32x4*)(g + 4 * lane + 256 * j); xr[64 * j] = (v[j] * rstd) * g4; }
    }
}

__device__ __forceinline__ void norm_block(const float* X, bf16_t* out, const float* g, const float* modl, int ish, int isc, int row0) {
    const int tid = opq(get_tid()), lane = tid & 63, wid = __builtin_amdgcn_readfirstlane(tid >> 6);
    const int b = row0 >> 12;
#pragma unroll 1
    for (int rr = 0; rr < 8; ++rr) {
        const int row = row0 + rr * 8 + wid;
        const f32x4* xr = (const f32x4*)(X + (size_t)row * D) + lane;
        f32x4 v[4]; float ss = 0.f;
#pragma unroll
        for (int j = 0; j < 4; ++j) { v[j] = xr[64 * j]; ss += (v[j].x * v[j].x + v[j].y * v[j].y) + (v[j].z * v[j].z + v[j].w * v[j].w); }
        const float rstd = rsqrtf(wave_sum(ss) * (1.0f / D) + RMS_EPS);
#pragma unroll
        for (int j = 0; j < 4; ++j) {
            const int col = 4 * lane + 256 * j;
            const f32x4 g4 = *(const f32x4*)(g + col), sc = *(const f32x4*)(modl + (size_t)b * 9216 + isc * 1024 + col), sh = *(const f32x4*)(modl + (size_t)b * 9216 + ish * 1024 + col);
            const f32x4 y = (v[j] * rstd) * g4 * (sc + 1.0f) + sh;
            u32x2 w; w.x = cvtpk(y.x, y.y); w.y = cvtpk(y.z, y.w);
            *(u32x2*)(out + (size_t)row * D + col) = w;
        }
    }
}
__device__ __forceinline__ void final_norm_block(float* X, const float* g, int row0) {
    const int tid = opq(get_tid()), lane = tid & 63, wid = __builtin_amdgcn_readfirstlane(tid >> 6);
#pragma unroll 1
    for (int rr = 0; rr < 8; ++rr) {
        const int row = row0 + rr * 8 + wid;
        f32x4* xr = (f32x4*)(X + (size_t)row * D) + lane;
        f32x4 v[4]; float ss = 0.f;
#pragma unroll
        for (int j = 0; j < 4; ++j) { v[j] = xr[64 * j]; ss += (v[j].x * v[j].x + v[j].y * v[j].y) + (v[j].z * v[j].z + v[j].w * v[j].w); }
        const float rstd = rsqrtf(wave_sum(ss) * (1.0f / D) + RMS_EPS);
#pragma unroll
        for (int j = 0; j < 4; ++j) { const f32x4 g4 = *(const f32x4*)(g + 4 * lane + 256 * j); xr[64 * j] = (v[j] * rstd) * g4; }
    }
}
struct CountedOrder : pg8::StaticOrder {
    unsigned* cnt;
    __device__ __forceinline__ void done(const pg8::Unit& u) const {
        __builtin_amdgcn_fence(__ATOMIC_RELEASE, "agent");
        if ((get_tid() & 63) == 0) __hip_atomic_fetch_add(cnt + u.pm, 1u, __ATOMIC_RELAXED, __HIP_MEMORY_SCOPE_AGENT);
    }
};
__device__ __forceinline__ void panel_wait(unsigned* cnt, int pm) {
    if (get_tid() == 0) {
        unsigned sp = 0;
        while (__hip_atomic_load(cnt + pm, __ATOMIC_RELAXED, __HIP_MEMORY_SCOPE_AGENT) < 32u) { __builtin_amdgcn_s_sleep(2); if (++sp > (1u << 22)) break; }
    }
    __syncthreads();
    __builtin_amdgcn_fence(__ATOMIC_ACQUIRE, "agent");
}

__device__ __forceinline__ void kpe_unit(const Args& A, int unit) {
    const int tid = opq(get_tid());
    unsigned char* w_ = ws_opq(A.ws);
    const bf16_t* P = (const bf16_t*)(w_ + WS_U); bf16_t* KPE = (bf16_t*)(w_ + WS_KPE); const float* rope = (const float*)(w_ + WS_ROPE);
#pragma unroll 2
    for (int k = 0; k < 8; ++k) {
        const int e = unit * 4096 + k * 512 + tid;
        const int row = e >> 4, i = e & 15, t = row & (T - 1);
        const float x0 = bf2f((short)P[(size_t)row * DINP + C_BKR + i]), x1 = bf2f((short)P[(size_t)row * DINP + C_BKR + 16 + i]);
        const float c = rope[t * 16 + i], sn = rope[T * 16 + t * 16 + i];
        KPE[(size_t)row * 32 + i] = (bf16_t)(cvtpk(x0 * c - x1 * sn, 0.f) & 0xffffu);
        KPE[(size_t)row * 32 + 16 + i] = (bf16_t)(cvtpk(x1 * c + x0 * sn, 0.f) & 0xffffu);
    }
}

constexpr int CTL_KN = 128;
__device__ __forceinline__ void kn_rows(const Args& A, int l) {
    const int tid = opq(get_tid()), lane = tid & 63, wid = __builtin_amdgcn_readfirstlane(tid >> 6), gw = blockIdx.x * NWAVE + wid, ngw = gridDim.x * NWAVE;
    unsigned char* w_ = ws_opq(A.ws);
    const bf16_t* P = (const bf16_t*)(w_ + WS_U); unsigned* kn = (unsigned*)(w_ + WS_CTL) + CTL_KN + l * 48;
    const int col2 = lane < 32 ? C_KS + 4 * lane : C_KW + 4 * (lane - 32);
    for (int it = gw; it < M / 16; it += ngw) {
        float m1 = 0.f, m2 = 0.f;
#pragma unroll 4
        for (int rr = 0; rr < 16; ++rr) {
            const bf16_t* rp = P + (size_t)(it * 16 + rr) * DINP;
            const s16x4 v1 = *(const s16x4*)(rp + C_AK + 4 * lane), v2 = *(const s16x4*)(rp + col2);
            float s1 = 0.f, s2 = 0.f;
#pragma unroll
            for (int j = 0; j < 4; ++j) { const float x = bf2f(v1[j]), y = bf2f(v2[j]); s1 += x * x; s2 += y * y; }
            s1 += __shfl_xor(s1, 1); s1 += __shfl_xor(s1, 2); s1 += __shfl_xor(s1, 4);
            s2 += __shfl_xor(s2, 1); s2 += __shfl_xor(s2, 2); s2 += __shfl_xor(s2, 4); s2 += __shfl_xor(s2, 8);
            m1 = fmaxf(m1, s1); m2 = fmaxf(m2, s2);
        }
        const int b = (it * 16) >> 12;
        if ((lane & 7) == 0) atomicMax(kn + b * 12 + (lane >> 3), __float_as_uint(m1));
        if ((lane & 15) == 0) atomicMax(kn + b * 12 + (lane < 32 ? 10 + (lane >> 4) : 8 + ((lane - 32) >> 4)), __float_as_uint(m2));
    }
}
#define XB_TMO      128
#define XB_XCNT(j)  (256  + 64 * (j))
#define XB_XSUB(j)  (1280 + 64 * (j))
#define XB_XGEN(j)  (2304 + 64 * (j))
#define XB_TOP      3328
#define XB_TOPGEN   3392
#define XCD_BAR_WORDS 3456
#define XB_SPIN_CAP (1u << 18)

__device__ __forceinline__ unsigned xb_ld(unsigned* p)              { return __hip_atomic_load(p, __ATOMIC_RELAXED, __HIP_MEMORY_SCOPE_AGENT); }
__device__ __forceinline__ unsigned xb_add(unsigned* p, unsigned v) { return __hip_atomic_fetch_add(p, v, __ATOMIC_RELAXED, __HIP_MEMORY_SCOPE_AGENT); }
__device__ __forceinline__ unsigned xb_xcc_id() { return (unsigned)__builtin_amdgcn_s_getreg((3 << 11) | 20) & 0xFu; }
#define XB_SPIN(cond, bar) do { unsigned _sp = 0; while (cond) { __builtin_amdgcn_s_sleep(1); \
    if ((++_sp & 255u) == 0u) { if (xb_ld(&(bar)[XB_TMO])) break; if (_sp > XB_SPIN_CAP) { atomicAdd(&(bar)[XB_TMO], 1u); break; } } } } while (0)

struct XcdBarrier {
    unsigned* bar; unsigned x;
    volatile LAS unsigned* st;
};

__device__ __forceinline__ XcdBarrier xcd_barrier_post(unsigned* bar, volatile LAS unsigned* st) {
    XcdBarrier b; b.bar = bar; b.x = xb_xcc_id(); b.st = st;
    if (get_tid() == 0) (void)xb_add(&bar[XB_XCNT(b.x)], 1u);
    return b;
}
__device__ __forceinline__ void xcd_barrier_complete(unsigned* bar, unsigned x, unsigned& nloc, unsigned& nx) {
    const unsigned G = gridDim.x * gridDim.y * gridDim.z;
    unsigned sum, cnt, mine, sp = 0u;
    for (;;) {
        sum = 0u; cnt = 0u; mine = 0u;
#pragma unroll
        for (unsigned j = 0; j < 16; ++j) { const unsigned c = xb_ld(&bar[XB_XCNT(j)]); sum += c; cnt += (c > 0u) ? 1u : 0u; mine = (j == x) ? c : mine; }
        if (sum == G) break;
        __builtin_amdgcn_s_sleep(1);
        if ((++sp & 255u) == 0u) { if (xb_ld(&bar[XB_TMO])) break; if (sp > XB_SPIN_CAP) { atomicAdd(&bar[XB_TMO], 1u); break; } }
    }
    nloc = mine > 0u ? mine : 1u; nx = cnt > 0u ? cnt : 1u;
}

__device__ __forceinline__ void xcd_barrier(const XcdBarrier& b) {
    asm volatile("s_waitcnt vmcnt(0)" ::: "memory");
    __syncthreads();
    if (get_tid() == 0) {
        unsigned* bar = b.bar;
        __builtin_amdgcn_s_waitcnt(0);
        unsigned nloc = b.st[0], nx = b.st[1];
        if (nloc == 0u) { xcd_barrier_complete(bar, b.x, nloc, nx); b.st[0] = nloc; b.st[1] = nx; }
        const unsigned old = xb_add(&bar[XB_XSUB(b.x)], 1u);
        const unsigned gen = old / nloc;
        if (old + 1u == (gen + 1u) * nloc) {
            __builtin_amdgcn_fence(__ATOMIC_RELEASE, "agent");
            asm volatile("s_waitcnt vmcnt(0)" ::: "memory");
            const unsigned og = xb_add(&bar[XB_TOP], 1u);
            const unsigned tg = og / nx;
            if (og + 1u == (tg + 1u) * nx) xb_add(&bar[XB_TOPGEN], 1u);
            else XB_SPIN(xb_ld(&bar[XB_TOPGEN]) == tg, bar);
            __builtin_amdgcn_fence(__ATOMIC_ACQUIRE, "agent");
            xb_add(&bar[XB_XGEN(b.x)], 1u);
            asm volatile("s_waitcnt vmcnt(0)" ::: "memory");
        } else {
            XB_SPIN(xb_ld(&bar[XB_XGEN(b.x)]) == gen, bar);
            __builtin_amdgcn_fence(__ATOMIC_ACQUIRE, "agent");
            asm volatile("s_waitcnt vmcnt(0)" ::: "memory");
        }
    }
    __syncthreads();
}

struct AttnArgs {
    const bf16_t* Q; int qpitch;
    const bf16_t* K1; int k1pitch;
    const bf16_t* K2; int k2pitch;
    const bf16_t* V; int vpitch;
    const float* rope;
    const unsigned long long* sel;
    float scale2, slope2; int window;
    float kmax;
};
constexpr int ATT_K_OFF = 0, ATT_V_OFF = 16384, ATT_BUF = 24576;

__device__ __forceinline__ s16x4 vtr(const LAS unsigned char* p) {
    typedef short v4i16_t __attribute__((ext_vector_type(4)));
    return __builtin_bit_cast(s16x4, __builtin_amdgcn_ds_read_tr16_b64_v4i16((LAS v4i16_t*)p));
}
template <bool ROWSUM> __device__ __forceinline__ void pv_tile_t(f32x16 (&o)[2], f32x16& osum, const f32x16& p0, const f32x16& p1, const LAS unsigned char* vl, int lane) {
    const int h = lane >> 5, i16 = lane & 15, q4 = i16 >> 2, p4 = i16 & 3, blk = (lane >> 4) & 1;
    const unsigned onew = ((lane & 31) == 0) ? 0x3f803f80u : 0u;
    const bf16x8 ones = __builtin_bit_cast(bf16x8, (u32x4){onew, onew, onew, onew});
    const LAS unsigned char* vb = vl + (4 * h + q4) * 64 + blk * 32 + p4 * 8;
#pragma unroll
    for (int s = 0; s < 4; ++s) {
        u32x4 pw;
        if (s == 0) { pw.x = cvtpk(p0[0], p0[1]); pw.y = cvtpk(p0[2], p0[3]); pw.z = cvtpk(p0[4], p0[5]); pw.w = cvtpk(p0[6], p0[7]); }
        else if (s == 1) { pw.x = cvtpk(p0[8], p0[9]); pw.y = cvtpk(p0[10], p0[11]); pw.z = cvtpk(p0[12], p0[13]); pw.w = cvtpk(p0[14], p0[15]); }
        else if (s == 2) { pw.x = cvtpk(p1[0], p1[1]); pw.y = cvtpk(p1[2], p1[3]); pw.z = cvtpk(p1[4], p1[5]); pw.w = cvtpk(p1[6], p1[7]); }
        else { pw.x = cvtpk(p1[8], p1[9]); pw.y = cvtpk(p1[10], p1[11]); pw.z = cvtpk(p1[12], p1[13]); pw.w = cvtpk(p1[14], p1[15]); }
        const bf16x8 pf = __builtin_bit_cast(bf16x8, pw);
#pragma unroll
        for (int db = 0; db < 2; ++db) {
            const s16x4 lo = vtr(vb + db * 4096 + (16 * s) * 64), hi = vtr(vb + db * 4096 + (16 * s + 8) * 64);
            const bf16x8 vf = __builtin_shufflevector(lo, hi, 0, 1, 2, 3, 4, 5, 6, 7);
            o[db] = MFMA32(vf, pf, o[db]);
        }
        if (ROWSUM) osum = MFMA32(ones, pf, osum);
    }
}
__device__ __forceinline__ void pv_tile(f32x16 (&o)[2], const f32x16& p0, const f32x16& p1, const LAS unsigned char* vl, int lane) {
    f32x16 dummy; pv_tile_t<false>(o, dummy, p0, p1, vl, lane);
}
template <int MODE> __device__ __forceinline__ void store_o(const f32x16 (&o)[2], bf16_t* out_row, int h, float sc) {
#pragma unroll
    for (int db = 0; db < 2; ++db)
#pragma unroll
        for (int g4 = 0; g4 < 4; ++g4) {
            bf16_t* p = out_row + 32 * db + 8 * g4 + 4 * h;
            float v0 = o[db][4 * g4] * sc, v1 = o[db][4 * g4 + 1] * sc, v2 = o[db][4 * g4 + 2] * sc, v3 = o[db][4 * g4 + 3] * sc;
            if (MODE == 1) { const u32x2 old = *(const u32x2*)p; v0 += __uint_as_float(old.x << 16); v1 += __uint_as_float(old.x & 0xffff0000u); v2 += __uint_as_float(old.y << 16); v3 += __uint_as_float(old.y & 0xffff0000u); }
            u32x2 w; w.x = cvtpk(v0, v1); w.y = cvtpk(v2, v3);
            *(u32x2*)p = w;
        }
}

constexpr int ATT_FLAG_OFF = 140480;
template <int DQK, bool ROPE, bool SEL, bool DUAL = false, bool EARLY = false>
__device__ __forceinline__ void attn_core(const AttnArgs& a, int q0, LAS unsigned char* lds, f32x16 (&o)[2]) {
    constexpr int KS = DQK / 16, DK = DUAL ? 2 * DQK : DQK, KP = DK * 2 + 16, D1 = DK < 64 ? DK : 64, NCH1 = D1 / 8, QROWS = DUAL ? 128 : 256;
    const int tid = opq(get_tid()), lane = tid & 63, wid = __builtin_amdgcn_readfirstlane(tid >> 6), r = lane & 31, h = lane >> 5;
    const int wq = DUAL ? (wid & 3) : wid, coff = DUAL ? (wid >> 2) * DQK : 0;
    const int qw0 = q0 + 32 * wq, qpos = qw0 + r;
    LAS unsigned char* Kl = lds + ATT_K_OFF; LAS unsigned char* Vl = lds + ATT_V_OFF;
    bf16x8 qf[KS];
    {
        const bf16_t* qrow = a.Q + (size_t)qpos * a.qpitch + coff;
#pragma unroll
        for (int ks = 0; ks < KS; ++ks) qf[ks] = *(const bf16x8*)(qrow + 16 * ks + 8 * h);
        if (ROPE) {
            const float* cs = a.rope + (size_t)qpos * 16 + 8 * h; const float* sn = cs + T * 16;
            float y0[8], y1[8];
#pragma unroll
            for (int j = 0; j < 8; ++j) { const float x0 = bf2f(qf[KS - 2][j]), x1 = bf2f(qf[KS - 1][j]), c = cs[j], s = sn[j]; y0[j] = x0 * c - x1 * s; y1[j] = x1 * c + x0 * s; }
            u32x4 w0, w1;
            w0.x = cvtpk(y0[0], y0[1]); w0.y = cvtpk(y0[2], y0[3]); w0.z = cvtpk(y0[4], y0[5]); w0.w = cvtpk(y0[6], y0[7]);
            w1.x = cvtpk(y1[0], y1[1]); w1.y = cvtpk(y1[2], y1[3]); w1.z = cvtpk(y1[4], y1[5]); w1.w = cvtpk(y1[6], y1[7]);
            qf[KS - 2] = __builtin_bit_cast(bf16x8, w0); qf[KS - 1] = __builtin_bit_cast(bf16x8, w1);
        }
    }
    float qk_bound = 0.f;
    if (EARLY) {
        float qq = 0.f;
#pragma unroll
        for (int ks = 0; ks < KS; ++ks)
#pragma unroll
            for (int j = 0; j < 8; ++j) { const float x = bf2f(qf[ks][j]); qq += x * x; }
        qq += __shfl_xor(qq, 32);
        qk_bound = sqrtf(qq) * a.kmax * a.scale2 * 1.001f + 0.01f;
    }
    unsigned long long selm = ~0ull;
    if (SEL) selm = a.sel[qpos];
    const int t_hi = (q0 + QROWS - 1) >> 6;
    int t_lo = 0;
    if (a.window) { const int lo = q0 - a.window + 1; t_lo = lo > 0 ? (lo >> 6) : 0; }
    const bool kA_on = tid < 64 * NCH1; const int rowA = tid / NCH1, chA = tid % NCH1;
    const bool kB_on = ROPE && tid < 128; const int rowB = tid >> 1, prB = tid & 1;
    const int rowV = tid >> 3, chV = tid & 7;
    u32x4 kA = {0, 0, 0, 0}, kB0 = {0, 0, 0, 0}, kB1 = {0, 0, 0, 0}, vR = {0, 0, 0, 0};
#define ATT_PREFETCH(t) do { \
        if (kA_on) kA = *(const u32x4*)(a.K1 + (size_t)(64 * (t) + rowA) * a.k1pitch + chA * 8); \
        if (kB_on) { const bf16_t* kp = a.K2 + (size_t)(64 * (t) + rowB) * a.k2pitch + prB * 8; kB0 = *(const u32x4*)kp; kB1 = *(const u32x4*)(kp + 16); } \
        vR = *(const u32x4*)(a.V + (size_t)(64 * (t) + rowV) * a.vpitch + chV * 8); } while (0)
#define ATT_STORE(tt, KL, VL) do { \
        if (kA_on) *(LAS u32x4*)((KL) + rowA * KP + chA * 16) = kA; \
        if (ROPE) { if (kB_on) { \
                *(LAS u32x4*)((KL) + rowB * KP + (64 + prB * 8) * 2) = kB0; \
                *(LAS u32x4*)((KL) + rowB * KP + (80 + prB * 8) * 2) = kB1; } } \
        *(LAS u32x4*)((VL) + (chV >> 2) * 4096 + rowV * 64 + (chV & 3) * 16) = vR; } while (0)
    float m = NEGBIG;
    f32x16 osum;
#pragma unroll
    for (int i = 0; i < 16; ++i) { o[0][i] = 0.f; o[1][i] = 0.f; osum[i] = 0.f; }
    float cbv[16];
#pragma unroll
    for (int i = 0; i < 16; ++i) cbv[i] = a.slope2 * (float)((i & 3) + 8 * (i >> 2) + 4 * h);
    volatile LAS unsigned* eflag = (volatile LAS unsigned*)(lds + ATT_FLAG_OFF);
    unsigned long long um = (t_hi >= 63 ? ~0ull : ((1ull << (t_hi + 1)) - 1ull)) & ~((1ull << t_lo) - 1ull);
    if (SEL) {
        LAS unsigned* uw = (LAS unsigned*)(lds + ATT_FLAG_OFF + 64);
        __syncthreads();
        if (tid < 2) uw[tid] = 0u;
        __syncthreads();
        __hip_atomic_fetch_or(uw, (unsigned)selm, __ATOMIC_RELAXED, __HIP_MEMORY_SCOPE_WORKGROUP);
        __hip_atomic_fetch_or(uw + 1, (unsigned)(selm >> 32), __ATOMIC_RELAXED, __HIP_MEMORY_SCOPE_WORKGROUP);
        __syncthreads();
        const unsigned lo_ = (unsigned)__builtin_amdgcn_readfirstlane((int)uw[0]), hi_ = (unsigned)__builtin_amdgcn_readfirstlane((int)uw[1]);
        um &= ((unsigned long long)hi_ << 32) | (unsigned long long)lo_;
    }
#define ATT_NEXT(tt) ((((tt) > 0) && (um & ((1ull << (tt)) - 1ull))) ? 63 - __builtin_clzll(um & ((1ull << (tt)) - 1ull)) : -1)
    int t = 63 - __builtin_clzll(um);
    int t1 = ATT_NEXT(t);
    ATT_PREFETCH(t);
    if (EARLY) { if (lane == 0) { eflag[wid] = 0u; eflag[8 + wid] = 0u; } }
    __syncthreads();
    ATT_STORE(t, Kl, Vl);
    __syncthreads();
    if (t1 >= 0) ATT_PREFETCH(t1);
    for (int step = 0; t >= 0; ++step) {
        const int cur = step & 1;
        const int t2 = (t1 >= 0) ? ATT_NEXT(t1) : -1;
        const LAS unsigned char* Kc = Kl + cur * ATT_BUF; const LAS unsigned char* Vc = Vl + cur * ATT_BUF;
        bool need = (64 * t <= qw0 + 31);
        if (a.window) need = need && (64 * t + 63 >= qw0 - a.window + 1);
        const bool selbit = SEL ? (((selm >> t) & 1ull) != 0ull) : true;
        if (SEL) need = need && (__ballot(selbit) != 0ull);
        if (need) {
            f32x16 p0, p1;
#pragma unroll
            for (int i = 0; i < 16; ++i) { p0[i] = 0.f; p1[i] = 0.f; }
#pragma unroll
            for (int ks = 0; ks < KS; ++ks) {
                const bf16x8 a0 = *(const LAS bf16x8*)(Kc + r * KP + coff * 2 + ks * 32 + h * 16);
                const bf16x8 a1 = *(const LAS bf16x8*)(Kc + (32 + r) * KP + coff * 2 + ks * 32 + h * 16);
                p0 = MFMA32(a0, qf[ks], p0); p1 = MFMA32(a1, qf[ks], p1);
            }
            if (!ROPE) {
#pragma unroll
                for (int i = 0; i < 16; ++i) { p0[i] = p0[i] * a.scale2 + cbv[i]; p1[i] = p1[i] * a.scale2 + cbv[i]; }
            }
            const float base0 = a.slope2 * (float)(64 * t - qpos), base1 = base0 + 32.0f * a.slope2;
            bool bnd = (64 * t + 63 > qw0);
            if (a.window) bnd = bnd || (64 * t < qw0 + 31 - a.window + 1);
            if (SEL) bnd = bnd || (__ballot(!selbit) != 0ull);
            if (bnd) {
                const int wlim = a.window ? a.window : (1 << 30);
#pragma unroll
                for (int i = 0; i < 16; ++i) {
                    const int kv0 = 64 * t + crow(i, h), d0 = qpos - kv0, d1 = d0 - 32;
                    const bool ok0 = selbit && d0 >= 0 && d0 < wlim, ok1 = selbit && d1 >= 0 && d1 < wlim;
                    p0[i] = ok0 ? p0[i] : NEGBIG; p1[i] = ok1 ? p1[i] : NEGBIG;
                }
            }
            float mx0 = p0[0], mx1 = p1[0];
#pragma unroll
            for (int i = 1; i < 16; ++i) { mx0 = fmaxf(mx0, p0[i]); mx1 = fmaxf(mx1, p1[i]); }
            float mloc = ROPE ? fmaxf(mx0, mx1) * a.scale2 : fmaxf(mx0 + base0, mx1 + base1);
            mloc = fmaxf(mloc, __shfl_xor(mloc, 32));
            const float mnew = fmaxf(m, mloc);
            if (__ballot(mnew > m) != 0ull) {
                const float alpha = fast_exp2(m - mnew);
                osum[0] *= alpha;
#pragma unroll
                for (int i = 0; i < 16; ++i) { o[0][i] *= alpha; o[1][i] *= alpha; }
            }
            m = mnew;
            const float r0 = mnew - base0, r1 = mnew - base1;
            if (ROPE) {
#pragma unroll
                for (int i = 0; i < 16; ++i) { p0[i] = fast_exp2(p0[i] * a.scale2 - mnew); p1[i] = fast_exp2(p1[i] * a.scale2 - mnew); }
            } else {
#pragma unroll
                for (int i = 0; i < 16; ++i) { p0[i] = fast_exp2(p0[i] - r0); p1[i] = fast_exp2(p1[i] - r1); }
            }
            pv_tile_t<true>(o, osum, p0, p1, Vc, lane);
        }
        if (EARLY) {
            const bool live = !(qk_bound - a.slope2 * (float)(qpos - 64 * t + 1) - m < -64.0f);
            const bool wdone = (__ballot(live) == 0ull);
            if (lane == 0) eflag[8 * cur + wid] = wdone ? 1u : 0u;
        }
        if (t1 >= 0) ATT_STORE(t1, Kl + (cur ^ 1) * ATT_BUF, Vl + (cur ^ 1) * ATT_BUF);
        __syncthreads();
        if (EARLY) {
            const unsigned alld = eflag[8 * cur] & eflag[8 * cur + 1] & eflag[8 * cur + 2] & eflag[8 * cur + 3] & eflag[8 * cur + 4] & eflag[8 * cur + 5] & eflag[8 * cur + 6] & eflag[8 * cur + 7];
            if (__builtin_amdgcn_readfirstlane((int)alld) != 0) break;
        }
        if (t2 >= 0) ATT_PREFETCH(t2);
        t = t1; t1 = t2;
    }
#undef ATT_NEXT
#undef ATT_STORE
#undef ATT_PREFETCH
    const float lt = __shfl(osum[0], lane & 31);
    const float inv = 1.0f / lt;
#pragma unroll
    for (int i = 0; i < 16; ++i) { o[0][i] *= inv; o[1][i] *= inv; }
}

__device__ __forceinline__ float da_slope(int hd) { return hd == 0 ? 0.25f : hd == 1 ? 0.0625f : hd == 2 ? 0.015625f : 0.00390625f; }
__device__ __forceinline__ float nsa_slope(int hh) { return hh == 0 ? 0.25f : hh == 1 ? 0.0625f : hh == 2 ? 0.015625f : hh == 3 ? 0.00390625f : hh == 4 ? 0.5f : 0.125f; }

constexpr int DA_X_OFF = 49152;
__device__ __forceinline__ void da_unit(const Args& A, int l, int b, int hd, int qb, LAS unsigned char* lds) {
    const int tid_ = opq(get_tid()), lane = tid_ & 63, wid = __builtin_amdgcn_readfirstlane(tid_ >> 6), r = lane & 31, h = lane >> 5;
    const bf16_t* P = (const bf16_t*)(A.ws + WS_U) + (size_t)b * T * DINP;
    const float lam = ((const float*)(A.ws + WS_CTL))[64 + l];
    const float one_m_li = ((const float*)(A.ws + WS_CTL))[66 + l];
    f32x16 o[2];
    AttnArgs a; a.Q = P + C_AQ + hd * 64; a.qpitch = DINP; a.K1 = P + C_AK + hd * 64; a.k1pitch = DINP; a.K2 = nullptr; a.k2pitch = 0;
    a.V = P + C_AV + hd * 64; a.vpitch = DINP; a.rope = nullptr; a.sel = nullptr; a.scale2 = 0.17677669529663687f * LOG2E; a.slope2 = da_slope(hd) * LOG2E; a.window = 0;
    { const unsigned* kn = (const unsigned*)(A.ws + WS_CTL) + CTL_KN + l * 48 + b * 12 + 2 * hd; a.kmax = sqrtf(fmaxf(__uint_as_float(kn[0]), __uint_as_float(kn[1]))); }
    attn_core<32, false, false, true, true>(a, qb * 128, lds, o);
    LAS float* xb = (LAS float*)(lds + DA_X_OFF) + (32 * (wid & 3) + r) * 65;
    if (wid >= 4) {
#pragma unroll
        for (int db = 0; db < 2; ++db)
#pragma unroll
            for (int i = 0; i < 16; ++i) xb[32 * db + crow(i, h)] = o[db][i];
    }
    __syncthreads();
    if (wid < 4) {
        float ss = 0.f;
#pragma unroll
        for (int db = 0; db < 2; ++db)
#pragma unroll
            for (int i = 0; i < 16; ++i) { o[db][i] = o[db][i] - lam * xb[32 * db + crow(i, h)]; ss += o[db][i] * o[db][i]; }
        ss += __shfl_xor(ss, 32);
        const float rs = rsqrtf(ss * (1.0f / 64.0f) + RMS_EPS) * one_m_li;
        const float* sg = A.in[14] + l * 64;
#pragma unroll
        for (int db = 0; db < 2; ++db)
#pragma unroll
            for (int i = 0; i < 16; ++i) o[db][i] *= rs * sg[32 * db + crow(i, h)];
        bf16_t* orow = (bf16_t*)(A.ws + WS_XN) + (size_t)(b * T + qb * 128 + 32 * wid + r) * D + hd * 64;
        store_o<0>(o, orow, h, EN_DA ? 1.0f : 0.0f);
    }
}
__device__ __forceinline__ void mla_unit(const Args& A, int b, int hd, int qb, LAS unsigned char* lds) {
    const int tid_ = opq(get_tid()), lane = tid_ & 63, wid = __builtin_amdgcn_readfirstlane(tid_ >> 6), r = lane & 31, h = lane >> 5;
    AttnArgs a; a.Q = (const bf16_t*)(A.ws + WS_MQ) + (size_t)b * T * 768 + hd * 96; a.qpitch = 768;
    a.K1 = (const bf16_t*)(A.ws + WS_MKV) + (size_t)b * T * 768 + hd * 128; a.k1pitch = 768;
    a.K2 = (const bf16_t*)(A.ws + WS_KPE) + (size_t)b * T * 32; a.k2pitch = 32;
    a.V = a.K1 + 64; a.vpitch = 768; a.rope = (const float*)(A.ws + WS_ROPE); a.sel = nullptr; a.scale2 = 0.10206207261596575f * LOG2E; a.slope2 = 0.f; a.window = 0; a.kmax = 0.f;
    f32x16 o[2];
    attn_core<96, true, false>(a, qb * 256, lds, o);
    bf16_t* orow = (bf16_t*)(A.ws + WS_XN) + (size_t)(b * T + qb * 256 + 32 * wid + r) * D + 256 + hd * 64;
    store_o<0>(o, orow, h, EN_MLA ? 1.0f : 0.0f);
}
template <int BR> __device__ __forceinline__ void nsa_unit(const Args& A, int l, int b, int hh, int qb, LAS unsigned char* lds) {
    const int tid_ = opq(get_tid()), lane = tid_ & 63, wid = __builtin_amdgcn_readfirstlane(tid_ >> 6), r = lane & 31, h = lane >> 5, g = hh / 3;
    const bf16_t* P = (const bf16_t*)(A.ws + WS_U) + (size_t)b * T * DINP;
    AttnArgs a; a.Q = P + C_CQ + hh * 64; a.qpitch = DINP; a.K1 = P + (BR == 2 ? C_KW : C_KS) + g * 64; a.k1pitch = DINP; a.K2 = nullptr; a.k2pitch = 0;
    a.V = P + (BR == 2 ? C_VW : C_VS) + g * 64; a.vpitch = DINP; a.rope = nullptr; a.sel = (const unsigned long long*)(A.ws + WS_SEL) + (size_t)(b * 2 + g) * T;
    a.scale2 = 0.125f * LOG2E; a.slope2 = nsa_slope(hh) * LOG2E; a.window = (BR == 2) ? 512 : 0;
    f32x16 o[2];
    a.kmax = sqrtf(__uint_as_float(((const unsigned*)(A.ws + WS_CTL))[CTL_KN + l * 48 + b * 12 + (BR == 2 ? 8 : 10) + g]));
    attn_core<64, false, BR == 1, false, true>(a, qb * 256, lds, o);
    const int qpos = qb * 256 + 32 * wid + r;
    const float gl = bf2f((short)P[(size_t)qpos * DINP + C_G + BR * 6 + hh]);
    bf16_t* orow = (bf16_t*)(A.ws + WS_XN) + (size_t)(b * T + qpos) * D + 640 + hh * 64;
    if (BR == 2) store_o<0>(o, orow, h, EN_WIN ? sigmoid_f(gl) : 0.0f);
    else store_o<1>(o, orow, h, EN_SLC ? sigmoid_f(gl) : 0.0f);
}

__device__ __forceinline__ void cmp_mlp_task(const Args& A, int l, int wt, LAS unsigned char* lds) {
    const int tid_ = opq(get_tid()), lane = tid_ & 63, wid = __builtin_amdgcn_readfirstlane(tid_ >> 6);
    const int kv = wt >> 7, bg = (wt >> 4) & 7, rg = wt & 15, b = bg >> 1, g = bg & 1, i16 = lane & 15, quad = lane >> 4;
    const bf16_t* P = (const bf16_t*)(A.ws + WS_U) + (size_t)b * T * DINP + (kv ? C_VC : C_KC) + g * 64;
    const bf16_t* W1 = (const bf16_t*)(A.ws + WS_W + W_C1) + (size_t)kv * 128 * 2048;
    const bf16_t* W2 = (const bf16_t*)(A.ws + WS_W + W_C2) + (size_t)kv * 64 * 128;
    const float* posb = (const float*)(A.ws + WS_POSB) + (l * 2 + kv) * 128;
    const int n = 16 * rg + i16;
    const bf16_t* arow = P + (size_t)(16 * n) * DINP + 8 * quad;
    const bf16_t* wrow1 = W1 + (size_t)i16 * 2048 + 8 * quad;
    f32x4 acc[8];
#pragma unroll
    for (int i = 0; i < 8; ++i) acc[i] = (f32x4){0.f, 0.f, 0.f, 0.f};
#pragma unroll 2
    for (int kk = 0; kk < 8; ++kk) {
        const int ks = 8 * wid + kk;
        const bf16x8 bfrag = *(const bf16x8*)(arow + (size_t)(ks >> 1) * DINP + 32 * (ks & 1));
#pragma unroll
        for (int ht = 0; ht < 8; ++ht) {
            const bf16x8 afrag = *(const bf16x8*)(wrow1 + (size_t)(16 * ht) * 2048 + 32 * ks);
            acc[ht] = MFMA16(afrag, bfrag, acc[ht]);
        }
    }
    {
        LAS float* red = (LAS float*)lds;
        if (wid > 0) {
#pragma unroll
            for (int ht = 0; ht < 8; ++ht)
#pragma unroll
                for (int j = 0; j < 4; ++j) red[(wid * 64 + lane) * 33 + ht * 4 + j] = acc[ht][j];
        }
        __syncthreads();
        if (wid > 0) return;
#pragma unroll 1
        for (int w = 1; w < 8; ++w)
#pragma unroll
            for (int ht = 0; ht < 8; ++ht)
#pragma unroll
                for (int j = 0; j < 4; ++j) acc[ht][j] += red[(w * 64 + lane) * 33 + ht * 4 + j];
    }
    bf16x8 hf[4];
#pragma unroll
    for (int ks2 = 0; ks2 < 4; ++ks2) {
        float v[8];
#pragma unroll
        for (int e = 0; e < 8; ++e) {
            const int ht = 2 * ks2 + (e >> 2), j = e & 3;
            const float x = acc[ht][j] + posb[16 * ht + 4 * quad + j];
            const float u2 = 0.7978845608028654f * (x + 0.044715f * x * x * x);
            const float ex = fast_exp2(2.0f * LOG2E * u2);
            const float th = 1.0f - 2.0f * fast_rcp(ex + 1.0f);
            v[e] = 0.5f * x * (1.0f + th);
        }
        u32x4 w; w.x = cvtpk(v[0], v[1]); w.y = cvtpk(v[2], v[3]); w.z = cvtpk(v[4], v[5]); w.w = cvtpk(v[6], v[7]);
        hf[ks2] = __builtin_bit_cast(bf16x8, w);
    }
    bf16_t* outp = (bf16_t*)(A.ws + WS_KCMP) + ((size_t)(kv * 8 + bg) * 256 + n) * 64;
#pragma unroll
    for (int ot = 0; ot < 4; ++ot) {
        f32x4 c2 = (f32x4){0.f, 0.f, 0.f, 0.f};
        const bf16_t* w2r = W2 + (size_t)(16 * ot + i16) * 128 + 4 * quad;
#pragma unroll
        for (int ks2 = 0; ks2 < 4; ++ks2) {
            const u32x2 lo = *(const u32x2*)(w2r + 32 * ks2), hi = *(const u32x2*)(w2r + 32 * ks2 + 16);
            u32x4 w; w.x = lo.x; w.y = lo.y; w.z = hi.x; w.w = hi.y;
            c2 = MFMA16(__builtin_bit_cast(bf16x8, w), hf[ks2], c2);
        }
        if (n < 255) { u32x2 w; w.x = cvtpk(c2[0], c2[1]); w.y = cvtpk(c2[2], c2[3]); *(u32x2*)(outp + 16 * ot + 4 * quad) = w; }
    }
}

constexpr int CMP_K_OFF = 0, CMP_V_OFF = 36864, CMP_IMP_OFF = 69632;
__device__ __forceinline__ void cmp_unit(const Args& A, int b, int g, int qb, LAS unsigned char* lds, float gmul = 1.0f) {
    const int tid = opq(get_tid()), lane = tid & 63, wid = __builtin_amdgcn_readfirstlane(tid >> 6), r = lane & 31, h = lane >> 5;
    const int q0 = qb * 256, qw0 = q0 + 32 * wid, qpos = qw0 + r, qloc = 32 * wid + r;
    const int ntile = (((q0 + 224) >> 4) >> 6) + 1;
    LAS unsigned char* Kl = lds + CMP_K_OFF; LAS unsigned char* Vl = lds + CMP_V_OFF; LAS float* imp = (LAS float*)(lds + CMP_IMP_OFF);
    const bf16_t* KC = (const bf16_t*)(A.ws + WS_KCMP) + (size_t)(b * 2 + g) * 256 * 64;
    const bf16_t* VC = KC + (size_t)8 * 256 * 64;
    __syncthreads();
    for (int idx = tid; idx < 512 * ntile; idx += NTHR) {
        const int n = idx >> 3, ch = idx & 7;
        u32x4 kx = {0, 0, 0, 0}, vx = {0, 0, 0, 0};
        if (n < 255) { kx = *(const u32x4*)(KC + (size_t)n * 64 + ch * 8); vx = *(const u32x4*)(VC + (size_t)n * 64 + ch * 8); }
        *(LAS u32x4*)(Kl + n * 144 + ch * 16) = kx;
        *(LAS u32x4*)(Vl + (n >> 6) * 8192 + (ch >> 2) * 4096 + (n & 63) * 64 + (ch & 3) * 16) = vx;
    }
    for (int idx = tid; idx < 256 * 65; idx += NTHR) imp[idx] = 0.f;
    __syncthreads();
    const bf16_t* P = (const bf16_t*)(A.ws + WS_U) + (size_t)b * T * DINP;
    const float scale2 = 0.125f * LOG2E;
#pragma unroll 1
    for (int rr = 0; rr < 3; ++rr) {
        const int hh = 3 * g + rr; const float slope2 = nsa_slope(hh) * LOG2E;
        bf16x8 qf[4];
        { const bf16_t* qrow = P + (size_t)qpos * DINP + C_CQ + hh * 64;
#pragma unroll
          for (int ks = 0; ks < 4; ++ks) qf[ks] = *(const bf16x8*)(qrow + 16 * ks + 8 * h); }
        float m = NEGBIG, lsum = 0.f, invl = 0.f;
        f32x16 o[2];
#pragma unroll
        for (int i = 0; i < 16; ++i) { o[0][i] = 0.f; o[1][i] = 0.f; }
#pragma unroll 1
        for (int pass = 0; pass < 2; ++pass) {
#pragma unroll 1
            for (int tt = 0; tt < ntile; ++tt) {
                if (16 * (64 * tt) + 31 > qw0 + 31) continue;
                f32x16 p0, p1;
#pragma unroll
                for (int i = 0; i < 16; ++i) { p0[i] = 0.f; p1[i] = 0.f; }
#pragma unroll
                for (int ks = 0; ks < 4; ++ks) {
                    const bf16x8 a0 = *(const LAS bf16x8*)(Kl + (64 * tt + r) * 144 + ks * 32 + h * 16);
                    const bf16x8 a1 = *(const LAS bf16x8*)(Kl + (64 * tt + 32 + r) * 144 + ks * 32 + h * 16);
                    p0 = MFMA32(a0, qf[ks], p0); p1 = MFMA32(a1, qf[ks], p1);
                }
#pragma unroll
                for (int i = 0; i < 16; ++i) {
                    const int n0 = 64 * tt + crow(i, h), d0 = qpos - (16 * n0 + 31), d1 = d0 - 512;
                    p0[i] = d0 >= 0 ? p0[i] * scale2 - slope2 * (float)d0 : NEGBIG;
                    p1[i] = d1 >= 0 ? p1[i] * scale2 - slope2 * (float)d1 : NEGBIG;
                }
                if (pass == 0) {
                    float mloc = fmaxf(p0[0], p1[0]);
#pragma unroll
                    for (int i = 1; i < 16; ++i) mloc = fmaxf(mloc, fmaxf(p0[i], p1[i]));
                    mloc = fmaxf(mloc, __shfl_xor(mloc, 32));
                    const float mnew = fmaxf(m, mloc), alpha = fast_exp2(m - mnew);
                    m = mnew;
                    float ls = 0.f;
#pragma unroll
                    for (int i = 0; i < 16; ++i) ls += fast_exp2(p0[i] - mnew) + fast_exp2(p1[i] - mnew);
                    lsum = lsum * alpha + ls;
                } else {
#pragma unroll
                    for (int i = 0; i < 16; ++i) {
                        p0[i] = p0[i] > -1e29f ? fast_exp2(p0[i] - m) * invl : 0.f;
                        p1[i] = p1[i] > -1e29f ? fast_exp2(p1[i] - m) * invl : 0.f;
                    }
                    pv_tile(o, p0, p1, Vl + tt * 8192, lane);
#pragma unroll
                    for (int blk = 0; blk < 2; ++blk)
#pragma unroll
                        for (int g4 = 0; g4 < 4; ++g4) {
                            const int j = 16 * tt + 8 * blk + 2 * g4 + h;
                            const float G = blk == 0 ? (p0[4 * g4] + p0[4 * g4 + 1]) + (p0[4 * g4 + 2] + p0[4 * g4 + 3]) : (p1[4 * g4] + p1[4 * g4 + 1]) + (p1[4 * g4 + 2] + p1[4 * g4 + 3]);
                            imp[qloc * 65 + j] += G;
                        }
                    asm volatile("s_waitcnt lgkmcnt(0)" ::: "memory");
#pragma unroll
                    for (int blk = 0; blk < 2; ++blk)
#pragma unroll
                        for (int g4 = 0; g4 < 4; ++g4) {
                            const int j = 16 * tt + 8 * blk + 2 * g4 + h;
                            const float Lst = blk == 0 ? p0[4 * g4 + 3] : p1[4 * g4 + 3];
                            if (j + 1 < 64) imp[qloc * 65 + j + 1] += Lst;
                        }
                    asm volatile("s_waitcnt lgkmcnt(0)" ::: "memory");
                }
            }
            if (pass == 0) { const float lt = lsum + __shfl_xor(lsum, 32); invl = (qpos >= 31) ? 1.0f / lt : 0.f; }
        }
        const float gl = bf2f((short)P[(size_t)qpos * DINP + C_G + 0 * 6 + hh]);
        bf16_t* orow = (bf16_t*)(A.ws + WS_XN) + (size_t)(b * T + qpos) * D + 640 + hh * 64;
        store_o<1>(o, orow, h, EN_CMP ? sigmoid_f(gl) * gmul : 0.0f);
    }
    __syncthreads();
    if (qb < 4) {
        if (tid < 256) { const int t = q0 + tid, cur = t >> 6; ((unsigned long long*)(A.ws + WS_SEL))[(size_t)(b * 2 + g) * T + t] = (1ull << (cur + 1)) - 1ull; }
    } else {
        const int qi = tid >> 1, hf = tid & 1, t = q0 + qi, cur = t >> 6;
        float v[32];
#pragma unroll
        for (int i = 0; i < 32; ++i) { const int j = 32 * hf + i; const float x = imp[qi * 65 + j]; v[i] = (j >= 1 && j <= cur - 2) ? x : -1.0f; }
        unsigned long long mask = 1ull | (1ull << cur) | (1ull << (cur - 1));
#pragma unroll 1
        for (int it = 0; it < 13; ++it) {
            float bv = v[0]; int bi = 0;
#pragma unroll
            for (int i = 1; i < 32; ++i) { const bool gt = v[i] > bv; bv = gt ? v[i] : bv; bi = gt ? i : bi; }
            const float ov = __shfl_xor(bv, 1); const int oi = __shfl_xor(bi, 1);
            const float v0 = hf ? ov : bv, v1 = hf ? bv : ov; const int i0 = hf ? oi : bi, i1 = hf ? bi : oi;
            const bool win0 = v0 >= v1;
            const int wj = win0 ? i0 : 32 + i1;
            mask |= 1ull << wj;
            const int clr = (win0 == (hf == 0)) ? (win0 ? i0 : i1) : -1;
#pragma unroll
            for (int i = 0; i < 32; ++i) v[i] = (i == clr) ? -1.0f : v[i];
        }
        if (hf == 0) ((unsigned long long*)(A.ws + WS_SEL))[(size_t)(b * 2 + g) * T + t] = mask;
    }
    __syncthreads();
}

__device__ __forceinline__ int fetch_unit(unsigned* ctr, LAS unsigned char* lds) {
    volatile LAS int* w = (volatile LAS int*)(lds + FETCH_OFF);
    __syncthreads();
    if (get_tid() == 0) *w = (int)atomicAdd(ctr, 1u);
    __syncthreads();
    return __builtin_amdgcn_readfirstlane(*w);
}
template <class Epi>
__device__ __forceinline__ void run_gemm_counted(LAS unsigned char* lds, const bf16_t* Am, const bf16_t* Bt, int N, int K, const Epi& E, unsigned* cnt) {
    pg8::Gemm g{Am, Bt, M, N, K}; CountedOrder S; S.init(M, N, (int)gridDim.x, (int)blockIdx.x); S.cnt = cnt;
    pg8::gemm_phase<Epi, CountedOrder, true, true>(lds, g, S, E);
}
template <class Epi>
__device__ __forceinline__ void run_gemm_small(LAS unsigned char* lds, const bf16_t* Am, const bf16_t* Bt, int N, int K, const Epi& E) {
    asm volatile("" : "+s"(N), "+s"(K));
    pg8::Gemm g{Am, Bt, M, N, K}; pg8::StaticOrder S; S.init(M, N, (int)gridDim.x, (int)blockIdx.x);
    pg8::gemm_phase<Epi, pg8::StaticOrder, true, true>(lds, g, S, E);
}
template <class Epi>
__device__ __forceinline__ void run_gemm(LAS unsigned char* lds, const bf16_t* Am, const bf16_t* Bt, int N, int K, const Epi& E) {
    pg8::Gemm g{Am, Bt, M, N, K}; pg8::StaticOrder S; S.init(M, N, (int)gridDim.x, (int)blockIdx.x);
    pg8::gemm_phase<Epi, pg8::StaticOrder, true, true>(lds, g, S, E);
}

__global__ void __launch_bounds__(NTHR, 2) fwd_megakernel(Args A) {
    LAS unsigned char* lds = (LAS unsigned char*)lds_raw;
    if (lane_id() == 0) *(volatile LAS int*)(lds + WIDTAB_OFF + 4 * hw_slot()) = (int)(threadIdx.x >> 6);
    __syncthreads();
    cg::grid_group grid = cg::this_grid();
    const int G = gridDim.x;
    { volatile LAS unsigned* st0 = (volatile LAS unsigned*)(lds + FETCH_OFF + 16); if (get_tid() < 2) st0[get_tid()] = 0u; }
    __syncthreads();
#ifdef PROBE_PHASE
    if (get_tid() < 32) { volatile LAS unsigned* ta_ = (volatile LAS unsigned*)(lds + 140000); ta_[get_tid()] = 0u; }
    __syncthreads();
    if (get_tid() == 0) { volatile LAS unsigned* ta_ = (volatile LAS unsigned*)(lds + 140000); ta_[31] = (unsigned)__builtin_amdgcn_s_memrealtime(); }
    __syncthreads();
#endif
    const unsigned xbar_x = (unsigned)__builtin_amdgcn_readfirstlane((int)xcd_barrier_post((unsigned*)(A.ws + WS_CTL) + 1024, (volatile LAS unsigned*)(lds + FETCH_OFF + 16)).x);
#ifdef PROBE_PHASE
#define STAMP(id) do { if (blockIdx.x == 0 && get_tid() == 0) { volatile LAS unsigned* ta_ = (volatile LAS unsigned*)(lds + 140000); const unsigned now_ = (unsigned)__builtin_amdgcn_s_memrealtime(); ta_[id] += now_ - ta_[31]; ta_[31] = now_; } } while (0)
#else
#define STAMP(id) do {} while (0)
#endif
#define GSYNC() do { XcdBarrier xb_; unsigned xx_ = xbar_x; asm volatile("" : "+s"(xx_)); xb_.bar = (unsigned*)(A.ws + WS_CTL) + 1024; xb_.x = xx_; \
                     xb_.st = (volatile LAS unsigned*)(lds + FETCH_OFF + 16); xcd_barrier(xb_); } while (0)
    unsigned char* ws = A.ws;
    unsigned* ctl = (unsigned*)(ws + WS_CTL);
    float* X = A.out;
    bf16_t* XN = (bf16_t*)(ws + WS_XN);
    bf16_t* U = (bf16_t*)(ws + WS_U);
    const float* mods = (const float*)(ws + WS_MODS);

    for (int task = blockIdx.x; task < 288; task += G) mods_task(A, task, lds);
    for (int task = G - 1 - (int)blockIdx.x; task < 64; task += G) posb_task(A, task, lds);
    rope_entries(A);
    { float* ssq = (float*)(ws + WS_SSQ); for (int i = blockIdx.x * NTHR + opq(get_tid()); i < 4 * M; i += G * NTHR) ssq[i] = 0.f; }
    if (blockIdx.x == 0 && get_tid() < 2) {
        const int tid = opq(get_tid());
        const float* lp = A.in[13] + tid * 128; float s1 = 0.f, s2 = 0.f;
        for (int i = 0; i < 32; ++i) { s1 += lp[i] * lp[32 + i]; s2 += lp[64 + i] * lp[96 + i]; }
        const float lam_init = tid == 0 ? 0.2f : 0.35550907f;
        ((float*)ctl)[64 + tid] = expf(s1) - expf(s2) + lam_init;
        ((float*)ctl)[66 + tid] = 1.0f - lam_init;
    }
    __syncthreads();
    convert_layer(A, 0, lds);
#ifdef PROBE_DUPCVT
    for (int i = 0; i < PROBE_DUPCVT; ++i) { __syncthreads(); convert_layer(A, 0, lds); }
#endif
#ifdef PROBE_DUPMODS
    for (int task = blockIdx.x; task < 288; task += G) mods_task(A, task, lds);
#endif
    grid.sync();
    STAMP(0);

    if (blockIdx.x == 0) posb_final(A);
#pragma unroll 1
    for (int l = 0; l < 2; ++l) {
        const float* modl = mods + (size_t)l * 4 * 9216;
        unsigned char* wb = ws + WS_W;
        if (l == 1) { __syncthreads(); convert_layer(A, 1, lds); }
#pragma unroll 1
        for (int s = 0; s < 2; ++s) {
            const float* xin = (l == 0 && s == 0) ? A.in[0] : X;
            norm_rows(xin, XN, A.in[s == 0 ? 4 : 6] + l * D, modl, s == 0 ? 0 : 6, s == 0 ? 1 : 7);
            GSYNC();
            STAMP(1);
            { EpiSwiGLU E{U}; run_gemm(lds, XN, (const bf16_t*)(wb + (s == 0 ? W_1A : W_2A)), F2, D, E); }
            GSYNC();
            STAMP(2);
            { EpiResid E{xin, X, modl + (s == 0 ? 2 : 8) * 1024, 0.5f}; run_gemm(lds, U, (const bf16_t*)(wb + (s == 0 ? W_1B : W_2B)), D, F, E); }
            GSYNC();
            STAMP(3);
            if (s == 0 && EN_MIX) {
                norm_rows(X, XN, A.in[5] + l * D, modl, 3, 4);
                GSYNC();
                STAMP(4);
                float* ssq = (float*)(ws + WS_SSQ) + (size_t)l * 2 * M;
                { EpiProj E{U, (bf16_t*)(ws + WS_CQ), (bf16_t*)(ws + WS_CKV), ssq, ssq + M}; run_gemm(lds, XN, (const bf16_t*)(wb + W_IN), DINP, D, E); }
                GSYNC();
                STAMP(5);
                kn_rows(A, l);
                GSYNC();
                STAMP(12);
                { EpiRowScale E{(bf16_t*)(ws + WS_MQ), 768, ssq, 1.0f / 256.0f}; run_gemm_small(lds, (const bf16_t*)(ws + WS_CQ), (const bf16_t*)(wb + W_UQ), 768, 256, E); }
                { EpiRowScale E{(bf16_t*)(ws + WS_MKV), 768, ssq + M, 1.0f / 128.0f}; run_gemm_small(lds, (const bf16_t*)(ws + WS_CKV), (const bf16_t*)(wb + W_UKV), 768, 128, E); }
                STAMP(11);
                for (;;) {
                    int u = fetch_unit(ctl + l * 4 + 0, lds);
                    if (u >= 64 + 256 + 512 + 384) break;
                    if (u < 512) { da_unit(A, l, (u & 15) >> 2, u & 3, 31 - (u >> 4), lds); continue; } u -= 512;
                    if (u < 384) { nsa_unit<2>(A, l, (u % 24) / 6, u % 6, 15 - u / 24, lds); continue; } u -= 384;
                    if (u < 256) { cmp_mlp_task(A, l, u, lds); continue; } u -= 256;
                    kpe_unit(A, u);
                }
                GSYNC();
                STAMP(6);
                for (;;) {
                    int u = fetch_unit(ctl + l * 4 + 1, lds);
                    if (u >= 384 + 128) break;
                    if (u < 192) { mla_unit(A, (u % 24) / 6, u % 6, 15 - u / 24, lds); continue; } u -= 192;
                    if (u < 128) { cmp_unit(A, (u & 7) >> 1, u & 1, 15 - (u >> 3), lds); continue; } u -= 128;
                    u += 192; mla_unit(A, (u % 24) / 6, u % 6, 15 - u / 24, lds);
                }
                GSYNC();
                STAMP(7);
                for (;;) {
                    const int u = fetch_unit(ctl + l * 4 + 2, lds);
                    if (u >= 384) break;
                    nsa_unit<1>(A, l, (u % 24) / 6, u % 6, 15 - u / 24, lds);
                }
                GSYNC();
                STAMP(8);
                { EpiResid E{X, X, modl + 5 * 1024, 1.0f}; run_gemm(lds, XN, (const bf16_t*)(wb + W_OUT), D, D, E); }
                GSYNC();
                STAMP(9);
            }
        }
    }
    final_norm_rows(X, A.in[22]);
#ifdef PROBE_PHASE
    STAMP(10);
    __syncthreads();
    if (blockIdx.x == 0 && get_tid() == 0) { volatile LAS unsigned* ta_ = (volatile LAS unsigned*)(lds + 140000); X[0] += (float)ta_[PROBE_PHASE] * 0.0001f; }
#endif
#ifdef PROBE_SYNCS
    for (int i = 0; i < PROBE_SYNCS; ++i) GSYNC();
#endif
}

extern "C" void kernel_launch(void* const* d_in, const int* in_sizes, int n_in, void* d_out, int out_size, void* d_ws, size_t ws_size, hipStream_t stream) {
    static int grid = 0;
    if (grid == 0) {
        if (n_in != 23 || out_size != M * D || ws_size < WS_END) { fprintf(stderr, "kernel_launch: unexpected problem shape (n_in %d out %d ws %zu)\n", n_in, out_size, ws_size); grid = -1; return; }
        int dev = 0, cus = 0, per_cu = 0;
        hipGetDevice(&dev);
        hipDeviceGetAttribute(&cus, hipDeviceAttributeMultiprocessorCount, dev);
        hipFuncSetAttribute((const void*)fwd_megakernel, hipFuncAttributeMaxDynamicSharedMemorySize, LDS_BYTES);
        hipOccupancyMaxActiveBlocksPerMultiprocessor(&per_cu, (const void*)fwd_megakernel, NTHR, LDS_BYTES);
        if (per_cu < 1) per_cu = 1;
        grid = cus * per_cu;
        (void)hipGetLastError();
    }
    if (grid < 0) return;
    hipMemsetAsync(d_ws, 0, 32768, stream);
    Args a{};
    for (int i = 0; i < 23; ++i) a.in[i] = (const float*)d_in[i];
    a.out = (float*)d_out; a.ws = (unsigned char*)d_ws;
    void* args[] = {&a};
    hipError_t e = hipLaunchCooperativeKernel((const void*)fwd_megakernel, dim3(grid), dim3(NTHR), args, LDS_BYTES, stream);
    if (e != hipSuccess) fprintf(stderr, "cooperative launch failed: %s (grid %d)\n", hipGetErrorString(e), grid);
}
```

```cpp
#include <hip/hip_runtime.h>
#include <hip/hip_cooperative_groups.h>
#include <cstdio>
#include <cstdint>
namespace cg = cooperative_groups;
extern __shared__ __attribute__((aligned(16))) unsigned char lds_raw[];
constexpr int WIDTAB_OFF = 140200;
__device__ __forceinline__ int lane_id() { return (int)__builtin_amdgcn_mbcnt_hi(~0u, __builtin_amdgcn_mbcnt_lo(~0u, 0u)); }
__device__ __forceinline__ int hw_slot() { return (int)(__builtin_amdgcn_s_getreg((5 << 11) | 4) & 63u); }
__device__ __forceinline__ int get_tid() {
    const int wid = __builtin_amdgcn_readfirstlane(*(volatile __attribute__((address_space(3))) int*)((__attribute__((address_space(3))) unsigned char*)lds_raw + WIDTAB_OFF + 4 * hw_slot()));
    return wid * 64 + lane_id();
}
__device__ __forceinline__ int pg8_opq_tid() { int v = get_tid(); asm volatile("" : "+v"(v)); return v; }
namespace pg8 {
#define PG8_LAS __attribute__((address_space(3)))
typedef unsigned short bf16_t;
typedef short bf16x8 __attribute__((ext_vector_type(8)));
typedef float f32x4 __attribute__((ext_vector_type(4)));
typedef unsigned u32x4 __attribute__((ext_vector_type(4)));
constexpr int BM = 256, BK = 64, HALF = 128, HTB = HALF * BK * 2  , STAGE_BYTES = 8 * HTB, NXCD = 8, WGM = 8;

__host__ __device__ __forceinline__ int lds_byte(int r, int c) { const int st = (r >> 4) * 2 + (c >> 5), rr = r & 15, cc = c & 31, ob = rr * 64 + cc * 2; return st * 1024 + (ob ^ (((ob >> 9) & 1) << 5)); }
__host__ __device__ __forceinline__ void stage_rc(int b, int& R, int& C) { const int st = b / 1024, sb = b % 1024, swz = sb ^ (((sb >> 9) & 1) << 5); R = (st >> 1) * 16 + swz / 64; C = (st & 1) * 32 + (swz % 64) / 2; }
__host__ __device__ __forceinline__ int perm32(int rho) { const int n = rho >> 4, i = rho & 15; return 8 * (i >> 2) + 4 * n + (i & 3); }

struct Unit { int pm, pn; };
struct Gemm { const bf16_t* A; const bf16_t* Bt; int M, N, K; };

struct StaticOrder {
    int nM, nN, nwg, G, c;
    __host__ __device__ void init(int M, int N, int G_, int c_) { nM = M / BM; nN = N / BM; nwg = nM * nN; G = G_; c = c_; }
    __host__ __device__ bool next(int i, Unit& u) const {
        const long L = (long)i * G + c; if (L >= nwg) return false;
        int wgid = (int)L; { const int q = nwg / NXCD, r = nwg % NXCD, xcd = wgid % NXCD, off = wgid / NXCD; wgid = (xcd < r ? xcd * (q + 1) : r * (q + 1) + (xcd - r) * q) + off; }
        const int nig = WGM * nN, gid = wgid / nig, fm = gid * WGM, gsz = (nM - fm) < WGM ? (nM - fm) : WGM;
        u.pm = fm + ((wgid % nig) % gsz); u.pn = (wgid % nig) / gsz; return true;
    }
    __device__ __forceinline__ void a_ready(const Unit&) const {}
    __device__ __forceinline__ void done(const Unit&) const {}
};

__device__ __forceinline__ unsigned cvt_pk_bf16(float lo, float hi) { unsigned r; asm volatile("v_cvt_pk_bf16_f32 %0, %1, %2" : "=v"(r) : "v"(lo), "v"(hi)); return r; }
typedef float f32x2 __attribute__((ext_vector_type(2)));
__device__ __forceinline__ f32x2 gelu_pk(f32x2 v) {
    const f32x2 av = __builtin_elementwise_abs(v), d = av * 0.2316418882f + 1.0f;
    f32x2 t; t.x = __builtin_amdgcn_rcpf(d.x); t.y = __builtin_amdgcn_rcpf(d.y);
    f32x2 q = t * 0.5307027145f + (-0.7265760135f); q = q * t + 0.7107068705f; q = q * t + (-0.142248368f); q = q * t + 0.127414796f; q = q * t;
    const f32x2 s = (v * v) * (-0.72134752044f);
    f32x2 e; e.x = __builtin_amdgcn_exp2f(s.x); e.y = __builtin_amdgcn_exp2f(s.y);
    const f32x2 m = v * (q * e), r = v - m;
    f32x2 o; o.x = v.x < 0.f ? m.x : r.x; o.y = v.y < 0.f ? m.y : r.y; return o;
}

template <int ACT  > struct EpiBf16 {
    static constexpr bool PERM = true, AFTER_DRAIN = false; static_assert(ACT == 0 || ACT == 1, "EpiBf16: ACT is 0 (none) or 1 (gelu_pk)");
    bf16_t* O; int ldc; const float* bias; int split_cols; size_t split_stride; float scale0;
    __device__ __forceinline__ void operator()(const f32x4 (&acc)[2][2][4][2], const Unit& u, int wr, int wc, int fr, int fq) const {
        const int row0 = u.pm * BM + wr * 64 + fr; int colt = u.pn * BM; bf16_t* base = O;
        float sc = 1.f; if (split_cols) { const int t = colt / split_cols; base += (size_t)t * split_stride; colt -= t * split_cols; if (t == 0) sc = scale0; }
        const int col0 = colt + wc * 32 + 8 * fq, bcol0 = u.pn * BM + wc * 32 + 8 * fq;
        f32x4 bv[2][2];
#pragma unroll
        for (int bj = 0; bj < 2; ++bj)
#pragma unroll
            for (int n = 0; n < 2; ++n) bv[bj][n] = bias ? *(const f32x4*)(bias + bcol0 + bj * HALF + 4 * n) : (f32x4){0.f, 0.f, 0.f, 0.f};
#pragma unroll
        for (int ai = 0; ai < 2; ++ai)
#pragma unroll
            for (int m = 0; m < 4; ++m) { bf16_t* rowp = base + (size_t)(row0 + ai * HALF + m * 16) * ldc + col0;
#pragma unroll
                for (int bj = 0; bj < 2; ++bj) { f32x4 v0 = acc[ai][bj][m][0] + bv[bj][0], v1 = acc[ai][bj][m][1] + bv[bj][1];
                    if (ACT == 1) { f32x2 a = gelu_pk((f32x2){v0[0], v0[1]}), b = gelu_pk((f32x2){v0[2], v0[3]}), c = gelu_pk((f32x2){v1[0], v1[1]}), d = gelu_pk((f32x2){v1[2], v1[3]});
                        v0 = (f32x4){a.x, a.y, b.x, b.y}; v1 = (f32x4){c.x, c.y, d.x, d.y}; }
                    v0 = v0 * sc; v1 = v1 * sc; u32x4 w; w.x = cvt_pk_bf16(v0[0], v0[1]); w.y = cvt_pk_bf16(v0[2], v0[3]); w.z = cvt_pk_bf16(v1[0], v1[1]); w.w = cvt_pk_bf16(v1[2], v1[3]);
                    *(u32x4*)(rowp + bj * HALF) = w; } }
    }
};
template <class Epi, class Sched, bool ALIGN_EPI = false, bool SP2 = false>
__device__ __forceinline__ void gemm_phase(PG8_LAS unsigned char* lds, const Gemm g, const Sched& S, const Epi& E) {
    const int tid = pg8_opq_tid(), wid = __builtin_amdgcn_readfirstlane(tid >> 6), lane = tid & 63, wr = wid >> 2, wc = wid & 3, fr = lane & 15, fq = lane >> 4;
    const int K = g.K, nt = K / BK;
    unsigned voffA[2], voffB[2];
#pragma unroll
    for (int i = 0; i < 2; ++i) { int R, C; stage_rc(tid * 16 + i * 8192, R, C); const int Rb = Epi::PERM ? ((R & ~31) + perm32(R & 31)) : R;
        voffA[i] = (unsigned)(R * K + C) * 2u; voffB[i] = (unsigned)(Rb * K + C) * 2u; }
    const size_t kstep = (size_t)(BK * 2);
    const size_t hstep = (size_t)HALF * K * 2;
    const size_t tstep = 2 * hstep;
    const unsigned ldsw = (unsigned)wid * 1024u;
    const int aoff = lds_byte(wr * 64 + fr, fq * 8), boff = lds_byte(wc * 32 + fr, fq * 8);
#define PG8_SA(b, h) (((b) * 2 + (h)) * HTB)
#define PG8_SB(b, h) ((4 + (b) * 2 + (h)) * HTB)
#define PG8_STAGE(bufoff, gbase, voff) do { _Pragma("unroll") for (int _i = 0; _i < 2; ++_i) \
        __builtin_amdgcn_global_load_lds((const unsigned*)((const char*)(gbase) + (voff)[_i]), (PG8_LAS unsigned*)(lds + (bufoff) + ldsw + _i * 8192), 16, 0, 0); } while (0)
#define PG8_LDA(dst, b, h) do { _Pragma("unroll") for (int m = 0; m < 4; ++m) _Pragma("unroll") for (int k = 0; k < 2; ++k) dst[m][k] = *(const PG8_LAS bf16x8*)(lds + PG8_SA(b, h) + aoff + m * 2048 + k * 1024); } while (0)
#define PG8_LDB(dst, b, h) do { _Pragma("unroll") for (int n = 0; n < 2; ++n) _Pragma("unroll") for (int k = 0; k < 2; ++k) dst[n][k] = *(const PG8_LAS bf16x8*)(lds + PG8_SB(b, h) + boff + n * 2048 + k * 1024); } while (0)
#define PG8_MMA(ai, bj, At, Bt) do { __builtin_amdgcn_s_setprio(1); _Pragma("unroll") for (int m = 0; m < 4; ++m) _Pragma("unroll") for (int n = 0; n < 2; ++n) _Pragma("unroll") for (int k = 0; k < 2; ++k) \
        acc[ai][bj][m][n] = __builtin_amdgcn_mfma_f32_16x16x32_bf16(Bt[n][k], At[m][k], acc[ai][bj][m][n], 0, 0, 0); __builtin_amdgcn_s_setprio(0); } while (0)
#define PG8_WAIT_V(n) asm volatile("s_waitcnt vmcnt(" #n ")" ::: "memory")
#define PG8_WAIT_L(n) asm volatile("s_waitcnt lgkmcnt(" #n ")" ::: "memory")
#define PG8_BAR __builtin_amdgcn_s_barrier()
#define PG8_SCHED __builtin_amdgcn_sched_barrier(0)
    Unit cur, nxt; int ui = 0;
    if (!S.next(0, cur)) return;
    f32x4 acc[2][2][4][2];
#pragma unroll
    for (int a = 0; a < 2; ++a)
#pragma unroll
        for (int b = 0; b < 2; ++b)
#pragma unroll
            for (int m = 0; m < 4; ++m)
#pragma unroll
                for (int n = 0; n < 2; ++n) acc[a][b][m][n] = (f32x4){0.f, 0.f, 0.f, 0.f};
    bf16x8 At[4][2], B0[2][2], B1[2][2];
    const char* cA = (const char*)g.A + (size_t)cur.pm * tstep; const char* cB = (const char*)g.Bt + (size_t)cur.pn * tstep;
    S.a_ready(cur);
    if constexpr (SP2) {
        PG8_STAGE(PG8_SB(0, 0), cB, voffB); PG8_STAGE(PG8_SB(0, 1), cB + hstep, voffB); PG8_STAGE(PG8_SA(0, 0), cA, voffA); PG8_STAGE(PG8_SA(0, 1), cA + hstep, voffA);
        if (wr == 1) PG8_BAR;
        PG8_WAIT_V(2); PG8_BAR;
        PG8_STAGE(PG8_SB(1, 0), cB + kstep, voffB); PG8_STAGE(PG8_SA(1, 0), cA + kstep, voffA); PG8_STAGE(PG8_SB(1, 1), cB + hstep + kstep, voffB);
        PG8_WAIT_V(6); PG8_BAR;
    } else {
        PG8_STAGE(PG8_SB(0, 0), cB, voffB); PG8_STAGE(PG8_SA(0, 0), cA, voffA); PG8_STAGE(PG8_SB(0, 1), cB + hstep, voffB); PG8_STAGE(PG8_SA(0, 1), cA + hstep, voffA);
        if (wr == 1) PG8_BAR;
        PG8_WAIT_V(4); PG8_BAR;
        PG8_STAGE(PG8_SB(1, 0), cB + kstep, voffB); PG8_STAGE(PG8_SA(1, 0), cA + kstep, voffA); PG8_STAGE(PG8_SB(1, 1), cB + hstep + kstep, voffB);
        PG8_WAIT_V(6); PG8_BAR;
    }
    for (;;) {
        const bool has_next = S.next(ui + 1, nxt);
        const char* nA = has_next ? (const char*)g.A + (size_t)nxt.pm * tstep : cA; const char* nB = has_next ? (const char*)g.Bt + (size_t)nxt.pn * tstep : cB;
        for (int t = 0; t < nt; t += 2) {
            const bool last = (t == nt - 2);
            const char* a1 = cA + (size_t)(t + 1) * kstep;
            const char* a2 = last ? nA : cA + (size_t)(t + 2) * kstep; const char* b2 = last ? nB : cB + (size_t)(t + 2) * kstep;
            const char* a3 = a2 + kstep; const char* b3 = b2 + kstep;
            if (last && has_next) S.a_ready(nxt);
            if constexpr (SP2) {
            PG8_LDB(B0, 0, 0); PG8_LDB(B1, 0, 1); PG8_SCHED; PG8_LDA(At, 0, 0); PG8_STAGE(PG8_SA(1, 1), a1 + hstep, voffA);
            PG8_WAIT_V(8); PG8_WAIT_L(0); PG8_BAR; PG8_MMA(0, 0, At, B0); PG8_MMA(0, 1, At, B1); PG8_BAR; PG8_SCHED;
            PG8_LDA(At, 0, 1); PG8_STAGE(PG8_SB(0, 0), b2, voffB); PG8_STAGE(PG8_SB(0, 1), b2 + hstep, voffB); PG8_STAGE(PG8_SA(0, 0), a2, voffA);
            PG8_WAIT_V(8); PG8_WAIT_L(0); PG8_BAR; PG8_MMA(1, 0, At, B0); PG8_MMA(1, 1, At, B1); PG8_BAR; PG8_SCHED;
            PG8_LDB(B0, 1, 0); PG8_LDB(B1, 1, 1); PG8_SCHED; PG8_LDA(At, 1, 0); PG8_STAGE(PG8_SA(0, 1), a2 + hstep, voffA);
            PG8_WAIT_V(8); PG8_WAIT_L(0); PG8_BAR; PG8_MMA(0, 0, At, B0); PG8_MMA(0, 1, At, B1); PG8_BAR; PG8_SCHED;
            PG8_LDA(At, 1, 1); PG8_STAGE(PG8_SB(1, 0), b3, voffB); PG8_STAGE(PG8_SB(1, 1), b3 + hstep, voffB); PG8_STAGE(PG8_SA(1, 0), a3, voffA);
            PG8_WAIT_V(8); PG8_WAIT_L(0); PG8_BAR; PG8_MMA(1, 0, At, B0); PG8_MMA(1, 1, At, B1); PG8_BAR; PG8_SCHED;
            } else {
            PG8_LDB(B0, 0, 0); PG8_SCHED; PG8_LDA(At, 0, 0); PG8_STAGE(PG8_SA(1, 1), a1 + hstep, voffA);
            PG8_WAIT_L(8); PG8_BAR; PG8_WAIT_L(0); PG8_MMA(0, 0, At, B0); PG8_BAR; PG8_SCHED;
            PG8_LDB(B1, 0, 1); PG8_STAGE(PG8_SB(0, 0), b2, voffB);
            PG8_BAR; PG8_WAIT_L(0); PG8_MMA(0, 1, At, B1); PG8_BAR;
            PG8_LDA(At, 0, 1); PG8_STAGE(PG8_SA(0, 0), a2, voffA);
            PG8_BAR; PG8_WAIT_L(0); PG8_MMA(1, 0, At, B0); PG8_BAR; PG8_SCHED;
            PG8_STAGE(PG8_SB(0, 1), b2 + hstep, voffB);
            PG8_WAIT_V(6); PG8_BAR; PG8_MMA(1, 1, At, B1); PG8_BAR;
            PG8_LDB(B0, 1, 0); PG8_SCHED; PG8_LDA(At, 1, 0); PG8_STAGE(PG8_SA(0, 1), a2 + hstep, voffA);
            PG8_WAIT_L(8); PG8_BAR; PG8_WAIT_L(0); PG8_MMA(0, 0, At, B0); PG8_BAR; PG8_SCHED;
            PG8_LDB(B1, 1, 1); PG8_STAGE(PG8_SB(1, 0), b3, voffB);
            PG8_BAR; PG8_WAIT_L(0); PG8_MMA(0, 1, At, B1); PG8_BAR;
            PG8_LDA(At, 1, 1); PG8_STAGE(PG8_SA(1, 0), a3, voffA);
            PG8_BAR; PG8_WAIT_L(0); PG8_MMA(1, 0, At, B0); PG8_BAR; PG8_SCHED;
            PG8_STAGE(PG8_SB(1, 1), b3 + hstep, voffB);
            PG8_WAIT_V(6); PG8_BAR; PG8_MMA(1, 1, At, B1); PG8_BAR;
            }
        }
        if constexpr (ALIGN_EPI) { if (wr == 0) PG8_BAR; }
        if constexpr (!Epi::AFTER_DRAIN) { E(acc, cur, wr, wc, fr, fq); S.done(cur); }
        if (!has_next) break;
#pragma unroll
        for (int a = 0; a < 2; ++a)
#pragma unroll
            for (int b = 0; b < 2; ++b)
#pragma unroll
                for (int m = 0; m < 4; ++m)
#pragma unroll
                    for (int n = 0; n < 2; ++n) acc[a][b][m][n] = (f32x4){0.f, 0.f, 0.f, 0.f};
        cur = nxt; cA = nA; cB = nB; ++ui;
        if constexpr (ALIGN_EPI) { if (wr == 1) PG8_BAR; }
    }
    PG8_WAIT_V(0);
    if constexpr (!ALIGN_EPI) { if (wr == 0) PG8_BAR; }
    PG8_BAR;
    if constexpr (Epi::AFTER_DRAIN) { E.fused(acc, cur, wr, wc, fr, fq, lds, wid, lane); S.done(cur); }
#undef PG8_SA
#undef PG8_SB
#undef PG8_STAGE
#undef PG8_LDA
#undef PG8_LDB
#undef PG8_MMA
#undef PG8_WAIT_V
#undef PG8_WAIT_L
#undef PG8_BAR
#undef PG8_SCHED
}
}

#define LAS __attribute__((address_space(3)))
typedef unsigned short bf16_t;
typedef short bf16x8 __attribute__((ext_vector_type(8)));
typedef short s16x4 __attribute__((ext_vector_type(4)));
typedef float f32x4 __attribute__((ext_vector_type(4)));
typedef float f32x2 __attribute__((ext_vector_type(2)));
typedef float f32x16 __attribute__((ext_vector_type(16)));
typedef unsigned u32x4 __attribute__((ext_vector_type(4)));
typedef unsigned u32x2 __attribute__((ext_vector_type(2)));
typedef __bf16 bf16x2_t __attribute__((ext_vector_type(2)));

#ifndef EN_MIX
#define EN_MIX 1
#endif
#ifndef EN_DA
#define EN_DA 1
#endif
#ifndef EN_MLA
#define EN_MLA 1
#endif
#ifndef EN_WIN
#define EN_WIN 1
#endif
#ifndef EN_CMP
#define EN_CMP 1
#endif
#ifndef EN_SLC
#define EN_SLC 1
#endif

constexpr int NB = 4, T = 4096, D = 1024, M = NB * T, F = 2816, F2 = 5632, DIN = 2354, DINP = 2560;
constexpr int NTHR = 512, NWAVE = 8, LDS_BYTES = 147456, FETCH_OFF = LDS_BYTES - 64;
constexpr int C_AQ = 0, C_AK = 256, C_AV = 512, C_BKR = 1152, C_CQ = 1184, C_KC = 1568, C_VC = 1696, C_KS = 1824, C_VS = 1952, C_KW = 2080, C_VW = 2208, C_G = 2336;
constexpr float LOG2E = 1.4426950408889634f, RMS_EPS = 1e-6f, NEGBIG = -1e30f;

constexpr size_t MiB = 1u << 20, KiB = 1u << 10;
constexpr size_t WS_CTL = 0;
constexpr size_t WS_MODS = 64 * KiB;
constexpr size_t WS_ROPE = 512 * KiB;
constexpr size_t WS_POSB = 1 * MiB;
constexpr size_t WS_SSQ = 1 * MiB + 64 * KiB;
constexpr size_t WS_KCMP = 2 * MiB;
constexpr size_t WS_SEL = 3 * MiB;
constexpr size_t WS_W = 4 * MiB;
constexpr size_t W_1A = 0, W_1B = W_1A + (size_t)F2 * D * 2, W_2A = W_1B + (size_t)D * F * 2, W_2B = W_2A + (size_t)F2 * D * 2,
                 W_IN = W_2B + (size_t)D * F * 2, W_OUT = W_IN + (size_t)DINP * D * 2, W_UQ = W_OUT + (size_t)D * D * 2, W_UKV = W_UQ + 768 * 256 * 2,
                 W_C1 = W_UKV + 768 * 128 * 2, W_C2 = W_C1 + 2 * 128 * 2048 * 2, W_END = W_C2 + 2 * 64 * 128 * 2;
static_assert(WS_W + W_END <= 48 * MiB, "weights");
constexpr size_t WS_XN = 48 * MiB;
constexpr size_t WS_U = 80 * MiB;
constexpr size_t WS_CQ = 168 * MiB;
constexpr size_t WS_CKV = 176 * MiB;
constexpr size_t WS_MQ = 180 * MiB;
constexpr size_t WS_MKV = 204 * MiB;
constexpr size_t WS_KPE = 228 * MiB;
constexpr size_t WS_END = 229 * MiB;

__device__ __forceinline__ unsigned cvtpk(float lo, float hi) { f32x2 v = {lo, hi}; bf16x2_t b = __builtin_convertvector(v, bf16x2_t); return __builtin_bit_cast(unsigned, b); }
__device__ __forceinline__ float bf2f(short b) { return __uint_as_float(((unsigned)(unsigned short)b) << 16); }
__device__ __forceinline__ float wave_sum(float v) {
#pragma unroll
    for (int o = 1; o < 64; o <<= 1) v += __shfl_xor(v, o);
    return v;
}
__device__ __forceinline__ float fast_exp2(float x) { return __builtin_amdgcn_exp2f(x); }
__device__ __forceinline__ float fast_rcp(float x) { return __builtin_amdgcn_rcpf(x); }
__device__ __forceinline__ float sigmoid_f(float x) { return fast_rcp(1.0f + fast_exp2(-x * LOG2E)); }
__device__ __forceinline__ int crow(int i, int h) { return (i & 3) + 8 * (i >> 2) + 4 * h; }
__device__ __forceinline__ int opq(int v) { asm volatile("" : "+v"(v)); return v; }
#define MFMA32(a, b, c) __builtin_amdgcn_mfma_f32_32x32x16_bf16((a), (b), (c), 0, 0, 0)
#define MFMA16(a, b, c) __builtin_amdgcn_mfma_f32_16x16x32_bf16((a), (b), (c), 0, 0, 0)

struct Args { const float* in[23]; float* out; unsigned char* ws; };
__device__ __forceinline__ unsigned char* ws_opq(unsigned char* p) {
    const unsigned long long v = (unsigned long long)p;
    unsigned lo = (unsigned)__builtin_amdgcn_readfirstlane((int)(unsigned)v), hi = (unsigned)__builtin_amdgcn_readfirstlane((int)(unsigned)(v >> 32));
    asm volatile("" : "+s"(lo), "+s"(hi));
    return (unsigned char*)(((unsigned long long)hi << 32) | (unsigned long long)lo);
}

struct EpiSwiGLU {
    static constexpr bool PERM = true, AFTER_DRAIN = false;
    bf16_t* O;
    __device__ __forceinline__ void operator()(const f32x4 (&acc)[2][2][4][2], const pg8::Unit& u, int wr_, int wc_, int fr_, int fq_) const {
        const int t_ = opq(get_tid()), w_ = __builtin_amdgcn_readfirstlane(t_ >> 6), wr = w_ >> 2, wc = w_ & 3, fr = t_ & 15, fq = (t_ >> 4) & 3;
        const int row0 = u.pm * 256 + wr * 64 + fr, col0 = u.pn * 128 + wc * 32 + 8 * fq;
#pragma unroll
        for (int ai = 0; ai < 2; ++ai)
#pragma unroll
            for (int m = 0; m < 4; ++m) {
                bf16_t* rowp = O + (size_t)(row0 + ai * 128 + m * 16) * F + col0;
                float r[8];
#pragma unroll
                for (int n = 0; n < 2; ++n)
#pragma unroll
                    for (int j = 0; j < 4; ++j) { const float g = acc[ai][0][m][n][j], up = acc[ai][1][m][n][j]; r[n * 4 + j] = g * sigmoid_f(g) * up; }
                u32x4 w; w.x = cvtpk(r[0], r[1]); w.y = cvtpk(r[2], r[3]); w.z = cvtpk(r[4], r[5]); w.w = cvtpk(r[6], r[7]);
                *(u32x4*)rowp = w;
            }
    }
};
struct EpiResid {
    static constexpr bool PERM = false, AFTER_DRAIN = false;
    const float* resid; float* out; const float* gate; float coef;
    __device__ __forceinline__ void operator()(const f32x4 (&acc)[2][2][4][2], const pg8::Unit& u, int wr_, int wc_, int fr_, int fq_) const {
        const int t_ = opq(get_tid()), w_ = __builtin_amdgcn_readfirstlane(t_ >> 6), wr = w_ >> 2, wc = w_ & 3, fr = t_ & 15, fq = (t_ >> 4) & 3;
        const int row0 = u.pm * 256 + wr * 64 + fr, b = (u.pm * 256) >> 12, col0 = u.pn * 256 + wc * 32 + 4 * fq;
#pragma unroll
        for (int bj = 0; bj < 2; ++bj)
#pragma unroll
            for (int n = 0; n < 2; ++n) {
                const int c = col0 + bj * 128 + n * 16;
                const f32x4 gv = *(const f32x4*)(gate + (size_t)b * 9216 + c) * coef;
#pragma unroll
                for (int ai = 0; ai < 2; ++ai)
#pragma unroll
                    for (int m = 0; m < 4; ++m) {
                        const size_t off = (size_t)(row0 + ai * 128 + m * 16) * D + c;
                        const f32x4 o = *(const f32x4*)(resid + off) + gv * acc[ai][bj][m][n];
                        *(f32x4*)(out + off) = o;
                        if (m & 1) asm volatile("" ::: "memory");
                    }
            }
    }
};
struct EpiProj {
    static constexpr bool PERM = true, AFTER_DRAIN = false;
    bf16_t* PROJ; bf16_t* CQ; bf16_t* CKV; float* ssq_q; float* ssq_kv; unsigned* kn;
    __device__ __forceinline__ void operator()(const f32x4 (&acc)[2][2][4][2], const pg8::Unit& u, int wr_, int wc_, int fr_, int fq_) const {
        const int t_ = opq(get_tid()), w_ = __builtin_amdgcn_readfirstlane(t_ >> 6), wr = w_ >> 2, wc = w_ & 3, fr = t_ & 15, fq = (t_ >> 4) & 3;
        const int row0 = u.pm * 256 + wr * 64 + fr;
        const int kti = u.pn == 1 ? 0 : (u.pn == 7 ? 1 : (u.pn == 8 ? 2 : -1));
#pragma unroll
        for (int bj = 0; bj < 2; ++bj) {
            float gmax = 0.f;
            bf16_t* base; int ld, cb; float* ssq;
            if (u.pn == 3) { base = CQ; ld = 256; cb = bj * 128; ssq = ssq_q; }
            else if (u.pn == 4 && bj == 0) { base = CKV; ld = 128; cb = 0; ssq = ssq_kv; }
            else { base = PROJ; ld = DINP; cb = u.pn * 256 + bj * 128; ssq = nullptr; }
            const int col0 = cb + wc * 32 + 8 * fq;
#pragma unroll
            for (int ai = 0; ai < 2; ++ai)
#pragma unroll
                for (int m = 0; m < 4; ++m) {
                    const int row = row0 + ai * 128 + m * 16;
                    const f32x4 v0 = acc[ai][bj][m][0], v1 = acc[ai][bj][m][1];
                    u32x4 w; w.x = cvtpk(v0[0], v0[1]); w.y = cvtpk(v0[2], v0[3]); w.z = cvtpk(v1[0], v1[1]); w.w = cvtpk(v1[2], v1[3]);
                    *(u32x4*)(base + (size_t)row * ld + col0) = w;
                    if (ssq || kti >= 0) {
                        float s = (v0[0] * v0[0] + v0[1] * v0[1]) + (v0[2] * v0[2] + v0[3] * v0[3]) + (v1[0] * v1[0] + v1[1] * v1[1]) + (v1[2] * v1[2] + v1[3] * v1[3]);
                        s += __shfl_xor(s, 16); s += __shfl_xor(s, 32);
                        if (ssq) { if (fq == 0) atomicAdd(ssq + row, s); }
                        else gmax = fmaxf(gmax, s);
                    }
                    asm volatile("" ::: "memory");
                }
            if (kti >= 0) {
                gmax = fmaxf(gmax, __shfl_xor(gmax, 1)); gmax = fmaxf(gmax, __shfl_xor(gmax, 2)); gmax = fmaxf(gmax, __shfl_xor(gmax, 4)); gmax = fmaxf(gmax, __shfl_xor(gmax, 8));
                if (fr == 0 && fq == 0) atomicMax(kn + ((u.pm * 256) >> 12) * 24 + kti * 8 + bj * 4 + wc, __float_as_uint(gmax));
            }
        }
    }
};
struct EpiRowScale {
    static constexpr bool PERM = true, AFTER_DRAIN = false;
    bf16_t* O; int ldc; const float* ssq; float inv_n;
    __device__ __forceinline__ void operator()(const f32x4 (&acc)[2][2][4][2], const pg8::Unit& u, int wr_, int wc_, int fr_, int fq_) const {
        const int t_ = opq(get_tid()), w_ = __builtin_amdgcn_readfirstlane(t_ >> 6), wr = w_ >> 2, wc = w_ & 3, fr = t_ & 15, fq = (t_ >> 4) & 3;
        const int row0 = u.pm * 256 + wr * 64 + fr, col0 = u.pn * 256 + wc * 32 + 8 * fq;
#pragma unroll
        for (int ai = 0; ai < 2; ++ai)
#pragma unroll
            for (int m = 0; m < 4; ++m) {
                const int row = row0 + ai * 128 + m * 16;
                const float rs = rsqrtf(ssq[row] * inv_n + RMS_EPS);
#pragma unroll
                for (int bj = 0; bj < 2; ++bj) {
                    const f32x4 v0 = acc[ai][bj][m][0] * rs, v1 = acc[ai][bj][m][1] * rs;
                    u32x4 w; w.x = cvtpk(v0[0], v0[1]); w.y = cvtpk(v0[2], v0[3]); w.z = cvtpk(v1[0], v1[1]); w.w = cvtpk(v1[2], v1[3]);
                    *(u32x4*)(O + (size_t)row * ldc + col0 + bj * 128) = w;
                }
                asm volatile("" ::: "memory");
            }
    }
};

template <int MODE> __device__ __forceinline__ int wrow(int n) {
    if (MODE == 1) return n < F ? ((n >> 7) * 256 + (n & 127)) : (((n - F) >> 7) * 256 + 128 + ((n - F) & 127));
    return n;
}
template <int MODE>
__device__ __forceinline__ void cvt_item(const float* W, int K, int N, int NP, bf16_t* WT, const float* kscale, LAS float* scr, int item, int lane) {
    const int nblk = NP / 32, kb = item / nblk, nb = item % nblk, k0 = 64 * kb, n0 = 32 * nb;
    const int n_rd = n0 + (lane & 31);
#pragma unroll 8
    for (int i = 0; i < 32; ++i) {
        const int kk = 2 * i + (lane >> 5);
        float v = (n_rd < N) ? W[(size_t)(k0 + kk) * N + n_rd] : 0.f;
        if (kscale) v *= kscale[k0 + kk];
        scr[kk * 33 + (lane & 31)] = v;
    }
    asm volatile("s_waitcnt lgkmcnt(0)" ::: "memory");
    const int c = lane & 7;
#pragma unroll
    for (int j = 0; j < 4; ++j) {
        const int n = (lane >> 3) + 8 * j; const LAS float* s = scr + (8 * c) * 33 + n;
        u32x4 o; o.x = cvtpk(s[0 * 33], s[1 * 33]); o.y = cvtpk(s[2 * 33], s[3 * 33]); o.z = cvtpk(s[4 * 33], s[5 * 33]); o.w = cvtpk(s[6 * 33], s[7 * 33]);
        *(u32x4*)(WT + (size_t)wrow<MODE>(n0 + n) * K + k0 + 8 * c) = o;
    }
    asm volatile("s_waitcnt lgkmcnt(0)" ::: "memory");
}
__device__ __forceinline__ void convert_layer(const Args& A, int l, LAS unsigned char* lds) {
    const int tid = opq(get_tid()), lane = tid & 63, wid = __builtin_amdgcn_readfirstlane(tid >> 6), gw = blockIdx.x * NWAVE + wid, ngw = gridDim.x * NWAVE;
    LAS float* scr = (LAS float*)(lds + wid * 8704);
    unsigned char* wb = A.ws + WS_W;
    constexpr int I_A = 16 * 176, I_B = 44 * 32, I_IN = 16 * 80, I_OUT = 16 * 32, I_UQ = 4 * 24, I_UKV = 2 * 24, I_C1 = 32 * 4, I_C2 = 2 * 2;
    constexpr int NITEMS = 2 * I_A + 2 * I_B + I_IN + I_OUT + I_UQ + I_UKV + 2 * I_C1 + 2 * I_C2;
    for (int it = gw; it < NITEMS; it += ngw) {
        int r = it;
        if (r < I_A) { cvt_item<1>(A.in[7] + (size_t)l * D * F2, D, F2, F2, (bf16_t*)(wb + W_1A), nullptr, scr, r, lane); continue; } r -= I_A;
        if (r < I_A) { cvt_item<1>(A.in[9] + (size_t)l * D * F2, D, F2, F2, (bf16_t*)(wb + W_2A), nullptr, scr, r, lane); continue; } r -= I_A;
        if (r < I_B) { cvt_item<0>(A.in[8] + (size_t)l * F * D, F, D, D, (bf16_t*)(wb + W_1B), nullptr, scr, r, lane); continue; } r -= I_B;
        if (r < I_B) { cvt_item<0>(A.in[10] + (size_t)l * F * D, F, D, D, (bf16_t*)(wb + W_2B), nullptr, scr, r, lane); continue; } r -= I_B;
        if (r < I_IN) { cvt_item<0>(A.in[11] + (size_t)l * D * DIN, D, DIN, DINP, (bf16_t*)(wb + W_IN), nullptr, scr, r, lane); continue; } r -= I_IN;
        if (r < I_OUT) { cvt_item<0>(A.in[12] + (size_t)l * D * D, D, D, D, (bf16_t*)(wb + W_OUT), nullptr, scr, r, lane); continue; } r -= I_OUT;
        if (r < I_UQ) { cvt_item<0>(A.in[17] + (size_t)l * 256 * 576, 256, 576, 768, (bf16_t*)(wb + W_UQ), A.in[15] + l * 256, scr, r, lane); continue; } r -= I_UQ;
        if (r < I_UKV) { cvt_item<0>(A.in[18] + (size_t)l * 128 * 768, 128, 768, 768, (bf16_t*)(wb + W_UKV), A.in[16] + l * 128, scr, r, lane); continue; } r -= I_UKV;
        if (r < 2 * I_C1) { const int kv = r / I_C1; cvt_item<0>(A.in[20] + (size_t)(l * 2 + kv) * 2048 * 128, 2048, 128, 128, (bf16_t*)(wb + W_C1) + (size_t)kv * 128 * 2048, nullptr, scr, r % I_C1, lane); continue; } r -= 2 * I_C1;
        { const int kv = r / I_C2; cvt_item<0>(A.in[21] + (size_t)(l * 2 + kv) * 128 * 64, 128, 64, 64, (bf16_t*)(wb + W_C2) + (size_t)kv * 64 * 128, nullptr, scr, r % I_C2, lane); }
    }
}
__device__ __forceinline__ void mods_task(const Args& A, int task, LAS unsigned char* lds) {
    const int tid = opq(get_tid()), lane = tid & 63, wid = __builtin_amdgcn_readfirstlane(tid >> 6);
    const int l = task / 144, chunk = task % 144;
    LAS float* cond = (LAS float*)lds;
    LAS float* red = (LAS float*)(lds + 16384);
    __syncthreads();
    for (int i = tid; i < 4096; i += NTHR) { const float c = A.in[1][i]; cond[i] = c / (1.0f + expf(-c)); }
    __syncthreads();
    const float* W = A.in[2] + (size_t)l * D * 9216 + chunk * 64 + lane;
    float acc[4] = {0.f, 0.f, 0.f, 0.f};
#pragma unroll 16
    for (int kk = 0; kk < 128; ++kk) {
        const int k = wid * 128 + kk;
        const float w = W[(size_t)k * 9216];
#pragma unroll
        for (int b = 0; b < 4; ++b) acc[b] += cond[b * 1024 + k] * w;
    }
#pragma unroll
    for (int b = 0; b < 4; ++b) red[(wid * 4 + b) * 64 + lane] = acc[b];
    __syncthreads();
    if (tid < 256) {
        const int b = tid >> 6, col = tid & 63; float s = 0.f;
#pragma unroll
        for (int w = 0; w < 8; ++w) s += red[(w * 4 + b) * 64 + col];
        s += A.in[3][(size_t)l * 9216 + chunk * 64 + col];
        ((float*)(A.ws + WS_MODS))[(size_t)(l * 4 + b) * 9216 + chunk * 64 + col] = s;
    }
    __syncthreads();
}
__device__ __forceinline__ void posb_task(const Args& A, int task, LAS unsigned char* lds) {
    const int tid = opq(get_tid());
    const int lkv = task >> 4, kp = task & 15, hid = tid & 127, sub = tid >> 7;
    const float* pos = A.in[19] + (size_t)lkv * 2048 + kp * 128 + sub * 32; const float* w1 = A.in[20] + ((size_t)lkv * 2048 + kp * 128 + sub * 32) * 128 + hid;
    float s = 0.f;
#pragma unroll
    for (int k = 0; k < 32; ++k) s += pos[k] * w1[(size_t)k * 128];
    LAS float* red = (LAS float*)lds;
    __syncthreads();
    red[tid] = s;
    __syncthreads();
    if (tid < 128) ((float*)(A.ws + WS_POSB + 4096))[task * 128 + tid] = red[tid] + red[tid + 128] + red[tid + 256] + red[tid + 384];
    __syncthreads();
}
__device__ __forceinline__ void posb_final(const Args& A) {
    const int o = opq(get_tid());
    const float* part = (const float*)(A.ws + WS_POSB + 4096) + (size_t)(o >> 7) * 16 * 128 + (o & 127);
    float s = 0.f;
#pragma unroll
    for (int p = 0; p < 16; ++p) s += part[p * 128];
    ((float*)(A.ws + WS_POSB))[o] = s;
}
__device__ __forceinline__ void rope_entries(const Args& A) {
    const int gtid = blockIdx.x * NTHR + opq(get_tid()), gn = gridDim.x * NTHR;
    float* tab = (float*)(A.ws + WS_ROPE);
    for (int e = gtid; e < T * 16; e += gn) {
        const int t = e >> 4, i = e & 15;
        double inv = 1.0; for (int j = 0; j < i; ++j) inv *= 0.5623413251903491;
        const float ang = (float)t * (float)inv;
        const double rev = (double)ang * 0.15915494309189535; const double fr = rev - __builtin_rint(rev);
        tab[e] = __builtin_amdgcn_cosf((float)fr); tab[T * 16 + e] = __builtin_amdgcn_sinf((float)fr);
    }
}
__device__ __forceinline__ void norm_rows(const float* X, bf16_t* out, const float* g, const float* modl, int ish, int isc) {
    const int tid = opq(get_tid()), lane = tid & 63, wid = __builtin_amdgcn_readfirstlane(tid >> 6), gw = blockIdx.x * NWAVE + wid, ngw = gridDim.x * NWAVE;
#pragma unroll 1
    for (int b = 0; b < NB; ++b) {
        f32x4 gs[4], sh[4];
#pragma unroll
        for (int j = 0; j < 4; ++j) {
            const int col = 4 * lane + 256 * j;
            gs[j] = *(const f32x4*)(g + col) * (*(const f32x4*)(modl + (size_t)b * 9216 + isc * 1024 + col) + 1.0f);
            sh[j] = *(const f32x4*)(modl + (size_t)b * 9216 + ish * 1024 + col);
        }
        for (int row = b * T + gw; row < (b + 1) * T; row += ngw) {
            const f32x4* xr = (const f32x4*)(X + (size_t)row * D) + lane;
            f32x4 v[4]; float ss = 0.f;
#pragma unroll
            for (int j = 0; j < 4; ++j) { v[j] = xr[64 * j]; ss += (v[j].x * v[j].x + v[j].y * v[j].y) + (v[j].z * v[j].z + v[j].w * v[j].w); }
            const float rstd = rsqrtf(wave_sum(ss) * (1.0f / D) + RMS_EPS);
#pragma unroll
            for (int j = 0; j < 4; ++j) {
                const f32x4 y = (v[j] * rstd) * gs[j] + sh[j];
                u32x2 w; w.x = cvtpk(y.x, y.y); w.y = cvtpk(y.z, y.w);
                *(u32x2*)(out + (size_t)row * D + 4 * lane + 256 * j) = w;
            }
        }
    }
}
__device__ __forceinline__ void final_norm_rows(float* X, const float* g) {
    const int tid = opq(get_tid()), lane = tid & 63, wid = __builtin_amdgcn_readfirstlane(tid >> 6), gw = blockIdx.x * NWAVE + wid, ngw = gridDim.x * NWAVE;
    for (int row = gw; row < M; row += ngw) {
        f32x4* xr = (f32x4*)(X + (size_t)row * D) + lane;
        f32x4 v[4]; float ss = 0.f;
#pragma unroll
        for (int j = 0; j < 4; ++j) { v[j] = xr[64 * j]; ss += (v[j].x * v[j].x + v[j].y * v[j].y) + (v[j].z * v[j].z + v[j].w * v[j].w); }
        const float rstd = rsqrtf(wave_sum(ss) * (1.0f / D) + RMS_EPS);
#pragma unroll
        for (int j = 0; j < 4; ++j) { const f32x4 g4 = *(const f32x4*)(g + 4 * lane + 256 * j); xr[64 * j] = (v[j] * rstd) * g4; }
    }
}

__device__ __forceinline__ void norm_block(const float* X, bf16_t* out, const float* g, const float* modl, int ish, int isc, int row0) {
    const int tid = opq(get_tid()), lane = tid & 63, wid = __builtin_amdgcn_readfirstlane(tid >> 6);
    const int b = row0 >> 12;
#pragma unroll 1
    for (int rr = 0; rr < 8; ++rr) {
        const int row = row0 + rr * 8 + wid;
        const f32x4* xr = (const f32x4*)(X + (size_t)row * D) + lane;
        f32x4 v[4]; float ss = 0.f;
#pragma unroll
        for (int j = 0; j < 4; ++j) { v[j] = xr[64 * j]; ss += (v[j].x * v[j].x + v[j].y * v[j].y) + (v[j].z * v[j].z + v[j].w * v[j].w); }
        const float rstd = rsqrtf(wave_sum(ss) * (1.0f / D) + RMS_EPS);
#pragma unroll
        for (int j = 0; j < 4; ++j) {
            const int col = 4 * lane + 256 * j;
            const f32x4 g4 = *(const f32x4*)(g + col), sc = *(const f32x4*)(modl + (size_t)b * 9216 + isc * 1024 + col), sh = *(const f32x4*)(modl + (size_t)b * 9216 + ish * 1024 + col);
            const f32x4 y = (v[j] * rstd) * g4 * (sc + 1.0f) + sh;
            u32x2 w; w.x = cvtpk(y.x, y.y); w.y = cvtpk(y.z, y.w);
            *(u32x2*)(out + (size_t)row * D + col) = w;
        }
    }
}
__device__ __forceinline__ void final_norm_block(float* X, const float* g, int row0) {
    const int tid = opq(get_tid()), lane = tid & 63, wid = __builtin_amdgcn_readfirstlane(tid >> 6);
#pragma unroll 1
    for (int rr = 0; rr < 8; ++rr) {
        const int row = row0 + rr * 8 + wid;
        f32x4* xr = (f32x4*)(X + (size_t)row * D) + lane;
        f32x4 v[4]; float ss = 0.f;
#pragma unroll
        for (int j = 0; j < 4; ++j) { v[j] = xr[64 * j]; ss += (v[j].x * v[j].x + v[j].y * v[j].y) + (v[j].z * v[j].z + v[j].w * v[j].w); }
        const float rstd = rsqrtf(wave_sum(ss) * (1.0f / D) + RMS_EPS);
#pragma unroll
        for (int j = 0; j < 4; ++j) { const f32x4 g4 = *(const f32x4*)(g + 4 * lane + 256 * j); xr[64 * j] = (v[j] * rstd) * g4; }
    }
}
struct CountedOrder : pg8::StaticOrder {
    unsigned* cnt;
    __device__ __forceinline__ void done(const pg8::Unit& u) const {
        __builtin_amdgcn_fence(__ATOMIC_RELEASE, "agent");
        if ((get_tid() & 63) == 0) __hip_atomic_fetch_add(cnt + u.pm, 1u, __ATOMIC_RELAXED, __HIP_MEMORY_SCOPE_AGENT);
    }
};
__device__ __forceinline__ void panel_wait(unsigned* cnt, int pm) {
    if (get_tid() == 0) {
        unsigned sp = 0;
        while (__hip_atomic_load(cnt + pm, __ATOMIC_RELAXED, __HIP_MEMORY_SCOPE_AGENT) < 32u) { __builtin_amdgcn_s_sleep(2); if (++sp > (1u << 22)) break; }
    }
    __syncthreads();
    __builtin_amdgcn_fence(__ATOMIC_ACQUIRE, "agent");
}

__device__ __forceinline__ void kpe_unit(const Args& A, int unit) {
    const int tid = opq(get_tid());
    unsigned char* w_ = ws_opq(A.ws);
    const bf16_t* P = (const bf16_t*)(w_ + WS_U); bf16_t* KPE = (bf16_t*)(w_ + WS_KPE); const float* rope = (const float*)(w_ + WS_ROPE);
#pragma unroll 2
    for (int k = 0; k < 8; ++k) {
        const int e = unit * 4096 + k * 512 + tid;
        const int row = e >> 4, i = e & 15, t = row & (T - 1);
        const float x0 = bf2f((short)P[(size_t)row * DINP + C_BKR + i]), x1 = bf2f((short)P[(size_t)row * DINP + C_BKR + 16 + i]);
        const float c = rope[t * 16 + i], sn = rope[T * 16 + t * 16 + i];
        KPE[(size_t)row * 32 + i] = (bf16_t)(cvtpk(x0 * c - x1 * sn, 0.f) & 0xffffu);
        KPE[(size_t)row * 32 + 16 + i] = (bf16_t)(cvtpk(x1 * c + x0 * sn, 0.f) & 0xffffu);
    }
}

constexpr int CTL_KN = 128;
__device__ __forceinline__ void kn_rows(const Args& A, int l) {
    const int tid = opq(get_tid()), lane = tid & 63, wid = __builtin_amdgcn_readfirstlane(tid >> 6), gw = blockIdx.x * NWAVE + wid, ngw = gridDim.x * NWAVE;
    unsigned char* w_ = ws_opq(A.ws);
    const bf16_t* P = (const bf16_t*)(w_ + WS_U); unsigned* kn = (unsigned*)(w_ + WS_CTL) + CTL_KN + l * 48;
    const int col2 = lane < 32 ? C_KS + 4 * lane : C_KW + 4 * (lane - 32);
    for (int it = gw; it < M / 16; it += ngw) {
        float m1 = 0.f, m2 = 0.f;
#pragma unroll 4
        for (int rr = 0; rr < 16; ++rr) {
            const bf16_t* rp = P + (size_t)(it * 16 + rr) * DINP;
            const s16x4 v1 = *(const s16x4*)(rp + C_AK + 4 * lane), v2 = *(const s16x4*)(rp + col2);
            float s1 = 0.f, s2 = 0.f;
#pragma unroll
            for (int j = 0; j < 4; ++j) { const float x = bf2f(v1[j]), y = bf2f(v2[j]); s1 += x * x; s2 += y * y; }
            s1 += __shfl_xor(s1, 1); s1 += __shfl_xor(s1, 2); s1 += __shfl_xor(s1, 4);
            s2 += __shfl_xor(s2, 1); s2 += __shfl_xor(s2, 2); s2 += __shfl_xor(s2, 4); s2 += __shfl_xor(s2, 8);
            m1 = fmaxf(m1, s1); m2 = fmaxf(m2, s2);
        }
        const int b = (it * 16) >> 12;
        if ((lane & 7) == 0) atomicMax(kn + b * 12 + (lane >> 3), __float_as_uint(m1));
        if ((lane & 15) == 0) atomicMax(kn + b * 12 + (lane < 32 ? 10 + (lane >> 4) : 8 + ((lane - 32) >> 4)), __float_as_uint(m2));
    }
}
#define XB_TMO      128
#define XB_XCNT(j)  (256  + 64 * (j))
#define XB_XSUB(j)  (1280 + 64 * (j))
#define XB_XGEN(j)  (2304 + 64 * (j))
#define XB_TOP      3328
#define XB_TOPGEN   3392
#define XCD_BAR_WORDS 3456
#define XB_SPIN_CAP (1u << 18)

__device__ __forceinline__ unsigned xb_ld(unsigned* p)              { return __hip_atomic_load(p, __ATOMIC_RELAXED, __HIP_MEMORY_SCOPE_AGENT); }
__device__ __forceinline__ unsigned xb_add(unsigned* p, unsigned v) { return __hip_atomic_fetch_add(p, v, __ATOMIC_RELAXED, __HIP_MEMORY_SCOPE_AGENT); }
__device__ __forceinline__ unsigned xb_xcc_id() { return (unsigned)__builtin_amdgcn_s_getreg((3 << 11) | 20) & 0xFu; }
#define XB_SPIN(cond, bar) do { unsigned _sp = 0; while (cond) { __builtin_amdgcn_s_sleep(1); \
    if ((++_sp & 255u) == 0u) { if (xb_ld(&(bar)[XB_TMO])) break; if (_sp > XB_SPIN_CAP) { atomicAdd(&(bar)[XB_TMO], 1u); break; } } } } while (0)

struct XcdBarrier {
    unsigned* bar; unsigned x;
    volatile LAS unsigned* st;
};

__device__ __forceinline__ XcdBarrier xcd_barrier_post(unsigned* bar, volatile LAS unsigned* st) {
    XcdBarrier b; b.bar = bar; b.x = xb_xcc_id(); b.st = st;
    if (get_tid() == 0) (void)xb_add(&bar[XB_XCNT(b.x)], 1u);
    return b;
}
__device__ __forceinline__ void xcd_barrier_complete(unsigned* bar, unsigned x, unsigned& nloc, unsigned& nx) {
    const unsigned G = gridDim.x * gridDim.y * gridDim.z;
    unsigned sum, cnt, mine, sp = 0u;
    for (;;) {
        sum = 0u; cnt = 0u; mine = 0u;
#pragma unroll
        for (unsigned j = 0; j < 16; ++j) { const unsigned c = xb_ld(&bar[XB_XCNT(j)]); sum += c; cnt += (c > 0u) ? 1u : 0u; mine = (j == x) ? c : mine; }
        if (sum == G) break;
        __builtin_amdgcn_s_sleep(1);
        if ((++sp & 255u) == 0u) { if (xb_ld(&bar[XB_TMO])) break; if (sp > XB_SPIN_CAP) { atomicAdd(&bar[XB_TMO], 1u); break; } }
    }
    nloc = mine > 0u ? mine : 1u; nx = cnt > 0u ? cnt : 1u;
}

__device__ __forceinline__ void xcd_barrier(const XcdBarrier& b) {
    asm volatile("s_waitcnt vmcnt(0)" ::: "memory");
    __syncthreads();
    if (get_tid() == 0) {
        unsigned* bar = b.bar;
        __builtin_amdgcn_s_waitcnt(0);
        unsigned nloc = b.st[0], nx = b.st[1];
        if (nloc == 0u) { xcd_barrier_complete(bar, b.x, nloc, nx); b.st[0] = nloc; b.st[1] = nx; }
        const unsigned old = xb_add(&bar[XB_XSUB(b.x)], 1u);
        const unsigned gen = old / nloc;
        if (old + 1u == (gen + 1u) * nloc) {
            __builtin_amdgcn_fence(__ATOMIC_RELEASE, "agent");
            asm volatile("s_waitcnt vmcnt(0)" ::: "memory");
            const unsigned og = xb_add(&bar[XB_TOP], 1u);
            const unsigned tg = og / nx;
            if (og + 1u == (tg + 1u) * nx) xb_add(&bar[XB_TOPGEN], 1u);
            else XB_SPIN(xb_ld(&bar[XB_TOPGEN]) == tg, bar);
            __builtin_amdgcn_fence(__ATOMIC_ACQUIRE, "agent");
            xb_add(&bar[XB_XGEN(b.x)], 1u);
            asm volatile("s_waitcnt vmcnt(0)" ::: "memory");
        } else {
            XB_SPIN(xb_ld(&bar[XB_XGEN(b.x)]) == gen, bar);
            __builtin_amdgcn_fence(__ATOMIC_ACQUIRE, "agent");
            asm volatile("s_waitcnt vmcnt(0)" ::: "memory");
        }
    }
    __syncthreads();
}

struct AttnArgs {
    const bf16_t* Q; int qpitch;
    const bf16_t* K1; int k1pitch;
    const bf16_t* K2; int k2pitch;
    const bf16_t* V; int vpitch;
    const float* rope;
    const unsigned long long* sel;
    float scale2, slope2; int window;
    float kmax;
};
constexpr int ATT_K_OFF = 0, ATT_V_OFF = 16384, ATT_BUF = 24576;

__device__ __forceinline__ s16x4 vtr(const LAS unsigned char* p) {
    typedef short v4i16_t __attribute__((ext_vector_type(4)));
    return __builtin_bit_cast(s16x4, __builtin_amdgcn_ds_read_tr16_b64_v4i16((LAS v4i16_t*)p));
}
template <bool ROWSUM> __device__ __forceinline__ void pv_tile_t(f32x16 (&o)[2], f32x16& osum, const f32x16& p0, const f32x16& p1, const LAS unsigned char* vl, int lane) {
    const int h = lane >> 5, i16 = lane & 15, q4 = i16 >> 2, p4 = i16 & 3, blk = (lane >> 4) & 1;
    const unsigned onew = ((lane & 31) == 0) ? 0x3f803f80u : 0u;
    const bf16x8 ones = __builtin_bit_cast(bf16x8, (u32x4){onew, onew, onew, onew});
    const LAS unsigned char* vb = vl + (4 * h + q4) * 64 + blk * 32 + p4 * 8;
#pragma unroll
    for (int s = 0; s < 4; ++s) {
        u32x4 pw;
        if (s == 0) { pw.x = cvtpk(p0[0], p0[1]); pw.y = cvtpk(p0[2], p0[3]); pw.z = cvtpk(p0[4], p0[5]); pw.w = cvtpk(p0[6], p0[7]); }
        else if (s == 1) { pw.x = cvtpk(p0[8], p0[9]); pw.y = cvtpk(p0[10], p0[11]); pw.z = cvtpk(p0[12], p0[13]); pw.w = cvtpk(p0[14], p0[15]); }
        else if (s == 2) { pw.x = cvtpk(p1[0], p1[1]); pw.y = cvtpk(p1[2], p1[3]); pw.z = cvtpk(p1[4], p1[5]); pw.w = cvtpk(p1[6], p1[7]); }
        else { pw.x = cvtpk(p1[8], p1[9]); pw.y = cvtpk(p1[10], p1[11]); pw.z = cvtpk(p1[12], p1[13]); pw.w = cvtpk(p1[14], p1[15]); }
        const bf16x8 pf = __builtin_bit_cast(bf16x8, pw);
#pragma unroll
        for (int db = 0; db < 2; ++db) {
            const s16x4 lo = vtr(vb + db * 4096 + (16 * s) * 64), hi = vtr(vb + db * 4096 + (16 * s + 8) * 64);
            const bf16x8 vf = __builtin_shufflevector(lo, hi, 0, 1, 2, 3, 4, 5, 6, 7);
            o[db] = MFMA32(vf, pf, o[db]);
        }
        if (ROWSUM) osum = MFMA32(ones, pf, osum);
    }
}
__device__ __forceinline__ void pv_tile(f32x16 (&o)[2], const f32x16& p0, const f32x16& p1, const LAS unsigned char* vl, int lane) {
    f32x16 dummy; pv_tile_t<false>(o, dummy, p0, p1, vl, lane);
}
template <int MODE> __device__ __forceinline__ void store_o(const f32x16 (&o)[2], bf16_t* out_row, int h, float sc) {
#pragma unroll
    for (int db = 0; db < 2; ++db)
#pragma unroll
        for (int g4 = 0; g4 < 4; ++g4) {
            bf16_t* p = out_row + 32 * db + 8 * g4 + 4 * h;
            float v0 = o[db][4 * g4] * sc, v1 = o[db][4 * g4 + 1] * sc, v2 = o[db][4 * g4 + 2] * sc, v3 = o[db][4 * g4 + 3] * sc;
            if (MODE == 1) { const u32x2 old = *(const u32x2*)p; v0 += __uint_as_float(old.x << 16); v1 += __uint_as_float(old.x & 0xffff0000u); v2 += __uint_as_float(old.y << 16); v3 += __uint_as_float(old.y & 0xffff0000u); }
            u32x2 w; w.x = cvtpk(v0, v1); w.y = cvtpk(v2, v3);
            *(u32x2*)p = w;
        }
}

constexpr int ATT_FLAG_OFF = 140480;
template <int DQK, bool ROPE, bool SEL, bool DUAL = false, bool EARLY = false>
__device__ __forceinline__ void attn_core(const AttnArgs& a, int q0, LAS unsigned char* lds, f32x16 (&o)[2]) {
    constexpr int KS = DQK / 16, DK = DUAL ? 2 * DQK : DQK, KP = DK * 2 + 16, D1 = DK < 64 ? DK : 64, NCH1 = D1 / 8, QROWS = DUAL ? 128 : 256;
    const int tid = opq(get_tid()), lane = tid & 63, wid = __builtin_amdgcn_readfirstlane(tid >> 6), r = lane & 31, h = lane >> 5;
    const int wq = DUAL ? (wid & 3) : wid, coff = DUAL ? (wid >> 2) * DQK : 0;
    const int qw0 = q0 + 32 * wq, qpos = qw0 + r;
    LAS unsigned char* Kl = lds + ATT_K_OFF; LAS unsigned char* Vl = lds + ATT_V_OFF;
    bf16x8 qf[KS];
    {
        const bf16_t* qrow = a.Q + (size_t)qpos * a.qpitch + coff;
#pragma unroll
        for (int ks = 0; ks < KS; ++ks) qf[ks] = *(const bf16x8*)(qrow + 16 * ks + 8 * h);
        if (ROPE) {
            const float* cs = a.rope + (size_t)qpos * 16 + 8 * h; const float* sn = cs + T * 16;
            float y0[8], y1[8];
#pragma unroll
            for (int j = 0; j < 8; ++j) { const float x0 = bf2f(qf[KS - 2][j]), x1 = bf2f(qf[KS - 1][j]), c = cs[j], s = sn[j]; y0[j] = x0 * c - x1 * s; y1[j] = x1 * c + x0 * s; }
            u32x4 w0, w1;
            w0.x = cvtpk(y0[0], y0[1]); w0.y = cvtpk(y0[2], y0[3]); w0.z = cvtpk(y0[4], y0[5]); w0.w = cvtpk(y0[6], y0[7]);
            w1.x = cvtpk(y1[0], y1[1]); w1.y = cvtpk(y1[2], y1[3]); w1.z = cvtpk(y1[4], y1[5]); w1.w = cvtpk(y1[6], y1[7]);
            qf[KS - 2] = __builtin_bit_cast(bf16x8, w0); qf[KS - 1] = __builtin_bit_cast(bf16x8, w1);
        }
    }
    float qk_bound = 0.f;
    if (EARLY) {
        float qq = 0.f;
#pragma unroll
        for (int ks = 0; ks < KS; ++ks)
#pragma unroll
            for (int j = 0; j < 8; ++j) { const float x = bf2f(qf[ks][j]); qq += x * x; }
        qq += __shfl_xor(qq, 32);
        qk_bound = sqrtf(qq) * a.kmax * a.scale2 * 1.01f + 0.01f;
    }
    unsigned long long selm = ~0ull;
    if (SEL) selm = a.sel[qpos];
    const int t_hi = (q0 + QROWS - 1) >> 6;
    int t_lo = 0;
    if (a.window) { const int lo = q0 - a.window + 1; t_lo = lo > 0 ? (lo >> 6) : 0; }
    const bool kA_on = tid < 64 * NCH1; const int rowA = tid / NCH1, chA = tid % NCH1;
    const bool kB_on = ROPE && tid < 128; const int rowB = tid >> 1, prB = tid & 1;
    const int rowV = tid >> 3, chV = tid & 7;
    u32x4 kA = {0, 0, 0, 0}, kB0 = {0, 0, 0, 0}, kB1 = {0, 0, 0, 0}, vR = {0, 0, 0, 0};
#define ATT_PREFETCH(t) do { \
        if (kA_on) kA = *(const u32x4*)(a.K1 + (size_t)(64 * (t) + rowA) * a.k1pitch + chA * 8); \
        if (kB_on) { const bf16_t* kp = a.K2 + (size_t)(64 * (t) + rowB) * a.k2pitch + prB * 8; kB0 = *(const u32x4*)kp; kB1 = *(const u32x4*)(kp + 16); } \
        vR = *(const u32x4*)(a.V + (size_t)(64 * (t) + rowV) * a.vpitch + chV * 8); } while (0)
#define ATT_STORE(tt, KL, VL) do { \
        if (kA_on) *(LAS u32x4*)((KL) + rowA * KP + chA * 16) = kA; \
        if (ROPE) { if (kB_on) { \
                *(LAS u32x4*)((KL) + rowB * KP + (64 + prB * 8) * 2) = kB0; \
                *(LAS u32x4*)((KL) + rowB * KP + (80 + prB * 8) * 2) = kB1; } } \
        *(LAS u32x4*)((VL) + (chV >> 2) * 4096 + rowV * 64 + (chV & 3) * 16) = vR; } while (0)
    float m = NEGBIG;
    f32x16 osum;
#pragma unroll
    for (int i = 0; i < 16; ++i) { o[0][i] = 0.f; o[1][i] = 0.f; osum[i] = 0.f; }
    float cbv[16];
#pragma unroll
    for (int i = 0; i < 16; ++i) cbv[i] = a.slope2 * (float)((i & 3) + 8 * (i >> 2) + 4 * h);
    volatile LAS unsigned* eflag = (volatile LAS unsigned*)(lds + ATT_FLAG_OFF);
    unsigned long long um = (t_hi >= 63 ? ~0ull : ((1ull << (t_hi + 1)) - 1ull)) & ~((1ull << t_lo) - 1ull);
    if (SEL) {
        LAS unsigned* uw = (LAS unsigned*)(lds + ATT_FLAG_OFF + 64);
        __syncthreads();
        if (tid < 2) uw[tid] = 0u;
        __syncthreads();
        __hip_atomic_fetch_or(uw, (unsigned)selm, __ATOMIC_RELAXED, __HIP_MEMORY_SCOPE_WORKGROUP);
        __hip_atomic_fetch_or(uw + 1, (unsigned)(selm >> 32), __ATOMIC_RELAXED, __HIP_MEMORY_SCOPE_WORKGROUP);
        __syncthreads();
        const unsigned lo_ = (unsigned)__builtin_amdgcn_readfirstlane((int)uw[0]), hi_ = (unsigned)__builtin_amdgcn_readfirstlane((int)uw[1]);
        um &= ((unsigned long long)hi_ << 32) | (unsigned long long)lo_;
    }
#define ATT_NEXT(tt) ((((tt) > 0) && (um & ((1ull << (tt)) - 1ull))) ? 63 - __builtin_clzll(um & ((1ull << (tt)) - 1ull)) : -1)
    int t = 63 - __builtin_clzll(um);
    int t1 = ATT_NEXT(t);
    ATT_PREFETCH(t);
    if (EARLY) { if (lane == 0) { eflag[wid] = 0u; eflag[8 + wid] = 0u; } }
    __syncthreads();
    ATT_STORE(t, Kl, Vl);
    __syncthreads();
    if (t1 >= 0) ATT_PREFETCH(t1);
    for (int step = 0; t >= 0; ++step) {
        const int cur = step & 1;
        const int t2 = (t1 >= 0) ? ATT_NEXT(t1) : -1;
        const LAS unsigned char* Kc = Kl + cur * ATT_BUF; const LAS unsigned char* Vc = Vl + cur * ATT_BUF;
        bool need = (64 * t <= qw0 + 31);
        if (a.window) need = need && (64 * t + 63 >= qw0 - a.window + 1);
        const bool selbit = SEL ? (((selm >> t) & 1ull) != 0ull) : true;
        if (SEL) need = need && (__ballot(selbit) != 0ull);
        if (need) {
            f32x16 p0, p1;
#pragma unroll
            for (int i = 0; i < 16; ++i) { p0[i] = 0.f; p1[i] = 0.f; }
#pragma unroll
            for (int ks = 0; ks < KS; ++ks) {
                const bf16x8 a0 = *(const LAS bf16x8*)(Kc + r * KP + coff * 2 + ks * 32 + h * 16);
                const bf16x8 a1 = *(const LAS bf16x8*)(Kc + (32 + r) * KP + coff * 2 + ks * 32 + h * 16);
                p0 = MFMA32(a0, qf[ks], p0); p1 = MFMA32(a1, qf[ks], p1);
            }
            if (!ROPE) {
#pragma unroll
                for (int i = 0; i < 16; ++i) { p0[i] = p0[i] * a.scale2 + cbv[i]; p1[i] = p1[i] * a.scale2 + cbv[i]; }
            }
            const float base0 = a.slope2 * (float)(64 * t - qpos), base1 = base0 + 32.0f * a.slope2;
            bool bnd = (64 * t + 63 > qw0);
            if (a.window) bnd = bnd || (64 * t < qw0 + 31 - a.window + 1);
            if (SEL) bnd = bnd || (__ballot(!selbit) != 0ull);
            if (bnd) {
                const int wlim = a.window ? a.window : (1 << 30);
#pragma unroll
                for (int i = 0; i < 16; ++i) {
                    const int kv0 = 64 * t + crow(i, h), d0 = qpos - kv0, d1 = d0 - 32;
                    const bool ok0 = selbit && d0 >= 0 && d0 < wlim, ok1 = selbit && d1 >= 0 && d1 < wlim;
                    p0[i] = ok0 ? p0[i] : NEGBIG; p1[i] = ok1 ? p1[i] : NEGBIG;
                }
            }
            float mx0 = p0[0], mx1 = p1[0];
#pragma unroll
            for (int i = 1; i < 16; ++i) { mx0 = fmaxf(mx0, p0[i]); mx1 = fmaxf(mx1, p1[i]); }
            float mloc = ROPE ? fmaxf(mx0, mx1) * a.scale2 : fmaxf(mx0 + base0, mx1 + base1);
            mloc = fmaxf(mloc, __shfl_xor(mloc, 32));
            const float mnew = fmaxf(m, mloc);
            if (__ballot(mnew > m) != 0ull) {
                const float alpha = fast_exp2(m - mnew);
                osum[0] *= alpha;
#pragma unroll
                for (int i = 0; i < 16; ++i) { o[0][i] *= alpha; o[1][i] *= alpha; }
            }
            m = mnew;
            const float r0 = mnew - base0, r1 = mnew - base1;
            if (ROPE) {
#pragma unroll
                for (int i = 0; i < 16; ++i) { p0[i] = fast_exp2(p0[i] * a.scale2 - mnew); p1[i] = fast_exp2(p1[i] * a.scale2 - mnew); }
            } else {
#pragma unroll
                for (int i = 0; i < 16; ++i) { p0[i] = fast_exp2(p0[i] - r0); p1[i] = fast_exp2(p1[i] - r1); }
            }
            pv_tile_t<true>(o, osum, p0, p1, Vc, lane);
        }
        if (EARLY) {
            const bool live = !(qk_bound - a.slope2 * (float)(qpos - 64 * t + 1) - m < -64.0f);
            const bool wdone = (__ballot(live) == 0ull);
            if (lane == 0) eflag[8 * cur + wid] = wdone ? 1u : 0u;
        }
        if (t1 >= 0) ATT_STORE(t1, Kl + (cur ^ 1) * ATT_BUF, Vl + (cur ^ 1) * ATT_BUF);
        __syncthreads();
        if (EARLY) {
            const unsigned alld = eflag[8 * cur] & eflag[8 * cur + 1] & eflag[8 * cur + 2] & eflag[8 * cur + 3] & eflag[8 * cur + 4] & eflag[8 * cur + 5] & eflag[8 * cur + 6] & eflag[8 * cur + 7];
            if (__builtin_amdgcn_readfirstlane((int)alld) != 0) break;
        }
        if (t2 >= 0) ATT_PREFETCH(t2);
        t = t1; t1 = t2;
    }
#undef ATT_NEXT
#undef ATT_STORE
#undef ATT_PREFETCH
    const float lt = __shfl(osum[0], lane & 31);
    const float inv = 1.0f / lt;
#pragma unroll
    for (int i = 0; i < 16; ++i) { o[0][i] *= inv; o[1][i] *= inv; }
}

__device__ __forceinline__ float da_slope(int hd) { return hd == 0 ? 0.25f : hd == 1 ? 0.0625f : hd == 2 ? 0.015625f : 0.00390625f; }
__device__ __forceinline__ float nsa_slope(int hh) { return hh == 0 ? 0.25f : hh == 1 ? 0.0625f : hh == 2 ? 0.015625f : hh == 3 ? 0.00390625f : hh == 4 ? 0.5f : 0.125f; }

constexpr int DA_X_OFF = 49152;
__device__ __forceinline__ void da_unit(const Args& A, int l, int b, int hd, int qb, LAS unsigned char* lds) {
    const int tid_ = opq(get_tid()), lane = tid_ & 63, wid = __builtin_amdgcn_readfirstlane(tid_ >> 6), r = lane & 31, h = lane >> 5;
    const bf16_t* P = (const bf16_t*)(A.ws + WS_U) + (size_t)b * T * DINP;
    const float lam = ((const float*)(A.ws + WS_CTL))[64 + l];
    const float one_m_li = ((const float*)(A.ws + WS_CTL))[66 + l];
    f32x16 o[2];
    AttnArgs a; a.Q = P + C_AQ + hd * 64; a.qpitch = DINP; a.K1 = P + C_AK + hd * 64; a.k1pitch = DINP; a.K2 = nullptr; a.k2pitch = 0;
    a.V = P + C_AV + hd * 64; a.vpitch = DINP; a.rope = nullptr; a.sel = nullptr; a.scale2 = 0.17677669529663687f * LOG2E; a.slope2 = da_slope(hd) * LOG2E; a.window = 0;
    { const unsigned* kn = (const unsigned*)(A.ws + WS_CTL) + CTL_KN + l * 96 + b * 24 + 2 * hd; a.kmax = sqrtf(fmaxf(__uint_as_float(kn[0]), __uint_as_float(kn[1]))); }
    attn_core<32, false, false, true, true>(a, qb * 128, lds, o);
    LAS float* xb = (LAS float*)(lds + DA_X_OFF) + (32 * (wid & 3) + r) * 65;
    if (wid >= 4) {
#pragma unroll
        for (int db = 0; db < 2; ++db)
#pragma unroll
            for (int i = 0; i < 16; ++i) xb[32 * db + crow(i, h)] = o[db][i];
    }
    __syncthreads();
    if (wid < 4) {
        float ss = 0.f;
#pragma unroll
        for (int db = 0; db < 2; ++db)
#pragma unroll
            for (int i = 0; i < 16; ++i) { o[db][i] = o[db][i] - lam * xb[32 * db + crow(i, h)]; ss += o[db][i] * o[db][i]; }
        ss += __shfl_xor(ss, 32);
        const float rs = rsqrtf(ss * (1.0f / 64.0f) + RMS_EPS) * one_m_li;
        const float* sg = A.in[14] + l * 64;
#pragma unroll
        for (int db = 0; db < 2; ++db)
#pragma unroll
            for (int i = 0; i < 16; ++i) o[db][i] *= rs * sg[32 * db + crow(i, h)];
        bf16_t* orow = (bf16_t*)(A.ws + WS_XN) + (size_t)(b * T + qb * 128 + 32 * wid + r) * D + hd * 64;
        store_o<0>(o, orow, h, EN_DA ? 1.0f : 0.0f);
    }
}
__device__ __forceinline__ void mla_unit(const Args& A, int b, int hd, int qb, LAS unsigned char* lds) {
    const int tid_ = opq(get_tid()), lane = tid_ & 63, wid = __builtin_amdgcn_readfirstlane(tid_ >> 6), r = lane & 31, h = lane >> 5;
    AttnArgs a; a.Q = (const bf16_t*)(A.ws + WS_MQ) + (size_t)b * T * 768 + hd * 96; a.qpitch = 768;
    a.K1 = (const bf16_t*)(A.ws + WS_MKV) + (size_t)b * T * 768 + hd * 128; a.k1pitch = 768;
    a.K2 = (const bf16_t*)(A.ws + WS_KPE) + (size_t)b * T * 32; a.k2pitch = 32;
    a.V = a.K1 + 64; a.vpitch = 768; a.rope = (const float*)(A.ws + WS_ROPE); a.sel = nullptr; a.scale2 = 0.10206207261596575f * LOG2E; a.slope2 = 0.f; a.window = 0; a.kmax = 0.f;
    f32x16 o[2];
    attn_core<96, true, false>(a, qb * 256, lds, o);
    bf16_t* orow = (bf16_t*)(A.ws + WS_XN) + (size_t)(b * T + qb * 256 + 32 * wid + r) * D + 256 + hd * 64;
    store_o<0>(o, orow, h, EN_MLA ? 1.0f : 0.0f);
}
template <int BR> __device__ __forceinline__ void nsa_unit(const Args& A, int l, int b, int hh, int qb, LAS unsigned char* lds) {
    const int tid_ = opq(get_tid()), lane = tid_ & 63, wid = __builtin_amdgcn_readfirstlane(tid_ >> 6), r = lane & 31, h = lane >> 5, g = hh / 3;
    const bf16_t* P = (const bf16_t*)(A.ws + WS_U) + (size_t)b * T * DINP;
    AttnArgs a; a.Q = P + C_CQ + hh * 64; a.qpitch = DINP; a.K1 = P + (BR == 2 ? C_KW : C_KS) + g * 64; a.k1pitch = DINP; a.K2 = nullptr; a.k2pitch = 0;
    a.V = P + (BR == 2 ? C_VW : C_VS) + g * 64; a.vpitch = DINP; a.rope = nullptr; a.sel = (const unsigned long long*)(A.ws + WS_SEL) + (size_t)(b * 2 + g) * T;
    a.scale2 = 0.125f * LOG2E; a.slope2 = nsa_slope(hh) * LOG2E; a.window = (BR == 2) ? 512 : 0;
    f32x16 o[2];
    { const unsigned* kn = (const unsigned*)(A.ws + WS_CTL) + CTL_KN + l * 96 + b * 24 + (BR == 2 ? 16 : 8) + 1 + 2 * g; a.kmax = sqrtf(__uint_as_float(kn[0]) + __uint_as_float(kn[1])); }
    attn_core<64, false, BR == 1, false, true>(a, qb * 256, lds, o);
    const int qpos = qb * 256 + 32 * wid + r;
    const float gl = bf2f((short)P[(size_t)qpos * DINP + C_G + BR * 6 + hh]);
    bf16_t* orow = (bf16_t*)(A.ws + WS_XN) + (size_t)(b * T + qpos) * D + 640 + hh * 64;
    if (BR == 2) store_o<0>(o, orow, h, EN_WIN ? sigmoid_f(gl) : 0.0f);
    else store_o<1>(o, orow, h, EN_SLC ? sigmoid_f(gl) : 0.0f);
}

__device__ __forceinline__ void cmp_mlp_task(const Args& A, int l, int wt, LAS unsigned char* lds) {
    const int tid_ = opq(get_tid()), lane = tid_ & 63, wid = __builtin_amdgcn_readfirstlane(tid_ >> 6);
    const int kv = wt >> 7, bg = (wt >> 4) & 7, rg = wt & 15, b = bg >> 1, g = bg & 1, i16 = lane & 15, quad = lane >> 4;
    const bf16_t* P = (const bf16_t*)(A.ws + WS_U) + (size_t)b * T * DINP + (kv ? C_VC : C_KC) + g * 64;
    const bf16_t* W1 = (const bf16_t*)(A.ws + WS_W + W_C1) + (size_t)kv * 128 * 2048;
    const bf16_t* W2 = (const bf16_t*)(A.ws + WS_W + W_C2) + (size_t)kv * 64 * 128;
    const float* posb = (const float*)(A.ws + WS_POSB) + (l * 2 + kv) * 128;
    const int n = 16 * rg + i16;
    const bf16_t* arow = P + (size_t)(16 * n) * DINP + 8 * quad;
    const bf16_t* wrow1 = W1 + (size_t)i16 * 2048 + 8 * quad;
    f32x4 acc[8];
#pragma unroll
    for (int i = 0; i < 8; ++i) acc[i] = (f32x4){0.f, 0.f, 0.f, 0.f};
#pragma unroll 2
    for (int kk = 0; kk < 8; ++kk) {
        const int ks = 8 * wid + kk;
        const bf16x8 bfrag = *(const bf16x8*)(arow + (size_t)(ks >> 1) * DINP + 32 * (ks & 1));
#pragma unroll
        for (int ht = 0; ht < 8; ++ht) {
            const bf16x8 afrag = *(const bf16x8*)(wrow1 + (size_t)(16 * ht) * 2048 + 32 * ks);
            acc[ht] = MFMA16(afrag, bfrag, acc[ht]);
        }
    }
    {
        LAS float* red = (LAS float*)lds;
        if (wid > 0) {
#pragma unroll
            for (int ht = 0; ht < 8; ++ht)
#pragma unroll
                for (int j = 0; j < 4; ++j) red[(wid * 64 + lane) * 33 + ht * 4 + j] = acc[ht][j];
        }
        __syncthreads();
        if (wid > 0) return;
#pragma unroll 1
        for (int w = 1; w < 8; ++w)
#pragma unroll
            for (int ht = 0; ht < 8; ++ht)
#pragma unroll
                for (int j = 0; j < 4; ++j) acc[ht][j] += red[(w * 64 + lane) * 33 + ht * 4 + j];
    }
    bf16x8 hf[4];
#pragma unroll
    for (int ks2 = 0; ks2 < 4; ++ks2) {
        float v[8];
#pragma unroll
        for (int e = 0; e < 8; ++e) {
            const int ht = 2 * ks2 + (e >> 2), j = e & 3;
            const float x = acc[ht][j] + posb[16 * ht + 4 * quad + j];
            const float u2 = 0.7978845608028654f * (x + 0.044715f * x * x * x);
            const float ex = fast_exp2(2.0f * LOG2E * u2);
            const float th = 1.0f - 2.0f * fast_rcp(ex + 1.0f);
            v[e] = 0.5f * x * (1.0f + th);
        }
        u32x4 w; w.x = cvtpk(v[0], v[1]); w.y = cvtpk(v[2], v[3]); w.z = cvtpk(v[4], v[5]); w.w = cvtpk(v[6], v[7]);
        hf[ks2] = __builtin_bit_cast(bf16x8, w);
    }
    bf16_t* outp = (bf16_t*)(A.ws + WS_KCMP) + ((size_t)(kv * 8 + bg) * 256 + n) * 64;
#pragma unroll
    for (int ot = 0; ot < 4; ++ot) {
        f32x4 c2 = (f32x4){0.f, 0.f, 0.f, 0.f};
        const bf16_t* w2r = W2 + (size_t)(16 * ot + i16) * 128 + 4 * quad;
#pragma unroll
        for (int ks2 = 0; ks2 < 4; ++ks2) {
            const u32x2 lo = *(const u32x2*)(w2r + 32 * ks2), hi = *(const u32x2*)(w2r + 32 * ks2 + 16);
            u32x4 w; w.x = lo.x; w.y = lo.y; w.z = hi.x; w.w = hi.y;
            c2 = MFMA16(__builtin_bit_cast(bf16x8, w), hf[ks2], c2);
        }
        if (n < 255) { u32x2 w; w.x = cvtpk(c2[0], c2[1]); w.y = cvtpk(c2[2], c2[3]); *(u32x2*)(outp + 16 * ot + 4 * quad) = w; }
    }
}

constexpr int CMP_K_OFF = 0, CMP_V_OFF = 36864, CMP_IMP_OFF = 69632;
__device__ __forceinline__ void cmp_unit(const Args& A, int b, int g, int qb, LAS unsigned char* lds, float gmul = 1.0f) {
    const int tid = opq(get_tid()), lane = tid & 63, wid = __builtin_amdgcn_readfirstlane(tid >> 6), r = lane & 31, h = lane >> 5;
    const int q0 = qb * 256, qw0 = q0 + 32 * wid, qpos = qw0 + r, qloc = 32 * wid + r;
    const int ntile = (((q0 + 224) >> 4) >> 6) + 1;
    LAS unsigned char* Kl = lds + CMP_K_OFF; LAS unsigned char* Vl = lds + CMP_V_OFF; LAS float* imp = (LAS float*)(lds + CMP_IMP_OFF);
    const bf16_t* KC = (const bf16_t*)(A.ws + WS_KCMP) + (size_t)(b * 2 + g) * 256 * 64;
    const bf16_t* VC = KC + (size_t)8 * 256 * 64;
    __syncthreads();
    for (int idx = tid; idx < 512 * ntile; idx += NTHR) {
        const int n = idx >> 3, ch = idx & 7;
        u32x4 kx = {0, 0, 0, 0}, vx = {0, 0, 0, 0};
        if (n < 255) { kx = *(const u32x4*)(KC + (size_t)n * 64 + ch * 8); vx = *(const u32x4*)(VC + (size_t)n * 64 + ch * 8); }
        *(LAS u32x4*)(Kl + n * 144 + ch * 16) = kx;
        *(LAS u32x4*)(Vl + (n >> 6) * 8192 + (ch >> 2) * 4096 + (n & 63) * 64 + (ch & 3) * 16) = vx;
    }
    for (int idx = tid; idx < 256 * 65; idx += NTHR) imp[idx] = 0.f;
    __syncthreads();
    const bf16_t* P = (const bf16_t*)(A.ws + WS_U) + (size_t)b * T * DINP;
    const float scale2 = 0.125f * LOG2E;
#pragma unroll 1
    for (int rr = 0; rr < 3; ++rr) {
        const int hh = 3 * g + rr; const float slope2 = nsa_slope(hh) * LOG2E;
        bf16x8 qf[4];
        { const bf16_t* qrow = P + (size_t)qpos * DINP + C_CQ + hh * 64;
#pragma unroll
          for (int ks = 0; ks < 4; ++ks) qf[ks] = *(const bf16x8*)(qrow + 16 * ks + 8 * h); }
        float m = NEGBIG, lsum = 0.f, invl = 0.f;
        f32x16 o[2];
#pragma unroll
        for (int i = 0; i < 16; ++i) { o[0][i] = 0.f; o[1][i] = 0.f; }
#pragma unroll 1
        for (int pass = 0; pass < 2; ++pass) {
#pragma unroll 1
            for (int tt = 0; tt < ntile; ++tt) {
                if (16 * (64 * tt) + 31 > qw0 + 31) continue;
                f32x16 p0, p1;
#pragma unroll
                for (int i = 0; i < 16; ++i) { p0[i] = 0.f; p1[i] = 0.f; }
#pragma unroll
                for (int ks = 0; ks < 4; ++ks) {
                    const bf16x8 a0 = *(const LAS bf16x8*)(Kl + (64 * tt + r) * 144 + ks * 32 + h * 16);
                    const bf16x8 a1 = *(const LAS bf16x8*)(Kl + (64 * tt + 32 + r) * 144 + ks * 32 + h * 16);
                    p0 = MFMA32(a0, qf[ks], p0); p1 = MFMA32(a1, qf[ks], p1);
                }
#pragma unroll
                for (int i = 0; i < 16; ++i) {
                    const int n0 = 64 * tt + crow(i, h), d0 = qpos - (16 * n0 + 31), d1 = d0 - 512;
                    p0[i] = d0 >= 0 ? p0[i] * scale2 - slope2 * (float)d0 : NEGBIG;
                    p1[i] = d1 >= 0 ? p1[i] * scale2 - slope2 * (float)d1 : NEGBIG;
                }
                if (pass == 0) {
                    float mloc = fmaxf(p0[0], p1[0]);
#pragma unroll
                    for (int i = 1; i < 16; ++i) mloc = fmaxf(mloc, fmaxf(p0[i], p1[i]));
                    mloc = fmaxf(mloc, __shfl_xor(mloc, 32));
                    const float mnew = fmaxf(m, mloc), alpha = fast_exp2(m - mnew);
                    m = mnew;
                    float ls = 0.f;
#pragma unroll
                    for (int i = 0; i < 16; ++i) ls += fast_exp2(p0[i] - mnew) + fast_exp2(p1[i] - mnew);
                    lsum = lsum * alpha + ls;
                } else {
#pragma unroll
                    for (int i = 0; i < 16; ++i) {
                        p0[i] = p0[i] > -1e29f ? fast_exp2(p0[i] - m) * invl : 0.f;
                        p1[i] = p1[i] > -1e29f ? fast_exp2(p1[i] - m) * invl : 0.f;
                    }
                    pv_tile(o, p0, p1, Vl + tt * 8192, lane);
#pragma unroll
                    for (int blk = 0; blk < 2; ++blk)
#pragma unroll
                        for (int g4 = 0; g4 < 4; ++g4) {
                            const int j = 16 * tt + 8 * blk + 2 * g4 + h;
                            const float G = blk == 0 ? (p0[4 * g4] + p0[4 * g4 + 1]) + (p0[4 * g4 + 2] + p0[4 * g4 + 3]) : (p1[4 * g4] + p1[4 * g4 + 1]) + (p1[4 * g4 + 2] + p1[4 * g4 + 3]);
                            imp[qloc * 65 + j] += G;
                        }
                    asm volatile("s_waitcnt lgkmcnt(0)" ::: "memory");
#pragma unroll
                    for (int blk = 0; blk < 2; ++blk)
#pragma unroll
                        for (int g4 = 0; g4 < 4; ++g4) {
                            const int j = 16 * tt + 8 * blk + 2 * g4 + h;
                            const float Lst = blk == 0 ? p0[4 * g4 + 3] : p1[4 * g4 + 3];
                            if (j + 1 < 64) imp[qloc * 65 + j + 1] += Lst;
                        }
                    asm volatile("s_waitcnt lgkmcnt(0)" ::: "memory");
                }
            }
            if (pass == 0) { const float lt = lsum + __shfl_xor(lsum, 32); invl = (qpos >= 31) ? 1.0f / lt : 0.f; }
        }
        const float gl = bf2f((short)P[(size_t)qpos * DINP + C_G + 0 * 6 + hh]);
        bf16_t* orow = (bf16_t*)(A.ws + WS_XN) + (size_t)(b * T + qpos) * D + 640 + hh * 64;
        store_o<1>(o, orow, h, EN_CMP ? sigmoid_f(gl) * gmul : 0.0f);
    }
    __syncthreads();
    if (qb < 4) {
        if (tid < 256) { const int t = q0 + tid, cur = t >> 6; ((unsigned long long*)(A.ws + WS_SEL))[(size_t)(b * 2 + g) * T + t] = (1ull << (cur + 1)) - 1ull; }
    } else {
        const int qi = tid >> 1, hf = tid & 1, t = q0 + qi, cur = t >> 6;
        float v[32];
#pragma unroll
        for (int i = 0; i < 32; ++i) { const int j = 32 * hf + i; const float x = imp[qi * 65 + j]; v[i] = (j >= 1 && j <= cur - 2) ? x : -1.0f; }
        unsigned long long mask = 1ull | (1ull << cur) | (1ull << (cur - 1));
#pragma unroll 1
        for (int it = 0; it < 13; ++it) {
            float bv = v[0]; int bi = 0;
#pragma unroll
            for (int i = 1; i < 32; ++i) { const bool gt = v[i] > bv; bv = gt ? v[i] : bv; bi = gt ? i : bi; }
            const float ov = __shfl_xor(bv, 1); const int oi = __shfl_xor(bi, 1);
            const float v0 = hf ? ov : bv, v1 = hf ? bv : ov; const int i0 = hf ? oi : bi, i1 = hf ? bi : oi;
            const bool win0 = v0 >= v1;
            const int wj = win0 ? i0 : 32 + i1;
            mask |= 1ull << wj;
            const int clr = (win0 == (hf == 0)) ? (win0 ? i0 : i1) : -1;
#pragma unroll
            for (int i = 0; i < 32; ++i) v[i] = (i == clr) ? -1.0f : v[i];
        }
        if (hf == 0) ((unsigned long long*)(A.ws + WS_SEL))[(size_t)(b * 2 + g) * T + t] = mask;
    }
    __syncthreads();
}

__device__ __forceinline__ int fetch_unit(unsigned* ctr, LAS unsigned char* lds) {
    volatile LAS int* w = (volatile LAS int*)(lds + FETCH_OFF);
    __syncthreads();
    if (get_tid() == 0) *w = (int)atomicAdd(ctr, 1u);
    __syncthreads();
    return __builtin_amdgcn_readfirstlane(*w);
}
template <class Epi>
__device__ __forceinline__ void run_gemm_counted(LAS unsigned char* lds, const bf16_t* Am, const bf16_t* Bt, int N, int K, const Epi& E, unsigned* cnt) {
    pg8::Gemm g{Am, Bt, M, N, K}; CountedOrder S; S.init(M, N, (int)gridDim.x, (int)blockIdx.x); S.cnt = cnt;
    pg8::gemm_phase<Epi, CountedOrder, true, true>(lds, g, S, E);
}
template <class Epi>
__device__ __forceinline__ void run_gemm_small(LAS unsigned char* lds, const bf16_t* Am, const bf16_t* Bt, int N, int K, const Epi& E) {
    asm volatile("" : "+s"(N), "+s"(K));
    pg8::Gemm g{Am, Bt, M, N, K}; pg8::StaticOrder S; S.init(M, N, (int)gridDim.x, (int)blockIdx.x);
    pg8::gemm_phase<Epi, pg8::StaticOrder, true, true>(lds, g, S, E);
}
template <class Epi>
__device__ __forceinline__ void run_gemm(LAS unsigned char* lds, const bf16_t* Am, const bf16_t* Bt, int N, int K, const Epi& E) {
    pg8::Gemm g{Am, Bt, M, N, K}; pg8::StaticOrder S; S.init(M, N, (int)gridDim.x, (int)blockIdx.x);
    pg8::gemm_phase<Epi, pg8::StaticOrder, true, true>(lds, g, S, E);
}

__global__ void __launch_bounds__(NTHR, 2) fwd_megakernel(Args A) {
    LAS unsigned char* lds = (LAS unsigned char*)lds_raw;
    if (lane_id() == 0) *(volatile LAS int*)(lds + WIDTAB_OFF + 4 * hw_slot()) = (int)(threadIdx.x >> 6);
    __syncthreads();
    cg::grid_group grid = cg::this_grid();
    const int G = gridDim.x;
    { volatile LAS unsigned* st0 = (volatile LAS unsigned*)(lds + FETCH_OFF + 16); if (get_tid() < 2) st0[get_tid()] = 0u; }
    __syncthreads();
#ifdef PROBE_PHASE
    if (get_tid() < 32) { volatile LAS unsigned* ta_ = (volatile LAS unsigned*)(lds + 140000); ta_[get_tid()] = 0u; }
    __syncthreads();
    if (get_tid() == 0) { volatile LAS unsigned* ta_ = (volatile LAS unsigned*)(lds + 140000); ta_[31] = (unsigned)__builtin_amdgcn_s_memrealtime(); }
    __syncthreads();
#endif
    const unsigned xbar_x = (unsigned)__builtin_amdgcn_readfirstlane((int)xcd_barrier_post((unsigned*)(A.ws + WS_CTL) + 1024, (volatile LAS unsigned*)(lds + FETCH_OFF + 16)).x);
#ifdef PROBE_PHASE
#define STAMP(id) do { if (blockIdx.x == 0 && get_tid() == 0) { volatile LAS unsigned* ta_ = (volatile LAS unsigned*)(lds + 140000); const unsigned now_ = (unsigned)__builtin_amdgcn_s_memrealtime(); ta_[id] += now_ - ta_[31]; ta_[31] = now_; } } while (0)
#else
#define STAMP(id) do {} while (0)
#endif
#define GSYNC() do { XcdBarrier xb_; unsigned xx_ = xbar_x; asm volatile("" : "+s"(xx_)); xb_.bar = (unsigned*)(A.ws + WS_CTL) + 1024; xb_.x = xx_; \
                     xb_.st = (volatile LAS unsigned*)(lds + FETCH_OFF + 16); xcd_barrier(xb_); } while (0)
    unsigned char* ws = A.ws;
    unsigned* ctl = (unsigned*)(ws + WS_CTL);
    float* X = A.out;
    bf16_t* XN = (bf16_t*)(ws + WS_XN);
    bf16_t* U = (bf16_t*)(ws + WS_U);
    const float* mods = (const float*)(ws + WS_MODS);

    for (int task = blockIdx.x; task < 288; task += G) mods_task(A, task, lds);
    for (int task = G - 1 - (int)blockIdx.x; task < 64; task += G) posb_task(A, task, lds);
    rope_entries(A);
    { float* ssq = (float*)(ws + WS_SSQ); for (int i = blockIdx.x * NTHR + opq(get_tid()); i < 4 * M; i += G * NTHR) ssq[i] = 0.f; }
    if (blockIdx.x == 0 && get_tid() < 2) {
        const int tid = opq(get_tid());
        const float* lp = A.in[13] + tid * 128; float s1 = 0.f, s2 = 0.f;
        for (int i = 0; i < 32; ++i) { s1 += lp[i] * lp[32 + i]; s2 += lp[64 + i] * lp[96 + i]; }
        const float lam_init = tid == 0 ? 0.2f : 0.35550907f;
        ((float*)ctl)[64 + tid] = expf(s1) - expf(s2) + lam_init;
        ((float*)ctl)[66 + tid] = 1.0f - lam_init;
    }
    __syncthreads();
    convert_layer(A, 0, lds);
#ifdef PROBE_DUPCVT
    for (int i = 0; i < PROBE_DUPCVT; ++i) { __syncthreads(); convert_layer(A, 0, lds); }
#endif
#ifdef PROBE_DUPMODS
    for (int task = blockIdx.x; task < 288; task += G) mods_task(A, task, lds);
#endif
    grid.sync();
    STAMP(0);

    if (blockIdx.x == 0) posb_final(A);
#pragma unroll 1
    for (int l = 0; l < 2; ++l) {
        const float* modl = mods + (size_t)l * 4 * 9216;
        unsigned char* wb = ws + WS_W;
        if (l == 1) { __syncthreads(); convert_layer(A, 1, lds); }
#pragma unroll 1
        for (int s = 0; s < 2; ++s) {
            const float* xin = (l == 0 && s == 0) ? A.in[0] : X;
            norm_rows(xin, XN, A.in[s == 0 ? 4 : 6] + l * D, modl, s == 0 ? 0 : 6, s == 0 ? 1 : 7);
            GSYNC();
            STAMP(1);
            { EpiSwiGLU E{U}; run_gemm(lds, XN, (const bf16_t*)(wb + (s == 0 ? W_1A : W_2A)), F2, D, E); }
            GSYNC();
            STAMP(2);
            { EpiResid E{xin, X, modl + (s == 0 ? 2 : 8) * 1024, 0.5f}; run_gemm(lds, U, (const bf16_t*)(wb + (s == 0 ? W_1B : W_2B)), D, F, E); }
            GSYNC();
            STAMP(3);
            if (s == 0 && EN_MIX) {
                norm_rows(X, XN, A.in[5] + l * D, modl, 3, 4);
                GSYNC();
                STAMP(4);
                float* ssq = (float*)(ws + WS_SSQ) + (size_t)l * 2 * M;
                { EpiProj E{U, (bf16_t*)(ws + WS_CQ), (bf16_t*)(ws + WS_CKV), ssq, ssq + M, ctl + CTL_KN + l * 96}; run_gemm(lds, XN, (const bf16_t*)(wb + W_IN), DINP, D, E); }
                GSYNC();
                STAMP(5);
                { EpiRowScale E{(bf16_t*)(ws + WS_MQ), 768, ssq, 1.0f / 256.0f}; run_gemm_small(lds, (const bf16_t*)(ws + WS_CQ), (const bf16_t*)(wb + W_UQ), 768, 256, E); }
                { EpiRowScale E{(bf16_t*)(ws + WS_MKV), 768, ssq + M, 1.0f / 128.0f}; run_gemm_small(lds, (const bf16_t*)(ws + WS_CKV), (const bf16_t*)(wb + W_UKV), 768, 128, E); }
                STAMP(11);
                for (;;) {
                    int u = fetch_unit(ctl + l * 4 + 0, lds);
                    if (u >= 64 + 256 + 512 + 384) break;
                    if (u < 512) { da_unit(A, l, (u & 15) >> 2, u & 3, 31 - (u >> 4), lds); continue; } u -= 512;
                    if (u < 384) { nsa_unit<2>(A, l, (u % 24) / 6, u % 6, 15 - u / 24, lds); continue; } u -= 384;
                    if (u < 256) { cmp_mlp_task(A, l, u, lds); continue; } u -= 256;
                    kpe_unit(A, u);
                }
                GSYNC();
                STAMP(6);
                for (;;) {
                    int u = fetch_unit(ctl + l * 4 + 1, lds);
                    if (u >= 384 + 128) break;
                    if (u < 192) { mla_unit(A, (u % 24) / 6, u % 6, 15 - u / 24, lds); continue; } u -= 192;
                    if (u < 128) { cmp_unit(A, (u & 7) >> 1, u & 1, 15 - (u >> 3), lds); continue; } u -= 128;
                    u += 192; mla_unit(A, (u % 24) / 6, u % 6, 15 - u / 24, lds);
                }
                GSYNC();
                STAMP(7);
                for (;;) {
                    const int u = fetch_unit(ctl + l * 4 + 2, lds);
                    if (u >= 384) break;
                    nsa_unit<1>(A, l, (u % 24) / 6, u % 6, 15 - u / 24, lds);
                }
                GSYNC();
                STAMP(8);
                { EpiResid E{X, X, modl + 5 * 1024, 1.0f}; run_gemm(lds, XN, (const bf16_t*)(wb + W_OUT), D, D, E); }
                GSYNC();
                STAMP(9);
            }
        }
    }
    final_norm_rows(X, A.in[22]);
#ifdef PROBE_PHASE
    STAMP(10);
    __syncthreads();
    if (blockIdx.x == 0 && get_tid() == 0) { volatile LAS unsigned* ta_ = (volatile LAS unsigned*)(lds + 140000); X[0] += (float)ta_[PROBE_PHASE] * 0.0001f; }
#endif
#ifdef PROBE_SYNCS
    for (int i = 0; i < PROBE_SYNCS; ++i) GSYNC();
#endif
}

extern "C" void kernel_launch(void* const* d_in, const int* in_sizes, int n_in, void* d_out, int out_size, void* d_ws, size_t ws_size, hipStream_t stream) {
    static int grid = 0;
    if (grid == 0) {
        if (n_in != 23 || out_size != M * D || ws_size < WS_END) { fprintf(stderr, "kernel_launch: unexpected problem shape (n_in %d out %d ws %zu)\n", n_in, out_size, ws_size); grid = -1; return; }
        int dev = 0, cus = 0, per_cu = 0;
        hipGetDevice(&dev);
        hipDeviceGetAttribute(&cus, hipDeviceAttributeMultiprocessorCount, dev);
        hipFuncSetAttribute((const void*)fwd_megakernel, hipFuncAttributeMaxDynamicSharedMemorySize, LDS_BYTES);
        hipOccupancyMaxActiveBlocksPerMultiprocessor(&per_cu, (const void*)fwd_megakernel, NTHR, LDS_BYTES);
        if (per_cu < 1) per_cu = 1;
        grid = cus * per_cu;
        (void)hipGetLastError();
    }
    if (grid < 0) return;
    hipMemsetAsync(d_ws, 0, 32768, stream);
    Args a{};
    for (int i = 0; i < 23; ++i) a.in[i] = (const float*)d_in[i];
    a.out = (float*)d_out; a.ws = (unsigned char*)d_ws;
    void* args[] = {&a};
    hipError_t e = hipLaunchCooperativeKernel((const void*)fwd_megakernel, dim3(grid), dim3(NTHR), args, LDS_BYTES, stream);
    if (e != hipSuccess) fprintf(stderr, "cooperative launch failed: %s (grid %d)\n", hipGetErrorString(e), grid);
}
```

```cpp
#include <hip/hip_runtime.h>
#include <hip/hip_cooperative_groups.h>
#include <cstdio>
#include <cstdint>
namespace cg = cooperative_groups;
extern __shared__ __attribute__((aligned(16))) unsigned char lds_raw[];
constexpr int WIDTAB_OFF = 140200;
__device__ __forceinline__ int lane_id() { return (int)__builtin_amdgcn_mbcnt_hi(~0u, __builtin_amdgcn_mbcnt_lo(~0u, 0u)); }
__device__ __forceinline__ int hw_slot() { return (int)(__builtin_amdgcn_s_getreg((5 << 11) | 4) & 63u); }
__device__ __forceinline__ int get_tid() {
    const int wid = __builtin_amdgcn_readfirstlane(*(volatile __attribute__((address_space(3))) int*)((__attribute__((address_space(3))) unsigned char*)lds_raw + WIDTAB_OFF + 4 * hw_slot()));
    return wid * 64 + lane_id();
}
__device__ __forceinline__ int pg8_opq_tid() { int v = get_tid(); asm volatile("" : "+v"(v)); return v; }
namespace pg8 {
#define PG8_LAS __attribute__((address_space(3)))
typedef unsigned short bf16_t;
typedef short bf16x8 __attribute__((ext_vector_type(8)));
typedef float f32x4 __attribute__((ext_vector_type(4)));
typedef unsigned u32x4 __attribute__((ext_vector_type(4)));
constexpr int BM = 256, BK = 64, HALF = 128, HTB = HALF * BK * 2  , STAGE_BYTES = 8 * HTB, NXCD = 8, WGM = 8;

__host__ __device__ __forceinline__ int lds_byte(int r, int c) { const int st = (r >> 4) * 2 + (c >> 5), rr = r & 15, cc = c & 31, ob = rr * 64 + cc * 2; return st * 1024 + (ob ^ (((ob >> 9) & 1) << 5)); }
__host__ __device__ __forceinline__ void stage_rc(int b, int& R, int& C) { const int st = b / 1024, sb = b % 1024, swz = sb ^ (((sb >> 9) & 1) << 5); R = (st >> 1) * 16 + swz / 64; C = (st & 1) * 32 + (swz % 64) / 2; }
__host__ __device__ __forceinline__ int perm32(int rho) { const int n = rho >> 4, i = rho & 15; return 8 * (i >> 2) + 4 * n + (i & 3); }

struct Unit { int pm, pn; };
struct Gemm { const bf16_t* A; const bf16_t* Bt; int M, N, K; };

struct StaticOrder {
    int nM, nN, nwg, G, c;
    __host__ __device__ void init(int M, int N, int G_, int c_) { nM = M / BM; nN = N / BM; nwg = nM * nN; G = G_; c = c_; }
    __host__ __device__ bool next(int i, Unit& u) const {
        const long L = (long)i * G + c; if (L >= nwg) return false;
        int wgid = (int)L; { const int q = nwg / NXCD, r = nwg % NXCD, xcd = wgid % NXCD, off = wgid / NXCD; wgid = (xcd < r ? xcd * (q + 1) : r * (q + 1) + (xcd - r) * q) + off; }
        const int nig = WGM * nN, gid = wgid / nig, fm = gid * WGM, gsz = (nM - fm) < WGM ? (nM - fm) : WGM;
        u.pm = fm + ((wgid % nig) % gsz); u.pn = (wgid % nig) / gsz; return true;
    }
    __device__ __forceinline__ void a_ready(const Unit&) const {}
    __device__ __forceinline__ void done(const Unit&) const {}
};

__device__ __forceinline__ unsigned cvt_pk_bf16(float lo, float hi) { unsigned r; asm volatile("v_cvt_pk_bf16_f32 %0, %1, %2" : "=v"(r) : "v"(lo), "v"(hi)); return r; }
typedef float f32x2 __attribute__((ext_vector_type(2)));
__device__ __forceinline__ f32x2 gelu_pk(f32x2 v) {
    const f32x2 av = __builtin_elementwise_abs(v), d = av * 0.2316418882f + 1.0f;
    f32x2 t; t.x = __builtin_amdgcn_rcpf(d.x); t.y = __builtin_amdgcn_rcpf(d.y);
    f32x2 q = t * 0.5307027145f + (-0.7265760135f); q = q * t + 0.7107068705f; q = q * t + (-0.142248368f); q = q * t + 0.127414796f; q = q * t;
    const f32x2 s = (v * v) * (-0.72134752044f);
    f32x2 e; e.x = __builtin_amdgcn_exp2f(s.x); e.y = __builtin_amdgcn_exp2f(s.y);
    const f32x2 m = v * (q * e), r = v - m;
    f32x2 o; o.x = v.x < 0.f ? m.x : r.x; o.y = v.y < 0.f ? m.y : r.y; return o;
}

template <int ACT  > struct EpiBf16 {
    static constexpr bool PERM = true, AFTER_DRAIN = false; static_assert(ACT == 0 || ACT == 1, "EpiBf16: ACT is 0 (none) or 1 (gelu_pk)");
    bf16_t* O; int ldc; const float* bias; int split_cols; size_t split_stride; float scale0;
    __device__ __forceinline__ void operator()(const f32x4 (&acc)[2][2][4][2], const Unit& u, int wr, int wc, int fr, int fq) const {
        const int row0 = u.pm * BM + wr * 64 + fr; int colt = u.pn * BM; bf16_t* base = O;
        float sc = 1.f; if (split_cols) { const int t = colt / split_cols; base += (size_t)t * split_stride; colt -= t * split_cols; if (t == 0) sc = scale0; }
        const int col0 = colt + wc * 32 + 8 * fq, bcol0 = u.pn * BM + wc * 32 + 8 * fq;
        f32x4 bv[2][2];
#pragma unroll
        for (int bj = 0; bj < 2; ++bj)
#pragma unroll
            for (int n = 0; n < 2; ++n) bv[bj][n] = bias ? *(const f32x4*)(bias + bcol0 + bj * HALF + 4 * n) : (f32x4){0.f, 0.f, 0.f, 0.f};
#pragma unroll
        for (int ai = 0; ai < 2; ++ai)
#pragma unroll
            for (int m = 0; m < 4; ++m) { bf16_t* rowp = base + (size_t)(row0 + ai * HALF + m * 16) * ldc + col0;
#pragma unroll
                for (int bj = 0; bj < 2; ++bj) { f32x4 v0 = acc[ai][bj][m][0] + bv[bj][0], v1 = acc[ai][bj][m][1] + bv[bj][1];
                    if (ACT == 1) { f32x2 a = gelu_pk((f32x2){v0[0], v0[1]}), b = gelu_pk((f32x2){v0[2], v0[3]}), c = gelu_pk((f32x2){v1[0], v1[1]}), d = gelu_pk((f32x2){v1[2], v1[3]});
                        v0 = (f32x4){a.x, a.y, b.x, b.y}; v1 = (f32x4){c.x, c.y, d.x, d.y}; }
                    v0 = v0 * sc; v1 = v1 * sc; u32x4 w; w.x = cvt_pk_bf16(v0[0], v0[1]); w.y = cvt_pk_bf16(v0[2], v0[3]); w.z = cvt_pk_bf16(v1[0], v1[1]); w.w = cvt_pk_bf16(v1[2], v1[3]);
                    *(u32x4*)(rowp + bj * HALF) = w; } }
    }
};
template <class Epi, class Sched, bool ALIGN_EPI = false, bool SP2 = false>
__device__ __forceinline__ void gemm_phase(PG8_LAS unsigned char* lds, const Gemm g, const Sched& S, const Epi& E) {
    const int tid = pg8_opq_tid(), wid = __builtin_amdgcn_readfirstlane(tid >> 6), lane = tid & 63, wr = wid >> 2, wc = wid & 3, fr = lane & 15, fq = lane >> 4;
    const int K = g.K, nt = K / BK;
    unsigned voffA[2], voffB[2];
#pragma unroll
    for (int i = 0; i < 2; ++i) { int R, C; stage_rc(tid * 16 + i * 8192, R, C); const int Rb = Epi::PERM ? ((R & ~31) + perm32(R & 31)) : R;
        voffA[i] = (unsigned)(R * K + C) * 2u; voffB[i] = (unsigned)(Rb * K + C) * 2u; }
    const size_t kstep = (size_t)(BK * 2);
    const size_t hstep = (size_t)HALF * K * 2;
    const size_t tstep = 2 * hstep;
    const unsigned ldsw = (unsigned)wid * 1024u;
    const int aoff = lds_byte(wr * 64 + fr, fq * 8), boff = lds_byte(wc * 32 + fr, fq * 8);
#define PG8_SA(b, h) (((b) * 2 + (h)) * HTB)
#define PG8_SB(b, h) ((4 + (b) * 2 + (h)) * HTB)
#define PG8_STAGE(bufoff, gbase, voff) do { _Pragma("unroll") for (int _i = 0; _i < 2; ++_i) \
        __builtin_amdgcn_global_load_lds((const unsigned*)((const char*)(gbase) + (voff)[_i]), (PG8_LAS unsigned*)(lds + (bufoff) + ldsw + _i * 8192), 16, 0, 0); } while (0)
#define PG8_LDA(dst, b, h) do { _Pragma("unroll") for (int m = 0; m < 4; ++m) _Pragma("unroll") for (int k = 0; k < 2; ++k) dst[m][k] = *(const PG8_LAS bf16x8*)(lds + PG8_SA(b, h) + aoff + m * 2048 + k * 1024); } while (0)
#define PG8_LDB(dst, b, h) do { _Pragma("unroll") for (int n = 0; n < 2; ++n) _Pragma("unroll") for (int k = 0; k < 2; ++k) dst[n][k] = *(const PG8_LAS bf16x8*)(lds + PG8_SB(b, h) + boff + n * 2048 + k * 1024); } while (0)
#define PG8_MMA(ai, bj, At, Bt) do { __builtin_amdgcn_s_setprio(1); _Pragma("unroll") for (int m = 0; m < 4; ++m) _Pragma("unroll") for (int n = 0; n < 2; ++n) _Pragma("unroll") for (int k = 0; k < 2; ++k) \
        acc[ai][bj][m][n] = __builtin_amdgcn_mfma_f32_16x16x32_bf16(Bt[n][k], At[m][k], acc[ai][bj][m][n], 0, 0, 0); __builtin_amdgcn_s_setprio(0); } while (0)
#define PG8_WAIT_V(n) asm volatile("s_waitcnt vmcnt(" #n ")" ::: "memory")
#define PG8_WAIT_L(n) asm volatile("s_waitcnt lgkmcnt(" #n ")" ::: "memory")
#define PG8_BAR __builtin_amdgcn_s_barrier()
#define PG8_SCHED __builtin_amdgcn_sched_barrier(0)
    Unit cur, nxt; int ui = 0;
    if (!S.next(0, cur)) return;
    f32x4 acc[2][2][4][2];
#pragma unroll
    for (int a = 0; a < 2; ++a)
#pragma unroll
        for (int b = 0; b < 2; ++b)
#pragma unroll
            for (int m = 0; m < 4; ++m)
#pragma unroll
                for (int n = 0; n < 2; ++n) acc[a][b][m][n] = (f32x4){0.f, 0.f, 0.f, 0.f};
    bf16x8 At[4][2], B0[2][2], B1[2][2];
    const char* cA = (const char*)g.A + (size_t)cur.pm * tstep; const char* cB = (const char*)g.Bt + (size_t)cur.pn * tstep;
    S.a_ready(cur);
    if constexpr (SP2) {
        PG8_STAGE(PG8_SB(0, 0), cB, voffB); PG8_STAGE(PG8_SB(0, 1), cB + hstep, voffB); PG8_STAGE(PG8_SA(0, 0), cA, voffA); PG8_STAGE(PG8_SA(0, 1), cA + hstep, voffA);
        if (wr == 1) PG8_BAR;
        PG8_WAIT_V(2); PG8_BAR;
        PG8_STAGE(PG8_SB(1, 0), cB + kstep, voffB); PG8_STAGE(PG8_SA(1, 0), cA + kstep, voffA); PG8_STAGE(PG8_SB(1, 1), cB + hstep + kstep, voffB);
        PG8_WAIT_V(6); PG8_BAR;
    } else {
        PG8_STAGE(PG8_SB(0, 0), cB, voffB); PG8_STAGE(PG8_SA(0, 0), cA, voffA); PG8_STAGE(PG8_SB(0, 1), cB + hstep, voffB); PG8_STAGE(PG8_SA(0, 1), cA + hstep, voffA);
        if (wr == 1) PG8_BAR;
        PG8_WAIT_V(4); PG8_BAR;
        PG8_STAGE(PG8_SB(1, 0), cB + kstep, voffB); PG8_STAGE(PG8_SA(1, 0), cA + kstep, voffA); PG8_STAGE(PG8_SB(1, 1), cB + hstep + kstep, voffB);
        PG8_WAIT_V(6); PG8_BAR;
    }
    for (;;) {
        const bool has_next = S.next(ui + 1, nxt);
        const char* nA = has_next ? (const char*)g.A + (size_t)nxt.pm * tstep : cA; const char* nB = has_next ? (const char*)g.Bt + (size_t)nxt.pn * tstep : cB;
        for (int t = 0; t < nt; t += 2) {
            const bool last = (t == nt - 2);
            const char* a1 = cA + (size_t)(t + 1) * kstep;
            const char* a2 = last ? nA : cA + (size_t)(t + 2) * kstep; const char* b2 = last ? nB : cB + (size_t)(t + 2) * kstep;
            const char* a3 = a2 + kstep; const char* b3 = b2 + kstep;
            if (last && has_next) S.a_ready(nxt);
            if constexpr (SP2) {
            PG8_LDB(B0, 0, 0); PG8_LDB(B1, 0, 1); PG8_SCHED; PG8_LDA(At, 0, 0); PG8_STAGE(PG8_SA(1, 1), a1 + hstep, voffA);
            PG8_WAIT_V(8); PG8_WAIT_L(0); PG8_BAR; PG8_MMA(0, 0, At, B0); PG8_MMA(0, 1, At, B1); PG8_BAR; PG8_SCHED;
            PG8_LDA(At, 0, 1); PG8_STAGE(PG8_SB(0, 0), b2, voffB); PG8_STAGE(PG8_SB(0, 1), b2 + hstep, voffB); PG8_STAGE(PG8_SA(0, 0), a2, voffA);
            PG8_WAIT_V(8); PG8_WAIT_L(0); PG8_BAR; PG8_MMA(1, 0, At, B0); PG8_MMA(1, 1, At, B1); PG8_BAR; PG8_SCHED;
            PG8_LDB(B0, 1, 0); PG8_LDB(B1, 1, 1); PG8_SCHED; PG8_LDA(At, 1, 0); PG8_STAGE(PG8_SA(0, 1), a2 + hstep, voffA);
            PG8_WAIT_V(8); PG8_WAIT_L(0); PG8_BAR; PG8_MMA(0, 0, At, B0); PG8_MMA(0, 1, At, B1); PG8_BAR; PG8_SCHED;
            PG8_LDA(At, 1, 1); PG8_STAGE(PG8_SB(1, 0), b3, voffB); PG8_STAGE(PG8_SB(1, 1), b3 + hstep, voffB); PG8_STAGE(PG8_SA(1, 0), a3, voffA);
            PG8_WAIT_V(8); PG8_WAIT_L(0); PG8_BAR; PG8_MMA(1, 0, At, B0); PG8_MMA(1, 1, At, B1); PG8_BAR; PG8_SCHED;
            } else {
            PG8_LDB(B0, 0, 0); PG8_SCHED; PG8_LDA(At, 0, 0); PG8_STAGE(PG8_SA(1, 1), a1 + hstep, voffA);
            PG8_WAIT_L(8); PG8_BAR; PG8_WAIT_L(0); PG8_MMA(0, 0, At, B0); PG8_BAR; PG8_SCHED;
            PG8_LDB(B1, 0, 1); PG8_STAGE(PG8_SB(0, 0), b2, voffB);
            PG8_BAR; PG8_WAIT_L(0); PG8_MMA(0, 1, At, B1); PG8_BAR;
            PG8_LDA(At, 0, 1); PG8_STAGE(PG8_SA(0, 0), a2, voffA);
            PG8_BAR; PG8_WAIT_L(0); PG8_MMA(1, 0, At, B0); PG8_BAR; PG8_SCHED;
            PG8_STAGE(PG8_SB(0, 1), b2 + hstep, voffB);
            PG8_WAIT_V(6); PG8_BAR; PG8_MMA(1, 1, At, B1); PG8_BAR;
            PG8_LDB(B0, 1, 0); PG8_SCHED; PG8_LDA(At, 1, 0); PG8_STAGE(PG8_SA(0, 1), a2 + hstep, voffA);
            PG8_WAIT_L(8); PG8_BAR; PG8_WAIT_L(0); PG8_MMA(0, 0, At, B0); PG8_BAR; PG8_SCHED;
            PG8_LDB(B1, 1, 1); PG8_STAGE(PG8_SB(1, 0), b3, voffB);
            PG8_BAR; PG8_WAIT_L(0); PG8_MMA(0, 1, At, B1); PG8_BAR;
            PG8_LDA(At, 1, 1); PG8_STAGE(PG8_SA(1, 0), a3, voffA);
            PG8_BAR; PG8_WAIT_L(0); PG8_MMA(1, 0, At, B0); PG8_BAR; PG8_SCHED;
            PG8_STAGE(PG8_SB(1, 1), b3 + hstep, voffB);
            PG8_WAIT_V(6); PG8_BAR; PG8_MMA(1, 1, At, B1); PG8_BAR;
            }
        }
        if constexpr (ALIGN_EPI) { if (wr == 0) PG8_BAR; }
        if constexpr (!Epi::AFTER_DRAIN) { E(acc, cur, wr, wc, fr, fq); S.done(cur); }
        if (!has_next) break;
#pragma unroll
        for (int a = 0; a < 2; ++a)
#pragma unroll
            for (int b = 0; b < 2; ++b)
#pragma unroll
                for (int m = 0; m < 4; ++m)
#pragma unroll
                    for (int n = 0; n < 2; ++n) acc[a][b][m][n] = (f32x4){0.f, 0.f, 0.f, 0.f};
        cur = nxt; cA = nA; cB = nB; ++ui;
        if constexpr (ALIGN_EPI) { if (wr == 1) PG8_BAR; }
    }
    PG8_WAIT_V(0);
    if constexpr (!ALIGN_EPI) { if (wr == 0) PG8_BAR; }
    PG8_BAR;
    if constexpr (Epi::AFTER_DRAIN) { E.fused(acc, cur, wr, wc, fr, fq, lds, wid, lane); S.done(cur); }
#undef PG8_SA
#undef PG8_SB
#undef PG8_STAGE
#undef PG8_LDA
#undef PG8_LDB
#undef PG8_MMA
#undef PG8_WAIT_V
#undef PG8_WAIT_L
#undef PG8_BAR
#undef PG8_SCHED
}
}

#define LAS __attribute__((address_space(3)))
typedef unsigned short bf16_t;
typedef short bf16x8 __attribute__((ext_vector_type(8)));
typedef short s16x4 __attribute__((ext_vector_type(4)));
typedef float f32x4 __attribute__((ext_vector_type(4)));
typedef float f32x2 __attribute__((ext_vector_type(2)));
typedef float f32x16 __attribute__((ext_vector_type(16)));
typedef unsigned u32x4 __attribute__((ext_vector_type(4)));
typedef unsigned u32x2 __attribute__((ext_vector_type(2)));
typedef __bf16 bf16x2_t __attribute__((ext_vector_type(2)));

#ifndef EN_MIX
#define EN_MIX 1
#endif
#ifndef EN_DA
#define EN_DA 1
#endif
#ifndef EN_MLA
#define EN_MLA 1
#endif
#ifndef EN_WIN
#define EN_WIN 1
#endif
#ifndef EN_CMP
#define EN_CMP 1
#endif
#ifndef EN_SLC
#define EN_SLC 1
#endif

constexpr int NB = 4, T = 4096, D = 1024, M = NB * T, F = 2816, F2 = 5632, DIN = 2354, DINP = 2560;
constexpr int NTHR = 512, NWAVE = 8, LDS_BYTES = 147456, FETCH_OFF = LDS_BYTES - 64;
constexpr int C_AQ = 0, C_AK = 256, C_AV = 512, C_BKR = 1152, C_CQ = 1184, C_KC = 1568, C_VC = 1696, C_KS = 1824, C_VS = 1952, C_KW = 2080, C_VW = 2208, C_G = 2336;
constexpr float LOG2E = 1.4426950408889634f, RMS_EPS = 1e-6f, NEGBIG = -1e30f;

constexpr size_t MiB = 1u << 20, KiB = 1u << 10;
constexpr size_t WS_CTL = 0;
constexpr size_t WS_MODS = 64 * KiB;
constexpr size_t WS_ROPE = 512 * KiB;
constexpr size_t WS_POSB = 1 * MiB;
constexpr size_t WS_SSQ = 1 * MiB + 64 * KiB;
constexpr size_t WS_KCMP = 2 * MiB;
constexpr size_t WS_SEL = 3 * MiB;
constexpr size_t WS_W = 4 * MiB;
constexpr size_t W_1A = 0, W_1B = W_1A + (size_t)F2 * D * 2, W_2A = W_1B + (size_t)D * F * 2, W_2B = W_2A + (size_t)F2 * D * 2,
                 W_IN = W_2B + (size_t)D * F * 2, W_OUT = W_IN + (size_t)DINP * D * 2, W_UQ = W_OUT + (size_t)D * D * 2, W_UKV = W_UQ + 768 * 256 * 2,
                 W_C1 = W_UKV + 768 * 128 * 2, W_C2 = W_C1 + 2 * 128 * 2048 * 2, W_END = W_C2 + 2 * 64 * 128 * 2;
static_assert(WS_W + W_END <= 48 * MiB, "weights");
constexpr size_t WS_XN = 48 * MiB;
constexpr size_t WS_U = 80 * MiB;
constexpr size_t WS_CQ = 168 * MiB;
constexpr size_t WS_CKV = 176 * MiB;
constexpr size_t WS_MQ = 180 * MiB;
constexpr size_t WS_MKV = 204 * MiB;
constexpr size_t WS_KPE = 228 * MiB;
constexpr size_t WS_END = 229 * MiB;

__device__ __forceinline__ unsigned cvtpk(float lo, float hi) { f32x2 v = {lo, hi}; bf16x2_t b = __builtin_convertvector(v, bf16x2_t); return __builtin_bit_cast(unsigned, b); }
__device__ __forceinline__ float bf2f(short b) { return __uint_as_float(((unsigned)(unsigned short)b) << 16); }
__device__ __forceinline__ float wave_sum(float v) {
#pragma unroll
    for (int o = 1; o < 64; o <<= 1) v += __shfl_xor(v, o);
    return v;
}
__device__ __forceinline__ float fast_exp2(float x) { return __builtin_amdgcn_exp2f(x); }
__device__ __forceinline__ float fast_rcp(float x) { return __builtin_amdgcn_rcpf(x); }
__device__ __forceinline__ float sigmoid_f(float x) { return fast_rcp(1.0f + fast_exp2(-x * LOG2E)); }
__device__ __forceinline__ int crow(int i, int h) { return (i & 3) + 8 * (i >> 2) + 4 * h; }
__device__ __forceinline__ int opq(int v) { asm volatile("" : "+v"(v)); return v; }
#define MFMA32(a, b, c) __builtin_amdgcn_mfma_f32_32x32x16_bf16((a), (b), (c), 0, 0, 0)
#define MFMA16(a, b, c) __builtin_amdgcn_mfma_f32_16x16x32_bf16((a), (b), (c), 0, 0, 0)

struct Args { const float* in[23]; float* out; unsigned char* ws; };
__device__ __forceinline__ unsigned char* ws_opq(unsigned char* p) {
    const unsigned long long v = (unsigned long long)p;
    unsigned lo = (unsigned)__builtin_amdgcn_readfirstlane((int)(unsigned)v), hi = (unsigned)__builtin_amdgcn_readfirstlane((int)(unsigned)(v >> 32));
    asm volatile("" : "+s"(lo), "+s"(hi));
    return (unsigned char*)(((unsigned long long)hi << 32) | (unsigned long long)lo);
}

struct EpiSwiGLU {
    static constexpr bool PERM = true, AFTER_DRAIN = false;
    bf16_t* O;
    __device__ __forceinline__ void operator()(const f32x4 (&acc)[2][2][4][2], const pg8::Unit& u, int wr_, int wc_, int fr_, int fq_) const {
        const int t_ = opq(get_tid()), w_ = __builtin_amdgcn_readfirstlane(t_ >> 6), wr = w_ >> 2, wc = w_ & 3, fr = t_ & 15, fq = (t_ >> 4) & 3;
        const int row0 = u.pm * 256 + wr * 64 + fr, col0 = u.pn * 128 + wc * 32 + 8 * fq;
#pragma unroll
        for (int ai = 0; ai < 2; ++ai)
#pragma unroll
            for (int m = 0; m < 4; ++m) {
                bf16_t* rowp = O + (size_t)(row0 + ai * 128 + m * 16) * F + col0;
                float r[8];
#pragma unroll
                for (int n = 0; n < 2; ++n)
#pragma unroll
                    for (int j = 0; j < 4; ++j) { const float g = acc[ai][0][m][n][j], up = acc[ai][1][m][n][j]; r[n * 4 + j] = g * sigmoid_f(g) * up; }
                u32x4 w; w.x = cvtpk(r[0], r[1]); w.y = cvtpk(r[2], r[3]); w.z = cvtpk(r[4], r[5]); w.w = cvtpk(r[6], r[7]);
                *(u32x4*)rowp = w;
            }
    }
};
struct EpiResid {
    static constexpr bool PERM = false, AFTER_DRAIN = false;
    const float* resid; float* out; const float* gate; float coef;
    __device__ __forceinline__ void operator()(const f32x4 (&acc)[2][2][4][2], const pg8::Unit& u, int wr_, int wc_, int fr_, int fq_) const {
        const int t_ = opq(get_tid()), w_ = __builtin_amdgcn_readfirstlane(t_ >> 6), wr = w_ >> 2, wc = w_ & 3, fr = t_ & 15, fq = (t_ >> 4) & 3;
        const int row0 = u.pm * 256 + wr * 64 + fr, b = (u.pm * 256) >> 12, col0 = u.pn * 256 + wc * 32 + 4 * fq;
#pragma unroll
        for (int bj = 0; bj < 2; ++bj)
#pragma unroll
            for (int n = 0; n < 2; ++n) {
                const int c = col0 + bj * 128 + n * 16;
                const f32x4 gv = *(const f32x4*)(gate + (size_t)b * 9216 + c) * coef;
#pragma unroll
                for (int ai = 0; ai < 2; ++ai)
#pragma unroll
                    for (int m = 0; m < 4; ++m) {
                        const size_t off = (size_t)(row0 + ai * 128 + m * 16) * D + c;
                        const f32x4 o = *(const f32x4*)(resid + off) + gv * acc[ai][bj][m][n];
                        *(f32x4*)(out + off) = o;
                        if (m & 1) asm volatile("" ::: "memory");
                    }
            }
    }
};
struct EpiProj {
    static constexpr bool PERM = true, AFTER_DRAIN = false;
    bf16_t* PROJ; bf16_t* CQ; bf16_t* CKV; float* ssq_q; float* ssq_kv; unsigned* kn;
    __device__ __forceinline__ void operator()(const f32x4 (&acc)[2][2][4][2], const pg8::Unit& u, int wr_, int wc_, int fr_, int fq_) const {
        const int t_ = opq(get_tid()), w_ = __builtin_amdgcn_readfirstlane(t_ >> 6), wr = w_ >> 2, wc = w_ & 3, fr = t_ & 15, fq = (t_ >> 4) & 3;
        const int row0 = u.pm * 256 + wr * 64 + fr;
        const int kti = u.pn == 1 ? 0 : (u.pn == 7 ? 1 : (u.pn == 8 ? 2 : -1));
#pragma unroll
        for (int bj = 0; bj < 2; ++bj) {
            float gmax = 0.f;
            bf16_t* base; int ld, cb; float* ssq;
            if (u.pn == 3) { base = CQ; ld = 256; cb = bj * 128; ssq = ssq_q; }
            else if (u.pn == 4 && bj == 0) { base = CKV; ld = 128; cb = 0; ssq = ssq_kv; }
            else { base = PROJ; ld = DINP; cb = u.pn * 256 + bj * 128; ssq = nullptr; }
            const int col0 = cb + wc * 32 + 8 * fq;
#pragma unroll
            for (int ai = 0; ai < 2; ++ai)
#pragma unroll
                for (int m = 0; m < 4; ++m) {
                    const int row = row0 + ai * 128 + m * 16;
                    const f32x4 v0 = acc[ai][bj][m][0], v1 = acc[ai][bj][m][1];
                    u32x4 w; w.x = cvtpk(v0[0], v0[1]); w.y = cvtpk(v0[2], v0[3]); w.z = cvtpk(v1[0], v1[1]); w.w = cvtpk(v1[2], v1[3]);
                    *(u32x4*)(base + (size_t)row * ld + col0) = w;
                    if (ssq || kti >= 0) {
                        float s = (v0[0] * v0[0] + v0[1] * v0[1]) + (v0[2] * v0[2] + v0[3] * v0[3]) + (v1[0] * v1[0] + v1[1] * v1[1]) + (v1[2] * v1[2] + v1[3] * v1[3]);
                        s += __shfl_xor(s, 16); s += __shfl_xor(s, 32);
                        if (ssq) { if (fq == 0) atomicAdd(ssq + row, s); }
                        else gmax = fmaxf(gmax, s);
                    }
                    asm volatile("" ::: "memory");
                }
            if (kti >= 0) {
                gmax = fmaxf(gmax, __shfl_xor(gmax, 1)); gmax = fmaxf(gmax, __shfl_xor(gmax, 2)); gmax = fmaxf(gmax, __shfl_xor(gmax, 4)); gmax = fmaxf(gmax, __shfl_xor(gmax, 8));
                if (fr == 0 && fq == 0) atomicMax(kn + ((u.pm * 256) >> 12) * 24 + kti * 8 + bj * 4 + wc, __float_as_uint(gmax));
            }
        }
    }
};
struct EpiRowScale {
    static constexpr bool PERM = true, AFTER_DRAIN = false;
    bf16_t* O; int ldc; const float* ssq; float inv_n;
    __device__ __forceinline__ void operator()(const f32x4 (&acc)[2][2][4][2], const pg8::Unit& u, int wr_, int wc_, int fr_, int fq_) const {
        const int t_ = opq(get_tid()), w_ = __builtin_amdgcn_readfirstlane(t_ >> 6), wr = w_ >> 2, wc = w_ & 3, fr = t_ & 15, fq = (t_ >> 4) & 3;
        const int row0 = u.pm * 256 + wr * 64 + fr, col0 = u.pn * 256 + wc * 32 + 8 * fq;
#pragma unroll
        for (int ai = 0; ai < 2; ++ai)
#pragma unroll
            for (int m = 0; m < 4; ++m) {
                const int row = row0 + ai * 128 + m * 16;
                const float rs = rsqrtf(ssq[row] * inv_n + RMS_EPS);
#pragma unroll
                for (int bj = 0; bj < 2; ++bj) {
                    const f32x4 v0 = acc[ai][bj][m][0] * rs, v1 = acc[ai][bj][m][1] * rs;
                    u32x4 w; w.x = cvtpk(v0[0], v0[1]); w.y = cvtpk(v0[2], v0[3]); w.z = cvtpk(v1[0], v1[1]); w.w = cvtpk(v1[2], v1[3]);
                    *(u32x4*)(O + (size_t)row * ldc + col0 + bj * 128) = w;
                }
                asm volatile("" ::: "memory");
            }
    }
};

template <int MODE> __device__ __forceinline__ int wrow(int n) {
    if (MODE == 1) return n < F ? ((n >> 7) * 256 + (n & 127)) : (((n - F) >> 7) * 256 + 128 + ((n - F) & 127));
    return n;
}
template <int MODE>
__device__ __forceinline__ void cvt_item(const float* W, int K, int N, int NP, bf16_t* WT, const float* kscale, LAS float* scr, int item, int lane) {
    const int nblk = NP / 32, kb = item / nblk, nb = item % nblk, k0 = 64 * kb, n0 = 32 * nb;
    const int n_rd = n0 + (lane & 31);
#pragma unroll 8
    for (int i = 0; i < 32; ++i) {
        const int kk = 2 * i + (lane >> 5);
        float v = (n_rd < N) ? W[(size_t)(k0 + kk) * N + n_rd] : 0.f;
        if (kscale) v *= kscale[k0 + kk];
        scr[kk * 33 + (lane & 31)] = v;
    }
    asm volatile("s_waitcnt lgkmcnt(0)" ::: "memory");
    const int c = lane & 7;
#pragma unroll
    for (int j = 0; j < 4; ++j) {
        const int n = (lane >> 3) + 8 * j; const LAS float* s = scr + (8 * c) * 33 + n;
        u32x4 o; o.x = cvtpk(s[0 * 33], s[1 * 33]); o.y = cvtpk(s[2 * 33], s[3 * 33]); o.z = cvtpk(s[4 * 33], s[5 * 33]); o.w = cvtpk(s[6 * 33], s[7 * 33]);
        *(u32x4*)(WT + (size_t)wrow<MODE>(n0 + n) * K + k0 + 8 * c) = o;
    }
    asm volatile("s_waitcnt lgkmcnt(0)" ::: "memory");
}
__device__ __forceinline__ void convert_layer(const Args& A, int l, LAS unsigned char* lds) {
    const int tid = opq(get_tid()), lane = tid & 63, wid = __builtin_amdgcn_readfirstlane(tid >> 6), gw = blockIdx.x * NWAVE + wid, ngw = gridDim.x * NWAVE;
    LAS float* scr = (LAS float*)(lds + wid * 8704);
    unsigned char* wb = A.ws + WS_W;
    constexpr int I_A = 16 * 176, I_B = 44 * 32, I_IN = 16 * 80, I_OUT = 16 * 32, I_UQ = 4 * 24, I_UKV = 2 * 24, I_C1 = 32 * 4, I_C2 = 2 * 2;
    constexpr int NITEMS = 2 * I_A + 2 * I_B + I_IN + I_OUT + I_UQ + I_UKV + 2 * I_C1 + 2 * I_C2;
    for (int it = gw; it < NITEMS; it += ngw) {
        int r = it;
        if (r < I_A) { cvt_item<1>(A.in[7] + (size_t)l * D * F2, D, F2, F2, (bf16_t*)(wb + W_1A), nullptr, scr, r, lane); continue; } r -= I_A;
        if (r < I_A) { cvt_item<1>(A.in[9] + (size_t)l * D * F2, D, F2, F2, (bf16_t*)(wb + W_2A), nullptr, scr, r, lane); continue; } r -= I_A;
        if (r < I_B) { cvt_item<0>(A.in[8] + (size_t)l * F * D, F, D, D, (bf16_t*)(wb + W_1B), nullptr, scr, r, lane); continue; } r -= I_B;
        if (r < I_B) { cvt_item<0>(A.in[10] + (size_t)l * F * D, F, D, D, (bf16_t*)(wb + W_2B), nullptr, scr, r, lane); continue; } r -= I_B;
        if (r < I_IN) { cvt_item<0>(A.in[11] + (size_t)l * D * DIN, D, DIN, DINP, (bf16_t*)(wb + W_IN), nullptr, scr, r, lane); continue; } r -= I_IN;
        if (r < I_OUT) { cvt_item<0>(A.in[12] + (size_t)l * D * D, D, D, D, (bf16_t*)(wb + W_OUT), nullptr, scr, r, lane); continue; } r -= I_OUT;
        if (r < I_UQ) { cvt_item<0>(A.in[17] + (size_t)l * 256 * 576, 256, 576, 768, (bf16_t*)(wb + W_UQ), A.in[15] + l * 256, scr, r, lane); continue; } r -= I_UQ;
        if (r < I_UKV) { cvt_item<0>(A.in[18] + (size_t)l * 128 * 768, 128, 768, 768, (bf16_t*)(wb + W_UKV), A.in[16] + l * 128, scr, r, lane); continue; } r -= I_UKV;
        if (r < 2 * I_C1) { const int kv = r / I_C1; cvt_item<0>(A.in[20] + (size_t)(l * 2 + kv) * 2048 * 128, 2048, 128, 128, (bf16_t*)(wb + W_C1) + (size_t)kv * 128 * 2048, nullptr, scr, r % I_C1, lane); continue; } r -= 2 * I_C1;
        { const int kv = r / I_C2; cvt_item<0>(A.in[21] + (size_t)(l * 2 + kv) * 128 * 64, 128, 64, 64, (bf16_t*)(wb + W_C2) + (size_t)kv * 64 * 128, nullptr, scr, r % I_C2, lane); }
    }
}
__device__ __forceinline__ void mods_task(const Args& A, int task, LAS unsigned char* lds) {
    const int tid = opq(get_tid()), lane = tid & 63, wid = __builtin_amdgcn_readfirstlane(tid >> 6);
    const int l = task / 144, chunk = task % 144;
    LAS float* cond = (LAS float*)lds;
    LAS float* red = (LAS float*)(lds + 16384);
    __syncthreads();
    for (int i = tid; i < 4096; i += NTHR) { const float c = A.in[1][i]; cond[i] = c / (1.0f + expf(-c)); }
    __syncthreads();
    const float* W = A.in[2] + (size_t)l * D * 9216 + chunk * 64 + lane;
    float acc[4] = {0.f, 0.f, 0.f, 0.f};
#pragma unroll 16
    for (int kk = 0; kk < 128; ++kk) {
        const int k = wid * 128 + kk;
        const float w = W[(size_t)k * 9216];
#pragma unroll
        for (int b = 0; b < 4; ++b) acc[b] += cond[b * 1024 + k] * w;
    }
#pragma unroll
    for (int b = 0; b < 4; ++b) red[(wid * 4 + b) * 64 + lane] = acc[b];
    __syncthreads();
    if (tid < 256) {
        const int b = tid >> 6, col = tid & 63; float s = 0.f;
#pragma unroll
        for (int w = 0; w < 8; ++w) s += red[(w * 4 + b) * 64 + col];
        s += A.in[3][(size_t)l * 9216 + chunk * 64 + col];
        ((float*)(A.ws + WS_MODS))[(size_t)(l * 4 + b) * 9216 + chunk * 64 + col] = s;
    }
    __syncthreads();
}
__device__ __forceinline__ void posb_task(const Args& A, int task, LAS unsigned char* lds) {
    const int tid = opq(get_tid());
    const int lkv = task >> 4, kp = task & 15, hid = tid & 127, sub = tid >> 7;
    const float* pos = A.in[19] + (size_t)lkv * 2048 + kp * 128 + sub * 32; const float* w1 = A.in[20] + ((size_t)lkv * 2048 + kp * 128 + sub * 32) * 128 + hid;
    float s = 0.f;
#pragma unroll
    for (int k = 0; k < 32; ++k) s += pos[k] * w1[(size_t)k * 128];
    LAS float* red = (LAS float*)lds;
    __syncthreads();
    red[tid] = s;
    __syncthreads();
    if (tid < 128) ((float*)(A.ws + WS_POSB + 4096))[task * 128 + tid] = red[tid] + red[tid + 128] + red[tid + 256] + red[tid + 384];
    __syncthreads();
}
__device__ __forceinline__ void posb_final(const Args& A) {
    const int o = opq(get_tid());
    const float* part = (const float*)(A.ws + WS_POSB + 4096) + (size_t)(o >> 7) * 16 * 128 + (o & 127);
    float s = 0.f;
#pragma unroll
    for (int p = 0; p < 16; ++p) s += part[p * 128];
    ((float*)(A.ws + WS_POSB))[o] = s;
}
__device__ __forceinline__ void rope_entries(const Args& A) {
    const int gtid = blockIdx.x * NTHR + opq(get_tid()), gn = gridDim.x * NTHR;
    float* tab = (float*)(A.ws + WS_ROPE);
    for (int e = gtid; e < T * 16; e += gn) {
        const int t = e >> 4, i = e & 15;
        double inv = 1.0; for (int j = 0; j < i; ++j) inv *= 0.5623413251903491;
        const float ang = (float)t * (float)inv;
        const double rev = (double)ang * 0.15915494309189535; const double fr = rev - __builtin_rint(rev);
        tab[e] = __builtin_amdgcn_cosf((float)fr); tab[T * 16 + e] = __builtin_amdgcn_sinf((float)fr);
    }
}
__device__ __forceinline__ void norm_rows(const float* X, bf16_t* out, const float* g, const float* modl, int ish, int isc) {
    const int tid = opq(get_tid()), lane = tid & 63, wid = __builtin_amdgcn_readfirstlane(tid >> 6), gw = blockIdx.x * NWAVE + wid, ngw = gridDim.x * NWAVE;
#pragma unroll 1
    for (int b = 0; b < NB; ++b) {
        f32x4 gs[4], sh[4];
#pragma unroll
        for (int j = 0; j < 4; ++j) {
            const int col = 4 * lane + 256 * j;
            gs[j] = *(const f32x4*)(g + col) * (*(const f32x4*)(modl + (size_t)b * 9216 + isc * 1024 + col) + 1.0f);
            sh[j] = *(const f32x4*)(modl + (size_t)b * 9216 + ish * 1024 + col);
        }
        for (int row = b * T + gw; row < (b + 1) * T; row += ngw) {
            const f32x4* xr = (const f32x4*)(X + (size_t)row * D) + lane;
            f32x4 v[4]; float ss = 0.f;
#pragma unroll
            for (int j = 0; j < 4; ++j) { v[j] = xr[64 * j]; ss += (v[j].x * v[j].x + v[j].y * v[j].y) + (v[j].z * v[j].z + v[j].w * v[j].w); }
            const float rstd = rsqrtf(wave_sum(ss) * (1.0f / D) + RMS_EPS);
#pragma unroll
            for (int j = 0; j < 4; ++j) {
                const f32x4 y = (v[j] * rstd) * gs[j] + sh[j];
                u32x2 w; w.x = cvtpk(y.x, y.y); w.y = cvtpk(y.z, y.w);
                *(u32x2*)(out + (size_t)row * D + 4 * lane + 256 * j) = w;
            }
        }
    }
}
__device__ __forceinline__ void final_norm_rows(float* X, const float* g) {
    const int tid = opq(get_tid()), lane = tid & 63, wid = __builtin_amdgcn_readfirstlane(tid >> 6), gw = blockIdx.x * NWAVE + wid, ngw = gridDim.x * NWAVE;
    for (int row = gw; row < M; row += ngw) {
        f32x4* xr = (f32x4*)(X + (size_t)row * D) + lane;
        f32x4 v[4]; float ss = 0.f;
#pragma unroll
        for (int j = 0; j < 4; ++j) { v[j] = xr[64 * j]; ss += (v[j].x * v[j].x + v[j].y * v[j].y) + (v[j].z * v[j].z + v[j].w * v[j].w); }
        const float rstd = rsqrtf(wave_sum(ss) * (1.0f / D) + RMS_EPS);
#pragma unroll
        for (int j = 0; j < 4; ++j) { const f32x4 g4 = *(const f32x4*)(g + 4 * lane + 256 * j); xr[64 * j] = (v[j] * rstd) * g4; }
    }
}

__device__ __forceinline__ void norm_block(const float* X, bf16_t* out, const float* g, const float* modl, int ish, int isc, int row0) {
    const int tid = opq(get_tid()), lane = tid & 63, wid = __builtin_amdgcn_readfirstlane(tid >> 6);
    const int b = row0 >> 12;
#pragma unroll 1
    for (int rr = 0; rr < 8; ++rr) {
        const int row = row0 + rr * 8 + wid;
        const f32x4* xr = (const f32x4*)(X + (size_t)row * D) + lane;
        f32x4 v[4]; float ss = 0.f;
#pragma unroll
        for (int j = 0; j < 4; ++j) { v[j] = xr[64 * j]; ss += (v[j].x * v[j].x + v[j].y * v[j].y) + (v[j].z * v[j].z + v[j].w * v[j].w); }
        const float rstd = rsqrtf(wave_sum(ss) * (1.0f / D) + RMS_EPS);
#pragma unroll
        for (int j = 0; j < 4; ++j) {
            const int col = 4 * lane + 256 * j;
            const f32x4 g4 = *(const f32x4*)(g + col), sc = *(const f32x4*)(modl + (size_t)b * 9216 + isc * 1024 + col), sh = *(const f32x4*)(modl + (size_t)b * 9216 + ish * 1024 + col);
            const f32x4 y = (v[j] * rstd) * g4 * (sc + 1.0f) + sh;
            u32x2 w; w.x = cvtpk(y.x, y.y); w.y = cvtpk(y.z, y.w);
            *(u32x2*)(out + (size_t)row * D + col) = w;
        }
    }
}
__device__ __forceinline__ void final_norm_block(float* X, const float* g, int row0) {
    const int tid = opq(get_tid()), lane = tid & 63, wid = __builtin_amdgcn_readfirstlane(tid >> 6);
#pragma unroll 1
    for (int rr = 0; rr < 8; ++rr) {
        const int row = row0 + rr * 8 + wid;
        f32x4* xr = (f32x4*)(X + (size_t)row * D) + lane;
        f32x4 v[4]; float ss = 0.f;
#pragma unroll
        for (int j = 0; j < 4; ++j) { v[j] = xr[64 * j]; ss += (v[j].x * v[j].x + v[j].y * v[j].y) + (v[j].z * v[j].z + v[j].w * v[j].w); }
        const float rstd = rsqrtf(wave_sum(ss) * (1.0f / D) + RMS_EPS);
#pragma unroll
        for (int j = 0; j < 4; ++j) { const f32x4 g4 = *(const f32x4*)(g + 4 * lane + 256 * j); xr[64 * j] = (v[j] * rstd) * g4; }
    }
}
struct CountedOrder : pg8::StaticOrder {
    unsigned* cnt;
    __device__ __forceinline__ void done(const pg8::Unit& u) const {
        __builtin_amdgcn_fence(__ATOMIC_RELEASE, "agent");
        if ((get_tid() & 63) == 0) __hip_atomic_fetch_add(cnt + u.pm, 1u, __ATOMIC_RELAXED, __HIP_MEMORY_SCOPE_AGENT);
    }
};
__device__ __forceinline__ void panel_wait(unsigned* cnt, int pm) {
    if (get_tid() == 0) {
        unsigned sp = 0;
        while (__hip_atomic_load(cnt + pm, __ATOMIC_RELAXED, __HIP_MEMORY_SCOPE_AGENT) < 32u) { __builtin_amdgcn_s_sleep(2); if (++sp > (1u << 22)) break; }
    }
    __syncthreads();
    __builtin_amdgcn_fence(__ATOMIC_ACQUIRE, "agent");
}

__device__ __forceinline__ void kpe_unit(const Args& A, int unit) {
    const int tid = opq(get_tid());
    unsigned char* w_ = ws_opq(A.ws);
    const bf16_t* P = (const bf16_t*)(w_ + WS_U); bf16_t* KPE = (bf16_t*)(w_ + WS_KPE); const float* rope = (const float*)(w_ + WS_ROPE);
#pragma unroll 2
    for (int k = 0; k < 8; ++k) {
        const int e = unit * 4096 + k * 512 + tid;
        const int row = e >> 4, i = e & 15, t = row & (T - 1);
        const float x0 = bf2f((short)P[(size_t)row * DINP + C_BKR + i]), x1 = bf2f((short)P[(size_t)row * DINP + C_BKR + 16 + i]);
        const float c = rope[t * 16 + i], sn = rope[T * 16 + t * 16 + i];
        KPE[(size_t)row * 32 + i] = (bf16_t)(cvtpk(x0 * c - x1 * sn, 0.f) & 0xffffu);
        KPE[(size_t)row * 32 + 16 + i] = (bf16_t)(cvtpk(x1 * c + x0 * sn, 0.f) & 0xffffu);
    }
}

constexpr int CTL_KN = 128;
__device__ __forceinline__ void kn_rows(const Args& A, int l) {
    const int tid = opq(get_tid()), lane = tid & 63, wid = __builtin_amdgcn_readfirstlane(tid >> 6), gw = blockIdx.x * NWAVE + wid, ngw = gridDim.x * NWAVE;
    unsigned char* w_ = ws_opq(A.ws);
    const bf16_t* P = (const bf16_t*)(w_ + WS_U); unsigned* kn = (unsigned*)(w_ + WS_CTL) + CTL_KN + l * 48;
    const int col2 = lane < 32 ? C_KS + 4 * lane : C_KW + 4 * (lane - 32);
    for (int it = gw; it < M / 16; it += ngw) {
        float m1 = 0.f, m2 = 0.f;
#pragma unroll 4
        for (int rr = 0; rr < 16; ++rr) {
            const bf16_t* rp = P + (size_t)(it * 16 + rr) * DINP;
            const s16x4 v1 = *(const s16x4*)(rp + C_AK + 4 * lane), v2 = *(const s16x4*)(rp + col2);
            float s1 = 0.f, s2 = 0.f;
#pragma unroll
            for (int j = 0; j < 4; ++j) { const float x = bf2f(v1[j]), y = bf2f(v2[j]); s1 += x * x; s2 += y * y; }
            s1 += __shfl_xor(s1, 1); s1 += __shfl_xor(s1, 2); s1 += __shfl_xor(s1, 4);
            s2 += __shfl_xor(s2, 1); s2 += __shfl_xor(s2, 2); s2 += __shfl_xor(s2, 4); s2 += __shfl_xor(s2, 8);
            m1 = fmaxf(m1, s1); m2 = fmaxf(m2, s2);
        }
        const int b = (it * 16) >> 12;
        if ((lane & 7) == 0) atomicMax(kn + b * 12 + (lane >> 3), __float_as_uint(m1));
        if ((lane & 15) == 0) atomicMax(kn + b * 12 + (lane < 32 ? 10 + (lane >> 4) : 8 + ((lane - 32) >> 4)), __float_as_uint(m2));
    }
}
#define XB_TMO      128
#define XB_XCNT(j)  (256  + 64 * (j))
#define XB_XSUB(j)  (1280 + 64 * (j))
#define XB_XGEN(j)  (2304 + 64 * (j))
#define XB_TOP      3328
#define XB_TOPGEN   3392
#define XCD_BAR_WORDS 3456
#define XB_SPIN_CAP (1u << 18)

__device__ __forceinline__ unsigned xb_ld(unsigned* p)              { return __hip_atomic_load(p, __ATOMIC_RELAXED, __HIP_MEMORY_SCOPE_AGENT); }
__device__ __forceinline__ unsigned xb_add(unsigned* p, unsigned v) { return __hip_atomic_fetch_add(p, v, __ATOMIC_RELAXED, __HIP_MEMORY_SCOPE_AGENT); }
__device__ __forceinline__ unsigned xb_xcc_id() { return (unsigned)__builtin_amdgcn_s_getreg((3 << 11) | 20) & 0xFu; }
#define XB_SPIN(cond, bar) do { unsigned _sp = 0; while (cond) { __builtin_amdgcn_s_sleep(1); \
    if ((++_sp & 255u) == 0u) { if (xb_ld(&(bar)[XB_TMO])) break; if (_sp > XB_SPIN_CAP) { atomicAdd(&(bar)[XB_TMO], 1u); break; } } } } while (0)

struct XcdBarrier {
    unsigned* bar; unsigned x;
    volatile LAS unsigned* st;
};

__device__ __forceinline__ XcdBarrier xcd_barrier_post(unsigned* bar, volatile LAS unsigned* st) {
    XcdBarrier b; b.bar = bar; b.x = xb_xcc_id(); b.st = st;
    if (get_tid() == 0) (void)xb_add(&bar[XB_XCNT(b.x)], 1u);
    return b;
}
__device__ __forceinline__ void xcd_barrier_complete(unsigned* bar, unsigned x, unsigned& nloc, unsigned& nx) {
    const unsigned G = gridDim.x * gridDim.y * gridDim.z;
    unsigned sum, cnt, mine, sp = 0u;
    for (;;) {
        sum = 0u; cnt = 0u; mine = 0u;
#pragma unroll
        for (unsigned j = 0; j < 16; ++j) { const unsigned c = xb_ld(&bar[XB_XCNT(j)]); sum += c; cnt += (c > 0u) ? 1u : 0u; mine = (j == x) ? c : mine; }
        if (sum == G) break;
        __builtin_amdgcn_s_sleep(1);
        if ((++sp & 255u) == 0u) { if (xb_ld(&bar[XB_TMO])) break; if (sp > XB_SPIN_CAP) { atomicAdd(&bar[XB_TMO], 1u); break; } }
    }
    nloc = mine > 0u ? mine : 1u; nx = cnt > 0u ? cnt : 1u;
}

__device__ __forceinline__ void xcd_barrier(const XcdBarrier& b) {
    asm volatile("s_waitcnt vmcnt(0)" ::: "memory");
    __syncthreads();
    if (get_tid() == 0) {
        unsigned* bar = b.bar;
        __builtin_amdgcn_s_waitcnt(0);
        unsigned nloc = b.st[0], nx = b.st[1];
        if (nloc == 0u) { xcd_barrier_complete(bar, b.x, nloc, nx); b.st[0] = nloc; b.st[1] = nx; }
        const unsigned old = xb_add(&bar[XB_XSUB(b.x)], 1u);
        const unsigned gen = old / nloc;
        if (old + 1u == (gen + 1u) * nloc) {
            __builtin_amdgcn_fence(__ATOMIC_RELEASE, "agent");
            asm volatile("s_waitcnt vmcnt(0)" ::: "memory");
            const unsigned og = xb_add(&bar[XB_TOP], 1u);
            const unsigned tg = og / nx;
            if (og + 1u == (tg + 1u) * nx) xb_add(&bar[XB_TOPGEN], 1u);
            else XB_SPIN(xb_ld(&bar[XB_TOPGEN]) == tg, bar);
            __builtin_amdgcn_fence(__ATOMIC_ACQUIRE, "agent");
            xb_add(&bar[XB_XGEN(b.x)], 1u);
            asm volatile("s_waitcnt vmcnt(0)" ::: "memory");
        } else {
            XB_SPIN(xb_ld(&bar[XB_XGEN(b.x)]) == gen, bar);
            __builtin_amdgcn_fence(__ATOMIC_ACQUIRE, "agent");
            asm volatile("s_waitcnt vmcnt(0)" ::: "memory");
        }
    }
    __syncthreads();
}

struct AttnArgs {
    const bf16_t* Q; int qpitch;
    const bf16_t* K1; int k1pitch;
    const bf16_t* K2; int k2pitch;
    const bf16_t* V; int vpitch;
    const float* rope;
    const unsigned long long* sel;
    float scale2, slope2; int window;
    float kmax;
};
constexpr int ATT_K_OFF = 0, ATT_V_OFF = 16384, ATT_BUF = 24576;

__device__ __forceinline__ s16x4 vtr(const LAS unsigned char* p) {
    typedef short v4i16_t __attribute__((ext_vector_type(4)));
    return __builtin_bit_cast(s16x4, __builtin_amdgcn_ds_read_tr16_b64_v4i16((LAS v4i16_t*)p));
}
template <bool ROWSUM> __device__ __forceinline__ void pv_tile_t(f32x16 (&o)[2], f32x16& osum, const f32x16& p0, const f32x16& p1, const LAS unsigned char* vl, int lane) {
    const int h = lane >> 5, i16 = lane & 15, q4 = i16 >> 2, p4 = i16 & 3, blk = (lane >> 4) & 1;
    const unsigned onew = ((lane & 31) == 0) ? 0x3f803f80u : 0u;
    const bf16x8 ones = __builtin_bit_cast(bf16x8, (u32x4){onew, onew, onew, onew});
    const LAS unsigned char* vb = vl + (4 * h + q4) * 64 + blk * 32 + p4 * 8;
#pragma unroll
    for (int s = 0; s < 4; ++s) {
        u32x4 pw;
        if (s == 0) { pw.x = cvtpk(p0[0], p0[1]); pw.y = cvtpk(p0[2], p0[3]); pw.z = cvtpk(p0[4], p0[5]); pw.w = cvtpk(p0[6], p0[7]); }
        else if (s == 1) { pw.x = cvtpk(p0[8], p0[9]); pw.y = cvtpk(p0[10], p0[11]); pw.z = cvtpk(p0[12], p0[13]); pw.w = cvtpk(p0[14], p0[15]); }
        else if (s == 2) { pw.x = cvtpk(p1[0], p1[1]); pw.y = cvtpk(p1[2], p1[3]); pw.z = cvtpk(p1[4], p1[5]); pw.w = cvtpk(p1[6], p1[7]); }
        else { pw.x = cvtpk(p1[8], p1[9]); pw.y = cvtpk(p1[10], p1[11]); pw.z = cvtpk(p1[12], p1[13]); pw.w = cvtpk(p1[14], p1[15]); }
        const bf16x8 pf = __builtin_bit_cast(bf16x8, pw);
#pragma unroll
        for (int db = 0; db < 2; ++db) {
            const s16x4 lo = vtr(vb + db * 4096 + (16 * s) * 64), hi = vtr(vb + db * 4096 + (16 * s + 8) * 64);
            const bf16x8 vf = __builtin_shufflevector(lo, hi, 0, 1, 2, 3, 4, 5, 6, 7);
            o[db] = MFMA32(vf, pf, o[db]);
        }
        if (ROWSUM) osum = MFMA32(ones, pf, osum);
    }
}
__device__ __forceinline__ void pv_tile(f32x16 (&o)[2], const f32x16& p0, const f32x16& p1, const LAS unsigned char* vl, int lane) {
    f32x16 dummy; pv_tile_t<false>(o, dummy, p0, p1, vl, lane);
}
template <int MODE> __device__ __forceinline__ void store_o(const f32x16 (&o)[2], bf16_t* out_row, int h, float sc) {
#pragma unroll
    for (int db = 0; db < 2; ++db)
#pragma unroll
        for (int g4 = 0; g4 < 4; ++g4) {
            bf16_t* p = out_row + 32 * db + 8 * g4 + 4 * h;
            float v0 = o[db][4 * g4] * sc, v1 = o[db][4 * g4 + 1] * sc, v2 = o[db][4 * g4 + 2] * sc, v3 = o[db][4 * g4 + 3] * sc;
            if (MODE == 1) { const u32x2 old = *(const u32x2*)p; v0 += __uint_as_float(old.x << 16); v1 += __uint_as_float(old.x & 0xffff0000u); v2 += __uint_as_float(old.y << 16); v3 += __uint_as_float(old.y & 0xffff0000u); }
            u32x2 w; w.x = cvtpk(v0, v1); w.y = cvtpk(v2, v3);
            *(u32x2*)p = w;
        }
}

constexpr int ATT_FLAG_OFF = 140480;
template <int DQK, bool ROPE, bool SEL, bool DUAL = false, bool EARLY = false>
__device__ __forceinline__ void attn_core(const AttnArgs& a, int q0, LAS unsigned char* lds, f32x16 (&o)[2]) {
    constexpr int KS = DQK / 16, DK = DUAL ? 2 * DQK : DQK, KP = DK * 2 + 16, D1 = DK < 64 ? DK : 64, NCH1 = D1 / 8, QROWS = DUAL ? 128 : 256;
    const int tid = opq(get_tid()), lane = tid & 63, wid = __builtin_amdgcn_readfirstlane(tid >> 6), r = lane & 31, h = lane >> 5;
    const int wq = DUAL ? (wid & 3) : wid, coff = DUAL ? (wid >> 2) * DQK : 0;
    const int qw0 = q0 + 32 * wq, qpos = qw0 + r;
    LAS unsigned char* Kl = lds + ATT_K_OFF; LAS unsigned char* Vl = lds + ATT_V_OFF;
    bf16x8 qf[KS];
    {
        const bf16_t* qrow = a.Q + (size_t)qpos * a.qpitch + coff;
#pragma unroll
        for (int ks = 0; ks < KS; ++ks) qf[ks] = *(const bf16x8*)(qrow + 16 * ks + 8 * h);
        if (ROPE) {
            const float* cs = a.rope + (size_t)qpos * 16 + 8 * h; const float* sn = cs + T * 16;
            float y0[8], y1[8];
#pragma unroll
            for (int j = 0; j < 8; ++j) { const float x0 = bf2f(qf[KS - 2][j]), x1 = bf2f(qf[KS - 1][j]), c = cs[j], s = sn[j]; y0[j] = x0 * c - x1 * s; y1[j] = x1 * c + x0 * s; }
            u32x4 w0, w1;
            w0.x = cvtpk(y0[0], y0[1]); w0.y = cvtpk(y0[2], y0[3]); w0.z = cvtpk(y0[4], y0[5]); w0.w = cvtpk(y0[6], y0[7]);
            w1.x = cvtpk(y1[0], y1[1]); w1.y = cvtpk(y1[2], y1[3]); w1.z = cvtpk(y1[4], y1[5]); w1.w = cvtpk(y1[6], y1[7]);
            qf[KS - 2] = __builtin_bit_cast(bf16x8, w0); qf[KS - 1] = __builtin_bit_cast(bf16x8, w1);
        }
    }
    float qk_bound = 0.f;
    if (EARLY) {
        float qq = 0.f;
#pragma unroll
        for (int ks = 0; ks < KS; ++ks)
#pragma unroll
            for (int j = 0; j < 8; ++j) { const float x = bf2f(qf[ks][j]); qq += x * x; }
        qq += __shfl_xor(qq, 32);
        qk_bound = sqrtf(qq) * a.kmax * a.scale2 * 1.01f + 0.01f;
    }
    unsigned long long selm = ~0ull;
    if (SEL) selm = a.sel[qpos];
    const int t_hi = (q0 + QROWS - 1) >> 6;
    int t_lo = 0;
    if (a.window) { const int lo = q0 - a.window + 1; t_lo = lo > 0 ? (lo >> 6) : 0; }
    const bool kA_on = tid < 64 * NCH1; const int rowA = tid / NCH1, chA = tid % NCH1;
    const bool kB_on = ROPE && tid < 128; const int rowB = tid >> 1, prB = tid & 1;
    const int rowV = tid >> 3, chV = tid & 7;
    u32x4 kA = {0, 0, 0, 0}, kB0 = {0, 0, 0, 0}, kB1 = {0, 0, 0, 0}, vR = {0, 0, 0, 0};
#define ATT_PREFETCH(t) do { \
        if (kA_on) kA = *(const u32x4*)(a.K1 + (size_t)(64 * (t) + rowA) * a.k1pitch + chA * 8); \
        if (kB_on) { const bf16_t* kp = a.K2 + (size_t)(64 * (t) + rowB) * a.k2pitch + prB * 8; kB0 = *(const u32x4*)kp; kB1 = *(const u32x4*)(kp + 16); } \
        vR = *(const u32x4*)(a.V + (size_t)(64 * (t) + rowV) * a.vpitch + chV * 8); } while (0)
#define ATT_STORE(tt, KL, VL) do { \
        if (kA_on) *(LAS u32x4*)((KL) + rowA * KP + chA * 16) = kA; \
        if (ROPE) { if (kB_on) { \
                *(LAS u32x4*)((KL) + rowB * KP + (64 + prB * 8) * 2) = kB0; \
                *(LAS u32x4*)((KL) + rowB * KP + (80 + prB * 8) * 2) = kB1; } } \
        *(LAS u32x4*)((VL) + (chV >> 2) * 4096 + rowV * 64 + (chV & 3) * 16) = vR; } while (0)
    float m = NEGBIG;
    f32x16 osum;
#pragma unroll
    for (int i = 0; i < 16; ++i) { o[0][i] = 0.f; o[1][i] = 0.f; osum[i] = 0.f; }
    float cbv[16];
#pragma unroll
    for (int i = 0; i < 16; ++i) cbv[i] = a.slope2 * (float)((i & 3) + 8 * (i >> 2) + 4 * h);
    volatile LAS unsigned* eflag = (volatile LAS unsigned*)(lds + ATT_FLAG_OFF);
    unsigned long long um = (t_hi >= 63 ? ~0ull : ((1ull << (t_hi + 1)) - 1ull)) & ~((1ull << t_lo) - 1ull);
    if (SEL) {
        LAS unsigned* uw = (LAS unsigned*)(lds + ATT_FLAG_OFF + 64);
        __syncthreads();
        if (tid < 2) uw[tid] = 0u;
        __syncthreads();
        __hip_atomic_fetch_or(uw, (unsigned)selm, __ATOMIC_RELAXED, __HIP_MEMORY_SCOPE_WORKGROUP);
        __hip_atomic_fetch_or(uw + 1, (unsigned)(selm >> 32), __ATOMIC_RELAXED, __HIP_MEMORY_SCOPE_WORKGROUP);
        __syncthreads();
        const unsigned lo_ = (unsigned)__builtin_amdgcn_readfirstlane((int)uw[0]), hi_ = (unsigned)__builtin_amdgcn_readfirstlane((int)uw[1]);
        um &= ((unsigned long long)hi_ << 32) | (unsigned long long)lo_;
    }
#define ATT_NEXT(tt) ((((tt) > 0) && (um & ((1ull << (tt)) - 1ull))) ? 63 - __builtin_clzll(um & ((1ull << (tt)) - 1ull)) : -1)
    int t = 63 - __builtin_clzll(um);
    int t1 = ATT_NEXT(t);
    ATT_PREFETCH(t);
    if (EARLY) { if (lane == 0) { eflag[wid] = 0u; eflag[8 + wid] = 0u; } }
    __syncthreads();
    ATT_STORE(t, Kl, Vl);
    __syncthreads();
    if (t1 >= 0) ATT_PREFETCH(t1);
    for (int step = 0; t >= 0; ++step) {
        const int cur = step & 1;
        const int t2 = (t1 >= 0) ? ATT_NEXT(t1) : -1;
        const LAS unsigned char* Kc = Kl + cur * ATT_BUF; const LAS unsigned char* Vc = Vl + cur * ATT_BUF;
        bool need = (64 * t <= qw0 + 31);
        if (a.window) need = need && (64 * t + 63 >= qw0 - a.window + 1);
        const bool selbit = SEL ? (((selm >> t) & 1ull) != 0ull) : true;
        if (SEL) need = need && (__ballot(selbit) != 0ull);
        if (need) {
            f32x16 p0, p1;
#pragma unroll
            for (int i = 0; i < 16; ++i) { p0[i] = 0.f; p1[i] = 0.f; }
#pragma unroll
            for (int ks = 0; ks < KS; ++ks) {
                const bf16x8 a0 = *(const LAS bf16x8*)(Kc + r * KP + coff * 2 + ks * 32 + h * 16);
                const bf16x8 a1 = *(const LAS bf16x8*)(Kc + (32 + r) * KP + coff * 2 + ks * 32 + h * 16);
                p0 = MFMA32(a0, qf[ks], p0); p1 = MFMA32(a1, qf[ks], p1);
            }
            if (!ROPE) {
#pragma unroll
                for (int i = 0; i < 16; ++i) { p0[i] = p0[i] * a.scale2 + cbv[i]; p1[i] = p1[i] * a.scale2 + cbv[i]; }
            }
            const float base0 = a.slope2 * (float)(64 * t - qpos), base1 = base0 + 32.0f * a.slope2;
            bool bnd = (64 * t + 63 > qw0);
            if (a.window) bnd = bnd || (64 * t < qw0 + 31 - a.window + 1);
            if (SEL) bnd = bnd || (__ballot(!selbit) != 0ull);
            if (bnd) {
                const int wlim = a.window ? a.window : (1 << 30);
#pragma unroll
                for (int i = 0; i < 16; ++i) {
                    const int kv0 = 64 * t + crow(i, h), d0 = qpos - kv0, d1 = d0 - 32;
                    const bool ok0 = selbit && d0 >= 0 && d0 < wlim, ok1 = selbit && d1 >= 0 && d1 < wlim;
                    p0[i] = ok0 ? p0[i] : NEGBIG; p1[i] = ok1 ? p1[i] : NEGBIG;
                }
            }
            float mx0 = p0[0], mx1 = p1[0];
#pragma unroll
            for (int i = 1; i < 16; ++i) { mx0 = fmaxf(mx0, p0[i]); mx1 = fmaxf(mx1, p1[i]); }
            float mloc = ROPE ? fmaxf(mx0, mx1) * a.scale2 : fmaxf(mx0 + base0, mx1 + base1);
            mloc = fmaxf(mloc, __shfl_xor(mloc, 32));
            const float mnew = fmaxf(m, mloc);
            if (__ballot(mnew > m) != 0ull) {
                const float alpha = fast_exp2(m - mnew);
                osum[0] *= alpha;
#pragma unroll
                for (int i = 0; i < 16; ++i) { o[0][i] *= alpha; o[1][i] *= alpha; }
            }
            m = mnew;
            const float r0 = mnew - base0, r1 = mnew - base1;
            if (ROPE) {
#pragma unroll
                for (int i = 0; i < 16; ++i) { p0[i] = fast_exp2(p0[i] * a.scale2 - mnew); p1[i] = fast_exp2(p1[i] * a.scale2 - mnew); }
            } else {
#pragma unroll
                for (int i = 0; i < 16; ++i) { p0[i] = fast_exp2(p0[i] - r0); p1[i] = fast_exp2(p1[i] - r1); }
            }
            pv_tile_t<true>(o, osum, p0, p1, Vc, lane);
        }
        if (EARLY) {
            const bool live = !(qk_bound - a.slope2 * (float)(qpos - 64 * t + 1) - m < -64.0f);
            const bool wdone = (__ballot(live) == 0ull);
            if (lane == 0) eflag[8 * cur + wid] = wdone ? 1u : 0u;
        }
        if (t1 >= 0) ATT_STORE(t1, Kl + (cur ^ 1) * ATT_BUF, Vl + (cur ^ 1) * ATT_BUF);
        __syncthreads();
        if (EARLY) {
            const unsigned alld = eflag[8 * cur] & eflag[8 * cur + 1] & eflag[8 * cur + 2] & eflag[8 * cur + 3] & eflag[8 * cur + 4] & eflag[8 * cur + 5] & eflag[8 * cur + 6] & eflag[8 * cur + 7];
            if (__builtin_amdgcn_readfirstlane((int)alld) != 0) break;
        }
        if (t2 >= 0) ATT_PREFETCH(t2);
        t = t1; t1 = t2;
    }
#undef ATT_NEXT
#undef ATT_STORE
#undef ATT_PREFETCH
    const float lt = __shfl(osum[0], lane & 31);
    const float inv = 1.0f / lt;
#pragma unroll
    for (int i = 0; i < 16; ++i) { o[0][i] *= inv; o[1][i] *= inv; }
}

__device__ __forceinline__ float da_slope(int hd) { return hd == 0 ? 0.25f : hd == 1 ? 0.0625f : hd == 2 ? 0.015625f : 0.00390625f; }
__device__ __forceinline__ float nsa_slope(int hh) { return hh == 0 ? 0.25f : hh == 1 ? 0.0625f : hh == 2 ? 0.015625f : hh == 3 ? 0.00390625f : hh == 4 ? 0.5f : 0.125f; }

constexpr int DA_X_OFF = 49152;
__device__ __forceinline__ void da_unit(const Args& A, int l, int b, int hd, int qb, LAS unsigned char* lds) {
    const int tid_ = opq(get_tid()), lane = tid_ & 63, wid = __builtin_amdgcn_readfirstlane(tid_ >> 6), r = lane & 31, h = lane >> 5;
    const bf16_t* P = (const bf16_t*)(A.ws + WS_U) + (size_t)b * T * DINP;
    const float lam = ((const float*)(A.ws + WS_CTL))[64 + l];
    const float one_m_li = ((const float*)(A.ws + WS_CTL))[66 + l];
    f32x16 o[2];
    AttnArgs a; a.Q = P + C_AQ + hd * 64; a.qpitch = DINP; a.K1 = P + C_AK + hd * 64; a.k1pitch = DINP; a.K2 = nullptr; a.k2pitch = 0;
    a.V = P + C_AV + hd * 64; a.vpitch = DINP; a.rope = nullptr; a.sel = nullptr; a.scale2 = 0.17677669529663687f * LOG2E; a.slope2 = da_slope(hd) * LOG2E; a.window = 0;
    { const unsigned* kn = (const unsigned*)(A.ws + WS_CTL) + CTL_KN + l * 96 + b * 24 + 2 * hd; a.kmax = sqrtf(fmaxf(__uint_as_float(kn[0]), __uint_as_float(kn[1]))); }
    attn_core<32, false, false, true, true>(a, qb * 128, lds, o);
    LAS float* xb = (LAS float*)(lds + DA_X_OFF) + (32 * (wid & 3) + r) * 65;
    if (wid >= 4) {
#pragma unroll
        for (int db = 0; db < 2; ++db)
#pragma unroll
            for (int i = 0; i < 16; ++i) xb[32 * db + crow(i, h)] = o[db][i];
    }
    __syncthreads();
    if (wid < 4) {
        float ss = 0.f;
#pragma unroll
        for (int db = 0; db < 2; ++db)
#pragma unroll
            for (int i = 0; i < 16; ++i) { o[db][i] = o[db][i] - lam * xb[32 * db + crow(i, h)]; ss += o[db][i] * o[db][i]; }
        ss += __shfl_xor(ss, 32);
        const float rs = rsqrtf(ss * (1.0f / 64.0f) + RMS_EPS) * one_m_li;
        const float* sg = A.in[14] + l * 64;
#pragma unroll
        for (int db = 0; db < 2; ++db)
#pragma unroll
            for (int i = 0; i < 16; ++i) o[db][i] *= rs * sg[32 * db + crow(i, h)];
        bf16_t* orow = (bf16_t*)(A.ws + WS_XN) + (size_t)(b * T + qb * 128 + 32 * wid + r) * D + hd * 64;
        store_o<0>(o, orow, h, EN_DA ? 1.0f : 0.0f);
    }
}
__device__ __forceinline__ void mla_unit(const Args& A, int b, int hd, int qb, LAS unsigned char* lds) {
    const int tid_ = opq(get_tid()), lane = tid_ & 63, wid = __builtin_amdgcn_readfirstlane(tid_ >> 6), r = lane & 31, h = lane >> 5;
    AttnArgs a; a.Q = (const bf16_t*)(A.ws + WS_MQ) + (size_t)b * T * 768 + hd * 96; a.qpitch = 768;
    a.K1 = (const bf16_t*)(A.ws + WS_MKV) + (size_t)b * T * 768 + hd * 128; a.k1pitch = 768;
    a.K2 = (const bf16_t*)(A.ws + WS_KPE) + (size_t)b * T * 32; a.k2pitch = 32;
    a.V = a.K1 + 64; a.vpitch = 768; a.rope = (const float*)(A.ws + WS_ROPE); a.sel = nullptr; a.scale2 = 0.10206207261596575f * LOG2E; a.slope2 = 0.f; a.window = 0; a.kmax = 0.f;
    f32x16 o[2];
    attn_core<96, true, false>(a, qb * 256, lds, o);
    bf16_t* orow = (bf16_t*)(A.ws + WS_XN) + (size_t)(b * T + qb * 256 + 32 * wid + r) * D + 256 + hd * 64;
    store_o<0>(o, orow, h, EN_MLA ? 1.0f : 0.0f);
}
template <int BR> __device__ __forceinline__ void nsa_unit(const Args& A, int l, int b, int hh, int qb, LAS unsigned char* lds) {
    const int tid_ = opq(get_tid()), lane = tid_ & 63, wid = __builtin_amdgcn_readfirstlane(tid_ >> 6), r = lane & 31, h = lane >> 5, g = hh / 3;
    if (BR == 1) {
        if (tid_ == 0) { const unsigned* fl = (const unsigned*)(A.ws + WS_CTL) + 512 + l * 128 + (b * 2 + g) * 16 + qb; unsigned sp = 0;
            while (__hip_atomic_load(fl, __ATOMIC_RELAXED, __HIP_MEMORY_SCOPE_AGENT) == 0u) { __builtin_amdgcn_s_sleep(4); if (++sp > (1u << 22)) break; } }
        __syncthreads();
        __builtin_amdgcn_fence(__ATOMIC_ACQUIRE, "agent");
    }
    const bf16_t* P = (const bf16_t*)(A.ws + WS_U) + (size_t)b * T * DINP;
    AttnArgs a; a.Q = P + C_CQ + hh * 64; a.qpitch = DINP; a.K1 = P + (BR == 2 ? C_KW : C_KS) + g * 64; a.k1pitch = DINP; a.K2 = nullptr; a.k2pitch = 0;
    a.V = P + (BR == 2 ? C_VW : C_VS) + g * 64; a.vpitch = DINP; a.rope = nullptr; a.sel = (const unsigned long long*)(A.ws + WS_SEL) + (size_t)(b * 2 + g) * T;
    a.scale2 = 0.125f * LOG2E; a.slope2 = nsa_slope(hh) * LOG2E; a.window = (BR == 2) ? 512 : 0;
    f32x16 o[2];
    { const unsigned* kn = (const unsigned*)(A.ws + WS_CTL) + CTL_KN + l * 96 + b * 24 + (BR == 2 ? 16 : 8) + 1 + 2 * g; a.kmax = sqrtf(__uint_as_float(kn[0]) + __uint_as_float(kn[1])); }
    attn_core<64, false, BR == 1, false, true>(a, qb * 256, lds, o);
    const int qpos = qb * 256 + 32 * wid + r;
    const float gl = bf2f((short)P[(size_t)qpos * DINP + C_G + BR * 6 + hh]);
    bf16_t* orow = (bf16_t*)(A.ws + WS_XN) + (size_t)(b * T + qpos) * D + 640 + hh * 64;
    if (BR == 2) store_o<0>(o, orow, h, EN_WIN ? sigmoid_f(gl) : 0.0f);
    else store_o<1>(o, orow, h, EN_SLC ? sigmoid_f(gl) : 0.0f);
}

__device__ __forceinline__ void cmp_mlp_task(const Args& A, int l, int wt, LAS unsigned char* lds) {
    const int tid_ = opq(get_tid()), lane = tid_ & 63, wid = __builtin_amdgcn_readfirstlane(tid_ >> 6);
    const int kv = wt >> 7, bg = (wt >> 4) & 7, rg = wt & 15, b = bg >> 1, g = bg & 1, i16 = lane & 15, quad = lane >> 4;
    const bf16_t* P = (const bf16_t*)(A.ws + WS_U) + (size_t)b * T * DINP + (kv ? C_VC : C_KC) + g * 64;
    const bf16_t* W1 = (const bf16_t*)(A.ws + WS_W + W_C1) + (size_t)kv * 128 * 2048;
    const bf16_t* W2 = (const bf16_t*)(A.ws + WS_W + W_C2) + (size_t)kv * 64 * 128;
    const float* posb = (const float*)(A.ws + WS_POSB) + (l * 2 + kv) * 128;
    const int n = 16 * rg + i16;
    const bf16_t* arow = P + (size_t)(16 * n) * DINP + 8 * quad;
    const bf16_t* wrow1 = W1 + (size_t)i16 * 2048 + 8 * quad;
    f32x4 acc[8];
#pragma unroll
    for (int i = 0; i < 8; ++i) acc[i] = (f32x4){0.f, 0.f, 0.f, 0.f};
#pragma unroll 2
    for (int kk = 0; kk < 8; ++kk) {
        const int ks = 8 * wid + kk;
        const bf16x8 bfrag = *(const bf16x8*)(arow + (size_t)(ks >> 1) * DINP + 32 * (ks & 1));
#pragma unroll
        for (int ht = 0; ht < 8; ++ht) {
            const bf16x8 afrag = *(const bf16x8*)(wrow1 + (size_t)(16 * ht) * 2048 + 32 * ks);
            acc[ht] = MFMA16(afrag, bfrag, acc[ht]);
        }
    }
    {
        LAS float* red = (LAS float*)lds;
        if (wid > 0) {
#pragma unroll
            for (int ht = 0; ht < 8; ++ht)
#pragma unroll
                for (int j = 0; j < 4; ++j) red[(wid * 64 + lane) * 33 + ht * 4 + j] = acc[ht][j];
        }
        __syncthreads();
        if (wid > 0) return;
#pragma unroll 1
        for (int w = 1; w < 8; ++w)
#pragma unroll
            for (int ht = 0; ht < 8; ++ht)
#pragma unroll
                for (int j = 0; j < 4; ++j) acc[ht][j] += red[(w * 64 + lane) * 33 + ht * 4 + j];
    }
    bf16x8 hf[4];
#pragma unroll
    for (int ks2 = 0; ks2 < 4; ++ks2) {
        float v[8];
#pragma unroll
        for (int e = 0; e < 8; ++e) {
            const int ht = 2 * ks2 + (e >> 2), j = e & 3;
            const float x = acc[ht][j] + posb[16 * ht + 4 * quad + j];
            const float u2 = 0.7978845608028654f * (x + 0.044715f * x * x * x);
            const float ex = fast_exp2(2.0f * LOG2E * u2);
            const float th = 1.0f - 2.0f * fast_rcp(ex + 1.0f);
            v[e] = 0.5f * x * (1.0f + th);
        }
        u32x4 w; w.x = cvtpk(v[0], v[1]); w.y = cvtpk(v[2], v[3]); w.z = cvtpk(v[4], v[5]); w.w = cvtpk(v[6], v[7]);
        hf[ks2] = __builtin_bit_cast(bf16x8, w);
    }
    bf16_t* outp = (bf16_t*)(A.ws + WS_KCMP) + ((size_t)(kv * 8 + bg) * 256 + n) * 64;
#pragma unroll
    for (int ot = 0; ot < 4; ++ot) {
        f32x4 c2 = (f32x4){0.f, 0.f, 0.f, 0.f};
        const bf16_t* w2r = W2 + (size_t)(16 * ot + i16) * 128 + 4 * quad;
#pragma unroll
        for (int ks2 = 0; ks2 < 4; ++ks2) {
            const u32x2 lo = *(const u32x2*)(w2r + 32 * ks2), hi = *(const u32x2*)(w2r + 32 * ks2 + 16);
            u32x4 w; w.x = lo.x; w.y = lo.y; w.z = hi.x; w.w = hi.y;
            c2 = MFMA16(__builtin_bit_cast(bf16x8, w), hf[ks2], c2);
        }
        if (n < 255) { u32x2 w; w.x = cvtpk(c2[0], c2[1]); w.y = cvtpk(c2[2], c2[3]); *(u32x2*)(outp + 16 * ot + 4 * quad) = w; }
    }
}

constexpr int CMP_K_OFF = 0, CMP_V_OFF = 36864, CMP_IMP_OFF = 69632;
__device__ __forceinline__ void cmp_unit(const Args& A, int l, int b, int g, int qb, LAS unsigned char* lds, float gmul = 1.0f) {
    const int tid = opq(get_tid()), lane = tid & 63, wid = __builtin_amdgcn_readfirstlane(tid >> 6), r = lane & 31, h = lane >> 5;
    const int q0 = qb * 256, qw0 = q0 + 32 * wid, qpos = qw0 + r, qloc = 32 * wid + r;
    const int ntile = (((q0 + 224) >> 4) >> 6) + 1;
    LAS unsigned char* Kl = lds + CMP_K_OFF; LAS unsigned char* Vl = lds + CMP_V_OFF; LAS float* imp = (LAS float*)(lds + CMP_IMP_OFF);
    const bf16_t* KC = (const bf16_t*)(A.ws + WS_KCMP) + (size_t)(b * 2 + g) * 256 * 64;
    const bf16_t* VC = KC + (size_t)8 * 256 * 64;
    __syncthreads();
    for (int idx = tid; idx < 512 * ntile; idx += NTHR) {
        const int n = idx >> 3, ch = idx & 7;
        u32x4 kx = {0, 0, 0, 0}, vx = {0, 0, 0, 0};
        if (n < 255) { kx = *(const u32x4*)(KC + (size_t)n * 64 + ch * 8); vx = *(const u32x4*)(VC + (size_t)n * 64 + ch * 8); }
        *(LAS u32x4*)(Kl + n * 144 + ch * 16) = kx;
        *(LAS u32x4*)(Vl + (n >> 6) * 8192 + (ch >> 2) * 4096 + (n & 63) * 64 + (ch & 3) * 16) = vx;
    }
    for (int idx = tid; idx < 256 * 65; idx += NTHR) imp[idx] = 0.f;
    __syncthreads();
    const bf16_t* P = (const bf16_t*)(A.ws + WS_U) + (size_t)b * T * DINP;
    const float scale2 = 0.125f * LOG2E;
#pragma unroll 1
    for (int rr = 0; rr < 3; ++rr) {
        const int hh = 3 * g + rr; const float slope2 = nsa_slope(hh) * LOG2E;
        bf16x8 qf[4];
        { const bf16_t* qrow = P + (size_t)qpos * DINP + C_CQ + hh * 64;
#pragma unroll
          for (int ks = 0; ks < 4; ++ks) qf[ks] = *(const bf16x8*)(qrow + 16 * ks + 8 * h); }
        float m = NEGBIG, lsum = 0.f, invl = 0.f;
        f32x16 o[2];
#pragma unroll
        for (int i = 0; i < 16; ++i) { o[0][i] = 0.f; o[1][i] = 0.f; }
#pragma unroll 1
        for (int pass = 0; pass < 2; ++pass) {
#pragma unroll 1
            for (int tt = 0; tt < ntile; ++tt) {
                if (16 * (64 * tt) + 31 > qw0 + 31) continue;
                f32x16 p0, p1;
#pragma unroll
                for (int i = 0; i < 16; ++i) { p0[i] = 0.f; p1[i] = 0.f; }
#pragma unroll
                for (int ks = 0; ks < 4; ++ks) {
                    const bf16x8 a0 = *(const LAS bf16x8*)(Kl + (64 * tt + r) * 144 + ks * 32 + h * 16);
                    const bf16x8 a1 = *(const LAS bf16x8*)(Kl + (64 * tt + 32 + r) * 144 + ks * 32 + h * 16);
                    p0 = MFMA32(a0, qf[ks], p0); p1 = MFMA32(a1, qf[ks], p1);
                }
#pragma unroll
                for (int i = 0; i < 16; ++i) {
                    const int n0 = 64 * tt + crow(i, h), d0 = qpos - (16 * n0 + 31), d1 = d0 - 512;
                    p0[i] = d0 >= 0 ? p0[i] * scale2 - slope2 * (float)d0 : NEGBIG;
                    p1[i] = d1 >= 0 ? p1[i] * scale2 - slope2 * (float)d1 : NEGBIG;
                }
                if (pass == 0) {
                    float mloc = fmaxf(p0[0], p1[0]);
#pragma unroll
                    for (int i = 1; i < 16; ++i) mloc = fmaxf(mloc, fmaxf(p0[i], p1[i]));
                    mloc = fmaxf(mloc, __shfl_xor(mloc, 32));
                    const float mnew = fmaxf(m, mloc), alpha = fast_exp2(m - mnew);
                    m = mnew;
                    float ls = 0.f;
#pragma unroll
                    for (int i = 0; i < 16; ++i) ls += fast_exp2(p0[i] - mnew) + fast_exp2(p1[i] - mnew);
                    lsum = lsum * alpha + ls;
                } else {
#pragma unroll
                    for (int i = 0; i < 16; ++i) {
                        p0[i] = p0[i] > -1e29f ? fast_exp2(p0[i] - m) * invl : 0.f;
                        p1[i] = p1[i] > -1e29f ? fast_exp2(p1[i] - m) * invl : 0.f;
                    }
                    pv_tile(o, p0, p1, Vl + tt * 8192, lane);
#pragma unroll
                    for (int blk = 0; blk < 2; ++blk)
#pragma unroll
                        for (int g4 = 0; g4 < 4; ++g4) {
                            const int j = 16 * tt + 8 * blk + 2 * g4 + h;
                            const float G = blk == 0 ? (p0[4 * g4] + p0[4 * g4 + 1]) + (p0[4 * g4 + 2] + p0[4 * g4 + 3]) : (p1[4 * g4] + p1[4 * g4 + 1]) + (p1[4 * g4 + 2] + p1[4 * g4 + 3]);
                            imp[qloc * 65 + j] += G;
                        }
                    asm volatile("s_waitcnt lgkmcnt(0)" ::: "memory");
#pragma unroll
                    for (int blk = 0; blk < 2; ++blk)
#pragma unroll
                        for (int g4 = 0; g4 < 4; ++g4) {
                            const int j = 16 * tt + 8 * blk + 2 * g4 + h;
                            const float Lst = blk == 0 ? p0[4 * g4 + 3] : p1[4 * g4 + 3];
                            if (j + 1 < 64) imp[qloc * 65 + j + 1] += Lst;
                        }
                    asm volatile("s_waitcnt lgkmcnt(0)" ::: "memory");
                }
            }
            if (pass == 0) { const float lt = lsum + __shfl_xor(lsum, 32); invl = (qpos >= 31) ? 1.0f / lt : 0.f; }
        }
        const float gl = bf2f((short)P[(size_t)qpos * DINP + C_G + 0 * 6 + hh]);
        bf16_t* orow = (bf16_t*)(A.ws + WS_XN) + (size_t)(b * T + qpos) * D + 640 + hh * 64;
        store_o<1>(o, orow, h, EN_CMP ? sigmoid_f(gl) * gmul : 0.0f);
    }
    __syncthreads();
    if (qb < 4) {
        if (tid < 256) { const int t = q0 + tid, cur = t >> 6; ((unsigned long long*)(A.ws + WS_SEL))[(size_t)(b * 2 + g) * T + t] = (1ull << (cur + 1)) - 1ull; }
    } else {
        const int qi = tid >> 1, hf = tid & 1, t = q0 + qi, cur = t >> 6;
        float v[32];
#pragma unroll
        for (int i = 0; i < 32; ++i) { const int j = 32 * hf + i; const float x = imp[qi * 65 + j]; v[i] = (j >= 1 && j <= cur - 2) ? x : -1.0f; }
        unsigned long long mask = 1ull | (1ull << cur) | (1ull << (cur - 1));
#pragma unroll 1
        for (int it = 0; it < 13; ++it) {
            float bv = v[0]; int bi = 0;
#pragma unroll
            for (int i = 1; i < 32; ++i) { const bool gt = v[i] > bv; bv = gt ? v[i] : bv; bi = gt ? i : bi; }
            const float ov = __shfl_xor(bv, 1); const int oi = __shfl_xor(bi, 1);
            const float v0 = hf ? ov : bv, v1 = hf ? bv : ov; const int i0 = hf ? oi : bi, i1 = hf ? bi : oi;
            const bool win0 = v0 >= v1;
            const int wj = win0 ? i0 : 32 + i1;
            mask |= 1ull << wj;
            const int clr = (win0 == (hf == 0)) ? (win0 ? i0 : i1) : -1;
#pragma unroll
            for (int i = 0; i < 32; ++i) v[i] = (i == clr) ? -1.0f : v[i];
        }
        if (hf == 0) ((unsigned long long*)(A.ws + WS_SEL))[(size_t)(b * 2 + g) * T + t] = mask;
    }
    __builtin_amdgcn_fence(__ATOMIC_RELEASE, "agent");
    __syncthreads();
    if (tid == 0) __hip_atomic_store((unsigned*)(A.ws + WS_CTL) + 512 + l * 128 + (b * 2 + g) * 16 + qb, 1u, __ATOMIC_RELAXED, __HIP_MEMORY_SCOPE_AGENT);
}

__device__ __forceinline__ int fetch_unit(unsigned* ctr, LAS unsigned char* lds) {
    volatile LAS int* w = (volatile LAS int*)(lds + FETCH_OFF);
    __syncthreads();
    if (get_tid() == 0) *w = (int)atomicAdd(ctr, 1u);
    __syncthreads();
    return __builtin_amdgcn_readfirstlane(*w);
}
template <class Epi>
__device__ __forceinline__ void run_gemm_counted(LAS unsigned char* lds, const bf16_t* Am, const bf16_t* Bt, int N, int K, const Epi& E, unsigned* cnt) {
    pg8::Gemm g{Am, Bt, M, N, K}; CountedOrder S; S.init(M, N, (int)gridDim.x, (int)blockIdx.x); S.cnt = cnt;
    pg8::gemm_phase<Epi, CountedOrder, true, true>(lds, g, S, E);
}
template <class Epi>
__device__ __forceinline__ void run_gemm_small(LAS unsigned char* lds, const bf16_t* Am, const bf16_t* Bt, int N, int K, const Epi& E) {
    asm volatile("" : "+s"(N), "+s"(K));
    pg8::Gemm g{Am, Bt, M, N, K}; pg8::StaticOrder S; S.init(M, N, (int)gridDim.x, (int)blockIdx.x);
    pg8::gemm_phase<Epi, pg8::StaticOrder, true, true>(lds, g, S, E);
}
template <class Epi>
__device__ __forceinline__ void run_gemm(LAS unsigned char* lds, const bf16_t* Am, const bf16_t* Bt, int N, int K, const Epi& E) {
    pg8::Gemm g{Am, Bt, M, N, K}; pg8::StaticOrder S; S.init(M, N, (int)gridDim.x, (int)blockIdx.x);
    pg8::gemm_phase<Epi, pg8::StaticOrder, true, true>(lds, g, S, E);
}

__global__ void __launch_bounds__(NTHR, 2) fwd_megakernel(Args A) {
    LAS unsigned char* lds = (LAS unsigned char*)lds_raw;
    if (lane_id() == 0) *(volatile LAS int*)(lds + WIDTAB_OFF + 4 * hw_slot()) = (int)(threadIdx.x >> 6);
    __syncthreads();
    cg::grid_group grid = cg::this_grid();
    const int G = gridDim.x;
    { volatile LAS unsigned* st0 = (volatile LAS unsigned*)(lds + FETCH_OFF + 16); if (get_tid() < 2) st0[get_tid()] = 0u; }
    __syncthreads();
#ifdef PROBE_PHASE
    if (get_tid() < 32) { volatile LAS unsigned* ta_ = (volatile LAS unsigned*)(lds + 140000); ta_[get_tid()] = 0u; }
    __syncthreads();
    if (get_tid() == 0) { volatile LAS unsigned* ta_ = (volatile LAS unsigned*)(lds + 140000); ta_[31] = (unsigned)__builtin_amdgcn_s_memrealtime(); }
    __syncthreads();
#endif
    const unsigned xbar_x = (unsigned)__builtin_amdgcn_readfirstlane((int)xcd_barrier_post((unsigned*)(A.ws + WS_CTL) + 1024, (volatile LAS unsigned*)(lds + FETCH_OFF + 16)).x);
#ifdef PROBE_PHASE
#define STAMP(id) do { if (blockIdx.x == 0 && get_tid() == 0) { volatile LAS unsigned* ta_ = (volatile LAS unsigned*)(lds + 140000); const unsigned now_ = (unsigned)__builtin_amdgcn_s_memrealtime(); ta_[id] += now_ - ta_[31]; ta_[31] = now_; } } while (0)
#else
#define STAMP(id) do {} while (0)
#endif
#define GSYNC() do { XcdBarrier xb_; unsigned xx_ = xbar_x; asm volatile("" : "+s"(xx_)); xb_.bar = (unsigned*)(A.ws + WS_CTL) + 1024; xb_.x = xx_; \
                     xb_.st = (volatile LAS unsigned*)(lds + FETCH_OFF + 16); xcd_barrier(xb_); } while (0)
    unsigned char* ws = A.ws;
    unsigned* ctl = (unsigned*)(ws + WS_CTL);
    float* X = A.out;
    bf16_t* XN = (bf16_t*)(ws + WS_XN);
    bf16_t* U = (bf16_t*)(ws + WS_U);
    const float* mods = (const float*)(ws + WS_MODS);

    for (int task = blockIdx.x; task < 288; task += G) mods_task(A, task, lds);
    for (int task = G - 1 - (int)blockIdx.x; task < 64; task += G) posb_task(A, task, lds);
    rope_entries(A);
    { float* ssq = (float*)(ws + WS_SSQ); for (int i = blockIdx.x * NTHR + opq(get_tid()); i < 4 * M; i += G * NTHR) ssq[i] = 0.f; }
    if (blockIdx.x == 0 && get_tid() < 2) {
        const int tid = opq(get_tid());
        const float* lp = A.in[13] + tid * 128; float s1 = 0.f, s2 = 0.f;
        for (int i = 0; i < 32; ++i) { s1 += lp[i] * lp[32 + i]; s2 += lp[64 + i] * lp[96 + i]; }
        const float lam_init = tid == 0 ? 0.2f : 0.35550907f;
        ((float*)ctl)[64 + tid] = expf(s1) - expf(s2) + lam_init;
        ((float*)ctl)[66 + tid] = 1.0f - lam_init;
    }
    __syncthreads();
    convert_layer(A, 0, lds);
#ifdef PROBE_DUPCVT
    for (int i = 0; i < PROBE_DUPCVT; ++i) { __syncthreads(); convert_layer(A, 0, lds); }
#endif
#ifdef PROBE_DUPMODS
    for (int task = blockIdx.x; task < 288; task += G) mods_task(A, task, lds);
#endif
    grid.sync();
    STAMP(0);

    if (blockIdx.x == 0) posb_final(A);
#pragma unroll 1
    for (int l = 0; l < 2; ++l) {
        const float* modl = mods + (size_t)l * 4 * 9216;
        unsigned char* wb = ws + WS_W;
        if (l == 1) { __syncthreads(); convert_layer(A, 1, lds); }
#pragma unroll 1
        for (int s = 0; s < 2; ++s) {
            const float* xin = (l == 0 && s == 0) ? A.in[0] : X;
            norm_rows(xin, XN, A.in[s == 0 ? 4 : 6] + l * D, modl, s == 0 ? 0 : 6, s == 0 ? 1 : 7);
            GSYNC();
            STAMP(1);
            { EpiSwiGLU E{U}; run_gemm(lds, XN, (const bf16_t*)(wb + (s == 0 ? W_1A : W_2A)), F2, D, E); }
            GSYNC();
            STAMP(2);
            { EpiResid E{xin, X, modl + (s == 0 ? 2 : 8) * 1024, 0.5f}; run_gemm(lds, U, (const bf16_t*)(wb + (s == 0 ? W_1B : W_2B)), D, F, E); }
            GSYNC();
            STAMP(3);
            if (s == 0 && EN_MIX) {
                norm_rows(X, XN, A.in[5] + l * D, modl, 3, 4);
                GSYNC();
                STAMP(4);
                float* ssq = (float*)(ws + WS_SSQ) + (size_t)l * 2 * M;
                { EpiProj E{U, (bf16_t*)(ws + WS_CQ), (bf16_t*)(ws + WS_CKV), ssq, ssq + M, ctl + CTL_KN + l * 96}; run_gemm(lds, XN, (const bf16_t*)(wb + W_IN), DINP, D, E); }
                GSYNC();
                STAMP(5);
                { EpiRowScale E{(bf16_t*)(ws + WS_MQ), 768, ssq, 1.0f / 256.0f}; run_gemm_small(lds, (const bf16_t*)(ws + WS_CQ), (const bf16_t*)(wb + W_UQ), 768, 256, E); }
                { EpiRowScale E{(bf16_t*)(ws + WS_MKV), 768, ssq + M, 1.0f / 128.0f}; run_gemm_small(lds, (const bf16_t*)(ws + WS_CKV), (const bf16_t*)(wb + W_UKV), 768, 128, E); }
                STAMP(11);
                for (;;) {
                    int u = fetch_unit(ctl + l * 4 + 0, lds);
                    if (u >= 64 + 256 + 512 + 384) break;
                    if (u < 512) { da_unit(A, l, (u & 15) >> 2, u & 3, 31 - (u >> 4), lds); continue; } u -= 512;
                    if (u < 384) { nsa_unit<2>(A, l, (u % 24) / 6, u % 6, 15 - u / 24, lds); continue; } u -= 384;
                    if (u < 256) { cmp_mlp_task(A, l, u, lds); continue; } u -= 256;
                    kpe_unit(A, u);
                }
                GSYNC();
                STAMP(6);
                for (;;) {
                    int u = fetch_unit(ctl + l * 4 + 1, lds);
                    if (u >= 384 + 128 + 384) break;
                    if (u < 192) { mla_unit(A, (u % 24) / 6, u % 6, 15 - u / 24, lds); continue; } u -= 192;
                    if (u < 128) { cmp_unit(A, l, (u & 7) >> 1, u & 1, 15 - (u >> 3), lds); continue; } u -= 128;
                    if (u < 192) { u += 192; mla_unit(A, (u % 24) / 6, u % 6, 15 - u / 24, lds); continue; } u -= 192;
                    nsa_unit<1>(A, l, (u % 24) / 6, u % 6, 15 - u / 24, lds);
                }
                GSYNC();
                STAMP(7);
                { EpiResid E{X, X, modl + 5 * 1024, 1.0f}; run_gemm(lds, XN, (const bf16_t*)(wb + W_OUT), D, D, E); }
                GSYNC();
                STAMP(9);
            }
        }
    }
    final_norm_rows(X, A.in[22]);
#ifdef PROBE_PHASE
    STAMP(10);
    __syncthreads();
    if (blockIdx.x == 0 && get_tid() == 0) { volatile LAS unsigned* ta_ = (volatile LAS unsigned*)(lds + 140000); X[0] += (float)ta_[PROBE_PHASE] * 0.0001f; }
#endif
#ifdef PROBE_SYNCS
    for (int i = 0; i < PROBE_SYNCS; ++i) GSYNC();
#endif
}

extern "C" void kernel_launch(void* const* d_in, const int* in_sizes, int n_in, void* d_out, int out_size, void* d_ws, size_t ws_size, hipStream_t stream) {
    static int grid = 0;
    if (grid == 0) {
        if (n_in != 23 || out_size != M * D || ws_size < WS_END) { fprintf(stderr, "kernel_launch: unexpected problem shape (n_in %d out %d ws %zu)\n", n_in, out_size, ws_size); grid = -1; return; }
        int dev = 0, cus = 0, per_cu = 0;
        hipGetDevice(&dev);
        hipDeviceGetAttribute(&cus, hipDeviceAttributeMultiprocessorCount, dev);
        hipFuncSetAttribute((const void*)fwd_megakernel, hipFuncAttributeMaxDynamicSharedMemorySize, LDS_BYTES);
        hipOccupancyMaxActiveBlocksPerMultiprocessor(&per_cu, (const void*)fwd_megakernel, NTHR, LDS_BYTES);
        if (per_cu < 1) per_cu = 1;
        grid = cus * per_cu;
        (void)hipGetLastError();
    }
    if (grid < 0) return;
    hipMemsetAsync(d_ws, 0, 32768, stream);
    Args a{};
    for (int i = 0; i < 23; ++i) a.in[i] = (const float*)d_in[i];
    a.out = (float*)d_out; a.ws = (unsigned char*)d_ws;
    void* args[] = {&a};
    hipError_t e = hipLaunchCooperativeKernel((const void*)fwd_megakernel, dim3(grid), dim3(NTHR), args, LDS_BYTES, stream);
    if (e != hipSuccess) fprintf(stderr, "cooperative launch failed: %s (grid %d)\n", hipGetErrorString(e), grid);
}
```

```cpp
#include <hip/hip_runtime.h>
#include <hip/hip_cooperative_groups.h>
#include <cstdio>
#include <cstdint>
namespace cg = cooperative_groups;
extern __shared__ __attribute__((aligned(16))) unsigned char lds_raw[];
constexpr int WIDTAB_OFF = 140200;
__device__ __forceinline__ int lane_id() { return (int)__builtin_amdgcn_mbcnt_hi(~0u, __builtin_amdgcn_mbcnt_lo(~0u, 0u)); }
__device__ __forceinline__ int hw_slot() { return (int)(__builtin_amdgcn_s_getreg((5 << 11) | 4) & 63u); }
__device__ __forceinline__ int get_tid() {
    const int wid = __builtin_amdgcn_readfirstlane(*(volatile __attribute__((address_space(3))) int*)((__attribute__((address_space(3))) unsigned char*)lds_raw + WIDTAB_OFF + 4 * hw_slot()));
    return wid * 64 + lane_id();
}
__device__ __forceinline__ int pg8_opq_tid() { int v = get_tid(); asm volatile("" : "+v"(v)); return v; }
namespace pg8 {
#define PG8_LAS __attribute__((address_space(3)))
typedef unsigned short bf16_t;
typedef short bf16x8 __attribute__((ext_vector_type(8)));
typedef float f32x4 __attribute__((ext_vector_type(4)));
typedef unsigned u32x4 __attribute__((ext_vector_type(4)));
constexpr int BM = 256, BK = 64, HALF = 128, HTB = HALF * BK * 2  , STAGE_BYTES = 8 * HTB, NXCD = 8, WGM = 8;

__host__ __device__ __forceinline__ int lds_byte(int r, int c) { const int st = (r >> 4) * 2 + (c >> 5), rr = r & 15, cc = c & 31, ob = rr * 64 + cc * 2; return st * 1024 + (ob ^ (((ob >> 9) & 1) << 5)); }
__host__ __device__ __forceinline__ void stage_rc(int b, int& R, int& C) { const int st = b / 1024, sb = b % 1024, swz = sb ^ (((sb >> 9) & 1) << 5); R = (st >> 1) * 16 + swz / 64; C = (st & 1) * 32 + (swz % 64) / 2; }
__host__ __device__ __forceinline__ int perm32(int rho) { const int n = rho >> 4, i = rho & 15; return 8 * (i >> 2) + 4 * n + (i & 3); }

struct Unit { int pm, pn; };
struct Gemm { const bf16_t* A; const bf16_t* Bt; int M, N, K; };

struct StaticOrder {
    int nM, nN, nwg, G, c;
    __host__ __device__ void init(int M, int N, int G_, int c_) { nM = M / BM; nN = N / BM; nwg = nM * nN; G = G_; c = c_; }
    __host__ __device__ bool next(int i, Unit& u) const {
        const long L = (long)i * G + c; if (L >= nwg) return false;
        int wgid = (int)L; { const int q = nwg / NXCD, r = nwg % NXCD, xcd = wgid % NXCD, off = wgid / NXCD; wgid = (xcd < r ? xcd * (q + 1) : r * (q + 1) + (xcd - r) * q) + off; }
        const int nig = WGM * nN, gid = wgid / nig, fm = gid * WGM, gsz = (nM - fm) < WGM ? (nM - fm) : WGM;
        u.pm = fm + ((wgid % nig) % gsz); u.pn = (wgid % nig) / gsz; return true;
    }
    __device__ __forceinline__ void a_ready(const Unit&) const {}
    __device__ __forceinline__ void done(const Unit&) const {}
};

__device__ __forceinline__ unsigned cvt_pk_bf16(float lo, float hi) { unsigned r; asm volatile("v_cvt_pk_bf16_f32 %0, %1, %2" : "=v"(r) : "v"(lo), "v"(hi)); return r; }
typedef float f32x2 __attribute__((ext_vector_type(2)));
__device__ __forceinline__ f32x2 gelu_pk(f32x2 v) {
    const f32x2 av = __builtin_elementwise_abs(v), d = av * 0.2316418882f + 1.0f;
    f32x2 t; t.x = __builtin_amdgcn_rcpf(d.x); t.y = __builtin_amdgcn_rcpf(d.y);
    f32x2 q = t * 0.5307027145f + (-0.7265760135f); q = q * t + 0.7107068705f; q = q * t + (-0.142248368f); q = q * t + 0.127414796f; q = q * t;
    const f32x2 s = (v * v) * (-0.72134752044f);
    f32x2 e; e.x = __builtin_amdgcn_exp2f(s.x); e.y = __builtin_amdgcn_exp2f(s.y);
    const f32x2 m = v * (q * e), r = v - m;
    f32x2 o; o.x = v.x < 0.f ? m.x : r.x; o.y = v.y < 0.f ? m.y : r.y; return o;
}

template <int ACT  > struct EpiBf16 {
    static constexpr bool PERM = true, AFTER_DRAIN = false; static_assert(ACT == 0 || ACT == 1, "EpiBf16: ACT is 0 (none) or 1 (gelu_pk)");
    bf16_t* O; int ldc; const float* bias; int split_cols; size_t split_stride; float scale0;
    __device__ __forceinline__ void operator()(const f32x4 (&acc)[2][2][4][2], const Unit& u, int wr, int wc, int fr, int fq) const {
        const int row0 = u.pm * BM + wr * 64 + fr; int colt = u.pn * BM; bf16_t* base = O;
        float sc = 1.f; if (split_cols) { const int t = colt / split_cols; base += (size_t)t * split_stride; colt -= t * split_cols; if (t == 0) sc = scale0; }
        const int col0 = colt + wc * 32 + 8 * fq, bcol0 = u.pn * BM + wc * 32 + 8 * fq;
        f32x4 bv[2][2];
#pragma unroll
        for (int bj = 0; bj < 2; ++bj)
#pragma unroll
            for (int n = 0; n < 2; ++n) bv[bj][n] = bias ? *(const f32x4*)(bias + bcol0 + bj * HALF + 4 * n) : (f32x4){0.f, 0.f, 0.f, 0.f};
#pragma unroll
        for (int ai = 0; ai < 2; ++ai)
#pragma unroll
            for (int m = 0; m < 4; ++m) { bf16_t* rowp = base + (size_t)(row0 + ai * HALF + m * 16) * ldc + col0;
#pragma unroll
                for (int bj = 0; bj < 2; ++bj) { f32x4 v0 = acc[ai][bj][m][0] + bv[bj][0], v1 = acc[ai][bj][m][1] + bv[bj][1];
                    if (ACT == 1) { f32x2 a = gelu_pk((f32x2){v0[0], v0[1]}), b = gelu_pk((f32x2){v0[2], v0[3]}), c = gelu_pk((f32x2){v1[0], v1[1]}), d = gelu_pk((f32x2){v1[2], v1[3]});
                        v0 = (f32x4){a.x, a.y, b.x, b.y}; v1 = (f32x4){c.x, c.y, d.x, d.y}; }
                    v0 = v0 * sc; v1 = v1 * sc; u32x4 w; w.x = cvt_pk_bf16(v0[0], v0[1]); w.y = cvt_pk_bf16(v0[2], v0[3]); w.z = cvt_pk_bf16(v1[0], v1[1]); w.w = cvt_pk_bf16(v1[2], v1[3]);
                    *(u32x4*)(rowp + bj * HALF) = w; } }
    }
};
template <class Epi, class Sched, bool ALIGN_EPI = false, bool SP2 = false>
__device__ __forceinline__ void gemm_phase(PG8_LAS unsigned char* lds, const Gemm g, const Sched& S, const Epi& E) {
    const int tid = pg8_opq_tid(), wid = __builtin_amdgcn_readfirstlane(tid >> 6), lane = tid & 63, wr = wid >> 2, wc = wid & 3, fr = lane & 15, fq = lane >> 4;
    const int K = g.K, nt = K / BK;
    unsigned voffA[2], voffB[2];
#pragma unroll
    for (int i = 0; i < 2; ++i) { int R, C; stage_rc(tid * 16 + i * 8192, R, C); const int Rb = Epi::PERM ? ((R & ~31) + perm32(R & 31)) : R;
        voffA[i] = (unsigned)(R * K + C) * 2u; voffB[i] = (unsigned)(Rb * K + C) * 2u; }
    const size_t kstep = (size_t)(BK * 2);
    const size_t hstep = (size_t)HALF * K * 2;
    const size_t tstep = 2 * hstep;
    const unsigned ldsw = (unsigned)wid * 1024u;
    const int aoff = lds_byte(wr * 64 + fr, fq * 8), boff = lds_byte(wc * 32 + fr, fq * 8);
#define PG8_SA(b, h) (((b) * 2 + (h)) * HTB)
#define PG8_SB(b, h) ((4 + (b) * 2 + (h)) * HTB)
#define PG8_STAGE(bufoff, gbase, voff) do { _Pragma("unroll") for (int _i = 0; _i < 2; ++_i) \
        __builtin_amdgcn_global_load_lds((const unsigned*)((const char*)(gbase) + (voff)[_i]), (PG8_LAS unsigned*)(lds + (bufoff) + ldsw + _i * 8192), 16, 0, 0); } while (0)
#define PG8_LDA(dst, b, h) do { _Pragma("unroll") for (int m = 0; m < 4; ++m) _Pragma("unroll") for (int k = 0; k < 2; ++k) dst[m][k] = *(const PG8_LAS bf16x8*)(lds + PG8_SA(b, h) + aoff + m * 2048 + k * 1024); } while (0)
#define PG8_LDB(dst, b, h) do { _Pragma("unroll") for (int n = 0; n < 2; ++n) _Pragma("unroll") for (int k = 0; k < 2; ++k) dst[n][k] = *(const PG8_LAS bf16x8*)(lds + PG8_SB(b, h) + boff + n * 2048 + k * 1024); } while (0)
#define PG8_MMA(ai, bj, At, Bt) do { __builtin_amdgcn_s_setprio(1); _Pragma("unroll") for (int m = 0; m < 4; ++m) _Pragma("unroll") for (int n = 0; n < 2; ++n) _Pragma("unroll") for (int k = 0; k < 2; ++k) \
        acc[ai][bj][m][n] = __builtin_amdgcn_mfma_f32_16x16x32_bf16(Bt[n][k], At[m][k], acc[ai][bj][m][n], 0, 0, 0); __builtin_amdgcn_s_setprio(0); } while (0)
#define PG8_WAIT_V(n) asm volatile("s_waitcnt vmcnt(" #n ")" ::: "memory")
#define PG8_WAIT_L(n) asm volatile("s_waitcnt lgkmcnt(" #n ")" ::: "memory")
#define PG8_BAR __builtin_amdgcn_s_barrier()
#define PG8_SCHED __builtin_amdgcn_sched_barrier(0)
    Unit cur, nxt; int ui = 0;
    if (!S.next(0, cur)) return;
    f32x4 acc[2][2][4][2];
#pragma unroll
    for (int a = 0; a < 2; ++a)
#pragma unroll
        for (int b = 0; b < 2; ++b)
#pragma unroll
            for (int m = 0; m < 4; ++m)
#pragma unroll
                for (int n = 0; n < 2; ++n) acc[a][b][m][n] = (f32x4){0.f, 0.f, 0.f, 0.f};
    bf16x8 At[4][2], B0[2][2], B1[2][2];
    const char* cA = (const char*)g.A + (size_t)cur.pm * tstep; const char* cB = (const char*)g.Bt + (size_t)cur.pn * tstep;
    S.a_ready(cur);
    if constexpr (SP2) {
        PG8_STAGE(PG8_SB(0, 0), cB, voffB); PG8_STAGE(PG8_SB(0, 1), cB + hstep, voffB); PG8_STAGE(PG8_SA(0, 0), cA, voffA); PG8_STAGE(PG8_SA(0, 1), cA + hstep, voffA);
        if (wr == 1) PG8_BAR;
        PG8_WAIT_V(2); PG8_BAR;
        PG8_STAGE(PG8_SB(1, 0), cB + kstep, voffB); PG8_STAGE(PG8_SA(1, 0), cA + kstep, voffA); PG8_STAGE(PG8_SB(1, 1), cB + hstep + kstep, voffB);
        PG8_WAIT_V(6); PG8_BAR;
    } else {
        PG8_STAGE(PG8_SB(0, 0), cB, voffB); PG8_STAGE(PG8_SA(0, 0), cA, voffA); PG8_STAGE(PG8_SB(0, 1), cB + hstep, voffB); PG8_STAGE(PG8_SA(0, 1), cA + hstep, voffA);
        if (wr == 1) PG8_BAR;
        PG8_WAIT_V(4); PG8_BAR;
        PG8_STAGE(PG8_SB(1, 0), cB + kstep, voffB); PG8_STAGE(PG8_SA(1, 0), cA + kstep, voffA); PG8_STAGE(PG8_SB(1, 1), cB + hstep + kstep, voffB);
        PG8_WAIT_V(6); PG8_BAR;
    }
    for (;;) {
        const bool has_next = S.next(ui + 1, nxt);
        const char* nA = has_next ? (const char*)g.A + (size_t)nxt.pm * tstep : cA; const char* nB = has_next ? (const char*)g.Bt + (size_t)nxt.pn * tstep : cB;
        for (int t = 0; t < nt; t += 2) {
            const bool last = (t == nt - 2);
            const char* a1 = cA + (size_t)(t + 1) * kstep;
            const char* a2 = last ? nA : cA + (size_t)(t + 2) * kstep; const char* b2 = last ? nB : cB + (size_t)(t + 2) * kstep;
            const char* a3 = a2 + kstep; const char* b3 = b2 + kstep;
            if (last && has_next) S.a_ready(nxt);
            if constexpr (SP2) {
            PG8_LDB(B0, 0, 0); PG8_LDB(B1, 0, 1); PG8_SCHED; PG8_LDA(At, 0, 0); PG8_STAGE(PG8_SA(1, 1), a1 + hstep, voffA);
            PG8_WAIT_V(8); PG8_WAIT_L(0); PG8_BAR; PG8_MMA(0, 0, At, B0); PG8_MMA(0, 1, At, B1); PG8_BAR; PG8_SCHED;
            PG8_LDA(At, 0, 1); PG8_STAGE(PG8_SB(0, 0), b2, voffB); PG8_STAGE(PG8_SB(0, 1), b2 + hstep, voffB); PG8_STAGE(PG8_SA(0, 0), a2, voffA);
            PG8_WAIT_V(8); PG8_WAIT_L(0); PG8_BAR; PG8_MMA(1, 0, At, B0); PG8_MMA(1, 1, At, B1); PG8_BAR; PG8_SCHED;
            PG8_LDB(B0, 1, 0); PG8_LDB(B1, 1, 1); PG8_SCHED; PG8_LDA(At, 1, 0); PG8_STAGE(PG8_SA(0, 1), a2 + hstep, voffA);
            PG8_WAIT_V(8); PG8_WAIT_L(0); PG8_BAR; PG8_MMA(0, 0, At, B0); PG8_MMA(0, 1, At, B1); PG8_BAR; PG8_SCHED;
            PG8_LDA(At, 1, 1); PG8_STAGE(PG8_SB(1, 0), b3, voffB); PG8_STAGE(PG8_SB(1, 1), b3 + hstep, voffB); PG8_STAGE(PG8_SA(1, 0), a3, voffA);
            PG8_WAIT_V(8); PG8_WAIT_L(0); PG8_BAR; PG8_MMA(1, 0, At, B0); PG8_MMA(1, 1, At, B1); PG8_BAR; PG8_SCHED;
            } else {
            PG8_LDB(B0, 0, 0); PG8_SCHED; PG8_LDA(At, 0, 0); PG8_STAGE(PG8_SA(1, 1), a1 + hstep, voffA);
            PG8_WAIT_L(8); PG8_BAR; PG8_WAIT_L(0); PG8_MMA(0, 0, At, B0); PG8_BAR; PG8_SCHED;
            PG8_LDB(B1, 0, 1); PG8_STAGE(PG8_SB(0, 0), b2, voffB);
            PG8_BAR; PG8_WAIT_L(0); PG8_MMA(0, 1, At, B1); PG8_BAR;
            PG8_LDA(At, 0, 1); PG8_STAGE(PG8_SA(0, 0), a2, voffA);
            PG8_BAR; PG8_WAIT_L(0); PG8_MMA(1, 0, At, B0); PG8_BAR; PG8_SCHED;
            PG8_STAGE(PG8_SB(0, 1), b2 + hstep, voffB);
            PG8_WAIT_V(6); PG8_BAR; PG8_MMA(1, 1, At, B1); PG8_BAR;
            PG8_LDB(B0, 1, 0); PG8_SCHED; PG8_LDA(At, 1, 0); PG8_STAGE(PG8_SA(0, 1), a2 + hstep, voffA);
            PG8_WAIT_L(8); PG8_BAR; PG8_WAIT_L(0); PG8_MMA(0, 0, At, B0); PG8_BAR; PG8_SCHED;
            PG8_LDB(B1, 1, 1); PG8_STAGE(PG8_SB(1, 0), b3, voffB);
            PG8_BAR; PG8_WAIT_L(0); PG8_MMA(0, 1, At, B1); PG8_BAR;
            PG8_LDA(At, 1, 1); PG8_STAGE(PG8_SA(1, 0), a3, voffA);
            PG8_BAR; PG8_WAIT_L(0); PG8_MMA(1, 0, At, B0); PG8_BAR; PG8_SCHED;
            PG8_STAGE(PG8_SB(1, 1), b3 + hstep, voffB);
            PG8_WAIT_V(6); PG8_BAR; PG8_MMA(1, 1, At, B1); PG8_BAR;
            }
        }
        if constexpr (ALIGN_EPI) { if (wr == 0) PG8_BAR; }
        if constexpr (!Epi::AFTER_DRAIN) { E(acc, cur, wr, wc, fr, fq); S.done(cur); }
        if (!has_next) break;
#pragma unroll
        for (int a = 0; a < 2; ++a)
#pragma unroll
            for (int b = 0; b < 2; ++b)
#pragma unroll
                for (int m = 0; m < 4; ++m)
#pragma unroll
                    for (int n = 0; n < 2; ++n) acc[a][b][m][n] = (f32x4){0.f, 0.f, 0.f, 0.f};
        cur = nxt; cA = nA; cB = nB; ++ui;
        if constexpr (ALIGN_EPI) { if (wr == 1) PG8_BAR; }
    }
    PG8_WAIT_V(0);
    if constexpr (!ALIGN_EPI) { if (wr == 0) PG8_BAR; }
    PG8_BAR;
    if constexpr (Epi::AFTER_DRAIN) { E.fused(acc, cur, wr, wc, fr, fq, lds, wid, lane); S.done(cur); }
#undef PG8_SA
#undef PG8_SB
#undef PG8_STAGE
#undef PG8_LDA
#undef PG8_LDB
#undef PG8_MMA
#undef PG8_WAIT_V
#undef PG8_WAIT_L
#undef PG8_BAR
#undef PG8_SCHED
}
}

#define LAS __attribute__((address_space(3)))
typedef unsigned short bf16_t;
typedef short bf16x8 __attribute__((ext_vector_type(8)));
typedef short s16x4 __attribute__((ext_vector_type(4)));
typedef float f32x4 __attribute__((ext_vector_type(4)));
typedef float f32x2 __attribute__((ext_vector_type(2)));
typedef float f32x16 __attribute__((ext_vector_type(16)));
typedef unsigned u32x4 __attribute__((ext_vector_type(4)));
typedef unsigned u32x2 __attribute__((ext_vector_type(2)));
typedef __bf16 bf16x2_t __attribute__((ext_vector_type(2)));

#ifndef EN_MIX
#define EN_MIX 1
#endif
#ifndef EN_DA
#define EN_DA 1
#endif
#ifndef EN_MLA
#define EN_MLA 1
#endif
#ifndef EN_WIN
#define EN_WIN 1
#endif
#ifndef EN_CMP
#define EN_CMP 1
#endif
#ifndef EN_SLC
#define EN_SLC 1
#endif

constexpr int NB = 4, T = 4096, D = 1024, M = NB * T, F = 2816, F2 = 5632, DIN = 2354, DINP = 2560;
constexpr int NTHR = 512, NWAVE = 8, LDS_BYTES = 147456, FETCH_OFF = LDS_BYTES - 64;
constexpr int C_AQ = 0, C_AK = 256, C_AV = 512, C_BKR = 1152, C_CQ = 1184, C_KC = 1568, C_VC = 1696, C_KS = 1824, C_VS = 1952, C_KW = 2080, C_VW = 2208, C_G = 2336;
constexpr float LOG2E = 1.4426950408889634f, RMS_EPS = 1e-6f, NEGBIG = -1e30f;

constexpr size_t MiB = 1u << 20, KiB = 1u << 10;
constexpr size_t WS_CTL = 0;
constexpr size_t WS_MODS = 64 * KiB;
constexpr size_t WS_ROPE = 512 * KiB;
constexpr size_t WS_POSB = 1 * MiB;
constexpr size_t WS_SSQ = 1 * MiB + 64 * KiB;
constexpr size_t WS_KCMP = 2 * MiB;
constexpr size_t WS_SEL = 3 * MiB;
constexpr size_t WS_W = 4 * MiB;
constexpr size_t W_1A = 0, W_1B = W_1A + (size_t)F2 * D * 2, W_2A = W_1B + (size_t)D * F * 2, W_2B = W_2A + (size_t)F2 * D * 2,
                 W_IN = W_2B + (size_t)D * F * 2, W_OUT = W_IN + (size_t)DINP * D * 2, W_UQ = W_OUT + (size_t)D * D * 2, W_UKV = W_UQ + 768 * 256 * 2,
                 W_C1 = W_UKV + 768 * 128 * 2, W_C2 = W_C1 + 2 * 128 * 2048 * 2, W_END = W_C2 + 2 * 64 * 128 * 2;
static_assert(WS_W + W_END <= 48 * MiB, "weights");
constexpr size_t WS_XN = 48 * MiB;
constexpr size_t WS_U = 80 * MiB;
constexpr size_t WS_CQ = 168 * MiB;
constexpr size_t WS_CKV = 176 * MiB;
constexpr size_t WS_MQ = 180 * MiB;
constexpr size_t WS_MKV = 204 * MiB;
constexpr size_t WS_KPE = 228 * MiB;
constexpr size_t WS_END = 229 * MiB;

__device__ __forceinline__ unsigned cvtpk(float lo, float hi) { f32x2 v = {lo, hi}; bf16x2_t b = __builtin_convertvector(v, bf16x2_t); return __builtin_bit_cast(unsigned, b); }
__device__ __forceinline__ float bf2f(short b) { return __uint_as_float(((unsigned)(unsigned short)b) << 16); }
__device__ __forceinline__ float wave_sum(float v) {
#pragma unroll
    for (int o = 1; o < 64; o <<= 1) v += __shfl_xor(v, o);
    return v;
}
__device__ __forceinline__ float fast_exp2(float x) { return __builtin_amdgcn_exp2f(x); }
__device__ __forceinline__ float fast_rcp(float x) { return __builtin_amdgcn_rcpf(x); }
__device__ __forceinline__ float sigmoid_f(float x) { return fast_rcp(1.0f + fast_exp2(-x * LOG2E)); }
__device__ __forceinline__ int crow(int i, int h) { return (i & 3) + 8 * (i >> 2) + 4 * h; }
__device__ __forceinline__ int opq(int v) { asm volatile("" : "+v"(v)); return v; }
#define MFMA32(a, b, c) __builtin_amdgcn_mfma_f32_32x32x16_bf16((a), (b), (c), 0, 0, 0)
#define MFMA16(a, b, c) __builtin_amdgcn_mfma_f32_16x16x32_bf16((a), (b), (c), 0, 0, 0)

struct Args { const float* in[23]; float* out; unsigned char* ws; };
__device__ __forceinline__ unsigned char* ws_opq(unsigned char* p) {
    const unsigned long long v = (unsigned long long)p;
    unsigned lo = (unsigned)__builtin_amdgcn_readfirstlane((int)(unsigned)v), hi = (unsigned)__builtin_amdgcn_readfirstlane((int)(unsigned)(v >> 32));
    asm volatile("" : "+s"(lo), "+s"(hi));
    return (unsigned char*)(((unsigned long long)hi << 32) | (unsigned long long)lo);
}

struct EpiSwiGLU {
    static constexpr bool PERM = true, AFTER_DRAIN = false;
    bf16_t* O;
    __device__ __forceinline__ void operator()(const f32x4 (&acc)[2][2][4][2], const pg8::Unit& u, int wr_, int wc_, int fr_, int fq_) const {
        const int t_ = opq(get_tid()), w_ = __builtin_amdgcn_readfirstlane(t_ >> 6), wr = w_ >> 2, wc = w_ & 3, fr = t_ & 15, fq = (t_ >> 4) & 3;
        const int row0 = u.pm * 256 + wr * 64 + fr, col0 = u.pn * 128 + wc * 32 + 8 * fq;
#pragma unroll
        for (int ai = 0; ai < 2; ++ai)
#pragma unroll
            for (int m = 0; m < 4; ++m) {
                bf16_t* rowp = O + (size_t)(row0 + ai * 128 + m * 16) * F + col0;
                float r[8];
#pragma unroll
                for (int n = 0; n < 2; ++n)
#pragma unroll
                    for (int j = 0; j < 4; ++j) { const float g = acc[ai][0][m][n][j], up = acc[ai][1][m][n][j]; r[n * 4 + j] = g * sigmoid_f(g) * up; }
                u32x4 w; w.x = cvtpk(r[0], r[1]); w.y = cvtpk(r[2], r[3]); w.z = cvtpk(r[4], r[5]); w.w = cvtpk(r[6], r[7]);
                *(u32x4*)rowp = w;
            }
    }
};
struct EpiResid {
    static constexpr bool PERM = false, AFTER_DRAIN = false;
    const float* resid; float* out; const float* gate; float coef;
    __device__ __forceinline__ void operator()(const f32x4 (&acc)[2][2][4][2], const pg8::Unit& u, int wr_, int wc_, int fr_, int fq_) const {
        const int t_ = opq(get_tid()), w_ = __builtin_amdgcn_readfirstlane(t_ >> 6), wr = w_ >> 2, wc = w_ & 3, fr = t_ & 15, fq = (t_ >> 4) & 3;
        const int row0 = u.pm * 256 + wr * 64 + fr, b = (u.pm * 256) >> 12, col0 = u.pn * 256 + wc * 32 + 4 * fq;
#pragma unroll
        for (int bj = 0; bj < 2; ++bj)
#pragma unroll
            for (int n = 0; n < 2; ++n) {
                const int c = col0 + bj * 128 + n * 16;
                const f32x4 gv = *(const f32x4*)(gate + (size_t)b * 9216 + c) * coef;
#pragma unroll
                for (int ai = 0; ai < 2; ++ai)
#pragma unroll
                    for (int m = 0; m < 4; ++m) {
                        const size_t off = (size_t)(row0 + ai * 128 + m * 16) * D + c;
                        const f32x4 o = *(const f32x4*)(resid + off) + gv * acc[ai][bj][m][n];
                        *(f32x4*)(out + off) = o;
                        if (m & 1) asm volatile("" ::: "memory");
                    }
            }
    }
};
struct EpiProj {
    static constexpr bool PERM = true, AFTER_DRAIN = false;
    bf16_t* PROJ; bf16_t* CQ; bf16_t* CKV; float* ssq_q; float* ssq_kv; unsigned* kn;
    __device__ __forceinline__ void operator()(const f32x4 (&acc)[2][2][4][2], const pg8::Unit& u, int wr_, int wc_, int fr_, int fq_) const {
        const int t_ = opq(get_tid()), w_ = __builtin_amdgcn_readfirstlane(t_ >> 6), wr = w_ >> 2, wc = w_ & 3, fr = t_ & 15, fq = (t_ >> 4) & 3;
        const int row0 = u.pm * 256 + wr * 64 + fr;
        const int kti = u.pn == 1 ? 0 : (u.pn == 7 ? 1 : (u.pn == 8 ? 2 : -1));
#pragma unroll
        for (int bj = 0; bj < 2; ++bj) {
            float gmax = 0.f;
            bf16_t* base; int ld, cb; float* ssq;
            if (u.pn == 3) { base = CQ; ld = 256; cb = bj * 128; ssq = ssq_q; }
            else if (u.pn == 4 && bj == 0) { base = CKV; ld = 128; cb = 0; ssq = ssq_kv; }
            else { base = PROJ; ld = DINP; cb = u.pn * 256 + bj * 128; ssq = nullptr; }
            const int col0 = cb + wc * 32 + 8 * fq;
#pragma unroll
            for (int ai = 0; ai < 2; ++ai)
#pragma unroll
                for (int m = 0; m < 4; ++m) {
                    const int row = row0 + ai * 128 + m * 16;
                    const f32x4 v0 = acc[ai][bj][m][0], v1 = acc[ai][bj][m][1];
                    u32x4 w; w.x = cvtpk(v0[0], v0[1]); w.y = cvtpk(v0[2], v0[3]); w.z = cvtpk(v1[0], v1[1]); w.w = cvtpk(v1[2], v1[3]);
                    *(u32x4*)(base + (size_t)row * ld + col0) = w;
                    if (ssq || kti >= 0) {
                        float s = (v0[0] * v0[0] + v0[1] * v0[1]) + (v0[2] * v0[2] + v0[3] * v0[3]) + (v1[0] * v1[0] + v1[1] * v1[1]) + (v1[2] * v1[2] + v1[3] * v1[3]);
                        s += __shfl_xor(s, 16); s += __shfl_xor(s, 32);
                        if (ssq) { if (fq == 0) atomicAdd(ssq + row, s); }
                        else gmax = fmaxf(gmax, s);
                    }
                    asm volatile("" ::: "memory");
                }
            if (kti >= 0) {
                gmax = fmaxf(gmax, __shfl_xor(gmax, 1)); gmax = fmaxf(gmax, __shfl_xor(gmax, 2)); gmax = fmaxf(gmax, __shfl_xor(gmax, 4)); gmax = fmaxf(gmax, __shfl_xor(gmax, 8));
                if (fr == 0 && fq == 0) atomicMax(kn + ((u.pm * 256) >> 12) * 24 + kti * 8 + bj * 4 + wc, __float_as_uint(gmax));
            }
        }
    }
};
struct EpiRowScale {
    static constexpr bool PERM = true, AFTER_DRAIN = false;
    bf16_t* O; int ldc; const float* ssq; float inv_n;
    __device__ __forceinline__ void operator()(const f32x4 (&acc)[2][2][4][2], const pg8::Unit& u, int wr_, int wc_, int fr_, int fq_) const {
        const int t_ = opq(get_tid()), w_ = __builtin_amdgcn_readfirstlane(t_ >> 6), wr = w_ >> 2, wc = w_ & 3, fr = t_ & 15, fq = (t_ >> 4) & 3;
        const int row0 = u.pm * 256 + wr * 64 + fr, col0 = u.pn * 256 + wc * 32 + 8 * fq;
#pragma unroll
        for (int ai = 0; ai < 2; ++ai)
#pragma unroll
            for (int m = 0; m < 4; ++m) {
                const int row = row0 + ai * 128 + m * 16;
                const float rs = rsqrtf(ssq[row] * inv_n + RMS_EPS);
#pragma unroll
                for (int bj = 0; bj < 2; ++bj) {
                    const f32x4 v0 = acc[ai][bj][m][0] * rs, v1 = acc[ai][bj][m][1] * rs;
                    u32x4 w; w.x = cvtpk(v0[0], v0[1]); w.y = cvtpk(v0[2], v0[3]); w.z = cvtpk(v1[0], v1[1]); w.w = cvtpk(v1[2], v1[3]);
                    *(u32x4*)(O + (size_t)row * ldc + col0 + bj * 128) = w;
                }
                asm volatile("" ::: "memory");
            }
    }
};

template <int MODE> __device__ __forceinline__ int wrow(int n) {
    if (MODE == 1) return n < F ? ((n >> 7) * 256 + (n & 127)) : (((n - F) >> 7) * 256 + 128 + ((n - F) & 127));
    return n;
}
template <int MODE>
__device__ __forceinline__ void cvt_item(const float* W, int K, int N, int NP, bf16_t* WT, const float* kscale, LAS float* scr, int item, int lane) {
    const int nblk = NP / 32, kb = item / nblk, nb = item % nblk, k0 = 64 * kb, n0 = 32 * nb;
    const int n_rd = n0 + (lane & 31);
#pragma unroll 8
    for (int i = 0; i < 32; ++i) {
        const int kk = 2 * i + (lane >> 5);
        float v = (n_rd < N) ? W[(size_t)(k0 + kk) * N + n_rd] : 0.f;
        if (kscale) v *= kscale[k0 + kk];
        scr[kk * 33 + (lane & 31)] = v;
    }
    asm volatile("s_waitcnt lgkmcnt(0)" ::: "memory");
    const int c = lane & 7;
#pragma unroll
    for (int j = 0; j < 4; ++j) {
        const int n = (lane >> 3) + 8 * j; const LAS float* s = scr + (8 * c) * 33 + n;
        u32x4 o; o.x = cvtpk(s[0 * 33], s[1 * 33]); o.y = cvtpk(s[2 * 33], s[3 * 33]); o.z = cvtpk(s[4 * 33], s[5 * 33]); o.w = cvtpk(s[6 * 33], s[7 * 33]);
        *(u32x4*)(WT + (size_t)wrow<MODE>(n0 + n) * K + k0 + 8 * c) = o;
    }
    asm volatile("s_waitcnt lgkmcnt(0)" ::: "memory");
}
__device__ __forceinline__ void convert_layer(const Args& A, int l, LAS unsigned char* lds) {
    const int tid = opq(get_tid()), lane = tid & 63, wid = __builtin_amdgcn_readfirstlane(tid >> 6), gw = blockIdx.x * NWAVE + wid, ngw = gridDim.x * NWAVE;
    LAS float* scr = (LAS float*)(lds + wid * 8704);
    unsigned char* wb = A.ws + WS_W;
    constexpr int I_A = 16 * 176, I_B = 44 * 32, I_IN = 16 * 80, I_OUT = 16 * 32, I_UQ = 4 * 24, I_UKV = 2 * 24, I_C1 = 32 * 4, I_C2 = 2 * 2;
    constexpr int NITEMS = 2 * I_A + 2 * I_B + I_IN + I_OUT + I_UQ + I_UKV + 2 * I_C1 + 2 * I_C2;
    for (int it = gw; it < NITEMS; it += ngw) {
        int r = it;
        if (r < I_A) { cvt_item<1>(A.in[7] + (size_t)l * D * F2, D, F2, F2, (bf16_t*)(wb + W_1A), nullptr, scr, r, lane); continue; } r -= I_A;
        if (r < I_A) { cvt_item<1>(A.in[9] + (size_t)l * D * F2, D, F2, F2, (bf16_t*)(wb + W_2A), nullptr, scr, r, lane); continue; } r -= I_A;
        if (r < I_B) { cvt_item<0>(A.in[8] + (size_t)l * F * D, F, D, D, (bf16_t*)(wb + W_1B), nullptr, scr, r, lane); continue; } r -= I_B;
        if (r < I_B) { cvt_item<0>(A.in[10] + (size_t)l * F * D, F, D, D, (bf16_t*)(wb + W_2B), nullptr, scr, r, lane); continue; } r -= I_B;
        if (r < I_IN) { cvt_item<0>(A.in[11] + (size_t)l * D * DIN, D, DIN, DINP, (bf16_t*)(wb + W_IN), nullptr, scr, r, lane); continue; } r -= I_IN;
        if (r < I_OUT) { cvt_item<0>(A.in[12] + (size_t)l * D * D, D, D, D, (bf16_t*)(wb + W_OUT), nullptr, scr, r, lane); continue; } r -= I_OUT;
        if (r < I_UQ) { cvt_item<0>(A.in[17] + (size_t)l * 256 * 576, 256, 576, 768, (bf16_t*)(wb + W_UQ), A.in[15] + l * 256, scr, r, lane); continue; } r -= I_UQ;
        if (r < I_UKV) { cvt_item<0>(A.in[18] + (size_t)l * 128 * 768, 128, 768, 768, (bf16_t*)(wb + W_UKV), A.in[16] + l * 128, scr, r, lane); continue; } r -= I_UKV;
        if (r < 2 * I_C1) { const int kv = r / I_C1; cvt_item<0>(A.in[20] + (size_t)(l * 2 + kv) * 2048 * 128, 2048, 128, 128, (bf16_t*)(wb + W_C1) + (size_t)kv * 128 * 2048, nullptr, scr, r % I_C1, lane); continue; } r -= 2 * I_C1;
        { const int kv = r / I_C2; cvt_item<0>(A.in[21] + (size_t)(l * 2 + kv) * 128 * 64, 128, 64, 64, (bf16_t*)(wb + W_C2) + (size_t)kv * 64 * 128, nullptr, scr, r % I_C2, lane); }
    }
}
__device__ __forceinline__ void mods_task(const Args& A, int task, LAS unsigned char* lds) {
    const int tid = opq(get_tid()), lane = tid & 63, wid = __builtin_amdgcn_readfirstlane(tid >> 6);
    const int l = task / 144, chunk = task % 144;
    LAS float* cond = (LAS float*)lds;
    LAS float* red = (LAS float*)(lds + 16384);
    __syncthreads();
    for (int i = tid; i < 4096; i += NTHR) { const float c = A.in[1][i]; cond[i] = c / (1.0f + expf(-c)); }
    __syncthreads();
    const float* W = A.in[2] + (size_t)l * D * 9216 + chunk * 64 + lane;
    float acc[4] = {0.f, 0.f, 0.f, 0.f};
#pragma unroll 16
    for (int kk = 0; kk < 128; ++kk) {
        const int k = wid * 128 + kk;
        const float w = W[(size_t)k * 9216];
#pragma unroll
        for (int b = 0; b < 4; ++b) acc[b] += cond[b * 1024 + k] * w;
    }
#pragma unroll
    for (int b = 0; b < 4; ++b) red[(wid * 4 + b) * 64 + lane] = acc[b];
    __syncthreads();
    if (tid < 256) {
        const int b = tid >> 6, col = tid & 63; float s = 0.f;
#pragma unroll
        for (int w = 0; w < 8; ++w) s += red[(w * 4 + b) * 64 + col];
        s += A.in[3][(size_t)l * 9216 + chunk * 64 + col];
        ((float*)(A.ws + WS_MODS))[(size_t)(l * 4 + b) * 9216 + chunk * 64 + col] = s;
    }
    __syncthreads();
}
__device__ __forceinline__ void posb_task(const Args& A, int task, LAS unsigned char* lds) {
    const int tid = opq(get_tid());
    const int lkv = task >> 4, kp = task & 15, hid = tid & 127, sub = tid >> 7;
    const float* pos = A.in[19] + (size_t)lkv * 2048 + kp * 128 + sub * 32; const float* w1 = A.in[20] + ((size_t)lkv * 2048 + kp * 128 + sub * 32) * 128 + hid;
    float s = 0.f;
#pragma unroll
    for (int k = 0; k < 32; ++k) s += pos[k] * w1[(size_t)k * 128];
    LAS float* red = (LAS float*)lds;
    __syncthreads();
    red[tid] = s;
    __syncthreads();
    if (tid < 128) ((float*)(A.ws + WS_POSB + 4096))[task * 128 + tid] = red[tid] + red[tid + 128] + red[tid + 256] + red[tid + 384];
    __syncthreads();
}
__device__ __forceinline__ void posb_final(const Args& A) {
    const int o = opq(get_tid());
    const float* part = (const float*)(A.ws + WS_POSB + 4096) + (size_t)(o >> 7) * 16 * 128 + (o & 127);
    float s = 0.f;
#pragma unroll
    for (int p = 0; p < 16; ++p) s += part[p * 128];
    ((float*)(A.ws + WS_POSB))[o] = s;
}
__device__ __forceinline__ void rope_entries(const Args& A) {
    const int gtid = blockIdx.x * NTHR + opq(get_tid()), gn = gridDim.x * NTHR;
    float* tab = (float*)(A.ws + WS_ROPE);
    for (int e = gtid; e < T * 16; e += gn) {
        const int t = e >> 4, i = e & 15;
        double inv = 1.0; for (int j = 0; j < i; ++j) inv *= 0.5623413251903491;
        const float ang = (float)t * (float)inv;
        const double rev = (double)ang * 0.15915494309189535; const double fr = rev - __builtin_rint(rev);
        tab[e] = __builtin_amdgcn_cosf((float)fr); tab[T * 16 + e] = __builtin_amdgcn_sinf((float)fr);
    }
}
__device__ __forceinline__ void norm_rows(const float* X, bf16_t* out, const float* g, const float* modl, int ish, int isc) {
    const int tid = opq(get_tid()), lane = tid & 63, wid = __builtin_amdgcn_readfirstlane(tid >> 6), gw = blockIdx.x * NWAVE + wid, ngw = gridDim.x * NWAVE;
#pragma unroll 1
    for (int b = 0; b < NB; ++b) {
        f32x4 gs[4], sh[4];
#pragma unroll
        for (int j = 0; j < 4; ++j) {
            const int col = 4 * lane + 256 * j;
            gs[j] = *(const f32x4*)(g + col) * (*(const f32x4*)(modl + (size_t)b * 9216 + isc * 1024 + col) + 1.0f);
            sh[j] = *(const f32x4*)(modl + (size_t)b * 9216 + ish * 1024 + col);
        }
        for (int row = b * T + gw; row < (b + 1) * T; row += ngw) {
            const f32x4* xr = (const f32x4*)(X + (size_t)row * D) + lane;
            f32x4 v[4]; float ss = 0.f;
#pragma unroll
            for (int j = 0; j < 4; ++j) { v[j] = xr[64 * j]; ss += (v[j].x * v[j].x + v[j].y * v[j].y) + (v[j].z * v[j].z + v[j].w * v[j].w); }
            const float rstd = rsqrtf(wave_sum(ss) * (1.0f / D) + RMS_EPS);
#pragma unroll
            for (int j = 0; j < 4; ++j) {
                const f32x4 y = (v[j] * rstd) * gs[j] + sh[j];
                u32x2 w; w.x = cvtpk(y.x, y.y); w.y = cvtpk(y.z, y.w);
                *(u32x2*)(out + (size_t)row * D + 4 * lane + 256 * j) = w;
            }
        }
    }
}
__device__ __forceinline__ void final_norm_rows(float* X, const float* g) {
    const int tid = opq(get_tid()), lane = tid & 63, wid = __builtin_amdgcn_readfirstlane(tid >> 6), gw = blockIdx.x * NWAVE + wid, ngw = gridDim.x * NWAVE;
    for (int row = gw; row < M; row += ngw) {
        f32x4* xr = (f32x4*)(X + (size_t)row * D) + lane;
        f32x4 v[4]; float ss = 0.f;
#pragma unroll
        for (int j = 0; j < 4; ++j) { v[j] = xr[64 * j]; ss += (v[j].x * v[j].x + v[j].y * v[j].y) + (v[j].z * v[j].z + v[j].w * v[j].w); }
        const float rstd = rsqrtf(wave_sum(ss) * (1.0f / D) + RMS_EPS);
#pragma unroll
        for (int j = 0; j < 4; ++j) { const f32x4 g4 = *(const f32x4*)(g + 4 * lane + 256 * j); xr[64 * j] = (v[j] * rstd) * g4; }
    }
}

__device__ __forceinline__ void norm_block(const float* X, bf16_t* out, const float* g, const float* modl, int ish, int isc, int row0) {
    const int tid = opq(get_tid()), lane = tid & 63, wid = __builtin_amdgcn_readfirstlane(tid >> 6);
    const int b = row0 >> 12;
#pragma unroll 1
    for (int rr = 0; rr < 8; ++rr) {
        const int row = row0 + rr * 8 + wid;
        const f32x4* xr = (const f32x4*)(X + (size_t)row * D) + lane;
        f32x4 v[4]; float ss = 0.f;
#pragma unroll
        for (int j = 0; j < 4; ++j) { v[j] = xr[64 * j]; ss += (v[j].x * v[j].x + v[j].y * v[j].y) + (v[j].z * v[j].z + v[j].w * v[j].w); }
        const float rstd = rsqrtf(wave_sum(ss) * (1.0f / D) + RMS_EPS);
#pragma unroll
        for (int j = 0; j < 4; ++j) {
            const int col = 4 * lane + 256 * j;
            const f32x4 g4 = *(const f32x4*)(g + col), sc = *(const f32x4*)(modl + (size_t)b * 9216 + isc * 1024 + col), sh = *(const f32x4*)(modl + (size_t)b * 9216 + ish * 1024 + col);
            const f32x4 y = (v[j] * rstd) * g4 * (sc + 1.0f) + sh;
            u32x2 w; w.x = cvtpk(y.x, y.y); w.y = cvtpk(y.z, y.w);
            *(u32x2*)(out + (size_t)row * D + col) = w;
        }
    }
}
__device__ __forceinline__ void final_norm_block(float* X, const float* g, int row0) {
    const int tid = opq(get_tid()), lane = tid & 63, wid = __builtin_amdgcn_readfirstlane(tid >> 6);
#pragma unroll 1
    for (int rr = 0; rr < 8; ++rr) {
        const int row = row0 + rr * 8 + wid;
        f32x4* xr = (f32x4*)(X + (size_t)row * D) + lane;
        f32x4 v[4]; float ss = 0.f;
#pragma unroll
        for (int j = 0; j < 4; ++j) { v[j] = xr[64 * j]; ss += (v[j].x * v[j].x + v[j].y * v[j].y) + (v[j].z * v[j].z + v[j].w * v[j].w); }
        const float rstd = rsqrtf(wave_sum(ss) * (1.0f / D) + RMS_EPS);
#pragma unroll
        for (int j = 0; j < 4; ++j) { const f32x4 g4 = *(const f32x4*)(g + 4 * lane + 256 * j); xr[64 * j] = (v[j] * rstd) * g4; }
    }
}
struct CountedOrder : pg8::StaticOrder {
    unsigned* cnt;
    __device__ __forceinline__ void done(const pg8::Unit& u) const {
        __builtin_amdgcn_fence(__ATOMIC_RELEASE, "agent");
        if ((get_tid() & 63) == 0) __hip_atomic_fetch_add(cnt + u.pm, 1u, __ATOMIC_RELAXED, __HIP_MEMORY_SCOPE_AGENT);
    }
};
__device__ __forceinline__ void panel_wait(unsigned* cnt, int pm) {
    if (get_tid() == 0) {
        unsigned sp = 0;
        while (__hip_atomic_load(cnt + pm, __ATOMIC_RELAXED, __HIP_MEMORY_SCOPE_AGENT) < 32u) { __builtin_amdgcn_s_sleep(2); if (++sp > (1u << 22)) break; }
    }
    __syncthreads();
    __builtin_amdgcn_fence(__ATOMIC_ACQUIRE, "agent");
}

__device__ __forceinline__ void kpe_unit(const Args& A, int unit) {
    const int tid = opq(get_tid());
    unsigned char* w_ = ws_opq(A.ws);
    const bf16_t* P = (const bf16_t*)(w_ + WS_U); bf16_t* KPE = (bf16_t*)(w_ + WS_KPE); const float* rope = (const float*)(w_ + WS_ROPE);
#pragma unroll 2
    for (int k = 0; k < 8; ++k) {
        const int e = unit * 4096 + k * 512 + tid;
        const int row = e >> 4, i = e & 15, t = row & (T - 1);
        const float x0 = bf2f((short)P[(size_t)row * DINP + C_BKR + i]), x1 = bf2f((short)P[(size_t)row * DINP + C_BKR + 16 + i]);
        const float c = rope[t * 16 + i], sn = rope[T * 16 + t * 16 + i];
        KPE[(size_t)row * 32 + i] = (bf16_t)(cvtpk(x0 * c - x1 * sn, 0.f) & 0xffffu);
        KPE[(size_t)row * 32 + 16 + i] = (bf16_t)(cvtpk(x1 * c + x0 * sn, 0.f) & 0xffffu);
    }
}

constexpr int CTL_KN = 128;
__device__ __forceinline__ void kn_rows(const Args& A, int l) {
    const int tid = opq(get_tid()), lane = tid & 63, wid = __builtin_amdgcn_readfirstlane(tid >> 6), gw = blockIdx.x * NWAVE + wid, ngw = gridDim.x * NWAVE;
    unsigned char* w_ = ws_opq(A.ws);
    const bf16_t* P = (const bf16_t*)(w_ + WS_U); unsigned* kn = (unsigned*)(w_ + WS_CTL) + CTL_KN + l * 48;
    const int col2 = lane < 32 ? C_KS + 4 * lane : C_KW + 4 * (lane - 32);
    for (int it = gw; it < M / 16; it += ngw) {
        float m1 = 0.f, m2 = 0.f;
#pragma unroll 4
        for (int rr = 0; rr < 16; ++rr) {
            const bf16_t* rp = P + (size_t)(it * 16 + rr) * DINP;
            const s16x4 v1 = *(const s16x4*)(rp + C_AK + 4 * lane), v2 = *(const s16x4*)(rp + col2);
            float s1 = 0.f, s2 = 0.f;
#pragma unroll
            for (int j = 0; j < 4; ++j) { const float x = bf2f(v1[j]), y = bf2f(v2[j]); s1 += x * x; s2 += y * y; }
            s1 += __shfl_xor(s1, 1); s1 += __shfl_xor(s1, 2); s1 += __shfl_xor(s1, 4);
            s2 += __shfl_xor(s2, 1); s2 += __shfl_xor(s2, 2); s2 += __shfl_xor(s2, 4); s2 += __shfl_xor(s2, 8);
            m1 = fmaxf(m1, s1); m2 = fmaxf(m2, s2);
        }
        const int b = (it * 16) >> 12;
        if ((lane & 7) == 0) atomicMax(kn + b * 12 + (lane >> 3), __float_as_uint(m1));
        if ((lane & 15) == 0) atomicMax(kn + b * 12 + (lane < 32 ? 10 + (lane >> 4) : 8 + ((lane - 32) >> 4)), __float_as_uint(m2));
    }
}
#define XB_TMO      128
#define XB_XCNT(j)  (256  + 64 * (j))
#define XB_XSUB(j)  (1280 + 64 * (j))
#define XB_XGEN(j)  (2304 + 64 * (j))
#define XB_TOP      3328
#define XB_TOPGEN   3392
#define XCD_BAR_WORDS 3456
#define XB_SPIN_CAP (1u << 18)

__device__ __forceinline__ unsigned xb_ld(unsigned* p)              { return __hip_atomic_load(p, __ATOMIC_RELAXED, __HIP_MEMORY_SCOPE_AGENT); }
__device__ __forceinline__ unsigned xb_add(unsigned* p, unsigned v) { return __hip_atomic_fetch_add(p, v, __ATOMIC_RELAXED, __HIP_MEMORY_SCOPE_AGENT); }
__device__ __forceinline__ unsigned xb_xcc_id() { return (unsigned)__builtin_amdgcn_s_getreg((3 << 11) | 20) & 0xFu; }
#define XB_SPIN(cond, bar) do { unsigned _sp = 0; while (cond) { __builtin_amdgcn_s_sleep(1); \
    if ((++_sp & 255u) == 0u) { if (xb_ld(&(bar)[XB_TMO])) break; if (_sp > XB_SPIN_CAP) { atomicAdd(&(bar)[XB_TMO], 1u); break; } } } } while (0)

struct XcdBarrier {
    unsigned* bar; unsigned x;
    volatile LAS unsigned* st;
};

__device__ __forceinline__ XcdBarrier xcd_barrier_post(unsigned* bar, volatile LAS unsigned* st) {
    XcdBarrier b; b.bar = bar; b.x = xb_xcc_id(); b.st = st;
    if (get_tid() == 0) (void)xb_add(&bar[XB_XCNT(b.x)], 1u);
    return b;
}
__device__ __forceinline__ void xcd_barrier_complete(unsigned* bar, unsigned x, unsigned& nloc, unsigned& nx) {
    const unsigned G = gridDim.x * gridDim.y * gridDim.z;
    unsigned sum, cnt, mine, sp = 0u;
    for (;;) {
        sum = 0u; cnt = 0u; mine = 0u;
#pragma unroll
        for (unsigned j = 0; j < 16; ++j) { const unsigned c = xb_ld(&bar[XB_XCNT(j)]); sum += c; cnt += (c > 0u) ? 1u : 0u; mine = (j == x) ? c : mine; }
        if (sum == G) break;
        __builtin_amdgcn_s_sleep(1);
        if ((++sp & 255u) == 0u) { if (xb_ld(&bar[XB_TMO])) break; if (sp > XB_SPIN_CAP) { atomicAdd(&bar[XB_TMO], 1u); break; } }
    }
    nloc = mine > 0u ? mine : 1u; nx = cnt > 0u ? cnt : 1u;
}

__device__ __forceinline__ void xcd_barrier(const XcdBarrier& b) {
    asm volatile("s_waitcnt vmcnt(0)" ::: "memory");
    __syncthreads();
    if (get_tid() == 0) {
        unsigned* bar = b.bar;
        __builtin_amdgcn_s_waitcnt(0);
        unsigned nloc = b.st[0], nx = b.st[1];
        if (nloc == 0u) { xcd_barrier_complete(bar, b.x, nloc, nx); b.st[0] = nloc; b.st[1] = nx; }
        const unsigned old = xb_add(&bar[XB_XSUB(b.x)], 1u);
        const unsigned gen = old / nloc;
        if (old + 1u == (gen + 1u) * nloc) {
            __builtin_amdgcn_fence(__ATOMIC_RELEASE, "agent");
            asm volatile("s_waitcnt vmcnt(0)" ::: "memory");
            const unsigned og = xb_add(&bar[XB_TOP], 1u);
            const unsigned tg = og / nx;
            if (og + 1u == (tg + 1u) * nx) xb_add(&bar[XB_TOPGEN], 1u);
            else XB_SPIN(xb_ld(&bar[XB_TOPGEN]) == tg, bar);
            __builtin_amdgcn_fence(__ATOMIC_ACQUIRE, "agent");
            xb_add(&bar[XB_XGEN(b.x)], 1u);
            asm volatile("s_waitcnt vmcnt(0)" ::: "memory");
        } else {
            XB_SPIN(xb_ld(&bar[XB_XGEN(b.x)]) == gen, bar);
            __builtin_amdgcn_fence(__ATOMIC_ACQUIRE, "agent");
            asm volatile("s_waitcnt vmcnt(0)" ::: "memory");
        }
    }
    __syncthreads();
}

struct AttnArgs {
    const bf16_t* Q; int qpitch;
    const bf16_t* K1; int k1pitch;
    const bf16_t* K2; int k2pitch;
    const bf16_t* V; int vpitch;
    const float* rope;
    const unsigned long long* sel;
    float scale2, slope2; int window;
    float kmax;
};
constexpr int ATT_K_OFF = 0, ATT_V_OFF = 16384, ATT_BUF = 24576;

__device__ __forceinline__ s16x4 vtr(const LAS unsigned char* p) {
    typedef short v4i16_t __attribute__((ext_vector_type(4)));
    return __builtin_bit_cast(s16x4, __builtin_amdgcn_ds_read_tr16_b64_v4i16((LAS v4i16_t*)p));
}
template <bool ROWSUM> __device__ __forceinline__ void pv_tile_t(f32x16 (&o)[2], f32x16& osum, const f32x16& p0, const f32x16& p1, const LAS unsigned char* vl, int lane) {
    const int h = lane >> 5, i16 = lane & 15, q4 = i16 >> 2, p4 = i16 & 3, blk = (lane >> 4) & 1;
    const unsigned onew = ((lane & 31) == 0) ? 0x3f803f80u : 0u;
    const bf16x8 ones = __builtin_bit_cast(bf16x8, (u32x4){onew, onew, onew, onew});
    const LAS unsigned char* vb = vl + (4 * h + q4) * 64 + blk * 32 + p4 * 8;
#pragma unroll
    for (int s = 0; s < 4; ++s) {
        u32x4 pw;
        if (s == 0) { pw.x = cvtpk(p0[0], p0[1]); pw.y = cvtpk(p0[2], p0[3]); pw.z = cvtpk(p0[4], p0[5]); pw.w = cvtpk(p0[6], p0[7]); }
        else if (s == 1) { pw.x = cvtpk(p0[8], p0[9]); pw.y = cvtpk(p0[10], p0[11]); pw.z = cvtpk(p0[12], p0[13]); pw.w = cvtpk(p0[14], p0[15]); }
        else if (s == 2) { pw.x = cvtpk(p1[0], p1[1]); pw.y = cvtpk(p1[2], p1[3]); pw.z = cvtpk(p1[4], p1[5]); pw.w = cvtpk(p1[6], p1[7]); }
        else { pw.x = cvtpk(p1[8], p1[9]); pw.y = cvtpk(p1[10], p1[11]); pw.z = cvtpk(p1[12], p1[13]); pw.w = cvtpk(p1[14], p1[15]); }
        const bf16x8 pf = __builtin_bit_cast(bf16x8, pw);
#pragma unroll
        for (int db = 0; db < 2; ++db) {
            const s16x4 lo = vtr(vb + db * 4096 + (16 * s) * 64), hi = vtr(vb + db * 4096 + (16 * s + 8) * 64);
            const bf16x8 vf = __builtin_shufflevector(lo, hi, 0, 1, 2, 3, 4, 5, 6, 7);
            o[db] = MFMA32(vf, pf, o[db]);
        }
        if (ROWSUM) osum = MFMA32(ones, pf, osum);
    }
}
__device__ __forceinline__ void pv_tile(f32x16 (&o)[2], const f32x16& p0, const f32x16& p1, const LAS unsigned char* vl, int lane) {
    f32x16 dummy; pv_tile_t<false>(o, dummy, p0, p1, vl, lane);
}
template <int MODE> __device__ __forceinline__ void store_o(const f32x16 (&o)[2], bf16_t* out_row, int h, float sc) {
#pragma unroll
    for (int db = 0; db < 2; ++db)
#pragma unroll
        for (int g4 = 0; g4 < 4; ++g4) {
            bf16_t* p = out_row + 32 * db + 8 * g4 + 4 * h;
            float v0 = o[db][4 * g4] * sc, v1 = o[db][4 * g4 + 1] * sc, v2 = o[db][4 * g4 + 2] * sc, v3 = o[db][4 * g4 + 3] * sc;
            if (MODE == 1) { const u32x2 old = *(const u32x2*)p; v0 += __uint_as_float(old.x << 16); v1 += __uint_as_float(old.x & 0xffff0000u); v2 += __uint_as_float(old.y << 16); v3 += __uint_as_float(old.y & 0xffff0000u); }
            u32x2 w; w.x = cvtpk(v0, v1); w.y = cvtpk(v2, v3);
            *(u32x2*)p = w;
        }
}

constexpr int ATT_FLAG_OFF = 140480;
template <int DQK, bool ROPE, bool SEL, bool DUAL = false, bool EARLY = false>
__device__ __forceinline__ void attn_core(const AttnArgs& a, int q0, LAS unsigned char* lds, f32x16 (&o)[2]) {
    constexpr int KS = DQK / 16, DK = DUAL ? 2 * DQK : DQK, KP = DK * 2 + 16, D1 = DK < 64 ? DK : 64, NCH1 = D1 / 8, QROWS = DUAL ? 128 : 256;
    const int tid = opq(get_tid()), lane = tid & 63, wid = __builtin_amdgcn_readfirstlane(tid >> 6), r = lane & 31, h = lane >> 5;
    const int wq = DUAL ? (wid & 3) : wid, coff = DUAL ? (wid >> 2) * DQK : 0;
    const int qw0 = q0 + 32 * wq, qpos = qw0 + r;
    LAS unsigned char* Kl = lds + ATT_K_OFF; LAS unsigned char* Vl = lds + ATT_V_OFF;
    bf16x8 qf[KS];
    {
        const bf16_t* qrow = a.Q + (size_t)qpos * a.qpitch + coff;
#pragma unroll
        for (int ks = 0; ks < KS; ++ks) qf[ks] = *(const bf16x8*)(qrow + 16 * ks + 8 * h);
        if (ROPE) {
            const float* cs = a.rope + (size_t)qpos * 16 + 8 * h; const float* sn = cs + T * 16;
            float y0[8], y1[8];
#pragma unroll
            for (int j = 0; j < 8; ++j) { const float x0 = bf2f(qf[KS - 2][j]), x1 = bf2f(qf[KS - 1][j]), c = cs[j], s = sn[j]; y0[j] = x0 * c - x1 * s; y1[j] = x1 * c + x0 * s; }
            u32x4 w0, w1;
            w0.x = cvtpk(y0[0], y0[1]); w0.y = cvtpk(y0[2], y0[3]); w0.z = cvtpk(y0[4], y0[5]); w0.w = cvtpk(y0[6], y0[7]);
            w1.x = cvtpk(y1[0], y1[1]); w1.y = cvtpk(y1[2], y1[3]); w1.z = cvtpk(y1[4], y1[5]); w1.w = cvtpk(y1[6], y1[7]);
            qf[KS - 2] = __builtin_bit_cast(bf16x8, w0); qf[KS - 1] = __builtin_bit_cast(bf16x8, w1);
        }
    }
    float qk_bound = 0.f;
    if (EARLY) {
        float qq = 0.f;
#pragma unroll
        for (int ks = 0; ks < KS; ++ks)
#pragma unroll
            for (int j = 0; j < 8; ++j) { const float x = bf2f(qf[ks][j]); qq += x * x; }
        qq += __shfl_xor(qq, 32);
        qk_bound = sqrtf(qq) * a.kmax * a.scale2 * 1.01f + 0.01f;
    }
    unsigned long long selm = ~0ull;
    if (SEL) selm = a.sel[qpos];
    const int t_hi = (q0 + QROWS - 1) >> 6;
    int t_lo = 0;
    if (a.window) { const int lo = q0 - a.window + 1; t_lo = lo > 0 ? (lo >> 6) : 0; }
    const bool kA_on = tid < 64 * NCH1; const int rowA = tid / NCH1, chA = tid % NCH1;
    const bool kB_on = ROPE && tid < 128; const int rowB = tid >> 1, prB = tid & 1;
    const int rowV = tid >> 3, chV = tid & 7;
    u32x4 kA = {0, 0, 0, 0}, kB0 = {0, 0, 0, 0}, kB1 = {0, 0, 0, 0}, vR = {0, 0, 0, 0};
#define ATT_PREFETCH(t) do { \
        if (kA_on) kA = *(const u32x4*)(a.K1 + (size_t)(64 * (t) + rowA) * a.k1pitch + chA * 8); \
        if (kB_on) { const bf16_t* kp = a.K2 + (size_t)(64 * (t) + rowB) * a.k2pitch + prB * 8; kB0 = *(const u32x4*)kp; kB1 = *(const u32x4*)(kp + 16); } \
        vR = *(const u32x4*)(a.V + (size_t)(64 * (t) + rowV) * a.vpitch + chV * 8); } while (0)
#define ATT_STORE(tt, KL, VL) do { \
        if (kA_on) *(LAS u32x4*)((KL) + rowA * KP + chA * 16) = kA; \
        if (ROPE) { if (kB_on) { \
                *(LAS u32x4*)((KL) + rowB * KP + (64 + prB * 8) * 2) = kB0; \
                *(LAS u32x4*)((KL) + rowB * KP + (80 + prB * 8) * 2) = kB1; } } \
        *(LAS u32x4*)((VL) + (chV >> 2) * 4096 + rowV * 64 + (chV & 3) * 16) = vR; } while (0)
    float m = NEGBIG;
    f32x16 osum;
#pragma unroll
    for (int i = 0; i < 16; ++i) { o[0][i] = 0.f; o[1][i] = 0.f; osum[i] = 0.f; }
    float cbv[16];
#pragma unroll
    for (int i = 0; i < 16; ++i) cbv[i] = a.slope2 * (float)((i & 3) + 8 * (i >> 2) + 4 * h);
    volatile LAS unsigned* eflag = (volatile LAS unsigned*)(lds + ATT_FLAG_OFF);
    unsigned long long um = (t_hi >= 63 ? ~0ull : ((1ull << (t_hi + 1)) - 1ull)) & ~((1ull << t_lo) - 1ull);
    if (SEL) {
        LAS unsigned* uw = (LAS unsigned*)(lds + ATT_FLAG_OFF + 64);
        __syncthreads();
        if (tid < 2) uw[tid] = 0u;
        __syncthreads();
        __hip_atomic_fetch_or(uw, (unsigned)selm, __ATOMIC_RELAXED, __HIP_MEMORY_SCOPE_WORKGROUP);
        __hip_atomic_fetch_or(uw + 1, (unsigned)(selm >> 32), __ATOMIC_RELAXED, __HIP_MEMORY_SCOPE_WORKGROUP);
        __syncthreads();
        const unsigned lo_ = (unsigned)__builtin_amdgcn_readfirstlane((int)uw[0]), hi_ = (unsigned)__builtin_amdgcn_readfirstlane((int)uw[1]);
        um &= ((unsigned long long)hi_ << 32) | (unsigned long long)lo_;
    }
#define ATT_NEXT(tt) ((((tt) > 0) && (um & ((1ull << (tt)) - 1ull))) ? 63 - __builtin_clzll(um & ((1ull << (tt)) - 1ull)) : -1)
    int t = 63 - __builtin_clzll(um);
    int t1 = ATT_NEXT(t);
    ATT_PREFETCH(t);
    if (EARLY) { if (lane == 0) { eflag[wid] = 0u; eflag[8 + wid] = 0u; } }
    __syncthreads();
    ATT_STORE(t, Kl, Vl);
    __syncthreads();
    if (t1 >= 0) ATT_PREFETCH(t1);
    for (int step = 0; t >= 0; ++step) {
        const int cur = step & 1;
        const int t2 = (t1 >= 0) ? ATT_NEXT(t1) : -1;
        const LAS unsigned char* Kc = Kl + cur * ATT_BUF; const LAS unsigned char* Vc = Vl + cur * ATT_BUF;
        bool need = (64 * t <= qw0 + 31);
        if (a.window) need = need && (64 * t + 63 >= qw0 - a.window + 1);
        const bool selbit = SEL ? (((selm >> t) & 1ull) != 0ull) : true;
        if (SEL) need = need && (__ballot(selbit) != 0ull);
        if (need) {
            f32x16 p0, p1;
#pragma unroll
            for (int i = 0; i < 16; ++i) { p0[i] = 0.f; p1[i] = 0.f; }
#pragma unroll
            for (int ks = 0; ks < KS; ++ks) {
                const bf16x8 a0 = *(const LAS bf16x8*)(Kc + r * KP + coff * 2 + ks * 32 + h * 16);
                const bf16x8 a1 = *(const LAS bf16x8*)(Kc + (32 + r) * KP + coff * 2 + ks * 32 + h * 16);
                p0 = MFMA32(a0, qf[ks], p0); p1 = MFMA32(a1, qf[ks], p1);
            }
            if (!ROPE) {
#pragma unroll
                for (int i = 0; i < 16; ++i) { p0[i] = p0[i] * a.scale2 + cbv[i]; p1[i] = p1[i] * a.scale2 + cbv[i]; }
            }
            const float base0 = a.slope2 * (float)(64 * t - qpos), base1 = base0 + 32.0f * a.slope2;
            bool bnd = (64 * t + 63 > qw0);
            if (a.window) bnd = bnd || (64 * t < qw0 + 31 - a.window + 1);
            if (SEL) bnd = bnd || (__ballot(!selbit) != 0ull);
            if (bnd) {
                const int wlim = a.window ? a.window : (1 << 30);
#pragma unroll
                for (int i = 0; i < 16; ++i) {
                    const int kv0 = 64 * t + crow(i, h), d0 = qpos - kv0, d1 = d0 - 32;
                    const bool ok0 = selbit && d0 >= 0 && d0 < wlim, ok1 = selbit && d1 >= 0 && d1 < wlim;
                    p0[i] = ok0 ? p0[i] : NEGBIG; p1[i] = ok1 ? p1[i] : NEGBIG;
                }
            }
            float mx0 = p0[0], mx1 = p1[0];
#pragma unroll
            for (int i = 1; i < 16; ++i) { mx0 = fmaxf(mx0, p0[i]); mx1 = fmaxf(mx1, p1[i]); }
            float mloc = ROPE ? fmaxf(mx0, mx1) * a.scale2 : fmaxf(mx0 + base0, mx1 + base1);
            mloc = fmaxf(mloc, __shfl_xor(mloc, 32));
            const float mnew = fmaxf(m, mloc);
            if (__ballot(mnew > m) != 0ull) {
                const float alpha = fast_exp2(m - mnew);
                osum[0] *= alpha;
#pragma unroll
                for (int i = 0; i < 16; ++i) { o[0][i] *= alpha; o[1][i] *= alpha; }
            }
            m = mnew;
            const float r0 = mnew - base0, r1 = mnew - base1;
            if (ROPE) {
#pragma unroll
                for (int i = 0; i < 16; ++i) { p0[i] = fast_exp2(p0[i] * a.scale2 - mnew); p1[i] = fast_exp2(p1[i] * a.scale2 - mnew); }
            } else {
#pragma unroll
                for (int i = 0; i < 16; ++i) { p0[i] = fast_exp2(p0[i] - r0); p1[i] = fast_exp2(p1[i] - r1); }
            }
            pv_tile_t<true>(o, osum, p0, p1, Vc, lane);
        }
        if (EARLY) {
            const bool live = !(qk_bound - a.slope2 * (float)(qpos - 64 * t + 1) - m < -64.0f);
            const bool wdone = (__ballot(live) == 0ull);
            if (lane == 0) eflag[8 * cur + wid] = wdone ? 1u : 0u;
        }
        if (t1 >= 0) ATT_STORE(t1, Kl + (cur ^ 1) * ATT_BUF, Vl + (cur ^ 1) * ATT_BUF);
        __syncthreads();
        if (EARLY) {
            const unsigned alld = eflag[8 * cur] & eflag[8 * cur + 1] & eflag[8 * cur + 2] & eflag[8 * cur + 3] & eflag[8 * cur + 4] & eflag[8 * cur + 5] & eflag[8 * cur + 6] & eflag[8 * cur + 7];
            if (__builtin_amdgcn_readfirstlane((int)alld) != 0) break;
        }
        if (t2 >= 0) ATT_PREFETCH(t2);
        t = t1; t1 = t2;
    }
#undef ATT_NEXT
#undef ATT_STORE
#undef ATT_PREFETCH
    const float lt = __shfl(osum[0], lane & 31);
    const float inv = 1.0f / lt;
#pragma unroll
    for (int i = 0; i < 16; ++i) { o[0][i] *= inv; o[1][i] *= inv; }
}

__device__ __forceinline__ float da_slope(int hd) { return hd == 0 ? 0.25f : hd == 1 ? 0.0625f : hd == 2 ? 0.015625f : 0.00390625f; }
__device__ __forceinline__ float nsa_slope(int hh) { return hh == 0 ? 0.25f : hh == 1 ? 0.0625f : hh == 2 ? 0.015625f : hh == 3 ? 0.00390625f : hh == 4 ? 0.5f : 0.125f; }

constexpr int DA_X_OFF = 49152;
__device__ __forceinline__ void da_unit(const Args& A, int l, int b, int hd, int qb, LAS unsigned char* lds) {
    const int tid_ = opq(get_tid()), lane = tid_ & 63, wid = __builtin_amdgcn_readfirstlane(tid_ >> 6), r = lane & 31, h = lane >> 5;
    const bf16_t* P = (const bf16_t*)(A.ws + WS_U) + (size_t)b * T * DINP;
    const float lam = ((const float*)(A.ws + WS_CTL))[64 + l];
    const float one_m_li = ((const float*)(A.ws + WS_CTL))[66 + l];
    f32x16 o[2];
    AttnArgs a; a.Q = P + C_AQ + hd * 64; a.qpitch = DINP; a.K1 = P + C_AK + hd * 64; a.k1pitch = DINP; a.K2 = nullptr; a.k2pitch = 0;
    a.V = P + C_AV + hd * 64; a.vpitch = DINP; a.rope = nullptr; a.sel = nullptr; a.scale2 = 0.17677669529663687f * LOG2E; a.slope2 = da_slope(hd) * LOG2E; a.window = 0;
    { const unsigned* kn = (const unsigned*)(A.ws + WS_CTL) + CTL_KN + l * 96 + b * 24 + 2 * hd; a.kmax = sqrtf(fmaxf(__uint_as_float(kn[0]), __uint_as_float(kn[1]))); }
    attn_core<32, false, false, true, true>(a, qb * 128, lds, o);
    LAS float* xb = (LAS float*)(lds + DA_X_OFF) + (32 * (wid & 3) + r) * 65;
    if (wid >= 4) {
#pragma unroll
        for (int db = 0; db < 2; ++db)
#pragma unroll
            for (int i = 0; i < 16; ++i) xb[32 * db + crow(i, h)] = o[db][i];
    }
    __syncthreads();
    if (wid < 4) {
        float ss = 0.f;
#pragma unroll
        for (int db = 0; db < 2; ++db)
#pragma unroll
            for (int i = 0; i < 16; ++i) { o[db][i] = o[db][i] - lam * xb[32 * db + crow(i, h)]; ss += o[db][i] * o[db][i]; }
        ss += __shfl_xor(ss, 32);
        const float rs = rsqrtf(ss * (1.0f / 64.0f) + RMS_EPS) * one_m_li;
        const float* sg = A.in[14] + l * 64;
#pragma unroll
        for (int db = 0; db < 2; ++db)
#pragma unroll
            for (int i = 0; i < 16; ++i) o[db][i] *= rs * sg[32 * db + crow(i, h)];
        bf16_t* orow = (bf16_t*)(A.ws + WS_XN) + (size_t)(b * T + qb * 128 + 32 * wid + r) * D + hd * 64;
        store_o<0>(o, orow, h, EN_DA ? 1.0f : 0.0f);
    }
}
__device__ __forceinline__ void mla_unit(const Args& A, int b, int hd, int qb, LAS unsigned char* lds) {
    const int tid_ = opq(get_tid()), lane = tid_ & 63, wid = __builtin_amdgcn_readfirstlane(tid_ >> 6), r = lane & 31, h = lane >> 5;
    AttnArgs a; a.Q = (const bf16_t*)(A.ws + WS_MQ) + (size_t)b * T * 768 + hd * 96; a.qpitch = 768;
    a.K1 = (const bf16_t*)(A.ws + WS_MKV) + (size_t)b * T * 768 + hd * 128; a.k1pitch = 768;
    a.K2 = (const bf16_t*)(A.ws + WS_KPE) + (size_t)b * T * 32; a.k2pitch = 32;
    a.V = a.K1 + 64; a.vpitch = 768; a.rope = (const float*)(A.ws + WS_ROPE); a.sel = nullptr; a.scale2 = 0.10206207261596575f * LOG2E; a.slope2 = 0.f; a.window = 0; a.kmax = 0.f;
    f32x16 o[2];
    attn_core<96, true, false>(a, qb * 256, lds, o);
    bf16_t* orow = (bf16_t*)(A.ws + WS_XN) + (size_t)(b * T + qb * 256 + 32 * wid + r) * D + 256 + hd * 64;
    store_o<0>(o, orow, h, EN_MLA ? 1.0f : 0.0f);
}
template <int BR> __device__ __forceinline__ void nsa_unit(const Args& A, int l, int b, int hh, int qb, LAS unsigned char* lds) {
    const int tid_ = opq(get_tid()), lane = tid_ & 63, wid = __builtin_amdgcn_readfirstlane(tid_ >> 6), r = lane & 31, h = lane >> 5, g = hh / 3;
    const bf16_t* P = (const bf16_t*)(A.ws + WS_U) + (size_t)b * T * DINP;
    AttnArgs a; a.Q = P + C_CQ + hh * 64; a.qpitch = DINP; a.K1 = P + (BR == 2 ? C_KW : C_KS) + g * 64; a.k1pitch = DINP; a.K2 = nullptr; a.k2pitch = 0;
    a.V = P + (BR == 2 ? C_VW : C_VS) + g * 64; a.vpitch = DINP; a.rope = nullptr; a.sel = (const unsigned long long*)(A.ws + WS_SEL) + (size_t)(b * 2 + g) * T;
    a.scale2 = 0.125f * LOG2E; a.slope2 = nsa_slope(hh) * LOG2E; a.window = (BR == 2) ? 512 : 0;
    f32x16 o[2];
    { const unsigned* kn = (const unsigned*)(A.ws + WS_CTL) + CTL_KN + l * 96 + b * 24 + (BR == 2 ? 16 : 8) + 1 + 2 * g; a.kmax = sqrtf(__uint_as_float(kn[0]) + __uint_as_float(kn[1])); }
    attn_core<64, false, BR == 1, false, true>(a, qb * 256, lds, o);
    const int qpos = qb * 256 + 32 * wid + r;
    const float gl = bf2f((short)P[(size_t)qpos * DINP + C_G + BR * 6 + hh]);
    bf16_t* orow = (bf16_t*)(A.ws + WS_XN) + (size_t)(b * T + qpos) * D + 640 + hh * 64;
    if (BR == 2) store_o<0>(o, orow, h, EN_WIN ? sigmoid_f(gl) : 0.0f);
    else store_o<1>(o, orow, h, EN_SLC ? sigmoid_f(gl) : 0.0f);
}

__device__ __forceinline__ void cmp_mlp_task(const Args& A, int l, int wt, LAS unsigned char* lds) {
    const int tid_ = opq(get_tid()), lane = tid_ & 63, wid = __builtin_amdgcn_readfirstlane(tid_ >> 6);
    const int kv = wt >> 7, bg = (wt >> 4) & 7, rg = wt & 15, b = bg >> 1, g = bg & 1, i16 = lane & 15, quad = lane >> 4;
    const bf16_t* P = (const bf16_t*)(A.ws + WS_U) + (size_t)b * T * DINP + (kv ? C_VC : C_KC) + g * 64;
    const bf16_t* W1 = (const bf16_t*)(A.ws + WS_W + W_C1) + (size_t)kv * 128 * 2048;
    const bf16_t* W2 = (const bf16_t*)(A.ws + WS_W + W_C2) + (size_t)kv * 64 * 128;
    const float* posb = (const float*)(A.ws + WS_POSB) + (l * 2 + kv) * 128;
    const int n = 16 * rg + i16;
    const bf16_t* arow = P + (size_t)(16 * n) * DINP + 8 * quad;
    const bf16_t* wrow1 = W1 + (size_t)i16 * 2048 + 8 * quad;
    f32x4 acc[8];
#pragma unroll
    for (int i = 0; i < 8; ++i) acc[i] = (f32x4){0.f, 0.f, 0.f, 0.f};
#pragma unroll 2
    for (int kk = 0; kk < 8; ++kk) {
        const int ks = 8 * wid + kk;
        const bf16x8 bfrag = *(const bf16x8*)(arow + (size_t)(ks >> 1) * DINP + 32 * (ks & 1));
#pragma unroll
        for (int ht = 0; ht < 8; ++ht) {
            const bf16x8 afrag = *(const bf16x8*)(wrow1 + (size_t)(16 * ht) * 2048 + 32 * ks);
            acc[ht] = MFMA16(afrag, bfrag, acc[ht]);
        }
    }
    {
        LAS float* red = (LAS float*)lds;
        if (wid > 0) {
#pragma unroll
            for (int ht = 0; ht < 8; ++ht)
#pragma unroll
                for (int j = 0; j < 4; ++j) red[(wid * 64 + lane) * 33 + ht * 4 + j] = acc[ht][j];
        }
        __syncthreads();
        if (wid > 0) return;
#pragma unroll 1
        for (int w = 1; w < 8; ++w)
#pragma unroll
            for (int ht = 0; ht < 8; ++ht)
#pragma unroll
                for (int j = 0; j < 4; ++j) acc[ht][j] += red[(w * 64 + lane) * 33 + ht * 4 + j];
    }
    bf16x8 hf[4];
#pragma unroll
    for (int ks2 = 0; ks2 < 4; ++ks2) {
        float v[8];
#pragma unroll
        for (int e = 0; e < 8; ++e) {
            const int ht = 2 * ks2 + (e >> 2), j = e & 3;
            const float x = acc[ht][j] + posb[16 * ht + 4 * quad + j];
            const float u2 = 0.7978845608028654f * (x + 0.044715f * x * x * x);
            const float ex = fast_exp2(2.0f * LOG2E * u2);
            const float th = 1.0f - 2.0f * fast_rcp(ex + 1.0f);
            v[e] = 0.5f * x * (1.0f + th);
        }
        u32x4 w; w.x = cvtpk(v[0], v[1]); w.y = cvtpk(v[2], v[3]); w.z = cvtpk(v[4], v[5]); w.w = cvtpk(v[6], v[7]);
        hf[ks2] = __builtin_bit_cast(bf16x8, w);
    }
    bf16_t* outp = (bf16_t*)(A.ws + WS_KCMP) + ((size_t)(kv * 8 + bg) * 256 + n) * 64;
#pragma unroll
    for (int ot = 0; ot < 4; ++ot) {
        f32x4 c2 = (f32x4){0.f, 0.f, 0.f, 0.f};
        const bf16_t* w2r = W2 + (size_t)(16 * ot + i16) * 128 + 4 * quad;
#pragma unroll
        for (int ks2 = 0; ks2 < 4; ++ks2) {
            const u32x2 lo = *(const u32x2*)(w2r + 32 * ks2), hi = *(const u32x2*)(w2r + 32 * ks2 + 16);
            u32x4 w; w.x = lo.x; w.y = lo.y; w.z = hi.x; w.w = hi.y;
            c2 = MFMA16(__builtin_bit_cast(bf16x8, w), hf[ks2], c2);
        }
        if (n < 255) { u32x2 w; w.x = cvtpk(c2[0], c2[1]); w.y = cvtpk(c2[2], c2[3]); *(u32x2*)(outp + 16 * ot + 4 * quad) = w; }
    }
}

constexpr int CMP_K_OFF = 0, CMP_V_OFF = 36864, CMP_IMP_OFF = 69632;
__device__ __forceinline__ void cmp_unit(const Args& A, int b, int g, int qb, LAS unsigned char* lds, float gmul = 1.0f) {
    const int tid = opq(get_tid()), lane = tid & 63, wid = __builtin_amdgcn_readfirstlane(tid >> 6), r = lane & 31, h = lane >> 5;
    const int q0 = qb * 256, qw0 = q0 + 32 * wid, qpos = qw0 + r, qloc = 32 * wid + r;
    const int ntile = (((q0 + 224) >> 4) >> 6) + 1;
    LAS unsigned char* Kl = lds + CMP_K_OFF; LAS unsigned char* Vl = lds + CMP_V_OFF; LAS float* imp = (LAS float*)(lds + CMP_IMP_OFF);
    const bf16_t* KC = (const bf16_t*)(A.ws + WS_KCMP) + (size_t)(b * 2 + g) * 256 * 64;
    const bf16_t* VC = KC + (size_t)8 * 256 * 64;
    __syncthreads();
    for (int idx = tid; idx < 512 * ntile; idx += NTHR) {
        const int n = idx >> 3, ch = idx & 7;
        u32x4 kx = {0, 0, 0, 0}, vx = {0, 0, 0, 0};
        if (n < 255) { kx = *(const u32x4*)(KC + (size_t)n * 64 + ch * 8); vx = *(const u32x4*)(VC + (size_t)n * 64 + ch * 8); }
        *(LAS u32x4*)(Kl + n * 144 + ch * 16) = kx;
        *(LAS u32x4*)(Vl + (n >> 6) * 8192 + (ch >> 2) * 4096 + (n & 63) * 64 + (ch & 3) * 16) = vx;
    }
    for (int idx = tid; idx < 256 * 65; idx += NTHR) imp[idx] = 0.f;
    __syncthreads();
    const bf16_t* P = (const bf16_t*)(A.ws + WS_U) + (size_t)b * T * DINP;
    const float scale2 = 0.125f * LOG2E;
#pragma unroll 1
    for (int rr = 0; rr < 3; ++rr) {
        const int hh = 3 * g + rr; const float slope2 = nsa_slope(hh) * LOG2E;
        bf16x8 qf[4];
        { const bf16_t* qrow = P + (size_t)qpos * DINP + C_CQ + hh * 64;
#pragma unroll
          for (int ks = 0; ks < 4; ++ks) qf[ks] = *(const bf16x8*)(qrow + 16 * ks + 8 * h); }
        float m = NEGBIG, lsum = 0.f, invl = 0.f;
        f32x16 o[2];
#pragma unroll
        for (int i = 0; i < 16; ++i) { o[0][i] = 0.f; o[1][i] = 0.f; }
#pragma unroll 1
        for (int pass = 0; pass < 2; ++pass) {
#pragma unroll 1
            for (int tt = 0; tt < ntile; ++tt) {
                if (16 * (64 * tt) + 31 > qw0 + 31) continue;
                f32x16 p0, p1;
#pragma unroll
                for (int i = 0; i < 16; ++i) { p0[i] = 0.f; p1[i] = 0.f; }
#pragma unroll
                for (int ks = 0; ks < 4; ++ks) {
                    const bf16x8 a0 = *(const LAS bf16x8*)(Kl + (64 * tt + r) * 144 + ks * 32 + h * 16);
                    const bf16x8 a1 = *(const LAS bf16x8*)(Kl + (64 * tt + 32 + r) * 144 + ks * 32 + h * 16);
                    p0 = MFMA32(a0, qf[ks], p0); p1 = MFMA32(a1, qf[ks], p1);
                }
#pragma unroll
                for (int i = 0; i < 16; ++i) {
                    const int n0 = 64 * tt + crow(i, h), d0 = qpos - (16 * n0 + 31), d1 = d0 - 512;
                    p0[i] = d0 >= 0 ? p0[i] * scale2 - slope2 * (float)d0 : NEGBIG;
                    p1[i] = d1 >= 0 ? p1[i] * scale2 - slope2 * (float)d1 : NEGBIG;
                }
                if (pass == 0) {
                    float mloc = fmaxf(p0[0], p1[0]);
#pragma unroll
                    for (int i = 1; i < 16; ++i) mloc = fmaxf(mloc, fmaxf(p0[i], p1[i]));
                    mloc = fmaxf(mloc, __shfl_xor(mloc, 32));
                    const float mnew = fmaxf(m, mloc), alpha = fast_exp2(m - mnew);
                    m = mnew;
                    float ls = 0.f;
#pragma unroll
                    for (int i = 0; i < 16; ++i) ls += fast_exp2(p0[i] - mnew) + fast_exp2(p1[i] - mnew);
                    lsum = lsum * alpha + ls;
                } else {
#pragma unroll
                    for (int i = 0; i < 16; ++i) {
                        p0[i] = p0[i] > -1e29f ? fast_exp2(p0[i] - m) * invl : 0.f;
                        p1[i] = p1[i] > -1e29f ? fast_exp2(p1[i] - m) * invl : 0.f;
                    }
                    pv_tile(o, p0, p1, Vl + tt * 8192, lane);
#pragma unroll
                    for (int blk = 0; blk < 2; ++blk)
#pragma unroll
                        for (int g4 = 0; g4 < 4; ++g4) {
                            const int j = 16 * tt + 8 * blk + 2 * g4 + h;
                            const float G = blk == 0 ? (p0[4 * g4] + p0[4 * g4 + 1]) + (p0[4 * g4 + 2] + p0[4 * g4 + 3]) : (p1[4 * g4] + p1[4 * g4 + 1]) + (p1[4 * g4 + 2] + p1[4 * g4 + 3]);
                            imp[qloc * 65 + j] += G;
                        }
                    asm volatile("s_waitcnt lgkmcnt(0)" ::: "memory");
#pragma unroll
                    for (int blk = 0; blk < 2; ++blk)
#pragma unroll
                        for (int g4 = 0; g4 < 4; ++g4) {
                            const int j = 16 * tt + 8 * blk + 2 * g4 + h;
                            const float Lst = blk == 0 ? p0[4 * g4 + 3] : p1[4 * g4 + 3];
                            if (j + 1 < 64) imp[qloc * 65 + j + 1] += Lst;
                        }
                    asm volatile("s_waitcnt lgkmcnt(0)" ::: "memory");
                }
            }
            if (pass == 0) { const float lt = lsum + __shfl_xor(lsum, 32); invl = (qpos >= 31) ? 1.0f / lt : 0.f; }
        }
        const float gl = bf2f((short)P[(size_t)qpos * DINP + C_G + 0 * 6 + hh]);
        bf16_t* orow = (bf16_t*)(A.ws + WS_XN) + (size_t)(b * T + qpos) * D + 640 + hh * 64;
        store_o<1>(o, orow, h, EN_CMP ? sigmoid_f(gl) * gmul : 0.0f);
    }
    __syncthreads();
    if (qb < 4) {
        if (tid < 256) { const int t = q0 + tid, cur = t >> 6; ((unsigned long long*)(A.ws + WS_SEL))[(size_t)(b * 2 + g) * T + t] = (1ull << (cur + 1)) - 1ull; }
    } else {
        const int qi = tid >> 1, hf = tid & 1, t = q0 + qi, cur = t >> 6;
        float v[32];
#pragma unroll
        for (int i = 0; i < 32; ++i) { const int j = 32 * hf + i; const float x = imp[qi * 65 + j]; v[i] = (j >= 1 && j <= cur - 2) ? x : -1.0f; }
        unsigned long long mask = 1ull | (1ull << cur) | (1ull << (cur - 1));
#pragma unroll 1
        for (int it = 0; it < 13; ++it) {
            float bv = v[0]; int bi = 0;
#pragma unroll
            for (int i = 1; i < 32; ++i) { const bool gt = v[i] > bv; bv = gt ? v[i] : bv; bi = gt ? i : bi; }
            const float ov = __shfl_xor(bv, 1); const int oi = __shfl_xor(bi, 1);
            const float v0 = hf ? ov : bv, v1 = hf ? bv : ov; const int i0 = hf ? oi : bi, i1 = hf ? bi : oi;
            const bool win0 = v0 >= v1;
            const int wj = win0 ? i0 : 32 + i1;
            mask |= 1ull << wj;
            const int clr = (win0 == (hf == 0)) ? (win0 ? i0 : i1) : -1;
#pragma unroll
            for (int i = 0; i < 32; ++i) v[i] = (i == clr) ? -1.0f : v[i];
        }
        if (hf == 0) ((unsigned long long*)(A.ws + WS_SEL))[(size_t)(b * 2 + g) * T + t] = mask;
    }
    __syncthreads();
}

__device__ __forceinline__ int fetch_unit(unsigned* ctr, LAS unsigned char* lds) {
    volatile LAS int* w = (volatile LAS int*)(lds + FETCH_OFF);
    __syncthreads();
    if (get_tid() == 0) *w = (int)atomicAdd(ctr, 1u);
    __syncthreads();
    return __builtin_amdgcn_readfirstlane(*w);
}
template <class Epi>
__device__ __forceinline__ void run_gemm_counted(LAS unsigned char* lds, const bf16_t* Am, const bf16_t* Bt, int N, int K, const Epi& E, unsigned* cnt) {
    pg8::Gemm g{Am, Bt, M, N, K}; CountedOrder S; S.init(M, N, (int)gridDim.x, (int)blockIdx.x); S.cnt = cnt;
    pg8::gemm_phase<Epi, CountedOrder, true, true>(lds, g, S, E);
}
template <class Epi>
__device__ __forceinline__ void run_gemm_small(LAS unsigned char* lds, const bf16_t* Am, const bf16_t* Bt, int N, int K, const Epi& E) {
    asm volatile("" : "+s"(N), "+s"(K));
    pg8::Gemm g{Am, Bt, M, N, K}; pg8::StaticOrder S; S.init(M, N, (int)gridDim.x, (int)blockIdx.x);
    pg8::gemm_phase<Epi, pg8::StaticOrder, true, true>(lds, g, S, E);
}
template <class Epi>
__device__ __forceinline__ void run_gemm(LAS unsigned char* lds, const bf16_t* Am, const bf16_t* Bt, int N, int K, const Epi& E) {
    pg8::Gemm g{Am, Bt, M, N, K}; pg8::StaticOrder S; S.init(M, N, (int)gridDim.x, (int)blockIdx.x);
    pg8::gemm_phase<Epi, pg8::StaticOrder, true, true>(lds, g, S, E);
}

__global__ void __launch_bounds__(NTHR, 2) fwd_megakernel(Args A) {
    LAS unsigned char* lds = (LAS unsigned char*)lds_raw;
    if (lane_id() == 0) *(volatile LAS int*)(lds + WIDTAB_OFF + 4 * hw_slot()) = (int)(threadIdx.x >> 6);
    __syncthreads();
    cg::grid_group grid = cg::this_grid();
    const int G = gridDim.x;
    { volatile LAS unsigned* st0 = (volatile LAS unsigned*)(lds + FETCH_OFF + 16); if (get_tid() < 2) st0[get_tid()] = 0u; }
    __syncthreads();
#ifdef PROBE_PHASE
    if (get_tid() < 32) { volatile LAS unsigned* ta_ = (volatile LAS unsigned*)(lds + 140000); ta_[get_tid()] = 0u; }
    __syncthreads();
    if (get_tid() == 0) { volatile LAS unsigned* ta_ = (volatile LAS unsigned*)(lds + 140000); ta_[31] = (unsigned)__builtin_amdgcn_s_memrealtime(); }
    __syncthreads();
#endif
    const unsigned xbar_x = (unsigned)__builtin_amdgcn_readfirstlane((int)xcd_barrier_post((unsigned*)(A.ws + WS_CTL) + 1024, (volatile LAS unsigned*)(lds + FETCH_OFF + 16)).x);
#ifdef PROBE_PHASE
#define STAMP(id) do { if (blockIdx.x == 0 && get_tid() == 0) { volatile LAS unsigned* ta_ = (volatile LAS unsigned*)(lds + 140000); const unsigned now_ = (unsigned)__builtin_amdgcn_s_memrealtime(); ta_[id] += now_ - ta_[31]; ta_[31] = now_; } } while (0)
#else
#define STAMP(id) do {} while (0)
#endif
#define GSYNC() do { XcdBarrier xb_; unsigned xx_ = xbar_x; asm volatile("" : "+s"(xx_)); xb_.bar = (unsigned*)(A.ws + WS_CTL) + 1024; xb_.x = xx_; \
                     xb_.st = (volatile LAS unsigned*)(lds + FETCH_OFF + 16); xcd_barrier(xb_); } while (0)
    unsigned char* ws = A.ws;
    unsigned* ctl = (unsigned*)(ws + WS_CTL);
    float* X = A.out;
    bf16_t* XN = (bf16_t*)(ws + WS_XN);
    bf16_t* U = (bf16_t*)(ws + WS_U);
    const float* mods = (const float*)(ws + WS_MODS);

    for (int task = blockIdx.x; task < 288; task += G) mods_task(A, task, lds);
    for (int task = G - 1 - (int)blockIdx.x; task < 64; task += G) posb_task(A, task, lds);
    rope_entries(A);
    { float* ssq = (float*)(ws + WS_SSQ); for (int i = blockIdx.x * NTHR + opq(get_tid()); i < 4 * M; i += G * NTHR) ssq[i] = 0.f; }
    if (blockIdx.x == 0 && get_tid() < 2) {
        const int tid = opq(get_tid());
        const float* lp = A.in[13] + tid * 128; float s1 = 0.f, s2 = 0.f;
        for (int i = 0; i < 32; ++i) { s1 += lp[i] * lp[32 + i]; s2 += lp[64 + i] * lp[96 + i]; }
        const float lam_init = tid == 0 ? 0.2f : 0.35550907f;
        ((float*)ctl)[64 + tid] = expf(s1) - expf(s2) + lam_init;
        ((float*)ctl)[66 + tid] = 1.0f - lam_init;
    }
    __syncthreads();
    convert_layer(A, 0, lds);
#ifdef PROBE_DUPCVT
    for (int i = 0; i < PROBE_DUPCVT; ++i) { __syncthreads(); convert_layer(A, 0, lds); }
#endif
#ifdef PROBE_DUPMODS
    for (int task = blockIdx.x; task < 288; task += G) mods_task(A, task, lds);
#endif
    if (A.out == nullptr) grid.sync();
    GSYNC();
    STAMP(0);

    if (blockIdx.x == 0) posb_final(A);
#pragma unroll 1
    for (int l = 0; l < 2; ++l) {
        const float* modl = mods + (size_t)l * 4 * 9216;
        unsigned char* wb = ws + WS_W;
        if (l == 1) { __syncthreads(); convert_layer(A, 1, lds); }
#pragma unroll 1
        for (int s = 0; s < 2; ++s) {
            const float* xin = (l == 0 && s == 0) ? A.in[0] : X;
            norm_rows(xin, XN, A.in[s == 0 ? 4 : 6] + l * D, modl, s == 0 ? 0 : 6, s == 0 ? 1 : 7);
            GSYNC();
            STAMP(1);
            { EpiSwiGLU E{U}; run_gemm(lds, XN, (const bf16_t*)(wb + (s == 0 ? W_1A : W_2A)), F2, D, E); }
            GSYNC();
            STAMP(2);
            { EpiResid E{xin, X, modl + (s == 0 ? 2 : 8) * 1024, 0.5f}; run_gemm(lds, U, (const bf16_t*)(wb + (s == 0 ? W_1B : W_2B)), D, F, E); }
            GSYNC();
            STAMP(3);
            if (s == 0 && EN_MIX) {
                norm_rows(X, XN, A.in[5] + l * D, modl, 3, 4);
                GSYNC();
                STAMP(4);
                float* ssq = (float*)(ws + WS_SSQ) + (size_t)l * 2 * M;
                { EpiProj E{U, (bf16_t*)(ws + WS_CQ), (bf16_t*)(ws + WS_CKV), ssq, ssq + M, ctl + CTL_KN + l * 96}; run_gemm(lds, XN, (const bf16_t*)(wb + W_IN), DINP, D, E); }
                GSYNC();
                STAMP(5);
                { EpiRowScale E{(bf16_t*)(ws + WS_MQ), 768, ssq, 1.0f / 256.0f}; run_gemm_small(lds, (const bf16_t*)(ws + WS_CQ), (const bf16_t*)(wb + W_UQ), 768, 256, E); }
                { EpiRowScale E{(bf16_t*)(ws + WS_MKV), 768, ssq + M, 1.0f / 128.0f}; run_gemm_small(lds, (const bf16_t*)(ws + WS_CKV), (const bf16_t*)(wb + W_UKV), 768, 128, E); }
                STAMP(11);
                for (;;) {
                    int u = fetch_unit(ctl + l * 4 + 0, lds);
                    if (u >= 64 + 256 + 512 + 384) break;
                    if (u < 512) { da_unit(A, l, (u & 15) >> 2, u & 3, 31 - (u >> 4), lds); continue; } u -= 512;
                    if (u < 384) { nsa_unit<2>(A, l, (u % 24) / 6, u % 6, 15 - u / 24, lds); continue; } u -= 384;
                    if (u < 256) { cmp_mlp_task(A, l, u, lds); continue; } u -= 256;
                    kpe_unit(A, u);
                }
                GSYNC();
                STAMP(6);
                for (;;) {
                    int u = fetch_unit(ctl + l * 4 + 1, lds);
                    if (u >= 384 + 128) break;
                    if (u < 192) { mla_unit(A, (u % 24) / 6, u % 6, 15 - u / 24, lds); continue; } u -= 192;
                    if (u < 128) { cmp_unit(A, (u & 7) >> 1, u & 1, 15 - (u >> 3), lds); continue; } u -= 128;
                    u += 192; mla_unit(A, (u % 24) / 6, u % 6, 15 - u / 24, lds);
                }
                GSYNC();
                STAMP(7);
                for (;;) {
                    const int u = fetch_unit(ctl + l * 4 + 2, lds);
                    if (u >= 384) break;
                    nsa_unit<1>(A, l, (u % 24) / 6, u % 6, 15 - u / 24, lds);
                }
                GSYNC();
                STAMP(8);
                { EpiResid E{X, X, modl + 5 * 1024, 1.0f}; run_gemm(lds, XN, (const bf16_t*)(wb + W_OUT), D, D, E); }
                GSYNC();
                STAMP(9);
            }
        }
    }
    final_norm_rows(X, A.in[22]);
#ifdef PROBE_PHASE
    STAMP(10);
    __syncthreads();
    if (blockIdx.x == 0 && get_tid() == 0) { volatile LAS unsigned* ta_ = (volatile LAS unsigned*)(lds + 140000); X[0] += (float)ta_[PROBE_PHASE] * 0.0001f; }
#endif
#ifdef PROBE_SYNCS
    for (int i = 0; i < PROBE_SYNCS; ++i) GSYNC();
#endif
}

extern "C" void kernel_launch(void* const* d_in, const int* in_sizes, int n_in, void* d_out, int out_size, void* d_ws, size_t ws_size, hipStream_t stream) {
    static int grid = 0;
    if (grid == 0) {
        if (n_in != 23 || out_size != M * D || ws_size < WS_END) { fprintf(stderr, "kernel_launch: unexpected problem shape (n_in %d out %d ws %zu)\n", n_in, out_size, ws_size); grid = -1; return; }
        int dev = 0, cus = 0, per_cu = 0;
        hipGetDevice(&dev);
        hipDeviceGetAttribute(&cus, hipDeviceAttributeMultiprocessorCount, dev);
        hipFuncSetAttribute((const void*)fwd_megakernel, hipFuncAttributeMaxDynamicSharedMemorySize, LDS_BYTES);
        hipOccupancyMaxActiveBlocksPerMultiprocessor(&per_cu, (const void*)fwd_megakernel, NTHR, LDS_BYTES);
        if (per_cu < 1) per_cu = 1;
        grid = cus * per_cu;
        (void)hipGetLastError();
    }
    if (grid < 0) return;
    hipMemsetAsync(d_ws, 0, 32768, stream);
    Args a{};
    for (int i = 0; i < 23; ++i) a.in[i] = (const float*)d_in[i];
    a.out = (float*)d_out; a.ws = (unsigned char*)d_ws;
    void* args[] = {&a};
    hipError_t e = hipLaunchCooperativeKernel((const void*)fwd_megakernel, dim3(grid), dim3(NTHR), args, LDS_BYTES, stream);
    if (e != hipSuccess) fprintf(stderr, "cooperative launch failed: %s (grid %d)\n", hipGetErrorString(e), grid);
}
```

```cpp
#include <hip/hip_runtime.h>
#include <hip/hip_cooperative_groups.h>
#include <cstdio>
#include <cstdint>
namespace cg = cooperative_groups;
extern __shared__ __attribute__((aligned(16))) unsigned char lds_raw[];
constexpr int WIDTAB_OFF = 140200;
__device__ __forceinline__ int lane_id() { return (int)__builtin_amdgcn_mbcnt_hi(~0u, __builtin_amdgcn_mbcnt_lo(~0u, 0u)); }
__device__ __forceinline__ int hw_slot() { return (int)(__builtin_amdgcn_s_getreg((5 << 11) | 4) & 63u); }
__device__ __forceinline__ int get_tid() {
    const int wid = __builtin_amdgcn_readfirstlane(*(volatile __attribute__((address_space(3))) int*)((__attribute__((address_space(3))) unsigned char*)lds_raw + WIDTAB_OFF + 4 * hw_slot()));
    return wid * 64 + lane_id();
}
__device__ __forceinline__ int pg8_opq_tid() { int v = get_tid(); asm volatile("" : "+v"(v)); return v; }
namespace pg8 {
#define PG8_LAS __attribute__((address_space(3)))
typedef unsigned short bf16_t;
typedef short bf16x8 __attribute__((ext_vector_type(8)));
typedef float f32x4 __attribute__((ext_vector_type(4)));
typedef unsigned u32x4 __attribute__((ext_vector_type(4)));
constexpr int BM = 256, BK = 64, HALF = 128, HTB = HALF * BK * 2  , STAGE_BYTES = 8 * HTB, NXCD = 8, WGM = 4;

__host__ __device__ __forceinline__ int lds_byte(int r, int c) { const int st = (r >> 4) * 2 + (c >> 5), rr = r & 15, cc = c & 31, ob = rr * 64 + cc * 2; return st * 1024 + (ob ^ (((ob >> 9) & 1) << 5)); }
__host__ __device__ __forceinline__ void stage_rc(int b, int& R, int& C) { const int st = b / 1024, sb = b % 1024, swz = sb ^ (((sb >> 9) & 1) << 5); R = (st >> 1) * 16 + swz / 64; C = (st & 1) * 32 + (swz % 64) / 2; }
__host__ __device__ __forceinline__ int perm32(int rho) { const int n = rho >> 4, i = rho & 15; return 8 * (i >> 2) + 4 * n + (i & 3); }

struct Unit { int pm, pn; };
struct Gemm { const bf16_t* A; const bf16_t* Bt; int M, N, K; };

struct StaticOrder {
    int nM, nN, nwg, G, c;
    __host__ __device__ void init(int M, int N, int G_, int c_) { nM = M / BM; nN = N / BM; nwg = nM * nN; G = G_; c = c_; }
    __host__ __device__ bool next(int i, Unit& u) const {
        const long L = (long)i * G + c; if (L >= nwg) return false;
        int wgid = (int)L; { const int q = nwg / NXCD, r = nwg % NXCD, xcd = wgid % NXCD, off = wgid / NXCD; wgid = (xcd < r ? xcd * (q + 1) : r * (q + 1) + (xcd - r) * q) + off; }
        const int nig = WGM * nN, gid = wgid / nig, fm = gid * WGM, gsz = (nM - fm) < WGM ? (nM - fm) : WGM;
        u.pm = fm + ((wgid % nig) % gsz); u.pn = (wgid % nig) / gsz; return true;
    }
    __device__ __forceinline__ void a_ready(const Unit&) const {}
    __device__ __forceinline__ void done(const Unit&) const {}
};

__device__ __forceinline__ unsigned cvt_pk_bf16(float lo, float hi) { unsigned r; asm volatile("v_cvt_pk_bf16_f32 %0, %1, %2" : "=v"(r) : "v"(lo), "v"(hi)); return r; }
typedef float f32x2 __attribute__((ext_vector_type(2)));
__device__ __forceinline__ f32x2 gelu_pk(f32x2 v) {
    const f32x2 av = __builtin_elementwise_abs(v), d = av * 0.2316418882f + 1.0f;
    f32x2 t; t.x = __builtin_amdgcn_rcpf(d.x); t.y = __builtin_amdgcn_rcpf(d.y);
    f32x2 q = t * 0.5307027145f + (-0.7265760135f); q = q * t + 0.7107068705f; q = q * t + (-0.142248368f); q = q * t + 0.127414796f; q = q * t;
    const f32x2 s = (v * v) * (-0.72134752044f);
    f32x2 e; e.x = __builtin_amdgcn_exp2f(s.x); e.y = __builtin_amdgcn_exp2f(s.y);
    const f32x2 m = v * (q * e), r = v - m;
    f32x2 o; o.x = v.x < 0.f ? m.x : r.x; o.y = v.y < 0.f ? m.y : r.y; return o;
}

template <int ACT  > struct EpiBf16 {
    static constexpr bool PERM = true, AFTER_DRAIN = false; static_assert(ACT == 0 || ACT == 1, "EpiBf16: ACT is 0 (none) or 1 (gelu_pk)");
    bf16_t* O; int ldc; const float* bias; int split_cols; size_t split_stride; float scale0;
    __device__ __forceinline__ void operator()(const f32x4 (&acc)[2][2][4][2], const Unit& u, int wr, int wc, int fr, int fq) const {
        const int row0 = u.pm * BM + wr * 64 + fr; int colt = u.pn * BM; bf16_t* base = O;
        float sc = 1.f; if (split_cols) { const int t = colt / split_cols; base += (size_t)t * split_stride; colt -= t * split_cols; if (t == 0) sc = scale0; }
        const int col0 = colt + wc * 32 + 8 * fq, bcol0 = u.pn * BM + wc * 32 + 8 * fq;
        f32x4 bv[2][2];
#pragma unroll
        for (int bj = 0; bj < 2; ++bj)
#pragma unroll
            for (int n = 0; n < 2; ++n) bv[bj][n] = bias ? *(const f32x4*)(bias + bcol0 + bj * HALF + 4 * n) : (f32x4){0.f, 0.f, 0.f, 0.f};
#pragma unroll
        for (int ai = 0; ai < 2; ++ai)
#pragma unroll
            for (int m = 0; m < 4; ++m) { bf16_t* rowp = base + (size_t)(row0 + ai * HALF + m * 16) * ldc + col0;
#pragma unroll
                for (int bj = 0; bj < 2; ++bj) { f32x4 v0 = acc[ai][bj][m][0] + bv[bj][0], v1 = acc[ai][bj][m][1] + bv[bj][1];
                    if (ACT == 1) { f32x2 a = gelu_pk((f32x2){v0[0], v0[1]}), b = gelu_pk((f32x2){v0[2], v0[3]}), c = gelu_pk((f32x2){v1[0], v1[1]}), d = gelu_pk((f32x2){v1[2], v1[3]});
                        v0 = (f32x4){a.x, a.y, b.x, b.y}; v1 = (f32x4){c.x, c.y, d.x, d.y}; }
                    v0 = v0 * sc; v1 = v1 * sc; u32x4 w; w.x = cvt_pk_bf16(v0[0], v0[1]); w.y = cvt_pk_bf16(v0[2], v0[3]); w.z = cvt_pk_bf16(v1[0], v1[1]); w.w = cvt_pk_bf16(v1[2], v1[3]);
                    *(u32x4*)(rowp + bj * HALF) = w; } }
    }
};
template <class Epi, class Sched, bool ALIGN_EPI = false, bool SP2 = false>
__device__ __forceinline__ void gemm_phase(PG8_LAS unsigned char* lds, const Gemm g, const Sched& S, const Epi& E) {
    const int tid = pg8_opq_tid(), wid = __builtin_amdgcn_readfirstlane(tid >> 6), lane = tid & 63, wr = wid >> 2, wc = wid & 3, fr = lane & 15, fq = lane >> 4;
    const int K = g.K, nt = K / BK;
    unsigned voffA[2], voffB[2];
#pragma unroll
    for (int i = 0; i < 2; ++i) { int R, C; stage_rc(tid * 16 + i * 8192, R, C); const int Rb = Epi::PERM ? ((R & ~31) + perm32(R & 31)) : R;
        voffA[i] = (unsigned)(R * K + C) * 2u; voffB[i] = (unsigned)(Rb * K + C) * 2u; }
    const size_t kstep = (size_t)(BK * 2);
    const size_t hstep = (size_t)HALF * K * 2;
    const size_t tstep = 2 * hstep;
    const unsigned ldsw = (unsigned)wid * 1024u;
    const int aoff = lds_byte(wr * 64 + fr, fq * 8), boff = lds_byte(wc * 32 + fr, fq * 8);
#define PG8_SA(b, h) (((b) * 2 + (h)) * HTB)
#define PG8_SB(b, h) ((4 + (b) * 2 + (h)) * HTB)
#define PG8_STAGE(bufoff, gbase, voff) do { _Pragma("unroll") for (int _i = 0; _i < 2; ++_i) \
        __builtin_amdgcn_global_load_lds((const unsigned*)((const char*)(gbase) + (voff)[_i]), (PG8_LAS unsigned*)(lds + (bufoff) + ldsw + _i * 8192), 16, 0, 0); } while (0)
#define PG8_LDA(dst, b, h) do { _Pragma("unroll") for (int m = 0; m < 4; ++m) _Pragma("unroll") for (int k = 0; k < 2; ++k) dst[m][k] = *(const PG8_LAS bf16x8*)(lds + PG8_SA(b, h) + aoff + m * 2048 + k * 1024); } while (0)
#define PG8_LDB(dst, b, h) do { _Pragma("unroll") for (int n = 0; n < 2; ++n) _Pragma("unroll") for (int k = 0; k < 2; ++k) dst[n][k] = *(const PG8_LAS bf16x8*)(lds + PG8_SB(b, h) + boff + n * 2048 + k * 1024); } while (0)
#define PG8_MMA(ai, bj, At, Bt) do { __builtin_amdgcn_s_setprio(1); _Pragma("unroll") for (int m = 0; m < 4; ++m) _Pragma("unroll") for (int n = 0; n < 2; ++n) _Pragma("unroll") for (int k = 0; k < 2; ++k) \
        acc[ai][bj][m][n] = __builtin_amdgcn_mfma_f32_16x16x32_bf16(Bt[n][k], At[m][k], acc[ai][bj][m][n], 0, 0, 0); __builtin_amdgcn_s_setprio(0); } while (0)
#define PG8_WAIT_V(n) asm volatile("s_waitcnt vmcnt(" #n ")" ::: "memory")
#define PG8_WAIT_L(n) asm volatile("s_waitcnt lgkmcnt(" #n ")" ::: "memory")
#define PG8_BAR __builtin_amdgcn_s_barrier()
#define PG8_SCHED __builtin_amdgcn_sched_barrier(0)
    Unit cur, nxt; int ui = 0;
    if (!S.next(0, cur)) return;
    f32x4 acc[2][2][4][2];
#pragma unroll
    for (int a = 0; a < 2; ++a)
#pragma unroll
        for (int b = 0; b < 2; ++b)
#pragma unroll
            for (int m = 0; m < 4; ++m)
#pragma unroll
                for (int n = 0; n < 2; ++n) acc[a][b][m][n] = (f32x4){0.f, 0.f, 0.f, 0.f};
    bf16x8 At[4][2], B0[2][2], B1[2][2];
    const char* cA = (const char*)g.A + (size_t)cur.pm * tstep; const char* cB = (const char*)g.Bt + (size_t)cur.pn * tstep;
    S.a_ready(cur);
    if constexpr (SP2) {
        PG8_STAGE(PG8_SB(0, 0), cB, voffB); PG8_STAGE(PG8_SB(0, 1), cB + hstep, voffB); PG8_STAGE(PG8_SA(0, 0), cA, voffA); PG8_STAGE(PG8_SA(0, 1), cA + hstep, voffA);
        if (wr == 1) PG8_BAR;
        PG8_WAIT_V(2); PG8_BAR;
        PG8_STAGE(PG8_SB(1, 0), cB + kstep, voffB); PG8_STAGE(PG8_SA(1, 0), cA + kstep, voffA); PG8_STAGE(PG8_SB(1, 1), cB + hstep + kstep, voffB);
        PG8_WAIT_V(6); PG8_BAR;
    } else {
        PG8_STAGE(PG8_SB(0, 0), cB, voffB); PG8_STAGE(PG8_SA(0, 0), cA, voffA); PG8_STAGE(PG8_SB(0, 1), cB + hstep, voffB); PG8_STAGE(PG8_SA(0, 1), cA + hstep, voffA);
        if (wr == 1) PG8_BAR;
        PG8_WAIT_V(4); PG8_BAR;
        PG8_STAGE(PG8_SB(1, 0), cB + kstep, voffB); PG8_STAGE(PG8_SA(1, 0), cA + kstep, voffA); PG8_STAGE(PG8_SB(1, 1), cB + hstep + kstep, voffB);
        PG8_WAIT_V(6); PG8_BAR;
    }
    for (;;) {
        const bool has_next = S.next(ui + 1, nxt);
        const char* nA = has_next ? (const char*)g.A + (size_t)nxt.pm * tstep : cA; const char* nB = has_next ? (const char*)g.Bt + (size_t)nxt.pn * tstep : cB;
        for (int t = 0; t < nt; t += 2) {
            const bool last = (t == nt - 2);
            const char* a1 = cA + (size_t)(t + 1) * kstep;
            const char* a2 = last ? nA : cA + (size_t)(t + 2) * kstep; const char* b2 = last ? nB : cB + (size_t)(t + 2) * kstep;
            const char* a3 = a2 + kstep; const char* b3 = b2 + kstep;
            if (last && has_next) S.a_ready(nxt);
            if constexpr (SP2) {
            PG8_LDB(B0, 0, 0); PG8_LDB(B1, 0, 1); PG8_SCHED; PG8_LDA(At, 0, 0); PG8_STAGE(PG8_SA(1, 1), a1 + hstep, voffA);
            PG8_WAIT_V(8); PG8_WAIT_L(0); PG8_BAR; PG8_MMA(0, 0, At, B0); PG8_MMA(0, 1, At, B1); PG8_BAR; PG8_SCHED;
            PG8_LDA(At, 0, 1); PG8_STAGE(PG8_SB(0, 0), b2, voffB); PG8_STAGE(PG8_SB(0, 1), b2 + hstep, voffB); PG8_STAGE(PG8_SA(0, 0), a2, voffA);
            PG8_WAIT_V(8); PG8_WAIT_L(0); PG8_BAR; PG8_MMA(1, 0, At, B0); PG8_MMA(1, 1, At, B1); PG8_BAR; PG8_SCHED;
            PG8_LDB(B0, 1, 0); PG8_LDB(B1, 1, 1); PG8_SCHED; PG8_LDA(At, 1, 0); PG8_STAGE(PG8_SA(0, 1), a2 + hstep, voffA);
            PG8_WAIT_V(8); PG8_WAIT_L(0); PG8_BAR; PG8_MMA(0, 0, At, B0); PG8_MMA(0, 1, At, B1); PG8_BAR; PG8_SCHED;
            PG8_LDA(At, 1, 1); PG8_STAGE(PG8_SB(1, 0), b3, voffB); PG8_STAGE(PG8_SB(1, 1), b3 + hstep, voffB); PG8_STAGE(PG8_SA(1, 0), a3, voffA);
            PG8_WAIT_V(8); PG8_WAIT_L(0); PG8_BAR; PG8_MMA(1, 0, At, B0); PG8_MMA(1, 1, At, B1); PG8_BAR; PG8_SCHED;
            } else {
            PG8_LDB(B0, 0, 0); PG8_SCHED; PG8_LDA(At, 0, 0); PG8_STAGE(PG8_SA(1, 1), a1 + hstep, voffA);
            PG8_WAIT_L(8); PG8_BAR; PG8_WAIT_L(0); PG8_MMA(0, 0, At, B0); PG8_BAR; PG8_SCHED;
            PG8_LDB(B1, 0, 1); PG8_STAGE(PG8_SB(0, 0), b2, voffB);
            PG8_BAR; PG8_WAIT_L(0); PG8_MMA(0, 1, At, B1); PG8_BAR;
            PG8_LDA(At, 0, 1); PG8_STAGE(PG8_SA(0, 0), a2, voffA);
            PG8_BAR; PG8_WAIT_L(0); PG8_MMA(1, 0, At, B0); PG8_BAR; PG8_SCHED;
            PG8_STAGE(PG8_SB(0, 1), b2 + hstep, voffB);
            PG8_WAIT_V(6); PG8_BAR; PG8_MMA(1, 1, At, B1); PG8_BAR;
            PG8_LDB(B0, 1, 0); PG8_SCHED; PG8_LDA(At, 1, 0); PG8_STAGE(PG8_SA(0, 1), a2 + hstep, voffA);
            PG8_WAIT_L(8); PG8_BAR; PG8_WAIT_L(0); PG8_MMA(0, 0, At, B0); PG8_BAR; PG8_SCHED;
            PG8_LDB(B1, 1, 1); PG8_STAGE(PG8_SB(1, 0), b3, voffB);
            PG8_BAR; PG8_WAIT_L(0); PG8_MMA(0, 1, At, B1); PG8_BAR;
            PG8_LDA(At, 1, 1); PG8_STAGE(PG8_SA(1, 0), a3, voffA);
            PG8_BAR; PG8_WAIT_L(0); PG8_MMA(1, 0, At, B0); PG8_BAR; PG8_SCHED;
            PG8_STAGE(PG8_SB(1, 1), b3 + hstep, voffB);
            PG8_WAIT_V(6); PG8_BAR; PG8_MMA(1, 1, At, B1); PG8_BAR;
            }
        }
        if constexpr (ALIGN_EPI) { if (wr == 0) PG8_BAR; }
        if constexpr (!Epi::AFTER_DRAIN) { E(acc, cur, wr, wc, fr, fq); S.done(cur); }
        if (!has_next) break;
#pragma unroll
        for (int a = 0; a < 2; ++a)
#pragma unroll
            for (int b = 0; b < 2; ++b)
#pragma unroll
                for (int m = 0; m < 4; ++m)
#pragma unroll
                    for (int n = 0; n < 2; ++n) acc[a][b][m][n] = (f32x4){0.f, 0.f, 0.f, 0.f};
        cur = nxt; cA = nA; cB = nB; ++ui;
        if constexpr (ALIGN_EPI) { if (wr == 1) PG8_BAR; }
    }
    PG8_WAIT_V(0);
    if constexpr (!ALIGN_EPI) { if (wr == 0) PG8_BAR; }
    PG8_BAR;
    if constexpr (Epi::AFTER_DRAIN) { E.fused(acc, cur, wr, wc, fr, fq, lds, wid, lane); S.done(cur); }
#undef PG8_SA
#undef PG8_SB
#undef PG8_STAGE
#undef PG8_LDA
#undef PG8_LDB
#undef PG8_MMA
#undef PG8_WAIT_V
#undef PG8_WAIT_L
#undef PG8_BAR
#undef PG8_SCHED
}
}

#define LAS __attribute__((address_space(3)))
typedef unsigned short bf16_t;
typedef short bf16x8 __attribute__((ext_vector_type(8)));
typedef short s16x4 __attribute__((ext_vector_type(4)));
typedef float f32x4 __attribute__((ext_vector_type(4)));
typedef float f32x2 __attribute__((ext_vector_type(2)));
typedef float f32x16 __attribute__((ext_vector_type(16)));
typedef unsigned u32x4 __attribute__((ext_vector_type(4)));
typedef unsigned u32x2 __attribute__((ext_vector_type(2)));
typedef __bf16 bf16x2_t __attribute__((ext_vector_type(2)));

#ifndef EN_MIX
#define EN_MIX 1
#endif
#ifndef EN_DA
#define EN_DA 1
#endif
#ifndef EN_MLA
#define EN_MLA 1
#endif
#ifndef EN_WIN
#define EN_WIN 1
#endif
#ifndef EN_CMP
#define EN_CMP 1
#endif
#ifndef EN_SLC
#define EN_SLC 1
#endif

constexpr int NB = 4, T = 4096, D = 1024, M = NB * T, F = 2816, F2 = 5632, DIN = 2354, DINP = 2560;
constexpr int NTHR = 512, NWAVE = 8, LDS_BYTES = 147456, FETCH_OFF = LDS_BYTES - 64;
constexpr int C_AQ = 0, C_AK = 256, C_AV = 512, C_BKR = 1152, C_CQ = 1184, C_KC = 1568, C_VC = 1696, C_KS = 1824, C_VS = 1952, C_KW = 2080, C_VW = 2208, C_G = 2336;
constexpr float LOG2E = 1.4426950408889634f, RMS_EPS = 1e-6f, NEGBIG = -1e30f;

constexpr size_t MiB = 1u << 20, KiB = 1u << 10;
constexpr size_t WS_CTL = 0;
constexpr size_t WS_MODS = 64 * KiB;
constexpr size_t WS_ROPE = 512 * KiB;
constexpr size_t WS_POSB = 1 * MiB;
constexpr size_t WS_SSQ = 1 * MiB + 64 * KiB;
constexpr size_t WS_KCMP = 2 * MiB;
constexpr size_t WS_SEL = 3 * MiB;
constexpr size_t WS_W = 4 * MiB;
constexpr size_t W_1A = 0, W_1B = W_1A + (size_t)F2 * D * 2, W_2A = W_1B + (size_t)D * F * 2, W_2B = W_2A + (size_t)F2 * D * 2,
                 W_IN = W_2B + (size_t)D * F * 2, W_OUT = W_IN + (size_t)DINP * D * 2, W_UQ = W_OUT + (size_t)D * D * 2, W_UKV = W_UQ + 768 * 256 * 2,
                 W_C1 = W_UKV + 768 * 128 * 2, W_C2 = W_C1 + 2 * 128 * 2048 * 2, W_END = W_C2 + 2 * 64 * 128 * 2;
static_assert(WS_W + W_END <= 48 * MiB, "weights");
constexpr size_t WS_XN = 48 * MiB;
constexpr size_t WS_U = 80 * MiB;
constexpr size_t WS_CQ = 168 * MiB;
constexpr size_t WS_CKV = 176 * MiB;
constexpr size_t WS_MQ = 180 * MiB;
constexpr size_t WS_MKV = 204 * MiB;
constexpr size_t WS_KPE = 228 * MiB;
constexpr size_t WS_END = 229 * MiB;

__device__ __forceinline__ unsigned cvtpk(float lo, float hi) { f32x2 v = {lo, hi}; bf16x2_t b = __builtin_convertvector(v, bf16x2_t); return __builtin_bit_cast(unsigned, b); }
__device__ __forceinline__ float bf2f(short b) { return __uint_as_float(((unsigned)(unsigned short)b) << 16); }
__device__ __forceinline__ float wave_sum(float v) {
#pragma unroll
    for (int o = 1; o < 64; o <<= 1) v += __shfl_xor(v, o);
    return v;
}
__device__ __forceinline__ float fast_exp2(float x) { return __builtin_amdgcn_exp2f(x); }
__device__ __forceinline__ float fast_rcp(float x) { return __builtin_amdgcn_rcpf(x); }
__device__ __forceinline__ float sigmoid_f(float x) { return fast_rcp(1.0f + fast_exp2(-x * LOG2E)); }
__device__ __forceinline__ int crow(int i, int h) { return (i & 3) + 8 * (i >> 2) + 4 * h; }
__device__ __forceinline__ int opq(int v) { asm volatile("" : "+v"(v)); return v; }
#define MFMA32(a, b, c) __builtin_amdgcn_mfma_f32_32x32x16_bf16((a), (b), (c), 0, 0, 0)
#define MFMA16(a, b, c) __builtin_amdgcn_mfma_f32_16x16x32_bf16((a), (b), (c), 0, 0, 0)

struct Args { const float* in[23]; float* out; unsigned char* ws; };
__device__ __forceinline__ unsigned char* ws_opq(unsigned char* p) {
    const unsigned long long v = (unsigned long long)p;
    unsigned lo = (unsigned)__builtin_amdgcn_readfirstlane((int)(unsigned)v), hi = (unsigned)__builtin_amdgcn_readfirstlane((int)(unsigned)(v >> 32));
    asm volatile("" : "+s"(lo), "+s"(hi));
    return (unsigned char*)(((unsigned long long)hi << 32) | (unsigned long long)lo);
}

struct EpiSwiGLU {
    static constexpr bool PERM = true, AFTER_DRAIN = false;
    bf16_t* O;
    __device__ __forceinline__ void operator()(const f32x4 (&acc)[2][2][4][2], const pg8::Unit& u, int wr_, int wc_, int fr_, int fq_) const {
        const int t_ = opq(get_tid()), w_ = __builtin_amdgcn_readfirstlane(t_ >> 6), wr = w_ >> 2, wc = w_ & 3, fr = t_ & 15, fq = (t_ >> 4) & 3;
        const int row0 = u.pm * 256 + wr * 64 + fr, col0 = u.pn * 128 + wc * 32 + 8 * fq;
#pragma unroll
        for (int ai = 0; ai < 2; ++ai)
#pragma unroll
            for (int m = 0; m < 4; ++m) {
                bf16_t* rowp = O + (size_t)(row0 + ai * 128 + m * 16) * F + col0;
                float r[8];
#pragma unroll
                for (int n = 0; n < 2; ++n)
#pragma unroll
                    for (int j = 0; j < 4; ++j) { const float g = acc[ai][0][m][n][j], up = acc[ai][1][m][n][j]; r[n * 4 + j] = g * sigmoid_f(g) * up; }
                u32x4 w; w.x = cvtpk(r[0], r[1]); w.y = cvtpk(r[2], r[3]); w.z = cvtpk(r[4], r[5]); w.w = cvtpk(r[6], r[7]);
                *(u32x4*)rowp = w;
            }
    }
};
struct EpiResid {
    static constexpr bool PERM = false, AFTER_DRAIN = false;
    const float* resid; float* out; const float* gate; float coef;
    __device__ __forceinline__ void operator()(const f32x4 (&acc)[2][2][4][2], const pg8::Unit& u, int wr_, int wc_, int fr_, int fq_) const {
        const int t_ = opq(get_tid()), w_ = __builtin_amdgcn_readfirstlane(t_ >> 6), wr = w_ >> 2, wc = w_ & 3, fr = t_ & 15, fq = (t_ >> 4) & 3;
        const int row0 = u.pm * 256 + wr * 64 + fr, b = (u.pm * 256) >> 12, col0 = u.pn * 256 + wc * 32 + 4 * fq;
#pragma unroll
        for (int bj = 0; bj < 2; ++bj)
#pragma unroll
            for (int n = 0; n < 2; ++n) {
                const int c = col0 + bj * 128 + n * 16;
                const f32x4 gv = *(const f32x4*)(gate + (size_t)b * 9216 + c) * coef;
#pragma unroll
                for (int ai = 0; ai < 2; ++ai)
#pragma unroll
                    for (int m = 0; m < 4; ++m) {
                        const size_t off = (size_t)(row0 + ai * 128 + m * 16) * D + c;
                        const f32x4 o = *(const f32x4*)(resid + off) + gv * acc[ai][bj][m][n];
                        *(f32x4*)(out + off) = o;
                        if (m & 1) asm volatile("" ::: "memory");
                    }
            }
    }
};
struct EpiProj {
    static constexpr bool PERM = true, AFTER_DRAIN = false;
    bf16_t* PROJ; bf16_t* CQ; bf16_t* CKV; float* ssq_q; float* ssq_kv; unsigned* kn;
    __device__ __forceinline__ void operator()(const f32x4 (&acc)[2][2][4][2], const pg8::Unit& u, int wr_, int wc_, int fr_, int fq_) const {
        const int t_ = opq(get_tid()), w_ = __builtin_amdgcn_readfirstlane(t_ >> 6), wr = w_ >> 2, wc = w_ & 3, fr = t_ & 15, fq = (t_ >> 4) & 3;
        const int row0 = u.pm * 256 + wr * 64 + fr;
        const int kti = u.pn == 1 ? 0 : (u.pn == 7 ? 1 : (u.pn == 8 ? 2 : -1));
#pragma unroll
        for (int bj = 0; bj < 2; ++bj) {
            float gmax = 0.f;
            bf16_t* base; int ld, cb; float* ssq;
            if (u.pn == 3) { base = CQ; ld = 256; cb = bj * 128; ssq = ssq_q; }
            else if (u.pn == 4 && bj == 0) { base = CKV; ld = 128; cb = 0; ssq = ssq_kv; }
            else { base = PROJ; ld = DINP; cb = u.pn * 256 + bj * 128; ssq = nullptr; }
            const int col0 = cb + wc * 32 + 8 * fq;
#pragma unroll
            for (int ai = 0; ai < 2; ++ai)
#pragma unroll
                for (int m = 0; m < 4; ++m) {
                    const int row = row0 + ai * 128 + m * 16;
                    const f32x4 v0 = acc[ai][bj][m][0], v1 = acc[ai][bj][m][1];
                    u32x4 w; w.x = cvtpk(v0[0], v0[1]); w.y = cvtpk(v0[2], v0[3]); w.z = cvtpk(v1[0], v1[1]); w.w = cvtpk(v1[2], v1[3]);
                    *(u32x4*)(base + (size_t)row * ld + col0) = w;
                    if (ssq || kti >= 0) {
                        float s = (v0[0] * v0[0] + v0[1] * v0[1]) + (v0[2] * v0[2] + v0[3] * v0[3]) + (v1[0] * v1[0] + v1[1] * v1[1]) + (v1[2] * v1[2] + v1[3] * v1[3]);
                        s += __shfl_xor(s, 16); s += __shfl_xor(s, 32);
                        if (ssq) { if (fq == 0) atomicAdd(ssq + row, s); }
                        else gmax = fmaxf(gmax, s);
                    }
                    asm volatile("" ::: "memory");
                }
            if (kti >= 0) {
                gmax = fmaxf(gmax, __shfl_xor(gmax, 1)); gmax = fmaxf(gmax, __shfl_xor(gmax, 2)); gmax = fmaxf(gmax, __shfl_xor(gmax, 4)); gmax = fmaxf(gmax, __shfl_xor(gmax, 8));
                if (fr == 0 && fq == 0) atomicMax(kn + ((u.pm * 256) >> 12) * 24 + kti * 8 + bj * 4 + wc, __float_as_uint(gmax));
            }
        }
    }
};
struct EpiRowScale {
    static constexpr bool PERM = true, AFTER_DRAIN = false;
    bf16_t* O; int ldc; const float* ssq; float inv_n;
    __device__ __forceinline__ void operator()(const f32x4 (&acc)[2][2][4][2], const pg8::Unit& u, int wr_, int wc_, int fr_, int fq_) const {
        const int t_ = opq(get_tid()), w_ = __builtin_amdgcn_readfirstlane(t_ >> 6), wr = w_ >> 2, wc = w_ & 3, fr = t_ & 15, fq = (t_ >> 4) & 3;
        const int row0 = u.pm * 256 + wr * 64 + fr, col0 = u.pn * 256 + wc * 32 + 8 * fq;
#pragma unroll
        for (int ai = 0; ai < 2; ++ai)
#pragma unroll
            for (int m = 0; m < 4; ++m) {
                const int row = row0 + ai * 128 + m * 16;
                const float rs = rsqrtf(ssq[row] * inv_n + RMS_EPS);
#pragma unroll
                for (int bj = 0; bj < 2; ++bj) {
                    const f32x4 v0 = acc[ai][bj][m][0] * rs, v1 = acc[ai][bj][m][1] * rs;
                    u32x4 w; w.x = cvtpk(v0[0], v0[1]); w.y = cvtpk(v0[2], v0[3]); w.z = cvtpk(v1[0], v1[1]); w.w = cvtpk(v1[2], v1[3]);
                    *(u32x4*)(O + (size_t)row * ldc + col0 + bj * 128) = w;
                }
                asm volatile("" ::: "memory");
            }
    }
};

template <int MODE> __device__ __forceinline__ int wrow(int n) {
    if (MODE == 1) return n < F ? ((n >> 7) * 256 + (n & 127)) : (((n - F) >> 7) * 256 + 128 + ((n - F) & 127));
    return n;
}
template <int MODE>
__device__ __forceinline__ void cvt_item(const float* W, int K, int N, int NP, bf16_t* WT, const float* kscale, LAS float* scr, int item, int lane) {
    const int nblk = NP / 32, kb = item / nblk, nb = item % nblk, k0 = 64 * kb, n0 = 32 * nb;
    const int n_rd = n0 + (lane & 31);
#pragma unroll 8
    for (int i = 0; i < 32; ++i) {
        const int kk = 2 * i + (lane >> 5);
        float v = (n_rd < N) ? W[(size_t)(k0 + kk) * N + n_rd] : 0.f;
        if (kscale) v *= kscale[k0 + kk];
        scr[kk * 33 + (lane & 31)] = v;
    }
    asm volatile("s_waitcnt lgkmcnt(0)" ::: "memory");
    const int c = lane & 7;
#pragma unroll
    for (int j = 0; j < 4; ++j) {
        const int n = (lane >> 3) + 8 * j; const LAS float* s = scr + (8 * c) * 33 + n;
        u32x4 o; o.x = cvtpk(s[0 * 33], s[1 * 33]); o.y = cvtpk(s[2 * 33], s[3 * 33]); o.z = cvtpk(s[4 * 33], s[5 * 33]); o.w = cvtpk(s[6 * 33], s[7 * 33]);
        *(u32x4*)(WT + (size_t)wrow<MODE>(n0 + n) * K + k0 + 8 * c) = o;
    }
    asm volatile("s_waitcnt lgkmcnt(0)" ::: "memory");
}
__device__ __forceinline__ void convert_layer(const Args& A, int l, LAS unsigned char* lds) {
    const int tid = opq(get_tid()), lane = tid & 63, wid = __builtin_amdgcn_readfirstlane(tid >> 6), gw = blockIdx.x * NWAVE + wid, ngw = gridDim.x * NWAVE;
    LAS float* scr = (LAS float*)(lds + wid * 8704);
    unsigned char* wb = A.ws + WS_W;
    constexpr int I_A = 16 * 176, I_B = 44 * 32, I_IN = 16 * 80, I_OUT = 16 * 32, I_UQ = 4 * 24, I_UKV = 2 * 24, I_C1 = 32 * 4, I_C2 = 2 * 2;
    constexpr int NITEMS = 2 * I_A + 2 * I_B + I_IN + I_OUT + I_UQ + I_UKV + 2 * I_C1 + 2 * I_C2;
    for (int it = gw; it < NITEMS; it += ngw) {
        int r = it;
        if (r < I_A) { cvt_item<1>(A.in[7] + (size_t)l * D * F2, D, F2, F2, (bf16_t*)(wb + W_1A), nullptr, scr, r, lane); continue; } r -= I_A;
        if (r < I_A) { cvt_item<1>(A.in[9] + (size_t)l * D * F2, D, F2, F2, (bf16_t*)(wb + W_2A), nullptr, scr, r, lane); continue; } r -= I_A;
        if (r < I_B) { cvt_item<0>(A.in[8] + (size_t)l * F * D, F, D, D, (bf16_t*)(wb + W_1B), nullptr, scr, r, lane); continue; } r -= I_B;
        if (r < I_B) { cvt_item<0>(A.in[10] + (size_t)l * F * D, F, D, D, (bf16_t*)(wb + W_2B), nullptr, scr, r, lane); continue; } r -= I_B;
        if (r < I_IN) { cvt_item<0>(A.in[11] + (size_t)l * D * DIN, D, DIN, DINP, (bf16_t*)(wb + W_IN), nullptr, scr, r, lane); continue; } r -= I_IN;
        if (r < I_OUT) { cvt_item<0>(A.in[12] + (size_t)l * D * D, D, D, D, (bf16_t*)(wb + W_OUT), nullptr, scr, r, lane); continue; } r -= I_OUT;
        if (r < I_UQ) { cvt_item<0>(A.in[17] + (size_t)l * 256 * 576, 256, 576, 768, (bf16_t*)(wb + W_UQ), A.in[15] + l * 256, scr, r, lane); continue; } r -= I_UQ;
        if (r < I_UKV) { cvt_item<0>(A.in[18] + (size_t)l * 128 * 768, 128, 768, 768, (bf16_t*)(wb + W_UKV), A.in[16] + l * 128, scr, r, lane); continue; } r -= I_UKV;
        if (r < 2 * I_C1) { const int kv = r / I_C1; cvt_item<0>(A.in[20] + (size_t)(l * 2 + kv) * 2048 * 128, 2048, 128, 128, (bf16_t*)(wb + W_C1) + (size_t)kv * 128 * 2048, nullptr, scr, r % I_C1, lane); continue; } r -= 2 * I_C1;
        { const int kv = r / I_C2; cvt_item<0>(A.in[21] + (size_t)(l * 2 + kv) * 128 * 64, 128, 64, 64, (bf16_t*)(wb + W_C2) + (size_t)kv * 64 * 128, nullptr, scr, r % I_C2, lane); }
    }
}
__device__ __forceinline__ void mods_task(const Args& A, int task, LAS unsigned char* lds) {
    const int tid = opq(get_tid()), lane = tid & 63, wid = __builtin_amdgcn_readfirstlane(tid >> 6);
    const int l = task / 144, chunk = task % 144;
    LAS float* cond = (LAS float*)lds;
    LAS float* red = (LAS float*)(lds + 16384);
    __syncthreads();
    for (int i = tid; i < 4096; i += NTHR) { const float c = A.in[1][i]; cond[i] = c / (1.0f + expf(-c)); }
    __syncthreads();
    const float* W = A.in[2] + (size_t)l * D * 9216 + chunk * 64 + lane;
    float acc[4] = {0.f, 0.f, 0.f, 0.f};
#pragma unroll 16
    for (int kk = 0; kk < 128; ++kk) {
        const int k = wid * 128 + kk;
        const float w = W[(size_t)k * 9216];
#pragma unroll
        for (int b = 0; b < 4; ++b) acc[b] += cond[b * 1024 + k] * w;
    }
#pragma unroll
    for (int b = 0; b < 4; ++b) red[(wid * 4 + b) * 64 + lane] = acc[b];
    __syncthreads();
    if (tid < 256) {
        const int b = tid >> 6, col = tid & 63; float s = 0.f;
#pragma unroll
        for (int w = 0; w < 8; ++w) s += red[(w * 4 + b) * 64 + col];
        s += A.in[3][(size_t)l * 9216 + chunk * 64 + col];
        ((float*)(A.ws + WS_MODS))[(size_t)(l * 4 + b) * 9216 + chunk * 64 + col] = s;
    }
    __syncthreads();
}
__device__ __forceinline__ void posb_task(const Args& A, int task, LAS unsigned char* lds) {
    const int tid = opq(get_tid());
    const int lkv = task >> 4, kp = task & 15, hid = tid & 127, sub = tid >> 7;
    const float* pos = A.in[19] + (size_t)lkv * 2048 + kp * 128 + sub * 32; const float* w1 = A.in[20] + ((size_t)lkv * 2048 + kp * 128 + sub * 32) * 128 + hid;
    float s = 0.f;
#pragma unroll
    for (int k = 0; k < 32; ++k) s += pos[k] * w1[(size_t)k * 128];
    LAS float* red = (LAS float*)lds;
    __syncthreads();
    red[tid] = s;
    __syncthreads();
    if (tid < 128) ((float*)(A.ws + WS_POSB + 4096))[task * 128 + tid] = red[tid] + red[tid + 128] + red[tid + 256] + red[tid + 384];
    __syncthreads();
}
__device__ __forceinline__ void posb_final(const Args& A) {
    const int o = opq(get_tid());
    const float* part = (const float*)(A.ws + WS_POSB + 4096) + (size_t)(o >> 7) * 16 * 128 + (o & 127);
    float s = 0.f;
#pragma unroll
    for (int p = 0; p < 16; ++p) s += part[p * 128];
    ((float*)(A.ws + WS_POSB))[o] = s;
}
__device__ __forceinline__ void rope_entries(const Args& A) {
    const int gtid = blockIdx.x * NTHR + opq(get_tid()), gn = gridDim.x * NTHR;
    float* tab = (float*)(A.ws + WS_ROPE);
    for (int e = gtid; e < T * 16; e += gn) {
        const int t = e >> 4, i = e & 15;
        double inv = 1.0; for (int j = 0; j < i; ++j) inv *= 0.5623413251903491;
        const float ang = (float)t * (float)inv;
        const double rev = (double)ang * 0.15915494309189535; const double fr = rev - __builtin_rint(rev);
        tab[e] = __builtin_amdgcn_cosf((float)fr); tab[T * 16 + e] = __builtin_amdgcn_sinf((float)fr);
    }
}
__device__ __forceinline__ void norm_rows(const float* X, bf16_t* out, const float* g, const float* modl, int ish, int isc) {
    const int tid = opq(get_tid()), lane = tid & 63, wid = __builtin_amdgcn_readfirstlane(tid >> 6), gw = blockIdx.x * NWAVE + wid, ngw = gridDim.x * NWAVE;
#pragma unroll 1
    for (int b = 0; b < NB; ++b) {
        f32x4 gs[4], sh[4];
#pragma unroll
        for (int j = 0; j < 4; ++j) {
            const int col = 4 * lane + 256 * j;
            gs[j] = *(const f32x4*)(g + col) * (*(const f32x4*)(modl + (size_t)b * 9216 + isc * 1024 + col) + 1.0f);
            sh[j] = *(const f32x4*)(modl + (size_t)b * 9216 + ish * 1024 + col);
        }
        for (int row = b * T + gw; row < (b + 1) * T; row += ngw) {
            const f32x4* xr = (const f32x4*)(X + (size_t)row * D) + lane;
            f32x4 v[4]; float ss = 0.f;
#pragma unroll
            for (int j = 0; j < 4; ++j) { v[j] = xr[64 * j]; ss += (v[j].x * v[j].x + v[j].y * v[j].y) + (v[j].z * v[j].z + v[j].w * v[j].w); }
            const float rstd = rsqrtf(wave_sum(ss) * (1.0f / D) + RMS_EPS);
#pragma unroll
            for (int j = 0; j < 4; ++j) {
                const f32x4 y = (v[j] * rstd) * gs[j] + sh[j];
                u32x2 w; w.x = cvtpk(y.x, y.y); w.y = cvtpk(y.z, y.w);
                *(u32x2*)(out + (size_t)row * D + 4 * lane + 256 * j) = w;
            }
        }
    }
}
__device__ __forceinline__ void final_norm_rows(float* X, const float* g) {
    const int tid = opq(get_tid()), lane = tid & 63, wid = __builtin_amdgcn_readfirstlane(tid >> 6), gw = blockIdx.x * NWAVE + wid, ngw = gridDim.x * NWAVE;
    for (int row = gw; row < M; row += ngw) {
        f32x4* xr = (f32x4*)(X + (size_t)row * D) + lane;
        f32x4 v[4]; float ss = 0.f;
#pragma unroll
        for (int j = 0; j < 4; ++j) { v[j] = xr[64 * j]; ss += (v[j].x * v[j].x + v[j].y * v[j].y) + (v[j].z * v[j].z + v[j].w * v[j].w); }
        const float rstd = rsqrtf(wave_sum(ss) * (1.0f / D) + RMS_EPS);
#pragma unroll
        for (int j = 0; j < 4; ++j) { const f32x4 g4 = *(const f32x4*)(g + 4 * lane + 256 * j); xr[64 * j] = (v[j] * rstd) * g4; }
    }
}

__device__ __forceinline__ void norm_block(const float* X, bf16_t* out, const float* g, const float* modl, int ish, int isc, int row0) {
    const int tid = opq(get_tid()), lane = tid & 63, wid = __builtin_amdgcn_readfirstlane(tid >> 6);
    const int b = row0 >> 12;
#pragma unroll 1
    for (int rr = 0; rr < 8; ++rr) {
        const int row = row0 + rr * 8 + wid;
        const f32x4* xr = (const f32x4*)(X + (size_t)row * D) + lane;
        f32x4 v[4]; float ss = 0.f;
#pragma unroll
        for (int j = 0; j < 4; ++j) { v[j] = xr[64 * j]; ss += (v[j].x * v[j].x + v[j].y * v[j].y) + (v[j].z * v[j].z + v[j].w * v[j].w); }
        const float rstd = rsqrtf(wave_sum(ss) * (1.0f / D) + RMS_EPS);
#pragma unroll
        for (int j = 0; j < 4; ++j) {
            const int col = 4 * lane + 256 * j;
            const f32x4 g4 = *(const f32x4*)(g + col), sc = *(const f32x4*)(modl + (size_t)b * 9216 + isc * 1024 + col), sh = *(const f32x4*)(modl + (size_t)b * 9216 + ish * 1024 + col);
            const f32x4 y = (v[j] * rstd) * g4 * (sc + 1.0f) + sh;
            u32x2 w; w.x = cvtpk(y.x, y.y); w.y = cvtpk(y.z, y.w);
            *(u32x2*)(out + (size_t)row * D + col) = w;
        }
    }
}
__device__ __forceinline__ void final_norm_block(float* X, const float* g, int row0) {
    const int tid = opq(get_tid()), lane = tid & 63, wid = __builtin_amdgcn_readfirstlane(tid >> 6);
#pragma unroll 1
    for (int rr = 0; rr < 8; ++rr) {
        const int row = row0 + rr * 8 + wid;
        f32x4* xr = (f32x4*)(X + (size_t)row * D) + lane;
        f32x4 v[4]; float ss = 0.f;
#pragma unroll
        for (int j = 0; j < 4; ++j) { v[j] = xr[64 * j]; ss += (v[j].x * v[j].x + v[j].y * v[j].y) + (v[j].z * v[j].z + v[j].w * v[j].w); }
        const float rstd = rsqrtf(wave_sum(ss) * (1.0f / D) + RMS_EPS);
#pragma unroll
        for (int j = 0; j < 4; ++j) { const f32x4 g4 = *(const f32x4*)(g + 4 * lane + 256 * j); xr[64 * j] = (v[j] * rstd) * g4; }
    }
}
struct CountedOrder : pg8::StaticOrder {
    unsigned* cnt;
    __device__ __forceinline__ void done(const pg8::Unit& u) const {
        __builtin_amdgcn_fence(__ATOMIC_RELEASE, "agent");
        if ((get_tid() & 63) == 0) __hip_atomic_fetch_add(cnt + u.pm, 1u, __ATOMIC_RELAXED, __HIP_MEMORY_SCOPE_AGENT);
    }
};
__device__ __forceinline__ void panel_wait(unsigned* cnt, int pm) {
    if (get_tid() == 0) {
        unsigned sp = 0;
        while (__hip_atomic_load(cnt + pm, __ATOMIC_RELAXED, __HIP_MEMORY_SCOPE_AGENT) < 32u) { __builtin_amdgcn_s_sleep(2); if (++sp > (1u << 22)) break; }
    }
    __syncthreads();
    __builtin_amdgcn_fence(__ATOMIC_ACQUIRE, "agent");
}

__device__ __forceinline__ void kpe_unit(const Args& A, int unit) {
    const int tid = opq(get_tid());
    unsigned char* w_ = ws_opq(A.ws);
    const bf16_t* P = (const bf16_t*)(w_ + WS_U); bf16_t* KPE = (bf16_t*)(w_ + WS_KPE); const float* rope = (const float*)(w_ + WS_ROPE);
#pragma unroll 2
    for (int k = 0; k < 8; ++k) {
        const int e = unit * 4096 + k * 512 + tid;
        const int row = e >> 4, i = e & 15, t = row & (T - 1);
        const float x0 = bf2f((short)P[(size_t)row * DINP + C_BKR + i]), x1 = bf2f((short)P[(size_t)row * DINP + C_BKR + 16 + i]);
        const float c = rope[t * 16 + i], sn = rope[T * 16 + t * 16 + i];
        KPE[(size_t)row * 32 + i] = (bf16_t)(cvtpk(x0 * c - x1 * sn, 0.f) & 0xffffu);
        KPE[(size_t)row * 32 + 16 + i] = (bf16_t)(cvtpk(x1 * c + x0 * sn, 0.f) & 0xffffu);
    }
}

constexpr int CTL_KN = 128;
__device__ __forceinline__ void kn_rows(const Args& A, int l) {
    const int tid = opq(get_tid()), lane = tid & 63, wid = __builtin_amdgcn_readfirstlane(tid >> 6), gw = blockIdx.x * NWAVE + wid, ngw = gridDim.x * NWAVE;
    unsigned char* w_ = ws_opq(A.ws);
    const bf16_t* P = (const bf16_t*)(w_ + WS_U); unsigned* kn = (unsigned*)(w_ + WS_CTL) + CTL_KN + l * 48;
    const int col2 = lane < 32 ? C_KS + 4 * lane : C_KW + 4 * (lane - 32);
    for (int it = gw; it < M / 16; it += ngw) {
        float m1 = 0.f, m2 = 0.f;
#pragma unroll 4
        for (int rr = 0; rr < 16; ++rr) {
            const bf16_t* rp = P + (size_t)(it * 16 + rr) * DINP;
            const s16x4 v1 = *(const s16x4*)(rp + C_AK + 4 * lane), v2 = *(const s16x4*)(rp + col2);
            float s1 = 0.f, s2 = 0.f;
#pragma unroll
            for (int j = 0; j < 4; ++j) { const float x = bf2f(v1[j]), y = bf2f(v2[j]); s1 += x * x; s2 += y * y; }
            s1 += __shfl_xor(s1, 1); s1 += __shfl_xor(s1, 2); s1 += __shfl_xor(s1, 4);
            s2 += __shfl_xor(s2, 1); s2 += __shfl_xor(s2, 2); s2 += __shfl_xor(s2, 4); s2 += __shfl_xor(s2, 8);
            m1 = fmaxf(m1, s1); m2 = fmaxf(m2, s2);
        }
        const int b = (it * 16) >> 12;
        if ((lane & 7) == 0) atomicMax(kn + b * 12 + (lane >> 3), __float_as_uint(m1));
        if ((lane & 15) == 0) atomicMax(kn + b * 12 + (lane < 32 ? 10 + (lane >> 4) : 8 + ((lane - 32) >> 4)), __float_as_uint(m2));
    }
}
#define XB_TMO      128
#define XB_XCNT(j)  (256  + 64 * (j))
#define XB_XSUB(j)  (1280 + 64 * (j))
#define XB_XGEN(j)  (2304 + 64 * (j))
#define XB_TOP      3328
#define XB_TOPGEN   3392
#define XCD_BAR_WORDS 3456
#define XB_SPIN_CAP (1u << 18)

__device__ __forceinline__ unsigned xb_ld(unsigned* p)              { return __hip_atomic_load(p, __ATOMIC_RELAXED, __HIP_MEMORY_SCOPE_AGENT); }
__device__ __forceinline__ unsigned xb_add(unsigned* p, unsigned v) { return __hip_atomic_fetch_add(p, v, __ATOMIC_RELAXED, __HIP_MEMORY_SCOPE_AGENT); }
__device__ __forceinline__ unsigned xb_xcc_id() { return (unsigned)__builtin_amdgcn_s_getreg((3 << 11) | 20) & 0xFu; }
#define XB_SPIN(cond, bar) do { unsigned _sp = 0; while (cond) { __builtin_amdgcn_s_sleep(1); \
    if ((++_sp & 255u) == 0u) { if (xb_ld(&(bar)[XB_TMO])) break; if (_sp > XB_SPIN_CAP) { atomicAdd(&(bar)[XB_TMO], 1u); break; } } } } while (0)

struct XcdBarrier {
    unsigned* bar; unsigned x;
    volatile LAS unsigned* st;
};

__device__ __forceinline__ XcdBarrier xcd_barrier_post(unsigned* bar, volatile LAS unsigned* st) {
    XcdBarrier b; b.bar = bar; b.x = xb_xcc_id(); b.st = st;
    if (get_tid() == 0) (void)xb_add(&bar[XB_XCNT(b.x)], 1u);
    return b;
}
__device__ __forceinline__ void xcd_barrier_complete(unsigned* bar, unsigned x, unsigned& nloc, unsigned& nx) {
    const unsigned G = gridDim.x * gridDim.y * gridDim.z;
    unsigned sum, cnt, mine, sp = 0u;
    for (;;) {
        sum = 0u; cnt = 0u; mine = 0u;
#pragma unroll
        for (unsigned j = 0; j < 16; ++j) { const unsigned c = xb_ld(&bar[XB_XCNT(j)]); sum += c; cnt += (c > 0u) ? 1u : 0u; mine = (j == x) ? c : mine; }
        if (sum == G) break;
        __builtin_amdgcn_s_sleep(1);
        if ((++sp & 255u) == 0u) { if (xb_ld(&bar[XB_TMO])) break; if (sp > XB_SPIN_CAP) { atomicAdd(&bar[XB_TMO], 1u); break; } }
    }
    nloc = mine > 0u ? mine : 1u; nx = cnt > 0u ? cnt : 1u;
}

__device__ __forceinline__ void xcd_barrier(const XcdBarrier& b) {
    asm volatile("s_waitcnt vmcnt(0)" ::: "memory");
    __syncthreads();
    if (get_tid() == 0) {
        unsigned* bar = b.bar;
        __builtin_amdgcn_s_waitcnt(0);
        unsigned nloc = b.st[0], nx = b.st[1];
        if (nloc == 0u) { xcd_barrier_complete(bar, b.x, nloc, nx); b.st[0] = nloc; b.st[1] = nx; }
        const unsigned old = xb_add(&bar[XB_XSUB(b.x)], 1u);
        const unsigned gen = old / nloc;
        if (old + 1u == (gen + 1u) * nloc) {
            __builtin_amdgcn_fence(__ATOMIC_RELEASE, "agent");
            asm volatile("s_waitcnt vmcnt(0)" ::: "memory");
            const unsigned og = xb_add(&bar[XB_TOP], 1u);
            const unsigned tg = og / nx;
            if (og + 1u == (tg + 1u) * nx) xb_add(&bar[XB_TOPGEN], 1u);
            else XB_SPIN(xb_ld(&bar[XB_TOPGEN]) == tg, bar);
            __builtin_amdgcn_fence(__ATOMIC_ACQUIRE, "agent");
            xb_add(&bar[XB_XGEN(b.x)], 1u);
            asm volatile("s_waitcnt vmcnt(0)" ::: "memory");
        } else {
            XB_SPIN(xb_ld(&bar[XB_XGEN(b.x)]) == gen, bar);
            __builtin_amdgcn_fence(__ATOMIC_ACQUIRE, "agent");
            asm volatile("s_waitcnt vmcnt(0)" ::: "memory");
        }
    }
    __syncthreads();
}

struct AttnArgs {
    const bf16_t* Q; int qpitch;
    const bf16_t* K1; int k1pitch;
    const bf16_t* K2; int k2pitch;
    const bf16_t* V; int vpitch;
    const float* rope;
    const unsigned long long* sel;
    float scale2, slope2; int window;
    float kmax;
};
constexpr int ATT_K_OFF = 0, ATT_V_OFF = 16384, ATT_BUF = 24576;

__device__ __forceinline__ s16x4 vtr(const LAS unsigned char* p) {
    typedef short v4i16_t __attribute__((ext_vector_type(4)));
    return __builtin_bit_cast(s16x4, __builtin_amdgcn_ds_read_tr16_b64_v4i16((LAS v4i16_t*)p));
}
template <bool ROWSUM> __device__ __forceinline__ void pv_tile_t(f32x16 (&o)[2], f32x16& osum, const f32x16& p0, const f32x16& p1, const LAS unsigned char* vl, int lane) {
    const int h = lane >> 5, i16 = lane & 15, q4 = i16 >> 2, p4 = i16 & 3, blk = (lane >> 4) & 1;
    const unsigned onew = ((lane & 31) == 0) ? 0x3f803f80u : 0u;
    const bf16x8 ones = __builtin_bit_cast(bf16x8, (u32x4){onew, onew, onew, onew});
    const LAS unsigned char* vb = vl + (4 * h + q4) * 64 + blk * 32 + p4 * 8;
#pragma unroll
    for (int s = 0; s < 4; ++s) {
        u32x4 pw;
        if (s == 0) { pw.x = cvtpk(p0[0], p0[1]); pw.y = cvtpk(p0[2], p0[3]); pw.z = cvtpk(p0[4], p0[5]); pw.w = cvtpk(p0[6], p0[7]); }
        else if (s == 1) { pw.x = cvtpk(p0[8], p0[9]); pw.y = cvtpk(p0[10], p0[11]); pw.z = cvtpk(p0[12], p0[13]); pw.w = cvtpk(p0[14], p0[15]); }
        else if (s == 2) { pw.x = cvtpk(p1[0], p1[1]); pw.y = cvtpk(p1[2], p1[3]); pw.z = cvtpk(p1[4], p1[5]); pw.w = cvtpk(p1[6], p1[7]); }
        else { pw.x = cvtpk(p1[8], p1[9]); pw.y = cvtpk(p1[10], p1[11]); pw.z = cvtpk(p1[12], p1[13]); pw.w = cvtpk(p1[14], p1[15]); }
        const bf16x8 pf = __builtin_bit_cast(bf16x8, pw);
#pragma unroll
        for (int db = 0; db < 2; ++db) {
            const s16x4 lo = vtr(vb + db * 4096 + (16 * s) * 64), hi = vtr(vb + db * 4096 + (16 * s + 8) * 64);
            const bf16x8 vf = __builtin_shufflevector(lo, hi, 0, 1, 2, 3, 4, 5, 6, 7);
            o[db] = MFMA32(vf, pf, o[db]);
        }
        if (ROWSUM) osum = MFMA32(ones, pf, osum);
    }
}
__device__ __forceinline__ void pv_tile(f32x16 (&o)[2], const f32x16& p0, const f32x16& p1, const LAS unsigned char* vl, int lane) {
    f32x16 dummy; pv_tile_t<false>(o, dummy, p0, p1, vl, lane);
}
template <int MODE> __device__ __forceinline__ void store_o(const f32x16 (&o)[2], bf16_t* out_row, int h, float sc) {
#pragma unroll
    for (int db = 0; db < 2; ++db)
#pragma unroll
        for (int g4 = 0; g4 < 4; ++g4) {
            bf16_t* p = out_row + 32 * db + 8 * g4 + 4 * h;
            float v0 = o[db][4 * g4] * sc, v1 = o[db][4 * g4 + 1] * sc, v2 = o[db][4 * g4 + 2] * sc, v3 = o[db][4 * g4 + 3] * sc;
            if (MODE == 1) { const u32x2 old = *(const u32x2*)p; v0 += __uint_as_float(old.x << 16); v1 += __uint_as_float(old.x & 0xffff0000u); v2 += __uint_as_float(old.y << 16); v3 += __uint_as_float(old.y & 0xffff0000u); }
            u32x2 w; w.x = cvtpk(v0, v1); w.y = cvtpk(v2, v3);
            *(u32x2*)p = w;
        }
}

constexpr int ATT_FLAG_OFF = 140480;
template <int DQK, bool ROPE, bool SEL, bool DUAL = false, bool EARLY = false>
__device__ __forceinline__ void attn_core(const AttnArgs& a, int q0, LAS unsigned char* lds, f32x16 (&o)[2]) {
    constexpr int KS = DQK / 16, DK = DUAL ? 2 * DQK : DQK, KP = DK * 2 + 16, D1 = DK < 64 ? DK : 64, NCH1 = D1 / 8, QROWS = DUAL ? 128 : 256;
    const int tid = opq(get_tid()), lane = tid & 63, wid = __builtin_amdgcn_readfirstlane(tid >> 6), r = lane & 31, h = lane >> 5;
    const int wq = DUAL ? (wid & 3) : wid, coff = DUAL ? (wid >> 2) * DQK : 0;
    const int qw0 = q0 + 32 * wq, qpos = qw0 + r;
    LAS unsigned char* Kl = lds + ATT_K_OFF; LAS unsigned char* Vl = lds + ATT_V_OFF;
    bf16x8 qf[KS];
    {
        const bf16_t* qrow = a.Q + (size_t)qpos * a.qpitch + coff;
#pragma unroll
        for (int ks = 0; ks < KS; ++ks) qf[ks] = *(const bf16x8*)(qrow + 16 * ks + 8 * h);
        if (ROPE) {
            const float* cs = a.rope + (size_t)qpos * 16 + 8 * h; const float* sn = cs + T * 16;
            float y0[8], y1[8];
#pragma unroll
            for (int j = 0; j < 8; ++j) { const float x0 = bf2f(qf[KS - 2][j]), x1 = bf2f(qf[KS - 1][j]), c = cs[j], s = sn[j]; y0[j] = x0 * c - x1 * s; y1[j] = x1 * c + x0 * s; }
            u32x4 w0, w1;
            w0.x = cvtpk(y0[0], y0[1]); w0.y = cvtpk(y0[2], y0[3]); w0.z = cvtpk(y0[4], y0[5]); w0.w = cvtpk(y0[6], y0[7]);
            w1.x = cvtpk(y1[0], y1[1]); w1.y = cvtpk(y1[2], y1[3]); w1.z = cvtpk(y1[4], y1[5]); w1.w = cvtpk(y1[6], y1[7]);
            qf[KS - 2] = __builtin_bit_cast(bf16x8, w0); qf[KS - 1] = __builtin_bit_cast(bf16x8, w1);
        }
    }
    float qk_bound = 0.f;
    if (EARLY) {
        float qq = 0.f;
#pragma unroll
        for (int ks = 0; ks < KS; ++ks)
#pragma unroll
            for (int j = 0; j < 8; ++j) { const float x = bf2f(qf[ks][j]); qq += x * x; }
        qq += __shfl_xor(qq, 32);
        qk_bound = sqrtf(qq) * a.kmax * a.scale2 * 1.01f + 0.01f;
    }
    unsigned long long selm = ~0ull;
    if (SEL) selm = a.sel[qpos];
    const int t_hi = (q0 + QROWS - 1) >> 6;
    int t_lo = 0;
    if (a.window) { const int lo = q0 - a.window + 1; t_lo = lo > 0 ? (lo >> 6) : 0; }
    const bool kA_on = tid < 64 * NCH1; const int rowA = tid / NCH1, chA = tid % NCH1;
    const bool kB_on = ROPE && tid < 128; const int rowB = tid >> 1, prB = tid & 1;
    const int rowV = tid >> 3, chV = tid & 7;
    u32x4 kA = {0, 0, 0, 0}, kB0 = {0, 0, 0, 0}, kB1 = {0, 0, 0, 0}, vR = {0, 0, 0, 0};
#define ATT_PREFETCH(t) do { \
        if (kA_on) kA = *(const u32x4*)(a.K1 + (size_t)(64 * (t) + rowA) * a.k1pitch + chA * 8); \
        if (kB_on) { const bf16_t* kp = a.K2 + (size_t)(64 * (t) + rowB) * a.k2pitch + prB * 8; kB0 = *(const u32x4*)kp; kB1 = *(const u32x4*)(kp + 16); } \
        vR = *(const u32x4*)(a.V + (size_t)(64 * (t) + rowV) * a.vpitch + chV * 8); } while (0)
#define ATT_STORE(tt, KL, VL) do { \
        if (kA_on) *(LAS u32x4*)((KL) + rowA * KP + chA * 16) = kA; \
        if (ROPE) { if (kB_on) { \
                *(LAS u32x4*)((KL) + rowB * KP + (64 + prB * 8) * 2) = kB0; \
                *(LAS u32x4*)((KL) + rowB * KP + (80 + prB * 8) * 2) = kB1; } } \
        *(LAS u32x4*)((VL) + (chV >> 2) * 4096 + rowV * 64 + (chV & 3) * 16) = vR; } while (0)
    float m = NEGBIG;
    f32x16 osum;
#pragma unroll
    for (int i = 0; i < 16; ++i) { o[0][i] = 0.f; o[1][i] = 0.f; osum[i] = 0.f; }
    float cbv[16];
#pragma unroll
    for (int i = 0; i < 16; ++i) cbv[i] = a.slope2 * (float)((i & 3) + 8 * (i >> 2) + 4 * h);
    volatile LAS unsigned* eflag = (volatile LAS unsigned*)(lds + ATT_FLAG_OFF);
    unsigned long long um = (t_hi >= 63 ? ~0ull : ((1ull << (t_hi + 1)) - 1ull)) & ~((1ull << t_lo) - 1ull);
    if (SEL) {
        LAS unsigned* uw = (LAS unsigned*)(lds + ATT_FLAG_OFF + 64);
        __syncthreads();
        if (tid < 2) uw[tid] = 0u;
        __syncthreads();
        __hip_atomic_fetch_or(uw, (unsigned)selm, __ATOMIC_RELAXED, __HIP_MEMORY_SCOPE_WORKGROUP);
        __hip_atomic_fetch_or(uw + 1, (unsigned)(selm >> 32), __ATOMIC_RELAXED, __HIP_MEMORY_SCOPE_WORKGROUP);
        __syncthreads();
        const unsigned lo_ = (unsigned)__builtin_amdgcn_readfirstlane((int)uw[0]), hi_ = (unsigned)__builtin_amdgcn_readfirstlane((int)uw[1]);
        um &= ((unsigned long long)hi_ << 32) | (unsigned long long)lo_;
    }
#define ATT_NEXT(tt) ((((tt) > 0) && (um & ((1ull << (tt)) - 1ull))) ? 63 - __builtin_clzll(um & ((1ull << (tt)) - 1ull)) : -1)
    int t = 63 - __builtin_clzll(um);
    int t1 = ATT_NEXT(t);
    ATT_PREFETCH(t);
    if (EARLY) { if (lane == 0) { eflag[wid] = 0u; eflag[8 + wid] = 0u; } }
    __syncthreads();
    ATT_STORE(t, Kl, Vl);
    __syncthreads();
    if (t1 >= 0) ATT_PREFETCH(t1);
    for (int step = 0; t >= 0; ++step) {
        const int cur = step & 1;
        const int t2 = (t1 >= 0) ? ATT_NEXT(t1) : -1;
        const LAS unsigned char* Kc = Kl + cur * ATT_BUF; const LAS unsigned char* Vc = Vl + cur * ATT_BUF;
        bool need = (64 * t <= qw0 + 31);
        if (a.window) need = need && (64 * t + 63 >= qw0 - a.window + 1);
        const bool selbit = SEL ? (((selm >> t) & 1ull) != 0ull) : true;
        if (SEL) need = need && (__ballot(selbit) != 0ull);
        if (need) {
            f32x16 p0, p1;
#pragma unroll
            for (int i = 0; i < 16; ++i) { p0[i] = 0.f; p1[i] = 0.f; }
#pragma unroll
            for (int ks = 0; ks < KS; ++ks) {
                const bf16x8 a0 = *(const LAS bf16x8*)(Kc + r * KP + coff * 2 + ks * 32 + h * 16);
                const bf16x8 a1 = *(const LAS bf16x8*)(Kc + (32 + r) * KP + coff * 2 + ks * 32 + h * 16);
                p0 = MFMA32(a0, qf[ks], p0); p1 = MFMA32(a1, qf[ks], p1);
            }
            if (!ROPE) {
#pragma unroll
                for (int i = 0; i < 16; ++i) { p0[i] = p0[i] * a.scale2 + cbv[i]; p1[i] = p1[i] * a.scale2 + cbv[i]; }
            }
            const float base0 = a.slope2 * (float)(64 * t - qpos), base1 = base0 + 32.0f * a.slope2;
            bool bnd = (64 * t + 63 > qw0);
            if (a.window) bnd = bnd || (64 * t < qw0 + 31 - a.window + 1);
            if (SEL) bnd = bnd || (__ballot(!selbit) != 0ull);
            if (bnd) {
                const int wlim = a.window ? a.window : (1 << 30);
#pragma unroll
                for (int i = 0; i < 16; ++i) {
                    const int kv0 = 64 * t + crow(i, h), d0 = qpos - kv0, d1 = d0 - 32;
                    const bool ok0 = selbit && d0 >= 0 && d0 < wlim, ok1 = selbit && d1 >= 0 && d1 < wlim;
                    p0[i] = ok0 ? p0[i] : NEGBIG; p1[i] = ok1 ? p1[i] : NEGBIG;
                }
            }
            float mx0 = p0[0], mx1 = p1[0];
#pragma unroll
            for (int i = 1; i < 16; ++i) { mx0 = fmaxf(mx0, p0[i]); mx1 = fmaxf(mx1, p1[i]); }
            float mloc = ROPE ? fmaxf(mx0, mx1) * a.scale2 : fmaxf(mx0 + base0, mx1 + base1);
            mloc = fmaxf(mloc, __shfl_xor(mloc, 32));
            const float mnew = fmaxf(m, mloc);
            if (__ballot(mnew > m) != 0ull) {
                const float alpha = fast_exp2(m - mnew);
                osum[0] *= alpha;
#pragma unroll
                for (int i = 0; i < 16; ++i) { o[0][i] *= alpha; o[1][i] *= alpha; }
            }
            m = mnew;
            const float r0 = mnew - base0, r1 = mnew - base1;
            if (ROPE) {
#pragma unroll
                for (int i = 0; i < 16; ++i) { p0[i] = fast_exp2(p0[i] * a.scale2 - mnew); p1[i] = fast_exp2(p1[i] * a.scale2 - mnew); }
            } else {
#pragma unroll
                for (int i = 0; i < 16; ++i) { p0[i] = fast_exp2(p0[i] - r0); p1[i] = fast_exp2(p1[i] - r1); }
            }
            pv_tile_t<true>(o, osum, p0, p1, Vc, lane);
        }
        if (EARLY) {
            const bool live = !(qk_bound - a.slope2 * (float)(qpos - 64 * t + 1) - m < -64.0f);
            const bool wdone = (__ballot(live) == 0ull);
            if (lane == 0) eflag[8 * cur + wid] = wdone ? 1u : 0u;
        }
        if (t1 >= 0) ATT_STORE(t1, Kl + (cur ^ 1) * ATT_BUF, Vl + (cur ^ 1) * ATT_BUF);
        __syncthreads();
        if (EARLY) {
            const unsigned alld = eflag[8 * cur] & eflag[8 * cur + 1] & eflag[8 * cur + 2] & eflag[8 * cur + 3] & eflag[8 * cur + 4] & eflag[8 * cur + 5] & eflag[8 * cur + 6] & eflag[8 * cur + 7];
            if (__builtin_amdgcn_readfirstlane((int)alld) != 0) break;
        }
        if (t2 >= 0) ATT_PREFETCH(t2);
        t = t1; t1 = t2;
    }
#undef ATT_NEXT
#undef ATT_STORE
#undef ATT_PREFETCH
    const float lt = __shfl(osum[0], lane & 31);
    const float inv = 1.0f / lt;
#pragma unroll
    for (int i = 0; i < 16; ++i) { o[0][i] *= inv; o[1][i] *= inv; }
}

__device__ __forceinline__ float da_slope(int hd) { return hd == 0 ? 0.25f : hd == 1 ? 0.0625f : hd == 2 ? 0.015625f : 0.00390625f; }
__device__ __forceinline__ float nsa_slope(int hh) { return hh == 0 ? 0.25f : hh == 1 ? 0.0625f : hh == 2 ? 0.015625f : hh == 3 ? 0.00390625f : hh == 4 ? 0.5f : 0.125f; }

constexpr int DA_X_OFF = 49152;
__device__ __forceinline__ void da_unit(const Args& A, int l, int b, int hd, int qb, LAS unsigned char* lds) {
    const int tid_ = opq(get_tid()), lane = tid_ & 63, wid = __builtin_amdgcn_readfirstlane(tid_ >> 6), r = lane & 31, h = lane >> 5;
    const bf16_t* P = (const bf16_t*)(A.ws + WS_U) + (size_t)b * T * DINP;
    const float lam = ((const float*)(A.ws + WS_CTL))[64 + l];
    const float one_m_li = ((const float*)(A.ws + WS_CTL))[66 + l];
    f32x16 o[2];
    AttnArgs a; a.Q = P + C_AQ + hd * 64; a.qpitch = DINP; a.K1 = P + C_AK + hd * 64; a.k1pitch = DINP; a.K2 = nullptr; a.k2pitch = 0;
    a.V = P + C_AV + hd * 64; a.vpitch = DINP; a.rope = nullptr; a.sel = nullptr; a.scale2 = 0.17677669529663687f * LOG2E; a.slope2 = da_slope(hd) * LOG2E; a.window = 0;
    { const unsigned* kn = (const unsigned*)(A.ws + WS_CTL) + CTL_KN + l * 96 + b * 24 + 2 * hd; a.kmax = sqrtf(fmaxf(__uint_as_float(kn[0]), __uint_as_float(kn[1]))); }
    attn_core<32, false, false, true, true>(a, qb * 128, lds, o);
    LAS float* xb = (LAS float*)(lds + DA_X_OFF) + (32 * (wid & 3) + r) * 65;
    if (wid >= 4) {
#pragma unroll
        for (int db = 0; db < 2; ++db)
#pragma unroll
            for (int i = 0; i < 16; ++i) xb[32 * db + crow(i, h)] = o[db][i];
    }
    __syncthreads();
    if (wid < 4) {
        float ss = 0.f;
#pragma unroll
        for (int db = 0; db < 2; ++db)
#pragma unroll
            for (int i = 0; i < 16; ++i) { o[db][i] = o[db][i] - lam * xb[32 * db + crow(i, h)]; ss += o[db][i] * o[db][i]; }
        ss += __shfl_xor(ss, 32);
        const float rs = rsqrtf(ss * (1.0f / 64.0f) + RMS_EPS) * one_m_li;
        const float* sg = A.in[14] + l * 64;
#pragma unroll
        for (int db = 0; db < 2; ++db)
#pragma unroll
            for (int i = 0; i < 16; ++i) o[db][i] *= rs * sg[32 * db + crow(i, h)];
        bf16_t* orow = (bf16_t*)(A.ws + WS_XN) + (size_t)(b * T + qb * 128 + 32 * wid + r) * D + hd * 64;
        store_o<0>(o, orow, h, EN_DA ? 1.0f : 0.0f);
    }
}
__device__ __forceinline__ void mla_unit(const Args& A, int b, int hd, int qb, LAS unsigned char* lds) {
    const int tid_ = opq(get_tid()), lane = tid_ & 63, wid = __builtin_amdgcn_readfirstlane(tid_ >> 6), r = lane & 31, h = lane >> 5;
    AttnArgs a; a.Q = (const bf16_t*)(A.ws + WS_MQ) + (size_t)b * T * 768 + hd * 96; a.qpitch = 768;
    a.K1 = (const bf16_t*)(A.ws + WS_MKV) + (size_t)b * T * 768 + hd * 128; a.k1pitch = 768;
    a.K2 = (const bf16_t*)(A.ws + WS_KPE) + (size_t)b * T * 32; a.k2pitch = 32;
    a.V = a.K1 + 64; a.vpitch = 768; a.rope = (const float*)(A.ws + WS_ROPE); a.sel = nullptr; a.scale2 = 0.10206207261596575f * LOG2E; a.slope2 = 0.f; a.window = 0; a.kmax = 0.f;
    f32x16 o[2];
    attn_core<96, true, false>(a, qb * 256, lds, o);
    bf16_t* orow = (bf16_t*)(A.ws + WS_XN) + (size_t)(b * T + qb * 256 + 32 * wid + r) * D + 256 + hd * 64;
    store_o<0>(o, orow, h, EN_MLA ? 1.0f : 0.0f);
}
template <int BR> __device__ __forceinline__ void nsa_unit(const Args& A, int l, int b, int hh, int qb, LAS unsigned char* lds) {
    const int tid_ = opq(get_tid()), lane = tid_ & 63, wid = __builtin_amdgcn_readfirstlane(tid_ >> 6), r = lane & 31, h = lane >> 5, g = hh / 3;
    const bf16_t* P = (const bf16_t*)(A.ws + WS_U) + (size_t)b * T * DINP;
    AttnArgs a; a.Q = P + C_CQ + hh * 64; a.qpitch = DINP; a.K1 = P + (BR == 2 ? C_KW : C_KS) + g * 64; a.k1pitch = DINP; a.K2 = nullptr; a.k2pitch = 0;
    a.V = P + (BR == 2 ? C_VW : C_VS) + g * 64; a.vpitch = DINP; a.rope = nullptr; a.sel = (const unsigned long long*)(A.ws + WS_SEL) + (size_t)(b * 2 + g) * T;
    a.scale2 = 0.125f * LOG2E; a.slope2 = nsa_slope(hh) * LOG2E; a.window = (BR == 2) ? 512 : 0;
    f32x16 o[2];
    { const unsigned* kn = (const unsigned*)(A.ws + WS_CTL) + CTL_KN + l * 96 + b * 24 + (BR == 2 ? 16 : 8) + 1 + 2 * g; a.kmax = sqrtf(__uint_as_float(kn[0]) + __uint_as_float(kn[1])); }
    attn_core<64, false, BR == 1, false, true>(a, qb * 256, lds, o);
    const int qpos = qb * 256 + 32 * wid + r;
    const float gl = bf2f((short)P[(size_t)qpos * DINP + C_G + BR * 6 + hh]);
    bf16_t* orow = (bf16_t*)(A.ws + WS_XN) + (size_t)(b * T + qpos) * D + 640 + hh * 64;
    if (BR == 2) store_o<0>(o, orow, h, EN_WIN ? sigmoid_f(gl) : 0.0f);
    else store_o<1>(o, orow, h, EN_SLC ? sigmoid_f(gl) : 0.0f);
}

__device__ __forceinline__ void cmp_mlp_task(const Args& A, int l, int wt, LAS unsigned char* lds) {
    const int tid_ = opq(get_tid()), lane = tid_ & 63, wid = __builtin_amdgcn_readfirstlane(tid_ >> 6);
    const int kv = wt >> 7, bg = (wt >> 4) & 7, rg = wt & 15, b = bg >> 1, g = bg & 1, i16 = lane & 15, quad = lane >> 4;
    const bf16_t* P = (const bf16_t*)(A.ws + WS_U) + (size_t)b * T * DINP + (kv ? C_VC : C_KC) + g * 64;
    const bf16_t* W1 = (const bf16_t*)(A.ws + WS_W + W_C1) + (size_t)kv * 128 * 2048;
    const bf16_t* W2 = (const bf16_t*)(A.ws + WS_W + W_C2) + (size_t)kv * 64 * 128;
    const float* posb = (const float*)(A.ws + WS_POSB) + (l * 2 + kv) * 128;
    const int n = 16 * rg + i16;
    const bf16_t* arow = P + (size_t)(16 * n) * DINP + 8 * quad;
    const bf16_t* wrow1 = W1 + (size_t)i16 * 2048 + 8 * quad;
    f32x4 acc[8];
#pragma unroll
    for (int i = 0; i < 8; ++i) acc[i] = (f32x4){0.f, 0.f, 0.f, 0.f};
#pragma unroll 2
    for (int kk = 0; kk < 8; ++kk) {
        const int ks = 8 * wid + kk;
        const bf16x8 bfrag = *(const bf16x8*)(arow + (size_t)(ks >> 1) * DINP + 32 * (ks & 1));
#pragma unroll
        for (int ht = 0; ht < 8; ++ht) {
            const bf16x8 afrag = *(const bf16x8*)(wrow1 + (size_t)(16 * ht) * 2048 + 32 * ks);
            acc[ht] = MFMA16(afrag, bfrag, acc[ht]);
        }
    }
    {
        LAS float* red = (LAS float*)lds;
        if (wid > 0) {
#pragma unroll
            for (int ht = 0; ht < 8; ++ht)
#pragma unroll
                for (int j = 0; j < 4; ++j) red[(wid * 64 + lane) * 33 + ht * 4 + j] = acc[ht][j];
        }
        __syncthreads();
        if (wid > 0) return;
#pragma unroll 1
        for (int w = 1; w < 8; ++w)
#pragma unroll
            for (int ht = 0; ht < 8; ++ht)
#pragma unroll
                for (int j = 0; j < 4; ++j) acc[ht][j] += red[(w * 64 + lane) * 33 + ht * 4 + j];
    }
    bf16x8 hf[4];
#pragma unroll
    for (int ks2 = 0; ks2 < 4; ++ks2) {
        float v[8];
#pragma unroll
        for (int e = 0; e < 8; ++e) {
            const int ht = 2 * ks2 + (e >> 2), j = e & 3;
            const float x = acc[ht][j] + posb[16 * ht + 4 * quad + j];
            const float u2 = 0.7978845608028654f * (x + 0.044715f * x * x * x);
            const float ex = fast_exp2(2.0f * LOG2E * u2);
            const float th = 1.0f - 2.0f * fast_rcp(ex + 1.0f);
            v[e] = 0.5f * x * (1.0f + th);
        }
        u32x4 w; w.x = cvtpk(v[0], v[1]); w.y = cvtpk(v[2], v[3]); w.z = cvtpk(v[4], v[5]); w.w = cvtpk(v[6], v[7]);
        hf[ks2] = __builtin_bit_cast(bf16x8, w);
    }
    bf16_t* outp = (bf16_t*)(A.ws + WS_KCMP) + ((size_t)(kv * 8 + bg) * 256 + n) * 64;
#pragma unroll
    for (int ot = 0; ot < 4; ++ot) {
        f32x4 c2 = (f32x4){0.f, 0.f, 0.f, 0.f};
        const bf16_t* w2r = W2 + (size_t)(16 * ot + i16) * 128 + 4 * quad;
#pragma unroll
        for (int ks2 = 0; ks2 < 4; ++ks2) {
            const u32x2 lo = *(const u32x2*)(w2r + 32 * ks2), hi = *(const u32x2*)(w2r + 32 * ks2 + 16);
            u32x4 w; w.x = lo.x; w.y = lo.y; w.z = hi.x; w.w = hi.y;
            c2 = MFMA16(__builtin_bit_cast(bf16x8, w), hf[ks2], c2);
        }
        if (n < 255) { u32x2 w; w.x = cvtpk(c2[0], c2[1]); w.y = cvtpk(c2[2], c2[3]); *(u32x2*)(outp + 16 * ot + 4 * quad) = w; }
    }
}

constexpr int CMP_K_OFF = 0, CMP_V_OFF = 36864, CMP_IMP_OFF = 69632;
__device__ __forceinline__ void cmp_unit(const Args& A, int b, int g, int qb, LAS unsigned char* lds, float gmul = 1.0f) {
    const int tid = opq(get_tid()), lane = tid & 63, wid = __builtin_amdgcn_readfirstlane(tid >> 6), r = lane & 31, h = lane >> 5;
    const int q0 = qb * 256, qw0 = q0 + 32 * wid, qpos = qw0 + r, qloc = 32 * wid + r;
    const int ntile = (((q0 + 224) >> 4) >> 6) + 1;
    LAS unsigned char* Kl = lds + CMP_K_OFF; LAS unsigned char* Vl = lds + CMP_V_OFF; LAS float* imp = (LAS float*)(lds + CMP_IMP_OFF);
    const bf16_t* KC = (const bf16_t*)(A.ws + WS_KCMP) + (size_t)(b * 2 + g) * 256 * 64;
    const bf16_t* VC = KC + (size_t)8 * 256 * 64;
    __syncthreads();
    for (int idx = tid; idx < 512 * ntile; idx += NTHR) {
        const int n = idx >> 3, ch = idx & 7;
        u32x4 kx = {0, 0, 0, 0}, vx = {0, 0, 0, 0};
        if (n < 255) { kx = *(const u32x4*)(KC + (size_t)n * 64 + ch * 8); vx = *(const u32x4*)(VC + (size_t)n * 64 + ch * 8); }
        *(LAS u32x4*)(Kl + n * 144 + ch * 16) = kx;
        *(LAS u32x4*)(Vl + (n >> 6) * 8192 + (ch >> 2) * 4096 + (n & 63) * 64 + (ch & 3) * 16) = vx;
    }
    for (int idx = tid; idx < 256 * 65; idx += NTHR) imp[idx] = 0.f;
    __syncthreads();
    const bf16_t* P = (const bf16_t*)(A.ws + WS_U) + (size_t)b * T * DINP;
    const float scale2 = 0.125f * LOG2E;
#pragma unroll 1
    for (int rr = 0; rr < 3; ++rr) {
        const int hh = 3 * g + rr; const float slope2 = nsa_slope(hh) * LOG2E;
        bf16x8 qf[4];
        { const bf16_t* qrow = P + (size_t)qpos * DINP + C_CQ + hh * 64;
#pragma unroll
          for (int ks = 0; ks < 4; ++ks) qf[ks] = *(const bf16x8*)(qrow + 16 * ks + 8 * h); }
        float m = NEGBIG, lsum = 0.f, invl = 0.f;
        f32x16 o[2];
#pragma unroll
        for (int i = 0; i < 16; ++i) { o[0][i] = 0.f; o[1][i] = 0.f; }
#pragma unroll 1
        for (int pass = 0; pass < 2; ++pass) {
#pragma unroll 1
            for (int tt = 0; tt < ntile; ++tt) {
                if (16 * (64 * tt) + 31 > qw0 + 31) continue;
                f32x16 p0, p1;
#pragma unroll
                for (int i = 0; i < 16; ++i) { p0[i] = 0.f; p1[i] = 0.f; }
#pragma unroll
                for (int ks = 0; ks < 4; ++ks) {
                    const bf16x8 a0 = *(const LAS bf16x8*)(Kl + (64 * tt + r) * 144 + ks * 32 + h * 16);
                    const bf16x8 a1 = *(const LAS bf16x8*)(Kl + (64 * tt + 32 + r) * 144 + ks * 32 + h * 16);
                    p0 = MFMA32(a0, qf[ks], p0); p1 = MFMA32(a1, qf[ks], p1);
                }
#pragma unroll
                for (int i = 0; i < 16; ++i) {
                    const int n0 = 64 * tt + crow(i, h), d0 = qpos - (16 * n0 + 31), d1 = d0 - 512;
                    p0[i] = d0 >= 0 ? p0[i] * scale2 - slope2 * (float)d0 : NEGBIG;
                    p1[i] = d1 >= 0 ? p1[i] * scale2 - slope2 * (float)d1 : NEGBIG;
                }
                if (pass == 0) {
                    float mloc = fmaxf(p0[0], p1[0]);
#pragma unroll
                    for (int i = 1; i < 16; ++i) mloc = fmaxf(mloc, fmaxf(p0[i], p1[i]));
                    mloc = fmaxf(mloc, __shfl_xor(mloc, 32));
                    const float mnew = fmaxf(m, mloc), alpha = fast_exp2(m - mnew);
                    m = mnew;
                    float ls = 0.f;
#pragma unroll
                    for (int i = 0; i < 16; ++i) ls += fast_exp2(p0[i] - mnew) + fast_exp2(p1[i] - mnew);
                    lsum = lsum * alpha + ls;
                } else {
#pragma unroll
                    for (int i = 0; i < 16; ++i) {
                        p0[i] = p0[i] > -1e29f ? fast_exp2(p0[i] - m) * invl : 0.f;
                        p1[i] = p1[i] > -1e29f ? fast_exp2(p1[i] - m) * invl : 0.f;
                    }
                    pv_tile(o, p0, p1, Vl + tt * 8192, lane);
#pragma unroll
                    for (int blk = 0; blk < 2; ++blk)
#pragma unroll
                        for (int g4 = 0; g4 < 4; ++g4) {
                            const int j = 16 * tt + 8 * blk + 2 * g4 + h;
                            const float G = blk == 0 ? (p0[4 * g4] + p0[4 * g4 + 1]) + (p0[4 * g4 + 2] + p0[4 * g4 + 3]) : (p1[4 * g4] + p1[4 * g4 + 1]) + (p1[4 * g4 + 2] + p1[4 * g4 + 3]);
                            imp[qloc * 65 + j] += G;
                        }
                    asm volatile("s_waitcnt lgkmcnt(0)" ::: "memory");
#pragma unroll
                    for (int blk = 0; blk < 2; ++blk)
#pragma unroll
                        for (int g4 = 0; g4 < 4; ++g4) {
                            const int j = 16 * tt + 8 * blk + 2 * g4 + h;
                            const float Lst = blk == 0 ? p0[4 * g4 + 3] : p1[4 * g4 + 3];
                            if (j + 1 < 64) imp[qloc * 65 + j + 1] += Lst;
                        }
                    asm volatile("s_waitcnt lgkmcnt(0)" ::: "memory");
                }
            }
            if (pass == 0) { const float lt = lsum + __shfl_xor(lsum, 32); invl = (qpos >= 31) ? 1.0f / lt : 0.f; }
        }
        const float gl = bf2f((short)P[(size_t)qpos * DINP + C_G + 0 * 6 + hh]);
        bf16_t* orow = (bf16_t*)(A.ws + WS_XN) + (size_t)(b * T + qpos) * D + 640 + hh * 64;
        store_o<1>(o, orow, h, EN_CMP ? sigmoid_f(gl) * gmul : 0.0f);
    }
    __syncthreads();
    if (qb < 4) {
        if (tid < 256) { const int t = q0 + tid, cur = t >> 6; ((unsigned long long*)(A.ws + WS_SEL))[(size_t)(b * 2 + g) * T + t] = (1ull << (cur + 1)) - 1ull; }
    } else {
        const int qi = tid >> 1, hf = tid & 1, t = q0 + qi, cur = t >> 6;
        float v[32];
#pragma unroll
        for (int i = 0; i < 32; ++i) { const int j = 32 * hf + i; const float x = imp[qi * 65 + j]; v[i] = (j >= 1 && j <= cur - 2) ? x : -1.0f; }
        unsigned long long mask = 1ull | (1ull << cur) | (1ull << (cur - 1));
#pragma unroll 1
        for (int it = 0; it < 13; ++it) {
            float bv = v[0]; int bi = 0;
#pragma unroll
            for (int i = 1; i < 32; ++i) { const bool gt = v[i] > bv; bv = gt ? v[i] : bv; bi = gt ? i : bi; }
            const float ov = __shfl_xor(bv, 1); const int oi = __shfl_xor(bi, 1);
            const float v0 = hf ? ov : bv, v1 = hf ? bv : ov; const int i0 = hf ? oi : bi, i1 = hf ? bi : oi;
            const bool win0 = v0 >= v1;
            const int wj = win0 ? i0 : 32 + i1;
            mask |= 1ull << wj;
            const int clr = (win0 == (hf == 0)) ? (win0 ? i0 : i1) : -1;
#pragma unroll
            for (int i = 0; i < 32; ++i) v[i] = (i == clr) ? -1.0f : v[i];
        }
        if (hf == 0) ((unsigned long long*)(A.ws + WS_SEL))[(size_t)(b * 2 + g) * T + t] = mask;
    }
    __syncthreads();
}

__device__ __forceinline__ int fetch_unit(unsigned* ctr, LAS unsigned char* lds) {
    volatile LAS int* w = (volatile LAS int*)(lds + FETCH_OFF);
    __syncthreads();
    if (get_tid() == 0) *w = (int)atomicAdd(ctr, 1u);
    __syncthreads();
    return __builtin_amdgcn_readfirstlane(*w);
}
template <class Epi>
__device__ __forceinline__ void run_gemm_counted(LAS unsigned char* lds, const bf16_t* Am, const bf16_t* Bt, int N, int K, const Epi& E, unsigned* cnt) {
    pg8::Gemm g{Am, Bt, M, N, K}; CountedOrder S; S.init(M, N, (int)gridDim.x, (int)blockIdx.x); S.cnt = cnt;
    pg8::gemm_phase<Epi, CountedOrder, true, true>(lds, g, S, E);
}
template <class Epi>
__device__ __forceinline__ void run_gemm_small(LAS unsigned char* lds, const bf16_t* Am, const bf16_t* Bt, int N, int K, const Epi& E) {
    asm volatile("" : "+s"(N), "+s"(K));
    pg8::Gemm g{Am, Bt, M, N, K}; pg8::StaticOrder S; S.init(M, N, (int)gridDim.x, (int)blockIdx.x);
    pg8::gemm_phase<Epi, pg8::StaticOrder, true, true>(lds, g, S, E);
}
template <class Epi>
__device__ __forceinline__ void run_gemm(LAS unsigned char* lds, const bf16_t* Am, const bf16_t* Bt, int N, int K, const Epi& E) {
    pg8::Gemm g{Am, Bt, M, N, K}; pg8::StaticOrder S; S.init(M, N, (int)gridDim.x, (int)blockIdx.x);
    pg8::gemm_phase<Epi, pg8::StaticOrder, true, true>(lds, g, S, E);
}

__global__ void __launch_bounds__(NTHR, 2) fwd_megakernel(Args A) {
    LAS unsigned char* lds = (LAS unsigned char*)lds_raw;
    if (lane_id() == 0) *(volatile LAS int*)(lds + WIDTAB_OFF + 4 * hw_slot()) = (int)(threadIdx.x >> 6);
    __syncthreads();
    cg::grid_group grid = cg::this_grid();
    const int G = gridDim.x;
    { volatile LAS unsigned* st0 = (volatile LAS unsigned*)(lds + FETCH_OFF + 16); if (get_tid() < 2) st0[get_tid()] = 0u; }
    __syncthreads();
#ifdef PROBE_PHASE
    if (get_tid() < 32) { volatile LAS unsigned* ta_ = (volatile LAS unsigned*)(lds + 140000); ta_[get_tid()] = 0u; }
    __syncthreads();
    if (get_tid() == 0) { volatile LAS unsigned* ta_ = (volatile LAS unsigned*)(lds + 140000); ta_[31] = (unsigned)__builtin_amdgcn_s_memrealtime(); }
    __syncthreads();
#endif
    const unsigned xbar_x = (unsigned)__builtin_amdgcn_readfirstlane((int)xcd_barrier_post((unsigned*)(A.ws + WS_CTL) + 1024, (volatile LAS unsigned*)(lds + FETCH_OFF + 16)).x);
#ifdef PROBE_PHASE
#define STAMP(id) do { if (blockIdx.x == 0 && get_tid() == 0) { volatile LAS unsigned* ta_ = (volatile LAS unsigned*)(lds + 140000); const unsigned now_ = (unsigned)__builtin_amdgcn_s_memrealtime(); ta_[id] += now_ - ta_[31]; ta_[31] = now_; } } while (0)
#else
#define STAMP(id) do {} while (0)
#endif
#define GSYNC() do { XcdBarrier xb_; unsigned xx_ = xbar_x; asm volatile("" : "+s"(xx_)); xb_.bar = (unsigned*)(A.ws + WS_CTL) + 1024; xb_.x = xx_; \
                     xb_.st = (volatile LAS unsigned*)(lds + FETCH_OFF + 16); xcd_barrier(xb_); } while (0)
    unsigned char* ws = A.ws;
    unsigned* ctl = (unsigned*)(ws + WS_CTL);
    float* X = A.out;
    bf16_t* XN = (bf16_t*)(ws + WS_XN);
    bf16_t* U = (bf16_t*)(ws + WS_U);
    const float* mods = (const float*)(ws + WS_MODS);

    for (int task = blockIdx.x; task < 288; task += G) mods_task(A, task, lds);
    for (int task = G - 1 - (int)blockIdx.x; task < 64; task += G) posb_task(A, task, lds);
    rope_entries(A);
    { float* ssq = (float*)(ws + WS_SSQ); for (int i = blockIdx.x * NTHR + opq(get_tid()); i < 4 * M; i += G * NTHR) ssq[i] = 0.f; }
    if (blockIdx.x == 0 && get_tid() < 2) {
        const int tid = opq(get_tid());
        const float* lp = A.in[13] + tid * 128; float s1 = 0.f, s2 = 0.f;
        for (int i = 0; i < 32; ++i) { s1 += lp[i] * lp[32 + i]; s2 += lp[64 + i] * lp[96 + i]; }
        const float lam_init = tid == 0 ? 0.2f : 0.35550907f;
        ((float*)ctl)[64 + tid] = expf(s1) - expf(s2) + lam_init;
        ((float*)ctl)[66 + tid] = 1.0f - lam_init;
    }
    __syncthreads();
    convert_layer(A, 0, lds);
#ifdef PROBE_DUPCVT
    for (int i = 0; i < PROBE_DUPCVT; ++i) { __syncthreads(); convert_layer(A, 0, lds); }
#endif
#ifdef PROBE_DUPMODS
    for (int task = blockIdx.x; task < 288; task += G) mods_task(A, task, lds);
#endif
    if (A.out == nullptr) grid.sync();
    GSYNC();
    STAMP(0);

    if (blockIdx.x == 0) posb_final(A);
#pragma unroll 1
    for (int l = 0; l < 2; ++l) {
        const float* modl = mods + (size_t)l * 4 * 9216;
        unsigned char* wb = ws + WS_W;
        if (l == 1) { __syncthreads(); convert_layer(A, 1, lds); }
#pragma unroll 1
        for (int s = 0; s < 2; ++s) {
            const float* xin = (l == 0 && s == 0) ? A.in[0] : X;
            norm_rows(xin, XN, A.in[s == 0 ? 4 : 6] + l * D, modl, s == 0 ? 0 : 6, s == 0 ? 1 : 7);
            GSYNC();
            STAMP(1);
            { EpiSwiGLU E{U}; run_gemm(lds, XN, (const bf16_t*)(wb + (s == 0 ? W_1A : W_2A)), F2, D, E); }
            GSYNC();
            STAMP(2);
            { EpiResid E{xin, X, modl + (s == 0 ? 2 : 8) * 1024, 0.5f}; run_gemm(lds, U, (const bf16_t*)(wb + (s == 0 ? W_1B : W_2B)), D, F, E); }
            GSYNC();
            STAMP(3);
            if (s == 0 && EN_MIX) {
                norm_rows(X, XN, A.in[5] + l * D, modl, 3, 4);
                GSYNC();
                STAMP(4);
                float* ssq = (float*)(ws + WS_SSQ) + (size_t)l * 2 * M;
                { EpiProj E{U, (bf16_t*)(ws + WS_CQ), (bf16_t*)(ws + WS_CKV), ssq, ssq + M, ctl + CTL_KN + l * 96}; run_gemm(lds, XN, (const bf16_t*)(wb + W_IN), DINP, D, E); }
                GSYNC();
                STAMP(5);
                { EpiRowScale E{(bf16_t*)(ws + WS_MQ), 768, ssq, 1.0f / 256.0f}; run_gemm_small(lds, (const bf16_t*)(ws + WS_CQ), (const bf16_t*)(wb + W_UQ), 768, 256, E); }
                { EpiRowScale E{(bf16_t*)(ws + WS_MKV), 768, ssq + M, 1.0f / 128.0f}; run_gemm_small(lds, (const bf16_t*)(ws + WS_CKV), (const bf16_t*)(wb + W_UKV), 768, 128, E); }
                STAMP(11);
                for (;;) {
                    int u = fetch_unit(ctl + l * 4 + 0, lds);
                    if (u >= 64 + 256 + 512 + 384) break;
                    if (u < 512) { da_unit(A, l, (u & 15) >> 2, u & 3, 31 - (u >> 4), lds); continue; } u -= 512;
                    if (u < 384) { nsa_unit<2>(A, l, (u % 24) / 6, u % 6, 15 - u / 24, lds); continue; } u -= 384;
                    if (u < 256) { cmp_mlp_task(A, l, u, lds); continue; } u -= 256;
                    kpe_unit(A, u);
                }
                GSYNC();
                STAMP(6);
                for (;;) {
                    int u = fetch_unit(ctl + l * 4 + 1, lds);
                    if (u >= 384 + 128) break;
                    if (u < 192) { mla_unit(A, (u % 24) / 6, u % 6, 15 - u / 24, lds); continue; } u -= 192;
                    if (u < 128) { cmp_unit(A, (u & 7) >> 1, u & 1, 15 - (u >> 3), lds); continue; } u -= 128;
                    u += 192; mla_unit(A, (u % 24) / 6, u % 6, 15 - u / 24, lds);
                }
                GSYNC();
                STAMP(7);
                for (;;) {
                    const int u = fetch_unit(ctl + l * 4 + 2, lds);
                    if (u >= 384) break;
                    nsa_unit<1>(A, l, (u % 24) / 6, u % 6, 15 - u / 24, lds);
                }
                GSYNC();
                STAMP(8);
                { EpiResid E{X, X, modl + 5 * 1024, 1.0f}; run_gemm(lds, XN, (const bf16_t*)(wb + W_OUT), D, D, E); }
                GSYNC();
                STAMP(9);
            }
        }
    }
    final_norm_rows(X, A.in[22]);
#ifdef PROBE_PHASE
    STAMP(10);
    __syncthreads();
    if (blockIdx.x == 0 && get_tid() == 0) { volatile LAS unsigned* ta_ = (volatile LAS unsigned*)(lds + 140000); X[0] += (float)ta_[PROBE_PHASE] * 0.0001f; }
#endif
#ifdef PROBE_SYNCS
    for (int i = 0; i < PROBE_SYNCS; ++i) GSYNC();
#endif
}

extern "C" void kernel_launch(void* const* d_in, const int* in_sizes, int n_in, void* d_out, int out_size, void* d_ws, size_t ws_size, hipStream_t stream) {
    static int grid = 0;
    if (grid == 0) {
        if (n_in != 23 || out_size != M * D || ws_size < WS_END) { fprintf(stderr, "kernel_launch: unexpected problem shape (n_in %d out %d ws %zu)\n", n_in, out_size, ws_size); grid = -1; return; }
        int dev = 0, cus = 0, per_cu = 0;
        hipGetDevice(&dev);
        hipDeviceGetAttribute(&cus, hipDeviceAttributeMultiprocessorCount, dev);
        hipFuncSetAttribute((const void*)fwd_megakernel, hipFuncAttributeMaxDynamicSharedMemorySize, LDS_BYTES);
        hipOccupancyMaxActiveBlocksPerMultiprocessor(&per_cu, (const void*)fwd_megakernel, NTHR, LDS_BYTES);
        if (per_cu < 1) per_cu = 1;
        grid = cus * per_cu;
        (void)hipGetLastError();
    }
    if (grid < 0) return;
    hipMemsetAsync(d_ws, 0, 32768, stream);
    Args a{};
    for (int i = 0; i < 23; ++i) a.in[i] = (const float*)d_in[i];
    a.out = (float*)d_out; a.ws = (unsigned char*)d_ws;
    void* args[] = {&a};
    hipError_t e = hipLaunchCooperativeKernel((const void*)fwd_megakernel, dim3(grid), dim3(NTHR), args, LDS_BYTES, stream);
    if (e != hipSuccess) fprintf(stderr, "cooperative launch failed: %s (grid %d)\n", hipGetErrorString(e), grid);
}
```
